# Optimizing an MI355X kernel written in HIP

```python
import jax, jax.numpy as jnp
from jax import lax
import numpy as np

D_MODEL = 1024
BATCH = 4
SEQ = 8192
DEPTH = 1

N_HEADS = 8
HEAD_DIM = 64
N_KV = 2
GQA_R = N_HEADS // N_KV
ATTN_WIDTH = N_HEADS * HEAD_DIM
KV_WIDTH = N_KV * HEAD_DIM
CMP_LEN = 32
CMP_STRIDE = 16
CMP_HID = 128
SEL_BLOCK = 64
SEL_TOPN = 16
WINDOW = 512
Q_BLOCK = 128
N_NSA_BRANCH = 3
SGU_WIDTH = 512
N_GROUPS_SGU = 8
SGU_GROUP_DIM = SGU_WIDTH // N_GROUPS_SGU
CHUNK = 128
N_BRANCH = 2
N_EXPERTS = 32
TOP_K = 4
D_FF = D_MODEL
SWIGLU_LIMIT = 7.0
SWIGLU_ALPHA = 1.702
MOE_BLOCK = 512
RMS_EPS = 1e-5
LN_EPS = 1e-5
NEG = -1e30
FORCE = 1e4
D_IN = ATTN_WIDTH + 6 * KV_WIDTH + N_NSA_BRANCH * N_HEADS + 2 * SGU_WIDTH + N_BRANCH * D_MODEL

kernel_name = "hybrid_nsa_sgu_moe_block"


def _split_points():
    p0 = ATTN_WIDTH
    p1 = p0 + 6 * KV_WIDTH
    p2 = p1 + N_NSA_BRANCH * N_HEADS
    p3 = p2 + SGU_WIDTH
    p4 = p3 + SGU_WIDTH
    return [p0, p1, p2, p3, p4]


def rmsnorm(x, g):
    xf = x.astype(jnp.float32)
    y = xf * lax.rsqrt(jnp.mean(xf * xf, axis=-1, keepdims=True) + RMS_EPS)
    return (y * g.astype(jnp.float32)).astype(x.dtype)


def layernorm(x, g, b):
    xf = x.astype(jnp.float32)
    mu = jnp.mean(xf, axis=-1, keepdims=True)
    var = jnp.mean(jnp.square(xf - mu), axis=-1, keepdims=True)
    y = (xf - mu) * lax.rsqrt(var + LN_EPS)
    return (y * g.astype(jnp.float32) + b.astype(jnp.float32)).astype(x.dtype)


def _masked_softmax(s, mask):
    return jax.nn.softmax(jnp.where(mask, s, NEG), axis=-1)


def _alibi_slopes():
    s = 2.0 ** (-8.0 * np.arange(1, N_HEADS + 1) / N_HEADS)
    return jnp.asarray(s, jnp.float32).reshape(N_KV, GQA_R)


def _cmp_to_sel_overlap(n_cmp, n_sel):
    cs = np.arange(n_cmp)[:, None] * CMP_STRIDE
    ss = np.arange(n_sel)[None, :] * SEL_BLOCK
    ov = np.clip(np.minimum(cs + CMP_LEN, ss + SEL_BLOCK) - np.maximum(cs, ss), 0, None)
    return jnp.asarray(ov / CMP_LEN, jnp.float32)


def _compress(k, w1, b1, w2, pe):
    S = k.shape[1]
    n_cmp = (S - CMP_LEN) // CMP_STRIDE + 1
    idx = np.arange(n_cmp)[:, None] * CMP_STRIDE + np.arange(CMP_LEN)[None, :]
    blk = k[:, idx] + pe[None, None, :, None, :]
    hid = jax.nn.gelu(jnp.einsum('bnlgd,ldf->bngf', blk, w1) + b1)
    return jnp.einsum('bngf,fd->bngd', hid, w2)


def nsa_attention(q, kc, vc, ks, vs, kw, vw, gate_logits,
                  w_ck1, b_ck1, w_ck2, pe_k, w_cv1, b_cv1, w_cv2, pe_v):
    B, S = q.shape[0], q.shape[1]
    n_cmp = (S - CMP_LEN) // CMP_STRIDE + 1
    n_sel = S // SEL_BLOCK
    top_n = min(SEL_TOPN, n_sel)
    n_qb = S // Q_BLOCK
    scale = HEAD_DIM ** -0.5
    slopes = _alibi_slopes()[:, :, None, None]

    k_cmp = _compress(kc, w_ck1, b_ck1, w_ck2, pe_k)
    v_cmp = _compress(vc, w_cv1, b_cv1, w_cv2, pe_v)
    c_pos = jnp.arange(n_cmp, dtype=jnp.float32) * CMP_STRIDE + (CMP_LEN - 1) / 2.0
    c_end = jnp.arange(n_cmp) * CMP_STRIDE + CMP_LEN - 1
    overlap = _cmp_to_sel_overlap(n_cmp, n_sel)

    ks_blk = ks.reshape(B, n_sel, SEL_BLOCK, N_KV, HEAD_DIM).transpose(0, 3, 1, 2, 4)
    vs_blk = vs.reshape(B, n_sel, SEL_BLOCK, N_KV, HEAD_DIM).transpose(0, 3, 1, 2, 4)
    kw_pad = jnp.pad(kw, ((0, 0), (WINDOW, 0), (0, 0), (0, 0)))
    vw_pad = jnp.pad(vw, ((0, 0), (WINDOW, 0), (0, 0), (0, 0)))

    qb = q.reshape(B, n_qb, Q_BLOCK, N_KV, GQA_R, HEAD_DIM).transpose(1, 0, 2, 3, 4, 5)
    gb = jax.nn.sigmoid(gate_logits.astype(jnp.float32)).reshape(
        B, n_qb, Q_BLOCK, N_KV, GQA_R, N_NSA_BRANCH).transpose(1, 0, 2, 3, 4, 5)
    b_ix = jnp.arange(B)[:, None, None, None]
    g_ix = jnp.arange(N_KV)[None, :, None, None]
    j_sel = jnp.arange(n_sel)

    def block(args):
        i, qi, gi = args
        t = i * Q_BLOCK + jnp.arange(Q_BLOCK)
        tf = t.astype(jnp.float32)
        s_c = jnp.einsum('bqgrd,bngd->bgrqn', qi, k_cmp).astype(jnp.float32) * scale \
            - slopes * (tf[:, None] - c_pos[None, :])
        p_c = _masked_softmax(s_c, c_end[None, :] <= t[:, None]) \
            * (t >= CMP_LEN - 1).astype(jnp.float32)[:, None]
        o_c = jnp.einsum('bgrqn,bngd->bqgrd', p_c.astype(v_cmp.dtype), v_cmp)
        imp = jnp.einsum('bgrqn,nj->bgqj', p_c, overlap)
        cur = (t // SEL_BLOCK)[:, None]
        forced = (j_sel[None] == 0) | (j_sel[None] == cur) | (j_sel[None] == cur - 1)
        causal_blk = j_sel[None] * SEL_BLOCK <= t[:, None]
        prio = jnp.where(forced, FORCE, jnp.where(causal_blk, imp, -1.0))
        _, sel = lax.top_k(prio, top_n)
        k_sel = ks_blk[b_ix, g_ix, sel].reshape(B, N_KV, Q_BLOCK, top_n * SEL_BLOCK, HEAD_DIM)
        v_sel = vs_blk[b_ix, g_ix, sel].reshape(B, N_KV, Q_BLOCK, top_n * SEL_BLOCK, HEAD_DIM)
        s_pos = (sel[..., None] * SEL_BLOCK + jnp.arange(SEL_BLOCK)).reshape(B, N_KV, Q_BLOCK, top_n * SEL_BLOCK)
        d_sel = (tf[None, None, :, None] - s_pos.astype(jnp.float32))[:, :, None]
        s_s = jnp.einsum('bqgrd,bgqkd->bgrqk', qi, k_sel).astype(jnp.float32) * scale - slopes * d_sel
        p_s = _masked_softmax(s_s, d_sel >= 0)
        o_s = jnp.einsum('bgrqk,bgqkd->bqgrd', p_s.astype(v_sel.dtype), v_sel)
        k_win = lax.dynamic_slice_in_dim(kw_pad, i * Q_BLOCK, WINDOW + Q_BLOCK, axis=1)
        v_win = lax.dynamic_slice_in_dim(vw_pad, i * Q_BLOCK, WINDOW + Q_BLOCK, axis=1)
        w_pos = i * Q_BLOCK - WINDOW + jnp.arange(WINDOW + Q_BLOCK)
        dist = t[:, None] - w_pos[None, :]
        mask_w = (dist >= 0) & (dist < WINDOW) & (w_pos[None, :] >= 0)
        s_w = jnp.einsum('bqgrd,bkgd->bgrqk', qi, k_win).astype(jnp.float32) * scale \
            - slopes * dist.astype(jnp.float32)
        p_w = _masked_softmax(s_w, mask_w)
        o_w = jnp.einsum('bgrqk,bkgd->bqgrd', p_w.astype(v_win.dtype), v_win)
        o = gi[..., 0:1] * o_c + gi[..., 1:2] * o_s + gi[..., 2:3] * o_w
        return o.reshape(B, Q_BLOCK, ATTN_WIDTH).astype(qi.dtype)

    out = lax.map(block, (jnp.arange(n_qb), qb, gb))
    return out.transpose(1, 0, 2, 3).reshape(B, S, ATTN_WIDTH)


def spatial_gating(u, v, ln_g, ln_b, w_s, b_s):
    B, S = u.shape[0], u.shape[1]
    u = jax.nn.gelu(u)
    v = layernorm(jax.nn.gelu(v), ln_g, ln_b)
    vc = v.reshape(B, S // CHUNK, CHUNK, N_GROUPS_SGU, SGU_GROUP_DIM)
    w = w_s * jnp.tril(jnp.ones((CHUNK, CHUNK), w_s.dtype))
    mixed = jnp.einsum('gts,bcsgd->bctgd', w, vc) + b_s.T[:, :, None]
    return u * mixed.reshape(B, S, SGU_WIDTH)


def moe(x, w_router, b_router, w_gu, b_gu, w_down, b_down):
    B, S, D = x.shape
    n_tok = B * S
    xt = x.reshape(n_tok, D)
    logits = (xt @ w_router + b_router).astype(jnp.float32)
    top_val, top_idx = lax.top_k(logits, TOP_K)
    top_w = jax.nn.softmax(top_val, axis=-1)
    n_assign = n_tok * TOP_K
    e_flat = top_idx.reshape(-1)
    tok_flat = jnp.repeat(jnp.arange(n_tok, dtype=jnp.int32), TOP_K)
    w_flat = top_w.reshape(-1)
    order = jnp.argsort(e_flat)
    e_sorted, tok_sorted, w_sorted = e_flat[order], tok_flat[order], w_flat[order]
    counts = jnp.bincount(e_flat, length=N_EXPERTS)
    start = jnp.cumsum(counts) - counts
    padded = (counts + MOE_BLOCK - 1) // MOE_BLOCK * MOE_BLOCK
    pad_end = jnp.cumsum(padded)
    pad_start = pad_end - padded
    dest = pad_start[e_sorted] + jnp.arange(n_assign) - start[e_sorted]
    n_blocks = -(-n_assign // MOE_BLOCK) + N_EXPERTS
    n_slots = n_blocks * MOE_BLOCK
    slot_tok = jnp.zeros((n_slots,), jnp.int32).at[dest].set(tok_sorted)
    slot_w = jnp.zeros((n_slots,), jnp.float32).at[dest].set(w_sorted)
    blk_expert = jnp.minimum(jnp.searchsorted(pad_end, jnp.arange(n_blocks) * MOE_BLOCK, side='right'),
                             N_EXPERTS - 1)

    def expert_block(args):
        e, toks, wts = args
        xb = xt[toks]
        gu = xb @ w_gu[e] + b_gu[e]
        gate = jnp.minimum(gu[:, :D_FF], SWIGLU_LIMIT)
        up = jnp.clip(gu[:, D_FF:], -SWIGLU_LIMIT, SWIGLU_LIMIT)
        act = gate * jax.nn.sigmoid(SWIGLU_ALPHA * gate) * (up + 1.0)
        y = act @ w_down[e] + b_down[e]
        return y * wts[:, None].astype(y.dtype)

    y_slots = lax.map(expert_block, (blk_expert, slot_tok.reshape(n_blocks, MOE_BLOCK),
                                     slot_w.reshape(n_blocks, MOE_BLOCK)))
    out = jnp.zeros_like(xt).at[slot_tok].add(y_slots.reshape(n_slots, D).astype(xt.dtype))
    return out.reshape(B, S, D)


def setup_inputs(seed: int = 0) -> dict:
    key = jax.random.key(seed)
    ks = jax.random.split(key, 32)
    f32 = jnp.float32

    def nrm(k, shape, scale):
        return jax.random.normal(k, shape, f32) * scale

    L = DEPTH
    return {
        "x": nrm(ks[0], (BATCH, SEQ, D_MODEL), 1.0),
        "g_mix": 1.0 + nrm(ks[1], (L, D_MODEL), 0.01),
        "w_in": nrm(ks[2], (L, D_MODEL, D_IN), D_MODEL ** -0.5),
        "w_ck1": nrm(ks[3], (L, CMP_LEN, HEAD_DIM, CMP_HID), (CMP_LEN * HEAD_DIM) ** -0.5),
        "b_ck1": nrm(ks[4], (L, CMP_HID), 0.01),
        "w_ck2": nrm(ks[5], (L, CMP_HID, HEAD_DIM), CMP_HID ** -0.5),
        "pe_k": nrm(ks[6], (L, CMP_LEN, HEAD_DIM), 0.02),
        "w_cv1": nrm(ks[7], (L, CMP_LEN, HEAD_DIM, CMP_HID), (CMP_LEN * HEAD_DIM) ** -0.5),
        "b_cv1": nrm(ks[8], (L, CMP_HID), 0.01),
        "w_cv2": nrm(ks[9], (L, CMP_HID, HEAD_DIM), CMP_HID ** -0.5),
        "pe_v": nrm(ks[10], (L, CMP_LEN, HEAD_DIM), 0.02),
        "sgu_ln_g": 1.0 + nrm(ks[11], (L, SGU_WIDTH), 0.01),
        "sgu_ln_b": nrm(ks[12], (L, SGU_WIDTH), 0.01),
        "w_spatial": nrm(ks[13], (L, N_GROUPS_SGU, CHUNK, CHUNK), CHUNK ** -0.5),
        "b_spatial": 1.0 + nrm(ks[14], (L, N_GROUPS_SGU, CHUNK), 0.1),
        "w_branch_a": nrm(ks[15], (L, ATTN_WIDTH, D_MODEL), ATTN_WIDTH ** -0.5),
        "w_branch_b": nrm(ks[16], (L, SGU_WIDTH, D_MODEL), SGU_WIDTH ** -0.5),
        "w_out": nrm(ks[17], (L, D_MODEL, D_MODEL), D_MODEL ** -0.5),
        "g_moe": 1.0 + nrm(ks[18], (L, D_MODEL), 0.01),
        "w_router": nrm(ks[19], (L, D_MODEL, N_EXPERTS), D_MODEL ** -0.5),
        "b_router": nrm(ks[20], (L, N_EXPERTS), 0.01),
        "w_gate_up": nrm(ks[21], (L, N_EXPERTS, D_MODEL, 2 * D_FF), D_MODEL ** -0.5),
        "b_gate_up": nrm(ks[22], (L, N_EXPERTS, 2 * D_FF), 0.01),
        "w_down": nrm(ks[23], (L, N_EXPERTS, D_FF, D_MODEL), D_FF ** -0.5),
        "b_down": nrm(ks[24], (L, N_EXPERTS, D_MODEL), 0.01),
        "g_final": 1.0 + nrm(ks[25], (D_MODEL,), 0.01),
    }


def reference(x, g_mix, w_in, w_ck1, b_ck1, w_ck2, pe_k, w_cv1, b_cv1, w_cv2, pe_v,
              sgu_ln_g, sgu_ln_b, w_spatial, b_spatial, w_branch_a, w_branch_b, w_out,
              g_moe, w_router, b_router, w_gate_up, b_gate_up, w_down, b_down, g_final):
    B, S = x.shape[0], x.shape[1]
    for l in range(DEPTH):
        h = rmsnorm(x, g_mix[l])
        proj = h @ w_in[l]
        q, kv, ng, u, v, mg = jnp.split(proj, _split_points(), axis=-1)
        q = q.reshape(B, S, N_KV, GQA_R, HEAD_DIM)
        kv = kv.reshape(B, S, 6, N_KV, HEAD_DIM)
        ng = ng.reshape(B, S, N_KV, GQA_R, N_NSA_BRANCH)
        y_a = nsa_attention(q, kv[:, :, 0], kv[:, :, 1], kv[:, :, 2], kv[:, :, 3], kv[:, :, 4], kv[:, :, 5], ng,
                            w_ck1[l], b_ck1[l], w_ck2[l], pe_k[l], w_cv1[l], b_cv1[l], w_cv2[l], pe_v[l])
        y_b = spatial_gating(u, v, sgu_ln_g[l], sgu_ln_b[l], w_spatial[l], b_spatial[l])
        g_a, g_b = jnp.split(jax.nn.sigmoid(mg), 2, axis=-1)
        merged = g_a * (y_a @ w_branch_a[l]) + g_b * (y_b @ w_branch_b[l])
        x = x + merged @ w_out[l]
        x = x + moe(rmsnorm(x, g_moe[l]), w_router[l], b_router[l], w_gate_up[l], b_gate_up[l],
                    w_down[l], b_down[l])
    return rmsnorm(x, g_final)
```

```cpp
#include <hip/hip_runtime.h>
#include <hip/hip_cooperative_groups.h>
#include <cstdio>
#include <cstdint>
namespace cg = cooperative_groups;
namespace pg8 {
#define PG8_LAS __attribute__((address_space(3)))
typedef unsigned short bf16_t;
typedef short bf16x8 __attribute__((ext_vector_type(8)));
typedef float f32x4 __attribute__((ext_vector_type(4)));
typedef unsigned u32x4 __attribute__((ext_vector_type(4)));
constexpr int BM = 256, BK = 64, HALF = 128, HTB = HALF * BK * 2  , STAGE_BYTES = 8 * HTB, NXCD = 8, WGM = 8;

__host__ __device__ __forceinline__ int lds_byte(int r, int c) { const int st = (r >> 4) * 2 + (c >> 5), rr = r & 15, cc = c & 31, ob = rr * 64 + cc * 2; return st * 1024 + (ob ^ (((ob >> 9) & 1) << 5)); }
__host__ __device__ __forceinline__ void stage_rc(int b, int& R, int& C) { const int st = b / 1024, sb = b % 1024, swz = sb ^ (((sb >> 9) & 1) << 5); R = (st >> 1) * 16 + swz / 64; C = (st & 1) * 32 + (swz % 64) / 2; }
__host__ __device__ __forceinline__ int perm32(int rho) { const int n = rho >> 4, i = rho & 15; return 8 * (i >> 2) + 4 * n + (i & 3); }

struct Unit { int pm, pn; };
struct Gemm { const bf16_t* A; const bf16_t* Bt; int M, N, K; };

struct StaticOrder {
    int nM, nN, nwg, G, c;
    __host__ __device__ void init(int M, int N, int G_, int c_) { nM = M / BM; nN = N / BM; nwg = nM * nN; G = G_; c = c_; }
    __host__ __device__ bool next(int i, Unit& u) const {
        const long L = (long)i * G + c; if (L >= nwg) return false;
        int wgid = (int)L; { const int q = nwg / NXCD, r = nwg % NXCD, xcd = wgid % NXCD, off = wgid / NXCD; wgid = (xcd < r ? xcd * (q + 1) : r * (q + 1) + (xcd - r) * q) + off; }
        const int nig = WGM * nN, gid = wgid / nig, fm = gid * WGM, gsz = (nM - fm) < WGM ? (nM - fm) : WGM;
        u.pm = fm + ((wgid % nig) % gsz); u.pn = (wgid % nig) / gsz; return true;
    }
    __device__ __forceinline__ void a_ready(const Unit&) const {}
    __device__ __forceinline__ void done(const Unit&) const {}
};

__device__ __forceinline__ unsigned cvt_pk_bf16(float lo, float hi) { unsigned r; asm volatile("v_cvt_pk_bf16_f32 %0, %1, %2" : "=v"(r) : "v"(lo), "v"(hi)); return r; }
typedef float f32x2 __attribute__((ext_vector_type(2)));
template <class Epi, class Sched, bool ALIGN_EPI = false, bool SP2 = false>
__device__ __forceinline__ void gemm_phase(PG8_LAS unsigned char* lds, const Gemm g, const Sched& S, const Epi& E) {
    const int tid = threadIdx.x, wid = __builtin_amdgcn_readfirstlane(tid >> 6), lane = tid & 63, wr = wid >> 2, wc = wid & 3, fr = lane & 15, fq = lane >> 4;
    const int K = g.K, nt = K / BK;
    unsigned voffA[2], voffB[2];
#pragma unroll
    for (int i = 0; i < 2; ++i) { int R, C; stage_rc(tid * 16 + i * 8192, R, C); const int Rb = Epi::PERM ? ((R & ~31) + perm32(R & 31)) : R;
        voffA[i] = (unsigned)(R * K + C) * 2u; voffB[i] = (unsigned)(Rb * K + C) * 2u; }
    const size_t kstep = (size_t)(BK * 2);
    const size_t hstep = (size_t)HALF * K * 2;
    const size_t tstep = 2 * hstep;
    const unsigned ldsw = (unsigned)wid * 1024u;
    const int aoff = lds_byte(wr * 64 + fr, fq * 8), boff = lds_byte(wc * 32 + fr, fq * 8);
#define PG8_SA(b, h) (((b) * 2 + (h)) * HTB)
#define PG8_SB(b, h) ((4 + (b) * 2 + (h)) * HTB)
#define PG8_STAGE(bufoff, gbase, voff) do { _Pragma("unroll") for (int _i = 0; _i < 2; ++_i) \
        __builtin_amdgcn_global_load_lds((const unsigned*)((const char*)(gbase) + (voff)[_i]), (PG8_LAS unsigned*)(lds + (bufoff) + ldsw + _i * 8192), 16, 0, 0); } while (0)
#define PG8_LDA(dst, b, h) do { _Pragma("unroll") for (int m = 0; m < 4; ++m) _Pragma("unroll") for (int k = 0; k < 2; ++k) dst[m][k] = *(const PG8_LAS bf16x8*)(lds + PG8_SA(b, h) + aoff + m * 2048 + k * 1024); } while (0)
#define PG8_LDB(dst, b, h) do { _Pragma("unroll") for (int n = 0; n < 2; ++n) _Pragma("unroll") for (int k = 0; k < 2; ++k) dst[n][k] = *(const PG8_LAS bf16x8*)(lds + PG8_SB(b, h) + boff + n * 2048 + k * 1024); } while (0)
#define PG8_MMA(ai, bj, At, Bt) do { __builtin_amdgcn_s_setprio(1); _Pragma("unroll") for (int m = 0; m < 4; ++m) _Pragma("unroll") for (int n = 0; n < 2; ++n) _Pragma("unroll") for (int k = 0; k < 2; ++k) \
        acc[ai][bj][m][n] = __builtin_amdgcn_mfma_f32_16x16x32_bf16(Bt[n][k], At[m][k], acc[ai][bj][m][n], 0, 0, 0); __builtin_amdgcn_s_setprio(0); } while (0)
#define PG8_WAIT_V(n) asm volatile("s_waitcnt vmcnt(" #n ")" ::: "memory")
#define PG8_WAIT_L(n) asm volatile("s_waitcnt lgkmcnt(" #n ")" ::: "memory")
#define PG8_BAR __builtin_amdgcn_s_barrier()
#define PG8_SCHED __builtin_amdgcn_sched_barrier(0)
    Unit cur, nxt; int ui = 0;
    if (!S.next(0, cur)) return;
    f32x4 acc[2][2][4][2];
#pragma unroll
    for (int a = 0; a < 2; ++a)
#pragma unroll
        for (int b = 0; b < 2; ++b)
#pragma unroll
            for (int m = 0; m < 4; ++m)
#pragma unroll
                for (int n = 0; n < 2; ++n) acc[a][b][m][n] = (f32x4){0.f, 0.f, 0.f, 0.f};
    bf16x8 At[4][2], B0[2][2], B1[2][2];
    const char* cA = (const char*)g.A + (size_t)cur.pm * tstep; const char* cB = (const char*)g.Bt + (size_t)cur.pn * tstep;
    S.a_ready(cur);
    if constexpr (SP2) {
        PG8_STAGE(PG8_SB(0, 0), cB, voffB); PG8_STAGE(PG8_SB(0, 1), cB + hstep, voffB); PG8_STAGE(PG8_SA(0, 0), cA, voffA); PG8_STAGE(PG8_SA(0, 1), cA + hstep, voffA);
        if (wr == 1) PG8_BAR;
        PG8_WAIT_V(2); PG8_BAR;
        PG8_STAGE(PG8_SB(1, 0), cB + kstep, voffB); PG8_STAGE(PG8_SA(1, 0), cA + kstep, voffA); PG8_STAGE(PG8_SB(1, 1), cB + hstep + kstep, voffB);
        PG8_WAIT_V(6); PG8_BAR;
    } else {
        PG8_STAGE(PG8_SB(0, 0), cB, voffB); PG8_STAGE(PG8_SA(0, 0), cA, voffA); PG8_STAGE(PG8_SB(0, 1), cB + hstep, voffB); PG8_STAGE(PG8_SA(0, 1), cA + hstep, voffA);
        if (wr == 1) PG8_BAR;
        PG8_WAIT_V(4); PG8_BAR;
        PG8_STAGE(PG8_SB(1, 0), cB + kstep, voffB); PG8_STAGE(PG8_SA(1, 0), cA + kstep, voffA); PG8_STAGE(PG8_SB(1, 1), cB + hstep + kstep, voffB);
        PG8_WAIT_V(6); PG8_BAR;
    }
    for (;;) {
        const bool has_next = S.next(ui + 1, nxt);
        const char* nA = has_next ? (const char*)g.A + (size_t)nxt.pm * tstep : cA; const char* nB = has_next ? (const char*)g.Bt + (size_t)nxt.pn * tstep : cB;
        for (int t = 0; t < nt; t += 2) {
            const bool last = (t == nt - 2);
            const char* a1 = cA + (size_t)(t + 1) * kstep;
            const char* a2 = last ? nA : cA + (size_t)(t + 2) * kstep; const char* b2 = last ? nB : cB + (size_t)(t + 2) * kstep;
            const char* a3 = a2 + kstep; const char* b3 = b2 + kstep;
            if (last && has_next) S.a_ready(nxt);
            if constexpr (SP2) {
            PG8_LDB(B0, 0, 0); PG8_LDB(B1, 0, 1); PG8_SCHED; PG8_LDA(At, 0, 0); PG8_STAGE(PG8_SA(1, 1), a1 + hstep, voffA);
            PG8_WAIT_V(8); PG8_WAIT_L(0); PG8_BAR; PG8_MMA(0, 0, At, B0); PG8_MMA(0, 1, At, B1); PG8_BAR; PG8_SCHED;
            PG8_LDA(At, 0, 1); PG8_STAGE(PG8_SB(0, 0), b2, voffB); PG8_STAGE(PG8_SB(0, 1), b2 + hstep, voffB); PG8_STAGE(PG8_SA(0, 0), a2, voffA);
            PG8_WAIT_V(8); PG8_WAIT_L(0); PG8_BAR; PG8_MMA(1, 0, At, B0); PG8_MMA(1, 1, At, B1); PG8_BAR; PG8_SCHED;
            PG8_LDB(B0, 1, 0); PG8_LDB(B1, 1, 1); PG8_SCHED; PG8_LDA(At, 1, 0); PG8_STAGE(PG8_SA(0, 1), a2 + hstep, voffA);
            PG8_WAIT_V(8); PG8_WAIT_L(0); PG8_BAR; PG8_MMA(0, 0, At, B0); PG8_MMA(0, 1, At, B1); PG8_BAR; PG8_SCHED;
            PG8_LDA(At, 1, 1); PG8_STAGE(PG8_SB(1, 0), b3, voffB); PG8_STAGE(PG8_SB(1, 1), b3 + hstep, voffB); PG8_STAGE(PG8_SA(1, 0), a3, voffA);
            PG8_WAIT_V(8); PG8_WAIT_L(0); PG8_BAR; PG8_MMA(1, 0, At, B0); PG8_MMA(1, 1, At, B1); PG8_BAR; PG8_SCHED;
            } else {
            PG8_LDB(B0, 0, 0); PG8_SCHED; PG8_LDA(At, 0, 0); PG8_STAGE(PG8_SA(1, 1), a1 + hstep, voffA);
            PG8_WAIT_L(8); PG8_BAR; PG8_WAIT_L(0); PG8_MMA(0, 0, At, B0); PG8_BAR; PG8_SCHED;
            PG8_LDB(B1, 0, 1); PG8_STAGE(PG8_SB(0, 0), b2, voffB);
            PG8_BAR; PG8_WAIT_L(0); PG8_MMA(0, 1, At, B1); PG8_BAR;
            PG8_LDA(At, 0, 1); PG8_STAGE(PG8_SA(0, 0), a2, voffA);
            PG8_BAR; PG8_WAIT_L(0); PG8_MMA(1, 0, At, B0); PG8_BAR; PG8_SCHED;
            PG8_STAGE(PG8_SB(0, 1), b2 + hstep, voffB);
            PG8_WAIT_V(6); PG8_BAR; PG8_MMA(1, 1, At, B1); PG8_BAR;
            PG8_LDB(B0, 1, 0); PG8_SCHED; PG8_LDA(At, 1, 0); PG8_STAGE(PG8_SA(0, 1), a2 + hstep, voffA);
            PG8_WAIT_L(8); PG8_BAR; PG8_WAIT_L(0); PG8_MMA(0, 0, At, B0); PG8_BAR; PG8_SCHED;
            PG8_LDB(B1, 1, 1); PG8_STAGE(PG8_SB(1, 0), b3, voffB);
            PG8_BAR; PG8_WAIT_L(0); PG8_MMA(0, 1, At, B1); PG8_BAR;
            PG8_LDA(At, 1, 1); PG8_STAGE(PG8_SA(1, 0), a3, voffA);
            PG8_BAR; PG8_WAIT_L(0); PG8_MMA(1, 0, At, B0); PG8_BAR; PG8_SCHED;
            PG8_STAGE(PG8_SB(1, 1), b3 + hstep, voffB);
            PG8_WAIT_V(6); PG8_BAR; PG8_MMA(1, 1, At, B1); PG8_BAR;
            }
        }
        if constexpr (ALIGN_EPI) { if (wr == 0) PG8_BAR; }
        if constexpr (!Epi::AFTER_DRAIN) { E(acc, cur, wr, wc, fr, fq); S.done(cur); }
        if (!has_next) break;
#pragma unroll
        for (int a = 0; a < 2; ++a)
#pragma unroll
            for (int b = 0; b < 2; ++b)
#pragma unroll
                for (int m = 0; m < 4; ++m)
#pragma unroll
                    for (int n = 0; n < 2; ++n) acc[a][b][m][n] = (f32x4){0.f, 0.f, 0.f, 0.f};
        cur = nxt; cA = nA; cB = nB; ++ui;
        if constexpr (ALIGN_EPI) { if (wr == 1) PG8_BAR; }
    }
    PG8_WAIT_V(0);
    if constexpr (!ALIGN_EPI) { if (wr == 0) PG8_BAR; }
    PG8_BAR;
    if constexpr (Epi::AFTER_DRAIN) { E.fused(acc, cur, wr, wc, fr, fq, lds, wid, lane); S.done(cur); }
#undef PG8_SA
#undef PG8_SB
#undef PG8_STAGE
#undef PG8_LDA
#undef PG8_LDB
#undef PG8_MMA
#undef PG8_WAIT_V
#undef PG8_WAIT_L
#undef PG8_BAR
#undef PG8_SCHED
}
}

#define LAS __attribute__((address_space(3)))
#define DI __device__ __forceinline__
typedef unsigned short bf16_t;
typedef short bf16x8 __attribute__((ext_vector_type(8)));
typedef short s16x4 __attribute__((ext_vector_type(4)));
typedef float f32x4 __attribute__((ext_vector_type(4)));
typedef float f32x16 __attribute__((ext_vector_type(16)));
typedef unsigned u32x4 __attribute__((ext_vector_type(4)));
typedef unsigned u32x2 __attribute__((ext_vector_type(2)));

#ifndef SKIP_ATTN
#define SKIP_ATTN 0
#endif
#ifndef SKIP_SGU
#define SKIP_SGU 0
#endif
#ifndef SKIP_MOE
#define SKIP_MOE 0
#endif
#ifndef PH_MASK
#define PH_MASK 0x3ff
#endif
#define PH(x) ((PH_MASK >> (x)) & 1)
#ifndef NO_P6A
#define NO_P6A 0
#endif
#ifndef NO_P6B
#define NO_P6B 0
#endif
#ifndef ATTN_BRANCHES
#define ATTN_BRANCHES 7
#endif

constexpr int NB = 4, SEQ = 8192, MTOK = NB * SEQ, DM = 1024;
constexpr int DIN = 4376, NPROJ = 4608;
constexpr int NEXP = 32, DFF = 1024;
constexpr int MPAD = 131072 + 32 * 256;
constexpr float LOG2E = 1.4426950408889634f;
constexpr float QSCALE = 0.125f * LOG2E;
constexpr float NEGBIG = -1e30f;

constexpr size_t MiB = 1u << 20;
constexpr size_t WS_CTL = 0;
constexpr size_t CTL_CNT = 0;
constexpr size_t CTL_TE = 64 * 1024;
constexpr size_t CTL_NT = 96 * 1024;
constexpr size_t CTL_C1 = 128 * 1024;
constexpr size_t WS_WIN = 1 * MiB, WS_WAB = 10 * MiB, WS_WOUT = 12 * MiB, WS_W1K = 14 * MiB, WS_W1V = 14 * MiB + 512 * 1024;
constexpr size_t WS_W2K = 15 * MiB, WS_W2V = 15 * MiB + 64 * 1024, WS_WTRIL = 15 * MiB + 512 * 1024;
constexpr size_t WS_WGU = 16 * MiB, WS_WD = 144 * MiB, WS_X2 = 208 * MiB;
constexpr size_t WS_H1 = 336 * MiB, WS_Q = 400 * MiB, WS_KV = 432 * MiB, WS_U = 480 * MiB, WS_V = 512 * MiB, WS_MG = 544 * MiB;
constexpr size_t WS_NG = 672 * MiB, WS_KCMP = 676 * MiB, WS_VCMP = 676 * MiB + 512 * 1024, WS_YAB = 678 * MiB, WS_MERGED = 742 * MiB;
constexpr size_t WS_AS = 336 * MiB, WS_Y = 336 * MiB, WS_ACT = 608 * MiB, WS_H2 = 608 * MiB;
constexpr size_t WS_TOKE = 880 * MiB, WS_TOKW = 881 * MiB, WS_SLOT = 882 * MiB, WS_WSLOT = 883 * MiB;
constexpr size_t WS_RINV = 884 * MiB;
constexpr size_t WS_END = 885 * MiB;

constexpr int LDS_BYTES = 147456;
constexpr int NWAVES = 8, NTHREADS = 512;

struct Args { const float* in[26]; float* out; unsigned char* ws; };

DI float bf2f(unsigned b) { return __uint_as_float(b << 16); }
DI unsigned pk2(float lo, float hi) {
    typedef float f2_t __attribute__((ext_vector_type(2))); typedef __bf16 b2_t __attribute__((ext_vector_type(2)));
    f2_t v = {lo, hi}; b2_t b = __builtin_convertvector(v, b2_t); return __builtin_bit_cast(unsigned, b);
}
DI unsigned short f2bf(float x) { return (unsigned short)(pk2(x, 0.f) & 0xffffu); }
DI float ex2(float x) { return __builtin_amdgcn_exp2f(x); }
DI float rcpf_(float x) { return __builtin_amdgcn_rcpf(x); }
DI float sigm(float x) { return rcpf_(1.f + ex2(-LOG2E * x)); }
DI float gelu_t(float x) { const float u = 0.7978845608028654f * (x + 0.044715f * x * x * x); return x * rcpf_(1.f + ex2(-2.f * LOG2E * u)); }
DI float wave_sum(float v) {
#pragma unroll
    for (int o = 1; o < 64; o <<= 1) v += __shfl_xor(v, o);
    return v;
}
DI float wave_max(float v) {
#pragma unroll
    for (int o = 1; o < 64; o <<= 1) v = fmaxf(v, __shfl_xor(v, o));
    return v;
}
DI int crow(int i, int h) { return (i & 3) + 8 * (i >> 2) + 4 * h; }
#define MFMA32(a, b, c) __builtin_amdgcn_mfma_f32_32x32x16_bf16((a), (b), (c), 0, 0, 0)
DI void lds_wait() { asm volatile("s_waitcnt lgkmcnt(0)" ::: "memory"); }

template <class RowMap>
DI void transpose_item(const float* __restrict__ W, int K, int N, bf16_t* __restrict__ WT, const float* __restrict__ kscale, LAS float* scr, int item, int lane, RowMap rm) {
    const int nblk = (N + 31) >> 5, kb = item / nblk, nb = item - kb * nblk, k0 = 64 * kb, n0 = 32 * nb;
    const int ncol = n0 + (lane & 31);
#pragma unroll 8
    for (int i = 0; i < 32; ++i) {
        const int kk = 2 * i + (lane >> 5);
        float v = (ncol < N) ? W[(size_t)(k0 + kk) * N + ncol] : 0.f;
        if (kscale) v *= kscale[k0 + kk];
        scr[kk * 33 + (lane & 31)] = v;
    }
    lds_wait();
    const int c = lane & 7;
#pragma unroll
    for (int j = 0; j < 4; ++j) {
        const int nl = (lane >> 3) + 8 * j, n = n0 + nl;
        const LAS float* s = scr + (8 * c) * 33 + nl;
        u32x4 o; o.x = pk2(s[0 * 33], s[1 * 33]); o.y = pk2(s[2 * 33], s[3 * 33]); o.z = pk2(s[4 * 33], s[5 * 33]); o.w = pk2(s[6 * 33], s[7 * 33]);
        if (n < N) *(u32x4*)(WT + (size_t)rm(n) * K + k0 + 8 * c) = o;
    }
    lds_wait();
}
struct MapId { int off; DI int operator()(int n) const { return n + off; } };
struct MapWin { DI int operator()(int n) const { return n < 1280 ? n : (n < 1304 ? n + 3072 : n - 24); } };
struct MapGU { DI int operator()(int n) const { return n < 1024 ? ((n >> 7) * 256 + (n & 127)) : ((((n - 1024) >> 7) * 256) + 128 + (n & 127)); } };

DI void p0_prep(const Args& a, LAS unsigned char* lds, int gw, int NGW, int wave, int lane) {
    unsigned char* ws = a.ws;
    LAS float* scr = (LAS float*)(lds + wave * 8704);
    constexpr int I_WIN = 16 * 137, I_WA = 8 * 32, I_WO = 16 * 32, I_W1 = 32 * 4, I_W2 = 2 * 2, I_GU1 = 16 * 64, I_GU = 32 * I_GU1, I_D1 = 16 * 32, I_D = 32 * I_D1;
    constexpr int NIT = I_WIN + 2 * I_WA + I_WO + 2 * I_W1 + 2 * I_W2 + I_GU + I_D;
    for (int it = gw; it < NIT; it += NGW) {
        int r = it;
        if (r < I_GU) { const int e = r / I_GU1; transpose_item(a.in[21] + (size_t)e * 1024 * 2048, 1024, 2048, (bf16_t*)(ws + WS_WGU) + (size_t)e * 2048 * 1024, nullptr, scr, r - e * I_GU1, lane, MapGU{}); continue; } r -= I_GU;
        if (r < I_D) { const int e = r / I_D1; transpose_item(a.in[23] + (size_t)e * 1024 * 1024, 1024, 1024, (bf16_t*)(ws + WS_WD) + (size_t)e * 1024 * 1024, nullptr, scr, r - e * I_D1, lane, MapId{0}); continue; } r -= I_D;
        if (r < I_WIN) { transpose_item(a.in[2], 1024, DIN, (bf16_t*)(ws + WS_WIN), a.in[1], scr, r, lane, MapWin{}); continue; } r -= I_WIN;
        if (r < I_WA) { transpose_item(a.in[15], 512, 1024, (bf16_t*)(ws + WS_WAB), nullptr, scr, r, lane, MapId{0}); continue; } r -= I_WA;
        if (r < I_WA) { transpose_item(a.in[16], 512, 1024, (bf16_t*)(ws + WS_WAB), nullptr, scr, r, lane, MapId{1024}); continue; } r -= I_WA;
        if (r < I_WO) { transpose_item(a.in[17], 1024, 1024, (bf16_t*)(ws + WS_WOUT), nullptr, scr, r, lane, MapId{0}); continue; } r -= I_WO;
        if (r < I_W1) { transpose_item(a.in[3], 2048, 128, (bf16_t*)(ws + WS_W1K), nullptr, scr, r, lane, MapId{0}); continue; } r -= I_W1;
        if (r < I_W1) { transpose_item(a.in[7], 2048, 128, (bf16_t*)(ws + WS_W1V), nullptr, scr, r, lane, MapId{0}); continue; } r -= I_W1;
        if (r < I_W2) { transpose_item(a.in[5], 128, 64, (bf16_t*)(ws + WS_W2K), nullptr, scr, r, lane, MapId{0}); continue; } r -= I_W2;
        transpose_item(a.in[9], 128, 64, (bf16_t*)(ws + WS_W2V), nullptr, scr, r, lane, MapId{0});
    }
    {
        const float* x = a.in[0]; bf16_t* H1 = (bf16_t*)(ws + WS_H1);
        for (int m = gw; m < MTOK; m += NGW) {
            const f32x4* xr = (const f32x4*)(x + (size_t)m * DM) + lane;
            f32x4 v[4]; float s = 0.f;
#pragma unroll
            for (int j = 0; j < 4; ++j) { v[j] = xr[64 * j]; s += (v[j].x * v[j].x + v[j].y * v[j].y) + (v[j].z * v[j].z + v[j].w * v[j].w); }
            const float rinv = 1.0f / sqrtf(wave_sum(s) * (1.f / DM) + 1e-5f);
            u32x2* o = (u32x2*)(H1 + (size_t)m * DM) + lane;
#pragma unroll
            for (int j = 0; j < 4; ++j) { u32x2 w; w.x = pk2(v[j].x * rinv, v[j].y * rinv); w.y = pk2(v[j].z * rinv, v[j].w * rinv); o[64 * j] = w; }
        }
    }
    {
        float* C1 = (float*)(ws + WS_CTL + CTL_C1);
        for (int o = gw; o < 256; o += NGW) {
            const int ty = o >> 7, f = o & 127; const float* pe = a.in[ty ? 10 : 6]; const float* w1 = a.in[ty ? 7 : 3]; const float* b1 = a.in[ty ? 8 : 4];
            float s = 0.f;
            for (int k = lane; k < 2048; k += 64) s += pe[k] * w1[(size_t)k * 128 + f];
            s = wave_sum(s);
            if (lane == 0) C1[o] = s + b1[f];
        }
    }
    {
        const float* wsp = a.in[13]; bf16_t* WT = (bf16_t*)(ws + WS_WTRIL);
        for (int i = gw * 64 + lane; i < 8 * 128 * 128; i += NGW * 64) { const int t = (i >> 7) & 127, s = i & 127; WT[i] = f2bf(s <= t ? wsp[i] : 0.f); }
    }
}

typedef pg8::f32x4 pf4;
struct Epi1 {
    static constexpr bool PERM = true, AFTER_DRAIN = false;
    bf16_t *Q, *KV, *U, *V, *MG; float* NG;
    DI void operator()(const pf4 (&acc)[2][2][4][2], const pg8::Unit& u, int wr, int wc, int fr, int fq) const {
        const int row0 = u.pm * 256 + wr * 64 + fr, pn = u.pn, c0 = wc * 32 + 8 * fq;
        if (pn == 17) {
            if (wc == 0 && fq < 3) {
#pragma unroll
                for (int ai = 0; ai < 2; ++ai)
#pragma unroll
                    for (int m = 0; m < 4; ++m) { float* p = NG + (size_t)(row0 + ai * 128 + m * 16) * 24 + c0; const pf4 v0 = acc[ai][0][m][0], v1 = acc[ai][0][m][1];
                        *(f32x4*)p = (f32x4){sigm(v0[0]), sigm(v0[1]), sigm(v0[2]), sigm(v0[3])}; *(f32x4*)(p + 4) = (f32x4){sigm(v1[0]), sigm(v1[1]), sigm(v1[2]), sigm(v1[3])}; }
            }
            return;
        }
        bf16_t* base; int ldc, ct, mode;
        float sc = 1.f;
        if (pn < 2) { base = Q; ldc = 512; ct = pn; mode = 0; sc = QSCALE; }
        else if (pn < 5) { base = KV; ldc = 768; ct = pn - 2; mode = 0; }
        else if (pn < 7) { base = U; ldc = 512; ct = pn - 5; mode = 1; }
        else if (pn < 9) { base = V; ldc = 512; ct = pn - 7; mode = 1; }
        else { base = MG; ldc = 2048; ct = pn - 9; mode = 2; }
#pragma unroll
        for (int ai = 0; ai < 2; ++ai)
#pragma unroll
            for (int m = 0; m < 4; ++m) {
                bf16_t* rowp = base + (size_t)(row0 + ai * 128 + m * 16) * ldc + ct * 256 + c0;
#pragma unroll
                for (int bj = 0; bj < 2; ++bj) {
                    pf4 v0 = acc[ai][bj][m][0], v1 = acc[ai][bj][m][1];
                    if (mode == 0) { v0 = v0 * sc; v1 = v1 * sc; }
                    else if (mode == 1) { v0 = (pf4){gelu_t(v0[0]), gelu_t(v0[1]), gelu_t(v0[2]), gelu_t(v0[3])}; v1 = (pf4){gelu_t(v1[0]), gelu_t(v1[1]), gelu_t(v1[2]), gelu_t(v1[3])}; }
                    else { v0 = (pf4){sigm(v0[0]), sigm(v0[1]), sigm(v0[2]), sigm(v0[3])}; v1 = (pf4){sigm(v1[0]), sigm(v1[1]), sigm(v1[2]), sigm(v1[3])}; }
                    u32x4 w; w.x = pk2(v0[0], v0[1]); w.y = pk2(v0[2], v0[3]); w.z = pk2(v1[0], v1[1]); w.w = pk2(v1[2], v1[3]);
                    *(u32x4*)(rowp + bj * 128) = w;
                }
            }
    }
};
struct PairOrder {
    int G, c;
    DI bool next(int i, pg8::Unit& u) const {
        const int L = (i >> 1) * G + c; if (L >= 512) return false;
        const int br = i & 1; u.pm = br * 128 + (L >> 2); u.pn = br * 4 + (L & 3); return true;
    }
    DI void a_ready(const pg8::Unit&) const {}
    DI void done(const pg8::Unit&) const {}
};
struct Epi4 {
    static constexpr bool PERM = true, AFTER_DRAIN = false;
    const bf16_t* MG; bf16_t* OUT;
    DI void operator()(const pf4 (&acc)[2][2][4][2], const pg8::Unit& u, int wr, int wc, int fr, int fq) const {
        const int br = u.pn >> 2, pn = u.pn & 3, pm = u.pm & 127;
        const int row0 = pm * 256 + wr * 64 + fr, c0 = pn * 256 + wc * 32 + 8 * fq;
#pragma unroll
        for (int ai = 0; ai < 2; ++ai)
#pragma unroll
            for (int m = 0; m < 4; ++m) {
                const size_t row = (size_t)(row0 + ai * 128 + m * 16);
#pragma unroll
                for (int bj = 0; bj < 2; ++bj) {
                    const int col = c0 + bj * 128;
                    const u32x4 gw = *(const u32x4*)(MG + row * 2048 + br * 1024 + col);
                    const pf4 v0 = acc[ai][bj][m][0], v1 = acc[ai][bj][m][1];
                    float r[8];
                    r[0] = v0[0] * bf2f(gw.x & 0xffffu); r[1] = v0[1] * bf2f(gw.x >> 16); r[2] = v0[2] * bf2f(gw.y & 0xffffu); r[3] = v0[3] * bf2f(gw.y >> 16);
                    r[4] = v1[0] * bf2f(gw.z & 0xffffu); r[5] = v1[1] * bf2f(gw.z >> 16); r[6] = v1[2] * bf2f(gw.w & 0xffffu); r[7] = v1[3] * bf2f(gw.w >> 16);
                    u32x4* op = (u32x4*)(OUT + row * 1024 + col);
                    if (br == 1) { const u32x4 pv = *op;
                        r[0] += bf2f(pv.x & 0xffffu); r[1] += bf2f(pv.x >> 16); r[2] += bf2f(pv.y & 0xffffu); r[3] += bf2f(pv.y >> 16);
                        r[4] += bf2f(pv.z & 0xffffu); r[5] += bf2f(pv.z >> 16); r[6] += bf2f(pv.w & 0xffffu); r[7] += bf2f(pv.w >> 16); }
                    u32x4 w; w.x = pk2(r[0], r[1]); w.y = pk2(r[2], r[3]); w.z = pk2(r[4], r[5]); w.w = pk2(r[6], r[7]);
                    *op = w;
                }
            }
    }
};
struct Epi5 {
    static constexpr bool PERM = false, AFTER_DRAIN = false;
    const float* X; float* X2;
    DI void operator()(const pf4 (&acc)[2][2][4][2], const pg8::Unit& u, int wr, int wc, int fr, int fq) const {
        const int row0 = u.pm * 256 + wr * 64 + fr, c0 = u.pn * 256 + wc * 32 + 4 * fq;
#pragma unroll
        for (int ai = 0; ai < 2; ++ai)
#pragma unroll
            for (int m = 0; m < 4; ++m) {
                const size_t off = (size_t)(row0 + ai * 128 + m * 16) * DM + c0;
#pragma unroll
                for (int bj = 0; bj < 2; ++bj)
#pragma unroll
                    for (int n = 0; n < 2; ++n) { const f32x4 xv = *(const f32x4*)(X + off + bj * 128 + n * 16); const pf4 v = acc[ai][bj][m][n];
                        *(f32x4*)(X2 + off + bj * 128 + n * 16) = (f32x4){xv[0] + v[0], xv[1] + v[1], xv[2] + v[2], xv[3] + v[3]}; }
            }
    }
};
struct MoeOrder {
    const int* TE; int NT, npn, G, c;
    DI bool next(int i, pg8::Unit& u) const {
        int mt, pn;
        if ((G & 7) == 0) { const int x = c & 7, jj = i * (G >> 3) + (c >> 3); mt = x + 8 * (jj / npn); pn = jj % npn; }
        else { const int L = i * G + c; mt = L / npn; pn = L % npn; }
        if (mt >= NT) return false;
        const int e = __builtin_amdgcn_readfirstlane(TE[mt]);
        u.pm = mt; u.pn = e * npn + pn; return true;
    }
    DI void a_ready(const pg8::Unit&) const {}
    DI void done(const pg8::Unit&) const {}
};
struct Epi7 {
    static constexpr bool PERM = true, AFTER_DRAIN = false;
    const float* BGU; bf16_t* ACT;
    DI void operator()(const pf4 (&acc)[2][2][4][2], const pg8::Unit& u, int wr, int wc, int fr, int fq) const {
        const int e = u.pn >> 3, pn = u.pn & 7, row0 = u.pm * 256 + wr * 64 + fr, c0 = pn * 128 + wc * 32 + 8 * fq;
        const float* bg = BGU + (size_t)e * 2048 + c0; const float* bu = bg + 1024;
        const f32x4 bg0 = *(const f32x4*)bg, bg1 = *(const f32x4*)(bg + 4), bu0 = *(const f32x4*)bu, bu1 = *(const f32x4*)(bu + 4);
#pragma unroll
        for (int ai = 0; ai < 2; ++ai)
#pragma unroll
            for (int m = 0; m < 4; ++m) {
                float r[8];
#pragma unroll
                for (int n = 0; n < 2; ++n)
#pragma unroll
                    for (int k = 0; k < 4; ++k) {
                        const float gt = fminf(acc[ai][0][m][n][k] + (n ? bg1[k] : bg0[k]), 7.0f);
                        const float up = fminf(fmaxf(acc[ai][1][m][n][k] + (n ? bu1[k] : bu0[k]), -7.0f), 7.0f);
                        r[n * 4 + k] = gt * rcpf_(1.f + ex2(-1.702f * LOG2E * gt)) * (up + 1.0f);
                    }
                u32x4 w; w.x = pk2(r[0], r[1]); w.y = pk2(r[2], r[3]); w.z = pk2(r[4], r[5]); w.w = pk2(r[6], r[7]);
                *(u32x4*)(ACT + (size_t)(row0 + ai * 128 + m * 16) * DFF + c0) = w;
            }
    }
};
struct Epi8 {
    static constexpr bool PERM = true, AFTER_DRAIN = false;
    const float* BD; const float* WSLOT; bf16_t* Y;
    DI void operator()(const pf4 (&acc)[2][2][4][2], const pg8::Unit& u, int wr, int wc, int fr, int fq) const {
        const int e = u.pn >> 2, pn = u.pn & 3, row0 = u.pm * 256 + wr * 64 + fr, c0 = pn * 256 + wc * 32 + 8 * fq;
        f32x4 bv[2][2];
#pragma unroll
        for (int bj = 0; bj < 2; ++bj)
#pragma unroll
            for (int n = 0; n < 2; ++n) bv[bj][n] = *(const f32x4*)(BD + (size_t)e * DM + c0 + bj * 128 + 4 * n);
#pragma unroll
        for (int ai = 0; ai < 2; ++ai)
#pragma unroll
            for (int m = 0; m < 4; ++m) {
                const size_t row = (size_t)(row0 + ai * 128 + m * 16); const float wt = WSLOT[row];
#pragma unroll
                for (int bj = 0; bj < 2; ++bj) {
                    const pf4 v0 = acc[ai][bj][m][0], v1 = acc[ai][bj][m][1]; const f32x4 b0 = bv[bj][0], b1 = bv[bj][1];
                    u32x4 w; w.x = pk2((v0[0] + b0[0]) * wt, (v0[1] + b0[1]) * wt); w.y = pk2((v0[2] + b0[2]) * wt, (v0[3] + b0[3]) * wt);
                    w.z = pk2((v1[0] + b1[0]) * wt, (v1[1] + b1[1]) * wt); w.w = pk2((v1[2] + b1[2]) * wt, (v1[3] + b1[3]) * wt);
                    *(u32x4*)(Y + row * DM + c0 + bj * 128) = w;
                }
            }
    }
};

DI void p2_compress_item(const Args& a, LAS unsigned char* lds, int item, int tid, int wave, int lane) {
    unsigned char* ws = a.ws;
    const int nt = item & 15, ty = (item >> 4) & 1, g = (item >> 5) & 1, b = item >> 6;
    const bf16_t* KV = (const bf16_t*)(ws + WS_KV);
    const bf16_t* W1 = (const bf16_t*)(ws + (ty ? WS_W1V : WS_W1K));
    const bf16_t* W2 = (const bf16_t*)(ws + (ty ? WS_W2V : WS_W2K));
    const float* C1 = (const float*)(ws + WS_CTL + CTL_C1) + ty * 128;
    bf16_t* OUT = (bf16_t*)(ws + (ty ? WS_VCMP : WS_KCMP)) + (size_t)((b * 2 + g) * 512 + nt * 32) * 64;
    LAS unsigned char* Xs = lds;
    LAS float* Hs = (LAS float*)(lds + 76032);
    LAS unsigned char* Hb = lds + 76032 + 32768;
    const int r = lane & 31, h = lane >> 5;
    const int p0 = 512 * nt, colsrc = ty * 128 + g * 64;
    for (int i = tid; i < 528 * 8; i += NTHREADS) {
        const int pr = i >> 3, ch = i & 7; int pos = p0 + pr; pos = pos > SEQ - 1 ? SEQ - 1 : pos;
        const u32x4 v = *(const u32x4*)(KV + (size_t)(b * SEQ + pos) * 768 + colsrc + ch * 8);
        *(LAS u32x4*)(Xs + pr * 144 + ch * 16) = v;
    }
    __syncthreads();
    {
        const int ft = wave & 3, kh = wave >> 2;
        f32x16 acc; for (int i = 0; i < 16; ++i) acc[i] = 0.f;
        const bf16_t* wrow = W1 + (size_t)(ft * 32 + r) * 2048 + 8 * h;
#pragma unroll 4
        for (int s = kh * 64; s < kh * 64 + 64; ++s) {
            const int l = s >> 2, d0 = (s & 3) * 16;
            const bf16x8 af = *(const LAS bf16x8*)(Xs + (16 * r + l) * 144 + (d0 + 8 * h) * 2);
            const bf16x8 bfr = *(const bf16x8*)(wrow + 16 * s);
            acc = MFMA32(af, bfr, acc);
        }
#pragma unroll
        for (int i = 0; i < 16; ++i) Hs[(kh * 32 + crow(i, h)) * 128 + ft * 32 + r] = acc[i];
    }
    __syncthreads();
    for (int i = tid; i < 32 * 128; i += NTHREADS) {
        const int n = i >> 7, f = i & 127;
        const float v = Hs[n * 128 + f] + Hs[(32 + n) * 128 + f] + C1[f];
        *(LAS unsigned short*)(Hb + n * 272 + f * 2) = f2bf(gelu_t(v));
    }
    __syncthreads();
    if (wave < 2) {
        f32x16 acc; for (int i = 0; i < 16; ++i) acc[i] = 0.f;
        const bf16_t* wrow = W2 + (size_t)(wave * 32 + r) * 128 + 8 * h;
#pragma unroll
        for (int s = 0; s < 8; ++s) {
            const bf16x8 af = *(const LAS bf16x8*)(Hb + r * 272 + (16 * s + 8 * h) * 2);
            const bf16x8 bfr = *(const bf16x8*)(wrow + 16 * s);
            acc = MFMA32(af, bfr, acc);
        }
#pragma unroll
        for (int i = 0; i < 16; ++i) OUT[(size_t)crow(i, h) * 64 + wave * 32 + r] = f2bf(acc[i]);
    }
    __syncthreads();
}

DI void p2_sgu_item(const Args& a, LAS unsigned char* lds, int item, int tid, int wave, int lane) {
    unsigned char* ws = a.ws;
    const bf16_t* U = (const bf16_t*)(ws + WS_U); const bf16_t* V = (const bf16_t*)(ws + WS_V);
    const bf16_t* WT = (const bf16_t*)(ws + WS_WTRIL);
    bf16_t* YB = (bf16_t*)(ws + WS_YAB) + (size_t)MTOK * 512;
    const float* lng = a.in[11]; const float* lnb = a.in[12]; const float* bs = a.in[14];
    const size_t row0 = (size_t)item * 128;
    LAS unsigned char* VnT = lds;
    const int r = lane & 31, h = lane >> 5;
    {
        float gg[8], bb[8];
#pragma unroll
        for (int e = 0; e < 8; ++e) { gg[e] = lng[8 * lane + e]; bb[e] = lnb[8 * lane + e]; }
        for (int pp = 0; pp < 16; ++pp) {
            const int pos = wave * 16 + pp;
            const u32x4 raw = *(const u32x4*)(V + (row0 + pos) * 512 + 8 * lane);
            float x[8]; x[0] = bf2f(raw.x & 0xffffu); x[1] = bf2f(raw.x >> 16); x[2] = bf2f(raw.y & 0xffffu); x[3] = bf2f(raw.y >> 16);
            x[4] = bf2f(raw.z & 0xffffu); x[5] = bf2f(raw.z >> 16); x[6] = bf2f(raw.w & 0xffffu); x[7] = bf2f(raw.w >> 16);
            float s = 0.f;
#pragma unroll
            for (int e = 0; e < 8; ++e) s += x[e];
            const float mu = wave_sum(s) * (1.f / 512.f); float q = 0.f;
#pragma unroll
            for (int e = 0; e < 8; ++e) { x[e] -= mu; q += x[e] * x[e]; }
            const float rstd = 1.0f / sqrtf(wave_sum(q) * (1.f / 512.f) + 1e-5f);
#pragma unroll
            for (int e = 0; e < 8; ++e) *(LAS unsigned short*)(VnT + (8 * lane + e) * 272 + pos * 2) = f2bf(x[e] * rstd * gg[e] + bb[e]);
        }
    }
    __syncthreads();
    {
        const int grp = wave;
        for (int tt = 0; tt < 4; ++tt) {
            f32x16 acc[2];
#pragma unroll
            for (int i = 0; i < 16; ++i) { acc[0][i] = 0.f; acc[1][i] = 0.f; }
            const bf16_t* wrow = WT + (size_t)(grp * 128 + tt * 32 + r) * 128 + 8 * h;
            const int nst = 2 * tt + 2;
            for (int s = 0; s < nst; ++s) {
                const bf16x8 bfr = *(const bf16x8*)(wrow + 16 * s);
#pragma unroll
                for (int dt = 0; dt < 2; ++dt) {
                    const bf16x8 af = *(const LAS bf16x8*)(VnT + (grp * 64 + dt * 32 + r) * 272 + (16 * s + 8 * h) * 2);
                    acc[dt] = MFMA32(af, bfr, acc[dt]);
                }
            }
            const int t = tt * 32 + r; const float bt = bs[grp * 128 + t];
            const size_t rowt = row0 + t;
#pragma unroll
            for (int dt = 0; dt < 2; ++dt)
#pragma unroll
                for (int q4 = 0; q4 < 4; ++q4) {
                    const int d = dt * 32 + 8 * q4 + 4 * h;
                    const u32x2 uu = *(const u32x2*)(U + rowt * 512 + grp * 64 + d);
                    const float y0 = bf2f(uu.x & 0xffffu) * (acc[dt][4 * q4 + 0] + bt), y1 = bf2f(uu.x >> 16) * (acc[dt][4 * q4 + 1] + bt);
                    const float y2 = bf2f(uu.y & 0xffffu) * (acc[dt][4 * q4 + 2] + bt), y3 = bf2f(uu.y >> 16) * (acc[dt][4 * q4 + 3] + bt);
                    u32x2 w; w.x = pk2(y0, y1); w.y = pk2(y2, y3);
                    *(u32x2*)(YB + rowt * 512 + grp * 64 + d) = w;
                }
        }
    }
    __syncthreads();
}

constexpr int AL_K0 = 0, AL_K1 = 9216, AL_V0 = 18432, AL_V1 = 27136, AL_PB = 35840, AL_IMP = 102400, AL_SELM = 135424, AL_UNI = 136448, AL_BL = 136512, AL_NBL = 137024, AL_THR = 137088;
static_assert(AL_THR + 256 <= LDS_BYTES, "attention LDS map");
struct KVSrc { const bf16_t* k; const bf16_t* v; int pitch; };

template <int MODE, class F>
DI void attn_block(const LAS unsigned char* Ks, const LAS unsigned char* Vs, const bf16x8 (&qf)[4], f32x16 (&o)[2], float& m, float& l, float invl, LAS float* pbrow, F f, int r, int h) {
    f32x16 p0, p1;
#pragma unroll
    for (int i = 0; i < 16; ++i) { p0[i] = 0.f; p1[i] = 0.f; }
#pragma unroll
    for (int s = 0; s < 4; ++s) {
        const bf16x8 a0 = *(const LAS bf16x8*)(Ks + r * 144 + s * 32 + h * 16);
        const bf16x8 a1 = *(const LAS bf16x8*)(Ks + (32 + r) * 144 + s * 32 + h * 16);
        p0 = MFMA32(a0, qf[s], p0); p1 = MFMA32(a1, qf[s], p1);
    }
#pragma unroll
    for (int i = 0; i < 16; ++i) { const int kv = crow(i, h); p0[i] = f(kv, p0[i]); p1[i] = f(kv + 32, p1[i]); }
    if (MODE == 0 || MODE == 1) {
        float mx = fmaxf(p0[0], p1[0]);
#pragma unroll
        for (int i = 1; i < 16; ++i) mx = fmaxf(mx, fmaxf(p0[i], p1[i]));
        mx = fmaxf(mx, __shfl_xor(mx, 32));
        const float mn = fmaxf(m, mx), alpha = ex2(m - mn); m = mn;
        float sum = 0.f;
#pragma unroll
        for (int i = 0; i < 16; ++i) { p0[i] = ex2(p0[i] - mn); p1[i] = ex2(p1[i] - mn); sum += p0[i] + p1[i]; }
        l = l * alpha + sum;
        if (MODE == 0) {
#pragma unroll
            for (int i = 0; i < 16; ++i) { o[0][i] *= alpha; o[1][i] *= alpha; }
        }
    } else {
#pragma unroll
        for (int i = 0; i < 16; ++i) {
            p0[i] = p0[i] > -1e29f ? ex2(p0[i] - m) * invl : 0.f; p1[i] = p1[i] > -1e29f ? ex2(p1[i] - m) * invl : 0.f;
            pbrow[crow(i, h)] = p0[i]; pbrow[32 + crow(i, h)] = p1[i];
        }
    }
    if (MODE != 1) {
        bf16x8 pf[4];
#pragma unroll
        for (int ks = 0; ks < 2; ++ks) {
            u32x4 w0, w1;
            w0.x = pk2(p0[8 * ks + 0], p0[8 * ks + 1]); w0.y = pk2(p0[8 * ks + 2], p0[8 * ks + 3]); w0.z = pk2(p0[8 * ks + 4], p0[8 * ks + 5]); w0.w = pk2(p0[8 * ks + 6], p0[8 * ks + 7]);
            w1.x = pk2(p1[8 * ks + 0], p1[8 * ks + 1]); w1.y = pk2(p1[8 * ks + 2], p1[8 * ks + 3]); w1.z = pk2(p1[8 * ks + 4], p1[8 * ks + 5]); w1.w = pk2(p1[8 * ks + 6], p1[8 * ks + 7]);
            pf[ks] = __builtin_bit_cast(bf16x8, w0); pf[2 + ks] = __builtin_bit_cast(bf16x8, w1);
        }
#pragma unroll
        for (int dh = 0; dh < 2; ++dh) {
            __builtin_amdgcn_sched_barrier(0);
#pragma unroll
            for (int ks = 0; ks < 4; ++ks) {
                const LAS unsigned char* vp = Vs + (dh * 32 + r) * 136 + ks * 32 + h * 8;
                const s16x4 lo = *(const LAS s16x4*)vp, hi = *(const LAS s16x4*)(vp + 16);
                const bf16x8 af = __builtin_shufflevector(lo, hi, 0, 1, 2, 3, 4, 5, 6, 7);
                o[dh] = MFMA32(af, pf[ks], o[dh]);
            }
        }
        __builtin_amdgcn_sched_barrier(0);
    }
}

DI void kv_load(const KVSrc& s, int tid, int wave, int lane, u32x4& kreg, u32x4& vreg) {
    kreg = *(const u32x4*)(s.k + (size_t)(tid >> 3) * s.pitch + (tid & 7) * 8);
    vreg = *(const u32x4*)(s.v + (size_t)lane * s.pitch + wave * 8);
}
DI void kv_store(LAS unsigned char* Kb, LAS unsigned char* Vb, int tid, int wave, int lane, const u32x4& kreg, const u32x4& vreg) {
    *(LAS u32x4*)(Kb + (tid >> 3) * 144 + (tid & 7) * 16) = kreg;
    LAS unsigned char* vp = Vb + (wave * 8) * 136 + lane * 2;
    *(LAS unsigned short*)(vp + 0 * 136) = (unsigned short)(vreg.x & 0xffffu); *(LAS unsigned short*)(vp + 1 * 136) = (unsigned short)(vreg.x >> 16);
    *(LAS unsigned short*)(vp + 2 * 136) = (unsigned short)(vreg.y & 0xffffu); *(LAS unsigned short*)(vp + 3 * 136) = (unsigned short)(vreg.y >> 16);
    *(LAS unsigned short*)(vp + 4 * 136) = (unsigned short)(vreg.z & 0xffffu); *(LAS unsigned short*)(vp + 5 * 136) = (unsigned short)(vreg.z >> 16);
    *(LAS unsigned short*)(vp + 6 * 136) = (unsigned short)(vreg.w & 0xffffu); *(LAS unsigned short*)(vp + 7 * 136) = (unsigned short)(vreg.w >> 16);
}

template <int MODE, class SrcF, class MaskF, class PostF>
DI void attn_run(int nb, SrcF src, MaskF mk, PostF post, LAS unsigned char* lds, const bf16x8 (&qf)[4], f32x16 (&o)[2], float& m, float& l, float invl, LAS float* pbrow,
                 int tid, int wave, int lane, int r, int h) {
    u32x4 kreg, vreg;
    kv_load(src(0), tid, wave, lane, kreg, vreg);
    kv_store(lds + AL_K0, lds + AL_V0, tid, wave, lane, kreg, vreg);
    __syncthreads();
    for (int i = 0; i < nb; ++i) {
        const int cur = i & 1;
        if (i + 1 < nb) kv_load(src(i + 1), tid, wave, lane, kreg, vreg);
        attn_block<MODE>(lds + (cur ? AL_K1 : AL_K0), lds + (cur ? AL_V1 : AL_V0), qf, o, m, l, invl, pbrow, mk(i), r, h);
        if (MODE == 2) { __syncthreads(); post(i); }
        if (i + 1 < nb) kv_store(lds + (cur ? AL_K0 : AL_K1), lds + (cur ? AL_V0 : AL_V1), tid, wave, lane, kreg, vreg);
        __syncthreads();
    }
}

#define CE_DESC(a, b) do { const unsigned _x = (a), _y = (b); (a) = _x > _y ? _x : _y; (b) = _x > _y ? _y : _x; } while (0)
DI void sort16_desc(unsigned (&k)[16]) {
#pragma unroll
    for (int kk = 2; kk <= 16; kk <<= 1)
#pragma unroll
        for (int j = kk >> 1; j > 0; j >>= 1)
#pragma unroll
            for (int i = 0; i < 16; ++i) { const int p = i ^ j; if (p > i) { if ((i & kk) == 0) CE_DESC(k[i], k[p]); else CE_DESC(k[p], k[i]); } }
}
DI void merge16_desc(unsigned (&k)[16]) {
#pragma unroll
    for (int j = 8; j > 0; j >>= 1)
#pragma unroll
        for (int i = 0; i < 16; ++i) { const int p = i ^ j; if (p > i) CE_DESC(k[i], k[p]); }
}

DI void attn_tile(const Args& a, LAS unsigned char* lds, int b, int g, int c, int tid, int wave, int lane) {
    asm volatile("" : "+v"(tid), "+v"(lane));
    unsigned char* ws = a.ws;
    const bf16_t* Q = (const bf16_t*)(ws + WS_Q); const bf16_t* KV = (const bf16_t*)(ws + WS_KV);
    const bf16_t* KC = (const bf16_t*)(ws + WS_KCMP) + (size_t)(b * 2 + g) * 512 * 64; const bf16_t* VC = (const bf16_t*)(ws + WS_VCMP) + (size_t)(b * 2 + g) * 512 * 64;
    const float* NG = (const float*)(ws + WS_NG); bf16_t* YA = (bf16_t*)(ws + WS_YAB);
    const int r = lane & 31, h = lane >> 5, hd = wave >> 1, th = wave & 1, tl = th * 32 + r, t = 64 * c + tl;
    const size_t row = (size_t)b * SEQ + t;
    const float slope2 = ex2(-(float)(g * 4 + hd + 1)) * LOG2E;
    const float tf = (float)t;
    bf16x8 qf[4];
#pragma unroll
    for (int s = 0; s < 4; ++s) qf[s] = *(const bf16x8*)(Q + row * 512 + g * 256 + hd * 64 + 16 * s + 8 * h);
    const float gate_c = NG[row * 24 + g * 12 + hd * 3 + 0], gate_s = NG[row * 24 + g * 12 + hd * 3 + 1], gate_w = NG[row * 24 + g * 12 + hd * 3 + 2];
    f32x16 tot[2];
#pragma unroll
    for (int i = 0; i < 16; ++i) { tot[0][i] = 0.f; tot[1][i] = 0.f; }
    LAS float* IMP = (LAS float*)(lds + AL_IMP);
    LAS float* PB = (LAS float*)(lds + AL_PB);
    LAS float* pbrow = PB + (hd * 64 + tl) * 65;
    const bf16_t* kvb = KV + (size_t)b * SEQ * 768 + g * 64;
    auto nopost = [](int) {};

    if (ATTN_BRANCHES & 1) {
        const int jb0 = c > 8 ? c - 8 : 0, nb = c - jb0 + 1;
        f32x16 o[2];
#pragma unroll
        for (int i = 0; i < 16; ++i) { o[0][i] = 0.f; o[1][i] = 0.f; }
        float m = NEGBIG, l = 0.f;
        auto src = [=](int i) { KVSrc s; s.k = kvb + (size_t)(64 * (jb0 + i)) * 768 + 4 * 128; s.v = s.k + 128; s.pitch = 768; return s; };
        auto mk = [=](int i) { const int pos0 = 64 * (jb0 + i); return [=](int kv, float s) { const int dist = t - (pos0 + kv); return (dist >= 0 && dist < 512) ? s - slope2 * (float)dist : NEGBIG; }; };
        attn_run<0>(nb, src, mk, nopost, lds, qf, o, m, l, 0.f, pbrow, tid, wave, lane, r, h);
        const float sc = gate_w * rcpf_(l + __shfl_xor(l, 32));
#pragma unroll
        for (int i = 0; i < 16; ++i) { tot[0][i] += sc * o[0][i]; tot[1][i] += sc * o[1][i]; }
    }
    for (int i = tid; i < 64 * 129; i += NTHREADS) IMP[i] = 0.f;
    if (ATTN_BRANCHES & 2) {
        const int nbc = (4 * c + 3 + 63) >> 6;
        auto src = [=](int i) { KVSrc s; s.k = KC + (size_t)(64 * i) * 64; s.v = VC + (size_t)(64 * i) * 64; s.pitch = 64; return s; };
        auto mk = [=](int i) { const int n0 = 64 * i; return [=](int kv, float s) { const int n = n0 + kv; return (16 * n + 31 <= t) ? s - slope2 * (tf - (float)(16 * n) - 15.5f) : NEGBIG; }; };
        f32x16 o[2];
#pragma unroll
        for (int i = 0; i < 16; ++i) { o[0][i] = 0.f; o[1][i] = 0.f; }
        float m = NEGBIG, l = 0.f;
        attn_run<1>(nbc, src, mk, nopost, lds, qf, o, m, l, 0.f, pbrow, tid, wave, lane, r, h);
        const float invl = rcpf_(l + __shfl_xor(l, 32));
        auto post = [=](int i) {
            for (int q = tid; q < 64 * 17; q += NTHREADS) {
                const int tok = q & 63, jj = q >> 6, j = 16 * i + jj;
                float acc = 0.f;
                if (jj < 16) {
#pragma unroll
                    for (int hh = 0; hh < 4; ++hh) { const LAS float* p = PB + (hh * 64 + tok) * 65 + 4 * jj; acc += (p[0] + p[1]) + (p[2] + 0.5f * p[3]); if (jj > 0) acc += 0.5f * p[-1]; }
                } else {
#pragma unroll
                    for (int hh = 0; hh < 4; ++hh) acc += 0.5f * PB[(hh * 64 + tok) * 65 + 63];
                }
                if (j < 128) IMP[tok * 129 + j] += acc;
            }
        };
        attn_run<2>(nbc, src, mk, post, lds, qf, o, m, l, invl, pbrow, tid, wave, lane, r, h);
#pragma unroll
        for (int i = 0; i < 16; ++i) { tot[0][i] += gate_c * o[0][i]; tot[1][i] += gate_c * o[1][i]; }
    }
    __syncthreads();
    if (ATTN_BRANCHES & 4) {
        LAS unsigned* L0 = (LAS unsigned*)(lds + AL_PB);
        LAS unsigned* L1 = L0 + 8 * 16 * 64;
        LAS unsigned* L2 = L1 + 4 * 16 * 64;
        LAS unsigned* THR = (LAS unsigned*)(lds + AL_THR);
        LAS unsigned short* SELM = (LAS unsigned short*)(lds + AL_SELM);
        LAS unsigned* UNI = (LAS unsigned*)(lds + AL_UNI);
        LAS int* BL = (LAS int*)(lds + AL_BL);
        LAS int* NBL = (LAS int*)(lds + AL_NBL);
        const int tok = lane, seg = wave;
        unsigned key[16];
#pragma unroll
        for (int i = 0; i < 16; ++i) {
            const int j = 16 * seg + i;
            const bool forced = (j == 0) || (j == c) || (j == c - 1);
            const unsigned kvv = forced ? 0x1FFFFFFu : (j <= c ? (__float_as_uint(IMP[tok * 129 + j]) >> 7) + 1u : 0u);
            key[i] = (kvv << 7) | (unsigned)(127 - j);
        }
        sort16_desc(key);
#pragma unroll
        for (int i = 0; i < 16; ++i) L0[(seg * 16 + i) * 64 + tok] = key[i];
        __syncthreads();
        if (wave < 4) {
            unsigned kk[16];
#pragma unroll
            for (int i = 0; i < 16; ++i) { const unsigned x = L0[((2 * wave) * 16 + i) * 64 + tok], y = L0[((2 * wave + 1) * 16 + 15 - i) * 64 + tok]; kk[i] = x > y ? x : y; }
            merge16_desc(kk);
#pragma unroll
            for (int i = 0; i < 16; ++i) L1[(wave * 16 + i) * 64 + tok] = kk[i];
        }
        __syncthreads();
        if (wave < 2) {
            unsigned kk[16];
#pragma unroll
            for (int i = 0; i < 16; ++i) { const unsigned x = L1[((2 * wave) * 16 + i) * 64 + tok], y = L1[((2 * wave + 1) * 16 + 15 - i) * 64 + tok]; kk[i] = x > y ? x : y; }
            merge16_desc(kk);
#pragma unroll
            for (int i = 0; i < 16; ++i) L2[(wave * 16 + i) * 64 + tok] = kk[i];
        }
        __syncthreads();
        if (wave == 0) {
            unsigned mn = 0xffffffffu;
#pragma unroll
            for (int i = 0; i < 16; ++i) { const unsigned x = L2[i * 64 + tok], y = L2[(16 + 15 - i) * 64 + tok]; const unsigned z = x > y ? x : y; mn = z < mn ? z : mn; }
            THR[tok] = mn;
        }
        __syncthreads();
        {
            const unsigned T = THR[tok]; unsigned m16 = 0;
#pragma unroll
            for (int i = 0; i < 16; ++i) m16 |= (key[i] >= T) ? (1u << (15 - (key[i] & 15u))) : 0u;
            SELM[tok * 8 + seg] = (unsigned short)m16;
            unsigned uni = 0;
#pragma unroll
            for (int bb = 0; bb < 16; ++bb) uni |= (__ballot((m16 >> bb) & 1u) != 0ull) ? (1u << bb) : 0u;
            if (lane == 0) UNI[seg] = uni;
        }
        __syncthreads();
        if (wave == 0) {
            int base = 0;
#pragma unroll
            for (int half = 0; half < 2; ++half) {
                const int j = half * 64 + lane;
                const bool on = ((UNI[j >> 4] >> (j & 15)) & 1u) && (j <= c);
                const unsigned long long bal = __ballot(on);
                const int pos = base + __builtin_popcountll(bal & ((1ull << lane) - 1ull));
                if (on) BL[pos] = j;
                base += __builtin_popcountll(bal);
            }
            if (lane == 0) NBL[0] = base;
        }
        __syncthreads();
        const int nbs = __builtin_amdgcn_readfirstlane(NBL[0]);
        f32x16 o[2];
#pragma unroll
        for (int i = 0; i < 16; ++i) { o[0][i] = 0.f; o[1][i] = 0.f; }
        float m = NEGBIG, l = 0.f;
        auto src = [=](int i) { const int j = __builtin_amdgcn_readfirstlane(BL[i]); KVSrc s; s.k = kvb + (size_t)(64 * j) * 768 + 2 * 128; s.v = s.k + 128; s.pitch = 768; return s; };
        auto mk = [=](int i) { const int j = __builtin_amdgcn_readfirstlane(BL[i]); const bool sel = (SELM[tl * 8 + (j >> 4)] >> (j & 15)) & 1; const int pos0 = 64 * j;
            return [=](int kv, float s) { const int dist = t - (pos0 + kv); return (sel && dist >= 0) ? s - slope2 * (float)dist : NEGBIG; }; };
        attn_run<0>(nbs, src, mk, nopost, lds, qf, o, m, l, 0.f, pbrow, tid, wave, lane, r, h);
        const float sc = gate_s * rcpf_(l + __shfl_xor(l, 32));
#pragma unroll
        for (int i = 0; i < 16; ++i) { tot[0][i] += sc * o[0][i]; tot[1][i] += sc * o[1][i]; }
    }
#pragma unroll
    for (int dh = 0; dh < 2; ++dh)
#pragma unroll
        for (int q4 = 0; q4 < 4; ++q4) {
            const int d = dh * 32 + 8 * q4 + 4 * h;
            u32x2 w; w.x = pk2(tot[dh][4 * q4 + 0], tot[dh][4 * q4 + 1]); w.y = pk2(tot[dh][4 * q4 + 2], tot[dh][4 * q4 + 3]);
            *(u32x2*)(YA + row * 512 + g * 256 + hd * 64 + d) = w;
        }
    __syncthreads();
}

DI void p6a_route(const Args& a, LAS unsigned char* lds, int tid, int wave, int lane) {
    unsigned char* ws = a.ws;
    const float* X2 = (const float*)(ws + WS_X2);
    const float* gm = a.in[18]; const float* wr = a.in[19]; const float* br = a.in[20];
    int* TOKE = (int*)(ws + WS_TOKE); float* TOKW = (float*)(ws + WS_TOKW); int* CNT = (int*)(ws + WS_CTL + CTL_CNT); float* RINV = (float*)(ws + WS_RINV);
    LAS unsigned char* WR = lds; LAS int* CNTL = (LAS int*)(lds + 131072);
    for (int i = tid; i < 1024 * 8; i += NTHREADS) { const int k = i >> 3, q = i & 7; const float gk = gm[k]; const f32x4 w = *(const f32x4*)(wr + k * 32 + q * 4);
        *(LAS f32x4*)(WR + k * 128 + ((q ^ ((k >> 1) & 7)) * 16)) = (f32x4){w[0] * gk, w[1] * gk, w[2] * gk, w[3] * gk}; }
    const float myb = br[lane >> 1];
    for (int blk = blockIdx.x; blk < 256; blk += gridDim.x) {
        if (tid < 32) CNTL[tid] = 0;
        __syncthreads();
        int mycnt = 0;
        for (int it = 0; it < 16; ++it) {
            const int t0 = blk * 128 + wave * 16 + it;
            const float* xpa = X2 + (size_t)t0 * DM + lane;
            float pa[32]; float sa = 0.f;
#pragma unroll
            for (int e = 0; e < 32; ++e) pa[e] = 0.f;
#pragma unroll 1
            for (int i0 = 0; i0 < 16; i0 += 4) {
                float xa[4];
#pragma unroll
                for (int ii = 0; ii < 4; ++ii) xa[ii] = xpa[64 * (i0 + ii)];
#pragma unroll
                for (int ii = 0; ii < 4; ++ii) {
                    sa += xa[ii] * xa[ii];
                    const int k = lane + 64 * (i0 + ii); const LAS unsigned char* wrow = WR + k * 128; const int sw = (k >> 1) & 7;
#pragma unroll
                    for (int q = 0; q < 8; ++q) { const f32x4 w4 = *(const LAS f32x4*)(wrow + ((q ^ sw) * 16));
#pragma unroll
                        for (int j = 0; j < 4; ++j) pa[4 * q + j] += xa[ii] * w4[j]; }
                }
            }
            const float ra = 1.0f / sqrtf(wave_sum(sa) * (1.f / DM) + 1e-5f);
            if (lane == 0) RINV[t0] = ra;
#pragma unroll
            for (int st = 0; st < 5; ++st) {
                const int n = 16 >> st, xo = 32 >> st; const bool up = (lane & xo) != 0;
#pragma unroll
                for (int e = 0; e < n; ++e) {
                    float a0 = pa[e], a1 = pa[e + n];
                    asm volatile("" : "+v"(a0), "+v"(a1));
                    const float sa_ = up ? a0 : a1, ka = up ? a1 : a0; pa[e] = ka + __shfl_xor(sa_, xo);
                }
            }
            float v = (pa[0] + __shfl_xor(pa[0], 1)) * ra + myb;
            if (lane & 1) v = -3e38f;
            {
                int es0, es1, es2, es3; float vs0, vs1, vs2, vs3;
#define TOPK_ROUND(ES, VS) { const float mx = wave_max(v); const unsigned long long bal = __ballot(v == mx); const int ln = __builtin_ctzll(bal); ES = ln >> 1; VS = mx; if (lane == ln) v = -3e38f; mycnt += (lane == (ln >> 1)) ? 1 : 0; }
                TOPK_ROUND(es0, vs0) TOPK_ROUND(es1, vs1) TOPK_ROUND(es2, vs2) TOPK_ROUND(es3, vs3)
#undef TOPK_ROUND
                const float e1 = ex2((vs1 - vs0) * LOG2E), e2 = ex2((vs2 - vs0) * LOG2E), e3 = ex2((vs3 - vs0) * LOG2E);
                const float inv = 1.0f / (1.0f + e1 + e2 + e3);
                if (lane == 0) {
                    const size_t o = (size_t)t0 * 4;
                    TOKE[o] = es0; TOKE[o + 1] = es1; TOKE[o + 2] = es2; TOKE[o + 3] = es3;
                    TOKW[o] = inv; TOKW[o + 1] = e1 * inv; TOKW[o + 2] = e2 * inv; TOKW[o + 3] = e3 * inv;
                }
            }
        }
        if (lane < 32) atomicAdd((int*)(CNTL + lane), mycnt);
        __syncthreads();
        if (tid < 32) CNT[blk * 32 + tid] = CNTL[tid];
        __syncthreads();
    }
}
DI void p6b_place(const Args& a, LAS unsigned char* lds, int tid, int wave, int lane) {
    unsigned char* ws = a.ws;
    const float* X2 = (const float*)(ws + WS_X2); const float* RINV = (const float*)(ws + WS_RINV); bf16_t* AS = (bf16_t*)(ws + WS_AS);
    const float* gm = a.in[18];
    const f32x4 g00 = *(const f32x4*)(gm + lane * 8), g01 = *(const f32x4*)(gm + lane * 8 + 4), g10 = *(const f32x4*)(gm + 512 + lane * 8), g11 = *(const f32x4*)(gm + 512 + lane * 8 + 4);
    const int* TOKE = (const int*)(ws + WS_TOKE); const float* TOKW = (const float*)(ws + WS_TOKW); const int* CNT = (const int*)(ws + WS_CTL + CTL_CNT);
    int* SLOT = (int*)(ws + WS_SLOT); float* WSLOT = (float*)(ws + WS_WSLOT); int* TE = (int*)(ws + WS_CTL + CTL_TE); int* NT = (int*)(ws + WS_CTL + CTL_NT);
    LAS int* TOT = (LAS int*)lds; LAS int* OFFS = TOT + 32; LAS int* PADS = TOT + 64; LAS int* CUR = TOT + 96;
    for (int blk = blockIdx.x; blk < 256; blk += gridDim.x) {
        if (tid < 32) { int tot = 0, mine = 0; for (int bb = 0; bb < 256; ++bb) { const int cc = CNT[bb * 32 + tid]; tot += cc; mine += (bb < blk) ? cc : 0; } TOT[tid] = tot; OFFS[tid] = mine; CUR[tid] = 0; }
        __syncthreads();
        if (tid == 0) {
            int ps = 0;
            for (int e = 0; e < 32; ++e) { PADS[e] = ps; ps += (TOT[e] + 255) & ~255; }
            if (blk == 0) { int tile = 0; for (int e = 0; e < 32; ++e) { const int n = (TOT[e] + 255) >> 8; for (int q = 0; q < n; ++q) TE[tile++] = e; } NT[0] = tile; }
        }
        __syncthreads();
        for (int it = 0; it < 16; ++it) {
            const int t = blk * 128 + wave * 16 + it;
            const float rv = RINV[t];
            u32x4 r0, r1;
            { const f32x4 a0 = *(const f32x4*)(X2 + (size_t)t * DM + lane * 8), a1 = *(const f32x4*)(X2 + (size_t)t * DM + lane * 8 + 4);
              const f32x4 b0 = *(const f32x4*)(X2 + (size_t)t * DM + 512 + lane * 8), b1 = *(const f32x4*)(X2 + (size_t)t * DM + 512 + lane * 8 + 4);
              r0.x = pk2(a0[0] * rv * g00[0], a0[1] * rv * g00[1]); r0.y = pk2(a0[2] * rv * g00[2], a0[3] * rv * g00[3]); r0.z = pk2(a1[0] * rv * g01[0], a1[1] * rv * g01[1]); r0.w = pk2(a1[2] * rv * g01[2], a1[3] * rv * g01[3]);
              r1.x = pk2(b0[0] * rv * g10[0], b0[1] * rv * g10[1]); r1.y = pk2(b0[2] * rv * g10[2], b0[3] * rv * g10[3]); r1.z = pk2(b1[0] * rv * g11[0], b1[1] * rv * g11[1]); r1.w = pk2(b1[2] * rv * g11[2], b1[3] * rv * g11[3]); }
#pragma unroll
            for (int k = 0; k < 4; ++k) {
                const int e = TOKE[(size_t)t * 4 + k];
                int p = 0; if (lane == 0) p = atomicAdd((int*)(CUR + e), 1);
                p = __builtin_amdgcn_readfirstlane(p);
                const int pos = PADS[e] + OFFS[e] + p;
                *(u32x4*)(AS + (size_t)pos * DM + lane * 8) = r0; *(u32x4*)(AS + (size_t)pos * DM + 512 + lane * 8) = r1;
                if (lane == 0) { SLOT[(size_t)t * 4 + k] = pos; WSLOT[pos] = TOKW[(size_t)t * 4 + k]; }
            }
        }
        __syncthreads();
    }
}
DI void p9_final(const Args& a, int gw, int NGW, int lane) {
    unsigned char* ws = a.ws;
    const float* X2 = (const float*)(ws + WS_X2); const bf16_t* Y = (const bf16_t*)(ws + WS_Y); const int* SLOT = (const int*)(ws + WS_SLOT);
    const float* gf = a.in[25]; float* out = a.out;
    f32x4 gv[4];
#pragma unroll
    for (int j = 0; j < 4; ++j) gv[j] = *((const f32x4*)gf + lane + 64 * j);
    for (int t = gw; t < MTOK; t += NGW) {
        f32x4 v[4];
#pragma unroll
        for (int j = 0; j < 4; ++j) v[j] = *((const f32x4*)(X2 + (size_t)t * DM) + lane + 64 * j);
        if (!SKIP_MOE) {
#pragma unroll
            for (int k = 0; k < 4; ++k) {
                const int pos = SLOT[(size_t)t * 4 + k];
#pragma unroll
                for (int j = 0; j < 4; ++j) { const u32x2 y = *((const u32x2*)(Y + (size_t)pos * DM) + lane + 64 * j);
                    v[j].x += bf2f(y.x & 0xffffu); v[j].y += bf2f(y.x >> 16); v[j].z += bf2f(y.y & 0xffffu); v[j].w += bf2f(y.y >> 16); }
            }
        }
        float s = 0.f;
#pragma unroll
        for (int j = 0; j < 4; ++j) s += (v[j].x * v[j].x + v[j].y * v[j].y) + (v[j].z * v[j].z + v[j].w * v[j].w);
        const float rinv = 1.0f / sqrtf(wave_sum(s) * (1.f / DM) + 1e-5f);
#pragma unroll
        for (int j = 0; j < 4; ++j) *((f32x4*)(out + (size_t)t * DM) + lane + 64 * j) = (f32x4){v[j].x * rinv * gv[j].x, v[j].y * rinv * gv[j].y, v[j].z * rinv * gv[j].z, v[j].w * rinv * gv[j].w};
    }
}

__global__ void __launch_bounds__(NTHREADS, 2) hybrid_fwd(Args args) {
    extern __shared__ __attribute__((aligned(16))) unsigned char lds_raw[];
    LAS unsigned char* lds = (LAS unsigned char*)lds_raw;
    cg::grid_group grid = cg::this_grid();
    const int tid = threadIdx.x, lane = tid & 63, wave = __builtin_amdgcn_readfirstlane(tid >> 6);
    const int G = gridDim.x, bx = blockIdx.x;
    const int gw = bx * NWAVES + wave, NGW = G * NWAVES;
    unsigned char* ws = args.ws;

    if (PH(0)) p0_prep(args, lds, gw, NGW, wave, lane);
    grid.sync();
    if (PH(1)) {
        pg8::Gemm g{(const pg8::bf16_t*)(ws + WS_H1), (const pg8::bf16_t*)(ws + WS_WIN), MTOK, NPROJ, DM};
        pg8::StaticOrder S; S.init(MTOK, NPROJ, G, bx);
        Epi1 E{(bf16_t*)(ws + WS_Q), (bf16_t*)(ws + WS_KV), (bf16_t*)(ws + WS_U), (bf16_t*)(ws + WS_V), (bf16_t*)(ws + WS_MG), (float*)(ws + WS_NG)};
        pg8::gemm_phase<Epi1, pg8::StaticOrder, true, true>(lds, g, S, E);
    }
    grid.sync();
    for (int it = bx; it < 512; it += G) {
        if (it < 256) { if (!SKIP_ATTN && PH(2)) p2_compress_item(args, lds, it, tid, wave, lane); }
        else { if (!SKIP_SGU && PH(2)) p2_sgu_item(args, lds, it - 256, tid, wave, lane); }
    }
    grid.sync();
    if (!SKIP_ATTN && PH(3)) {
        for (int it = bx; it < 1024; it += G) {
            const int w = it & 255, i = it >> 8, s = w & 31, bg = w >> 5;
            const int c = (i == 0) ? s : (i == 1) ? 63 - s : (i == 2) ? 64 + s : 127 - s;
            attn_tile(args, lds, bg >> 1, bg & 1, c, tid, wave, lane);
        }
    }
    grid.sync();
    if (PH(4)) {
        pg8::Gemm g{(const pg8::bf16_t*)(ws + WS_YAB), (const pg8::bf16_t*)(ws + WS_WAB), 2 * MTOK, 2048, 512};
        PairOrder S{G, bx};
        Epi4 E{(const bf16_t*)(ws + WS_MG), (bf16_t*)(ws + WS_MERGED)};
        pg8::gemm_phase<Epi4, PairOrder, true, true>(lds, g, S, E);
    }
    grid.sync();
    if (PH(5)) {
        pg8::Gemm g{(const pg8::bf16_t*)(ws + WS_MERGED), (const pg8::bf16_t*)(ws + WS_WOUT), MTOK, DM, DM};
        pg8::StaticOrder S; S.init(MTOK, DM, G, bx);
        Epi5 E{args.in[0], (float*)(ws + WS_X2)};
        pg8::gemm_phase<Epi5, pg8::StaticOrder, true, true>(lds, g, S, E);
    }
    grid.sync();
    if (!SKIP_MOE) {
        if (PH(6) && !NO_P6A) p6a_route(args, lds, tid, wave, lane);
        grid.sync();
        if (PH(6) && !NO_P6B) p6b_place(args, lds, tid, wave, lane);
        grid.sync();
        const int* TE = (const int*)(ws + WS_CTL + CTL_TE);
        const int NT = __builtin_amdgcn_readfirstlane(*(const int*)(ws + WS_CTL + CTL_NT));
        if (PH(7)) {
            pg8::Gemm g{(const pg8::bf16_t*)(ws + WS_AS), (const pg8::bf16_t*)(ws + WS_WGU), MPAD, NEXP * 2048, DM};
            MoeOrder S{TE, NT, 8, G, bx};
            Epi7 E{args.in[22], (bf16_t*)(ws + WS_ACT)};
            pg8::gemm_phase<Epi7, MoeOrder, true, true>(lds, g, S, E);
        }
        grid.sync();
        if (PH(8)) {
            pg8::Gemm g{(const pg8::bf16_t*)(ws + WS_ACT), (const pg8::bf16_t*)(ws + WS_WD), MPAD, NEXP * 1024, DFF};
            MoeOrder S{TE, NT, 4, G, bx};
            Epi8 E{args.in[24], (const float*)(ws + WS_WSLOT), (bf16_t*)(ws + WS_Y)};
            pg8::gemm_phase<Epi8, MoeOrder, true, true>(lds, g, S, E);
        }
        grid.sync();
    }
    if (PH(9)) p9_final(args, gw, NGW, lane);
}

extern "C" void kernel_launch(void* const* d_in, const int* in_sizes, int n_in, void* d_out, int out_size, void* d_ws, size_t ws_size, hipStream_t stream) {
    static int grid = 0;
    if (grid == 0) {
        if (n_in != 26 || in_sizes[0] != MTOK * DM || out_size != MTOK * DM || ws_size < WS_END) {
            fprintf(stderr, "kernel_launch: unexpected shapes (n_in %d, in0 %d, out %d, ws %zu < %zu)\n", n_in, n_in > 0 ? in_sizes[0] : -1, out_size, ws_size, (size_t)WS_END); grid = -1; return; }
        int dev = 0, cus = 0, per_cu = 0;
        hipGetDevice(&dev);
        hipDeviceGetAttribute(&cus, hipDeviceAttributeMultiprocessorCount, dev);
        if (hipFuncSetAttribute((const void*)hybrid_fwd, hipFuncAttributeMaxDynamicSharedMemorySize, LDS_BYTES) != hipSuccess) { fprintf(stderr, "kernel_launch: hipFuncSetAttribute failed\n"); grid = -1; return; }
        if (hipOccupancyMaxActiveBlocksPerMultiprocessor(&per_cu, (const void*)hybrid_fwd, NTHREADS, LDS_BYTES) != hipSuccess || per_cu < 1) { fprintf(stderr, "kernel_launch: occupancy query says %d\n", per_cu); per_cu = 1; }
        (void)hipGetLastError();
        grid = cus * 1;
        if (grid > cus * per_cu) grid = cus * per_cu;
    }
    if (grid < 0) return;
    Args a{};
    for (int i = 0; i < 26; ++i) a.in[i] = (const float*)d_in[i];
    a.out = (float*)d_out; a.ws = (unsigned char*)d_ws;
    void* kargs[] = {&a};
    hipError_t e = hipLaunchCooperativeKernel((const void*)hybrid_fwd, dim3(grid), dim3(NTHREADS), kargs, LDS_BYTES, stream);
    if (e != hipSuccess) fprintf(stderr, "kernel_launch: cooperative launch failed: %s (grid %d)\n", hipGetErrorString(e), grid);
}
```

```cpp
#include <hip/hip_runtime.h>
#include <hip/hip_cooperative_groups.h>
#include <cstdio>
#include <cstdint>
namespace cg = cooperative_groups;
namespace pg8 {
#define PG8_LAS __attribute__((address_space(3)))
typedef unsigned short bf16_t;
typedef short bf16x8 __attribute__((ext_vector_type(8)));
typedef float f32x4 __attribute__((ext_vector_type(4)));
typedef unsigned u32x4 __attribute__((ext_vector_type(4)));
constexpr int BM = 256, BK = 64, HALF = 128, HTB = HALF * BK * 2  , STAGE_BYTES = 8 * HTB, NXCD = 8, WGM = 8;

__host__ __device__ __forceinline__ int lds_byte(int r, int c) { const int st = (r >> 4) * 2 + (c >> 5), rr = r & 15, cc = c & 31, ob = rr * 64 + cc * 2; return st * 1024 + (ob ^ (((ob >> 9) & 1) << 5)); }
__host__ __device__ __forceinline__ void stage_rc(int b, int& R, int& C) { const int st = b / 1024, sb = b % 1024, swz = sb ^ (((sb >> 9) & 1) << 5); R = (st >> 1) * 16 + swz / 64; C = (st & 1) * 32 + (swz % 64) / 2; }
__host__ __device__ __forceinline__ int perm32(int rho) { const int n = rho >> 4, i = rho & 15; return 8 * (i >> 2) + 4 * n + (i & 3); }

struct Unit { int pm, pn; };
struct Gemm { const bf16_t* A; const bf16_t* Bt; int M, N, K; };

struct StaticOrder {
    int nM, nN, nwg, G, c;
    __host__ __device__ void init(int M, int N, int G_, int c_) { nM = M / BM; nN = N / BM; nwg = nM * nN; G = G_; c = c_; }
    __host__ __device__ bool next(int i, Unit& u) const {
        const long L = (long)i * G + c; if (L >= nwg) return false;
        int wgid = (int)L; { const int q = nwg / NXCD, r = nwg % NXCD, xcd = wgid % NXCD, off = wgid / NXCD; wgid = (xcd < r ? xcd * (q + 1) : r * (q + 1) + (xcd - r) * q) + off; }
        const int nig = WGM * nN, gid = wgid / nig, fm = gid * WGM, gsz = (nM - fm) < WGM ? (nM - fm) : WGM;
        u.pm = fm + ((wgid % nig) % gsz); u.pn = (wgid % nig) / gsz; return true;
    }
    __device__ __forceinline__ void a_ready(const Unit&) const {}
    __device__ __forceinline__ void done(const Unit&) const {}
};

__device__ __forceinline__ unsigned cvt_pk_bf16(float lo, float hi) { unsigned r; asm volatile("v_cvt_pk_bf16_f32 %0, %1, %2" : "=v"(r) : "v"(lo), "v"(hi)); return r; }
typedef float f32x2 __attribute__((ext_vector_type(2)));
template <class Epi, class Sched, bool ALIGN_EPI = false, bool SP2 = false>
__device__ __forceinline__ void gemm_phase(PG8_LAS unsigned char* lds, const Gemm g, const Sched& S, const Epi& E) {
    int tid_ = threadIdx.x; asm volatile("" : "+v"(tid_));
    const int tid = tid_, wid = __builtin_amdgcn_readfirstlane(tid >> 6), lane = tid & 63, wr = wid >> 2, wc = wid & 3, fr = lane & 15, fq = lane >> 4;
    const int K = g.K, nt = K / BK;
    unsigned voffA[2], voffB[2];
#pragma unroll
    for (int i = 0; i < 2; ++i) { int R, C; stage_rc(tid * 16 + i * 8192, R, C); const int Rb = Epi::PERM ? ((R & ~31) + perm32(R & 31)) : R;
        voffA[i] = (unsigned)(R * K + C) * 2u; voffB[i] = (unsigned)(Rb * K + C) * 2u; }
    const size_t kstep = (size_t)(BK * 2);
    const size_t hstep = (size_t)HALF * K * 2;
    const size_t tstep = 2 * hstep;
    const unsigned ldsw = (unsigned)wid * 1024u;
    const int aoff = lds_byte(wr * 64 + fr, fq * 8), boff = lds_byte(wc * 32 + fr, fq * 8);
#define PG8_SA(b, h) (((b) * 2 + (h)) * HTB)
#define PG8_SB(b, h) ((4 + (b) * 2 + (h)) * HTB)
#define PG8_STAGE(bufoff, gbase, voff) do { _Pragma("unroll") for (int _i = 0; _i < 2; ++_i) \
        __builtin_amdgcn_global_load_lds((const unsigned*)((const char*)(gbase) + (voff)[_i]), (PG8_LAS unsigned*)(lds + (bufoff) + ldsw + _i * 8192), 16, 0, 0); } while (0)
#define PG8_LDA(dst, b, h) do { _Pragma("unroll") for (int m = 0; m < 4; ++m) _Pragma("unroll") for (int k = 0; k < 2; ++k) dst[m][k] = *(const PG8_LAS bf16x8*)(lds + PG8_SA(b, h) + aoff + m * 2048 + k * 1024); } while (0)
#define PG8_LDB(dst, b, h) do { _Pragma("unroll") for (int n = 0; n < 2; ++n) _Pragma("unroll") for (int k = 0; k < 2; ++k) dst[n][k] = *(const PG8_LAS bf16x8*)(lds + PG8_SB(b, h) + boff + n * 2048 + k * 1024); } while (0)
#define PG8_MMA(ai, bj, At, Bt) do { __builtin_amdgcn_s_setprio(1); _Pragma("unroll") for (int m = 0; m < 4; ++m) _Pragma("unroll") for (int n = 0; n < 2; ++n) _Pragma("unroll") for (int k = 0; k < 2; ++k) \
        acc[ai][bj][m][n] = __builtin_amdgcn_mfma_f32_16x16x32_bf16(Bt[n][k], At[m][k], acc[ai][bj][m][n], 0, 0, 0); __builtin_amdgcn_s_setprio(0); } while (0)
#define PG8_WAIT_V(n) asm volatile("s_waitcnt vmcnt(" #n ")" ::: "memory")
#define PG8_WAIT_L(n) asm volatile("s_waitcnt lgkmcnt(" #n ")" ::: "memory")
#define PG8_BAR __builtin_amdgcn_s_barrier()
#define PG8_SCHED __builtin_amdgcn_sched_barrier(0)
    Unit cur, nxt; int ui = 0;
    if (!S.next(0, cur)) return;
    f32x4 acc[2][2][4][2];
#pragma unroll
    for (int a = 0; a < 2; ++a)
#pragma unroll
        for (int b = 0; b < 2; ++b)
#pragma unroll
            for (int m = 0; m < 4; ++m)
#pragma unroll
                for (int n = 0; n < 2; ++n) acc[a][b][m][n] = (f32x4){0.f, 0.f, 0.f, 0.f};
    bf16x8 At[4][2], B0[2][2], B1[2][2];
    const char* cA = (const char*)g.A + (size_t)cur.pm * tstep; const char* cB = (const char*)g.Bt + (size_t)cur.pn * tstep;
    S.a_ready(cur);
    if constexpr (SP2) {
        PG8_STAGE(PG8_SB(0, 0), cB, voffB); PG8_STAGE(PG8_SB(0, 1), cB + hstep, voffB); PG8_STAGE(PG8_SA(0, 0), cA, voffA); PG8_STAGE(PG8_SA(0, 1), cA + hstep, voffA);
        if (wr == 1) PG8_BAR;
        PG8_WAIT_V(2); PG8_BAR;
        PG8_STAGE(PG8_SB(1, 0), cB + kstep, voffB); PG8_STAGE(PG8_SA(1, 0), cA + kstep, voffA); PG8_STAGE(PG8_SB(1, 1), cB + hstep + kstep, voffB);
        PG8_WAIT_V(6); PG8_BAR;
    } else {
        PG8_STAGE(PG8_SB(0, 0), cB, voffB); PG8_STAGE(PG8_SA(0, 0), cA, voffA); PG8_STAGE(PG8_SB(0, 1), cB + hstep, voffB); PG8_STAGE(PG8_SA(0, 1), cA + hstep, voffA);
        if (wr == 1) PG8_BAR;
        PG8_WAIT_V(4); PG8_BAR;
        PG8_STAGE(PG8_SB(1, 0), cB + kstep, voffB); PG8_STAGE(PG8_SA(1, 0), cA + kstep, voffA); PG8_STAGE(PG8_SB(1, 1), cB + hstep + kstep, voffB);
        PG8_WAIT_V(6); PG8_BAR;
    }
    for (;;) {
        const bool has_next = S.next(ui + 1, nxt);
        const char* nA = has_next ? (const char*)g.A + (size_t)nxt.pm * tstep : cA; const char* nB = has_next ? (const char*)g.Bt + (size_t)nxt.pn * tstep : cB;
        for (int t = 0; t < nt; t += 2) {
            const bool last = (t == nt - 2);
            const char* a1 = cA + (size_t)(t + 1) * kstep;
            const char* a2 = last ? nA : cA + (size_t)(t + 2) * kstep; const char* b2 = last ? nB : cB + (size_t)(t + 2) * kstep;
            const char* a3 = a2 + kstep; const char* b3 = b2 + kstep;
            if (last && has_next) S.a_ready(nxt);
            if constexpr (SP2) {
            PG8_LDB(B0, 0, 0); PG8_LDB(B1, 0, 1); PG8_SCHED; PG8_LDA(At, 0, 0); PG8_STAGE(PG8_SA(1, 1), a1 + hstep, voffA);
            PG8_WAIT_V(8); PG8_WAIT_L(0); PG8_BAR; PG8_MMA(0, 0, At, B0); PG8_MMA(0, 1, At, B1); PG8_BAR; PG8_SCHED;
            PG8_LDA(At, 0, 1); PG8_STAGE(PG8_SB(0, 0), b2, voffB); PG8_STAGE(PG8_SB(0, 1), b2 + hstep, voffB); PG8_STAGE(PG8_SA(0, 0), a2, voffA);
            PG8_WAIT_V(8); PG8_WAIT_L(0); PG8_BAR; PG8_MMA(1, 0, At, B0); PG8_MMA(1, 1, At, B1); PG8_BAR; PG8_SCHED;
            PG8_LDB(B0, 1, 0); PG8_LDB(B1, 1, 1); PG8_SCHED; PG8_LDA(At, 1, 0); PG8_STAGE(PG8_SA(0, 1), a2 + hstep, voffA);
            PG8_WAIT_V(8); PG8_WAIT_L(0); PG8_BAR; PG8_MMA(0, 0, At, B0); PG8_MMA(0, 1, At, B1); PG8_BAR; PG8_SCHED;
            PG8_LDA(At, 1, 1); PG8_STAGE(PG8_SB(1, 0), b3, voffB); PG8_STAGE(PG8_SB(1, 1), b3 + hstep, voffB); PG8_STAGE(PG8_SA(1, 0), a3, voffA);
            PG8_WAIT_V(8); PG8_WAIT_L(0); PG8_BAR; PG8_MMA(1, 0, At, B0); PG8_MMA(1, 1, At, B1); PG8_BAR; PG8_SCHED;
            } else {
            PG8_LDB(B0, 0, 0); PG8_SCHED; PG8_LDA(At, 0, 0); PG8_STAGE(PG8_SA(1, 1), a1 + hstep, voffA);
            PG8_WAIT_L(8); PG8_BAR; PG8_WAIT_L(0); PG8_MMA(0, 0, At, B0); PG8_BAR; PG8_SCHED;
            PG8_LDB(B1, 0, 1); PG8_STAGE(PG8_SB(0, 0), b2, voffB);
            PG8_BAR; PG8_WAIT_L(0); PG8_MMA(0, 1, At, B1); PG8_BAR;
            PG8_LDA(At, 0, 1); PG8_STAGE(PG8_SA(0, 0), a2, voffA);
            PG8_BAR; PG8_WAIT_L(0); PG8_MMA(1, 0, At, B0); PG8_BAR; PG8_SCHED;
            PG8_STAGE(PG8_SB(0, 1), b2 + hstep, voffB);
            PG8_WAIT_V(6); PG8_BAR; PG8_MMA(1, 1, At, B1); PG8_BAR;
            PG8_LDB(B0, 1, 0); PG8_SCHED; PG8_LDA(At, 1, 0); PG8_STAGE(PG8_SA(0, 1), a2 + hstep, voffA);
            PG8_WAIT_L(8); PG8_BAR; PG8_WAIT_L(0); PG8_MMA(0, 0, At, B0); PG8_BAR; PG8_SCHED;
            PG8_LDB(B1, 1, 1); PG8_STAGE(PG8_SB(1, 0), b3, voffB);
            PG8_BAR; PG8_WAIT_L(0); PG8_MMA(0, 1, At, B1); PG8_BAR;
            PG8_LDA(At, 1, 1); PG8_STAGE(PG8_SA(1, 0), a3, voffA);
            PG8_BAR; PG8_WAIT_L(0); PG8_MMA(1, 0, At, B0); PG8_BAR; PG8_SCHED;
            PG8_STAGE(PG8_SB(1, 1), b3 + hstep, voffB);
            PG8_WAIT_V(6); PG8_BAR; PG8_MMA(1, 1, At, B1); PG8_BAR;
            }
        }
        if constexpr (ALIGN_EPI) { if (wr == 0) PG8_BAR; }
        if constexpr (!Epi::AFTER_DRAIN) { E(acc, cur, wr, wc, fr, fq); S.done(cur); }
        if (!has_next) break;
#pragma unroll
        for (int a = 0; a < 2; ++a)
#pragma unroll
            for (int b = 0; b < 2; ++b)
#pragma unroll
                for (int m = 0; m < 4; ++m)
#pragma unroll
                    for (int n = 0; n < 2; ++n) acc[a][b][m][n] = (f32x4){0.f, 0.f, 0.f, 0.f};
        cur = nxt; cA = nA; cB = nB; ++ui;
        if constexpr (ALIGN_EPI) { if (wr == 1) PG8_BAR; }
    }
    PG8_WAIT_V(0);
    if constexpr (!ALIGN_EPI) { if (wr == 0) PG8_BAR; }
    PG8_BAR;
    if constexpr (Epi::AFTER_DRAIN) { E.fused(acc, cur, wr, wc, fr, fq, lds, wid, lane); S.done(cur); }
#undef PG8_SA
#undef PG8_SB
#undef PG8_STAGE
#undef PG8_LDA
#undef PG8_LDB
#undef PG8_MMA
#undef PG8_WAIT_V
#undef PG8_WAIT_L
#undef PG8_BAR
#undef PG8_SCHED
}
}
#define LAS __attribute__((address_space(3)))
#define XB_TMO      128
#define XB_XCNT(j)  (256  + 64 * (j))
#define XB_XSUB(j)  (1280 + 64 * (j))
#define XB_XGEN(j)  (2304 + 64 * (j))
#define XB_TOP      3328
#define XB_TOPGEN   3392
#define XCD_BAR_WORDS 3456
#define XB_SPIN_CAP (1u << 18)

__device__ __forceinline__ unsigned xb_ld(unsigned* p)              { return __hip_atomic_load(p, __ATOMIC_RELAXED, __HIP_MEMORY_SCOPE_AGENT); }
__device__ __forceinline__ unsigned xb_add(unsigned* p, unsigned v) { return __hip_atomic_fetch_add(p, v, __ATOMIC_RELAXED, __HIP_MEMORY_SCOPE_AGENT); }
__device__ __forceinline__ unsigned xb_xcc_id() { return (unsigned)__builtin_amdgcn_s_getreg((3 << 11) | 20) & 0xFu; }
#define XB_SPIN(cond, bar) do { unsigned _sp = 0; while (cond) { __builtin_amdgcn_s_sleep(1); \
    if ((++_sp & 255u) == 0u) { if (xb_ld(&(bar)[XB_TMO])) break; if (_sp > XB_SPIN_CAP) { atomicAdd(&(bar)[XB_TMO], 1u); break; } } } } while (0)

struct XcdBarrier {
    unsigned* bar; unsigned x;
    volatile LAS unsigned* st;
};

__device__ __forceinline__ XcdBarrier xcd_barrier_post(unsigned* bar, volatile LAS unsigned* st) {
    XcdBarrier b; b.bar = bar; b.x = xb_xcc_id(); b.st = st;
    if (threadIdx.x == 0) (void)xb_add(&bar[XB_XCNT(b.x)], 1u);
    return b;
}
__device__ __forceinline__ void xcd_barrier_complete(unsigned* bar, unsigned x, unsigned& nloc, unsigned& nx) {
    const unsigned G = gridDim.x * gridDim.y * gridDim.z;
    unsigned sum, cnt, mine, sp = 0u;
    for (;;) {
        sum = 0u; cnt = 0u; mine = 0u;
#pragma unroll
        for (unsigned j = 0; j < 16; ++j) { const unsigned c = xb_ld(&bar[XB_XCNT(j)]); sum += c; cnt += (c > 0u) ? 1u : 0u; mine = (j == x) ? c : mine; }
        if (sum == G) break;
        __builtin_amdgcn_s_sleep(1);
        if ((++sp & 255u) == 0u) { if (xb_ld(&bar[XB_TMO])) break; if (sp > XB_SPIN_CAP) { atomicAdd(&bar[XB_TMO], 1u); break; } }
    }
    nloc = mine > 0u ? mine : 1u; nx = cnt > 0u ? cnt : 1u;
}

__device__ __forceinline__ void xcd_barrier(const XcdBarrier& b) {
    asm volatile("s_waitcnt vmcnt(0)" ::: "memory");
    __syncthreads();
    if (threadIdx.x == 0) {
        unsigned* bar = b.bar;
        __builtin_amdgcn_s_waitcnt(0);
        unsigned nloc = b.st[0], nx = b.st[1];
        if (nloc == 0u) { xcd_barrier_complete(bar, b.x, nloc, nx); b.st[0] = nloc; b.st[1] = nx; }
        const unsigned old = xb_add(&bar[XB_XSUB(b.x)], 1u);
        const unsigned gen = old / nloc;
        if (old + 1u == (gen + 1u) * nloc) {
            __builtin_amdgcn_fence(__ATOMIC_RELEASE, "agent");
            asm volatile("s_waitcnt vmcnt(0)" ::: "memory");
            const unsigned og = xb_add(&bar[XB_TOP], 1u);
            const unsigned tg = og / nx;
            if (og + 1u == (tg + 1u) * nx) xb_add(&bar[XB_TOPGEN], 1u);
            else XB_SPIN(xb_ld(&bar[XB_TOPGEN]) == tg, bar);
            __builtin_amdgcn_fence(__ATOMIC_ACQUIRE, "agent");
            xb_add(&bar[XB_XGEN(b.x)], 1u);
            asm volatile("s_waitcnt vmcnt(0)" ::: "memory");
        } else {
            XB_SPIN(xb_ld(&bar[XB_XGEN(b.x)]) == gen, bar);
            __builtin_amdgcn_fence(__ATOMIC_ACQUIRE, "agent");
            asm volatile("s_waitcnt vmcnt(0)" ::: "memory");
        }
    }
    __syncthreads();
}

#define DI __device__ __forceinline__
typedef unsigned short bf16_t;
typedef short bf16x8 __attribute__((ext_vector_type(8)));
typedef short s16x4 __attribute__((ext_vector_type(4)));
typedef float f32x4 __attribute__((ext_vector_type(4)));
typedef float f32x16 __attribute__((ext_vector_type(16)));
typedef unsigned u32x4 __attribute__((ext_vector_type(4)));
typedef unsigned u32x2 __attribute__((ext_vector_type(2)));

#ifndef SKIP_ATTN
#define SKIP_ATTN 0
#endif
#ifndef SKIP_SGU
#define SKIP_SGU 0
#endif
#ifndef SKIP_MOE
#define SKIP_MOE 0
#endif
#ifndef PH_MASK
#define PH_MASK 0x3ff
#endif
#define PH(x) ((PH_MASK >> (x)) & 1)
#ifndef REP_PH
#define REP_PH -1
#endif
#define NREP(x) ((x) == REP_PH ? 2 : 1)
#ifndef NO_P6A
#define NO_P6A 0
#endif
#ifndef NO_P6B
#define NO_P6B 0
#endif
#ifndef ATTN_BRANCHES
#define ATTN_BRANCHES 7
#endif

constexpr int NB = 4, SEQ = 8192, MTOK = NB * SEQ, DM = 1024;
constexpr int DIN = 4376, NPROJ = 4608;
constexpr int NEXP = 32, DFF = 1024;
constexpr int MPAD = 131072 + 32 * 256;
constexpr float LOG2E = 1.4426950408889634f;
constexpr float QSCALE = 0.125f * LOG2E;
constexpr float NEGBIG = -1e30f;

constexpr size_t MiB = 1u << 20;
constexpr size_t WS_CTL = 0;
constexpr size_t CTL_CNT = 0;
constexpr size_t CTL_TE = 64 * 1024;
constexpr size_t CTL_NT = 96 * 1024;
constexpr size_t CTL_C1 = 128 * 1024;
constexpr size_t CTL_BAR = 256 * 1024;
constexpr size_t WS_WIN = 1 * MiB, WS_WAB = 10 * MiB, WS_WOUT = 12 * MiB, WS_W1K = 14 * MiB, WS_W1V = 14 * MiB + 512 * 1024;
constexpr size_t WS_W2K = 15 * MiB, WS_W2V = 15 * MiB + 64 * 1024, WS_WTRIL = 15 * MiB + 512 * 1024;
constexpr size_t WS_WGU = 16 * MiB, WS_WD = 144 * MiB, WS_X2 = 208 * MiB;
constexpr size_t WS_H1 = 336 * MiB, WS_Q = 400 * MiB, WS_KV = 432 * MiB, WS_U = 480 * MiB, WS_V = 512 * MiB, WS_MG = 544 * MiB;
constexpr size_t WS_NG = 672 * MiB, WS_KCMP = 676 * MiB, WS_VCMP = 676 * MiB + 512 * 1024, WS_YAB = 678 * MiB, WS_MERGED = 742 * MiB;
constexpr size_t WS_AS = 336 * MiB, WS_Y = 336 * MiB, WS_ACT = 608 * MiB, WS_H2 = 608 * MiB;
constexpr size_t WS_TOKE = 880 * MiB, WS_TOKW = 881 * MiB, WS_SLOT = 882 * MiB, WS_WSLOT = 883 * MiB;
constexpr size_t WS_RINV = 884 * MiB;
constexpr size_t WS_END = 885 * MiB;

constexpr int LDS_BYTES = 147456;
constexpr int NWAVES = 8, NTHREADS = 512;

struct Args { const float* in[26]; float* out; unsigned char* ws; };

DI float bf2f(unsigned b) { return __uint_as_float(b << 16); }
DI unsigned pk2(float lo, float hi) {
    typedef float f2_t __attribute__((ext_vector_type(2))); typedef __bf16 b2_t __attribute__((ext_vector_type(2)));
    f2_t v = {lo, hi}; b2_t b = __builtin_convertvector(v, b2_t); return __builtin_bit_cast(unsigned, b);
}
DI unsigned short f2bf(float x) { return (unsigned short)(pk2(x, 0.f) & 0xffffu); }
DI float ex2(float x) { return __builtin_amdgcn_exp2f(x); }
DI float rcpf_(float x) { return __builtin_amdgcn_rcpf(x); }
DI float sigm(float x) { return rcpf_(1.f + ex2(-LOG2E * x)); }
DI float gelu_t(float x) { const float u = 0.7978845608028654f * (x + 0.044715f * x * x * x); return x * rcpf_(1.f + ex2(-2.f * LOG2E * u)); }
DI float wave_sum(float v) {
#pragma unroll
    for (int o = 1; o < 64; o <<= 1) v += __shfl_xor(v, o);
    return v;
}
DI float wave_max(float v) {
#pragma unroll
    for (int o = 1; o < 64; o <<= 1) v = fmaxf(v, __shfl_xor(v, o));
    return v;
}
DI int crow(int i, int h) { return (i & 3) + 8 * (i >> 2) + 4 * h; }
#define MFMA32(a, b, c) __builtin_amdgcn_mfma_f32_32x32x16_bf16((a), (b), (c), 0, 0, 0)
DI LAS unsigned char* lds_raw_las(unsigned char* p) { return (LAS unsigned char*)p; }
DI void lds_wait() { asm volatile("s_waitcnt lgkmcnt(0)" ::: "memory"); }

template <class RowMap>
DI void transpose_item(const float* __restrict__ W, int K, int N, bf16_t* __restrict__ WT, const float* __restrict__ kscale, LAS float* scr, int item, int lane, RowMap rm) {
    const int nblk = (N + 31) >> 5, kb = item / nblk, nb = item - kb * nblk, k0 = 64 * kb, n0 = 32 * nb;
    const int ncol = n0 + (lane & 31);
#pragma unroll 8
    for (int i = 0; i < 32; ++i) {
        const int kk = 2 * i + (lane >> 5);
        float v = (ncol < N) ? W[(size_t)(k0 + kk) * N + ncol] : 0.f;
        if (kscale) v *= kscale[k0 + kk];
        scr[kk * 33 + (lane & 31)] = v;
    }
    lds_wait();
    const int c = lane & 7;
#pragma unroll
    for (int j = 0; j < 4; ++j) {
        const int nl = (lane >> 3) + 8 * j, n = n0 + nl;
        const LAS float* s = scr + (8 * c) * 33 + nl;
        u32x4 o; o.x = pk2(s[0 * 33], s[1 * 33]); o.y = pk2(s[2 * 33], s[3 * 33]); o.z = pk2(s[4 * 33], s[5 * 33]); o.w = pk2(s[6 * 33], s[7 * 33]);
        if (n < N) *(u32x4*)(WT + (size_t)rm(n) * K + k0 + 8 * c) = o;
    }
    lds_wait();
}
struct MapId { int off; DI int operator()(int n) const { return n + off; } };
struct MapWin { DI int operator()(int n) const { return n < 1280 ? n : (n < 1304 ? n + 3072 : n - 24); } };
struct MapGU { DI int operator()(int n) const { return n < 1024 ? ((n >> 7) * 256 + (n & 127)) : ((((n - 1024) >> 7) * 256) + 128 + (n & 127)); } };

DI void p0_prep(const Args& a, LAS unsigned char* lds, int gw, int NGW, int wave, int lane) {
    unsigned char* ws = a.ws;
    LAS float* scr = (LAS float*)(lds + wave * 8704);
    constexpr int I_WIN = 16 * 137, I_WA = 8 * 32, I_WO = 16 * 32, I_W1 = 32 * 4, I_W2 = 2 * 2, I_GU1 = 16 * 64, I_GU = 32 * I_GU1, I_D1 = 16 * 32, I_D = 32 * I_D1;
    constexpr int NIT = I_WIN + 2 * I_WA + I_WO + 2 * I_W1 + 2 * I_W2 + I_GU + I_D;
    for (int it = gw; it < NIT; it += NGW) {
        int r = it;
        if (r < I_GU) { const int e = r / I_GU1; transpose_item(a.in[21] + (size_t)e * 1024 * 2048, 1024, 2048, (bf16_t*)(ws + WS_WGU) + (size_t)e * 2048 * 1024, nullptr, scr, r - e * I_GU1, lane, MapGU{}); continue; } r -= I_GU;
        if (r < I_D) { const int e = r / I_D1; transpose_item(a.in[23] + (size_t)e * 1024 * 1024, 1024, 1024, (bf16_t*)(ws + WS_WD) + (size_t)e * 1024 * 1024, nullptr, scr, r - e * I_D1, lane, MapId{0}); continue; } r -= I_D;
        if (r < I_WIN) { transpose_item(a.in[2], 1024, DIN, (bf16_t*)(ws + WS_WIN), a.in[1], scr, r, lane, MapWin{}); continue; } r -= I_WIN;
        if (r < I_WA) { transpose_item(a.in[15], 512, 1024, (bf16_t*)(ws + WS_WAB), nullptr, scr, r, lane, MapId{0}); continue; } r -= I_WA;
        if (r < I_WA) { transpose_item(a.in[16], 512, 1024, (bf16_t*)(ws + WS_WAB), nullptr, scr, r, lane, MapId{1024}); continue; } r -= I_WA;
        if (r < I_WO) { transpose_item(a.in[17], 1024, 1024, (bf16_t*)(ws + WS_WOUT), nullptr, scr, r, lane, MapId{0}); continue; } r -= I_WO;
        if (r < I_W1) { transpose_item(a.in[3], 2048, 128, (bf16_t*)(ws + WS_W1K), nullptr, scr, r, lane, MapId{0}); continue; } r -= I_W1;
        if (r < I_W1) { transpose_item(a.in[7], 2048, 128, (bf16_t*)(ws + WS_W1V), nullptr, scr, r, lane, MapId{0}); continue; } r -= I_W1;
        if (r < I_W2) { transpose_item(a.in[5], 128, 64, (bf16_t*)(ws + WS_W2K), nullptr, scr, r, lane, MapId{0}); continue; } r -= I_W2;
        transpose_item(a.in[9], 128, 64, (bf16_t*)(ws + WS_W2V), nullptr, scr, r, lane, MapId{0});
    }
    {
        const float* x = a.in[0]; bf16_t* H1 = (bf16_t*)(ws + WS_H1);
        for (int m = gw; m < MTOK; m += NGW) {
            const f32x4* xr = (const f32x4*)(x + (size_t)m * DM) + lane;
            f32x4 v[4]; float s = 0.f;
#pragma unroll
            for (int j = 0; j < 4; ++j) { v[j] = xr[64 * j]; s += (v[j].x * v[j].x + v[j].y * v[j].y) + (v[j].z * v[j].z + v[j].w * v[j].w); }
            const float rinv = 1.0f / sqrtf(wave_sum(s) * (1.f / DM) + 1e-5f);
            u32x2* o = (u32x2*)(H1 + (size_t)m * DM) + lane;
#pragma unroll
            for (int j = 0; j < 4; ++j) { u32x2 w; w.x = pk2(v[j].x * rinv, v[j].y * rinv); w.y = pk2(v[j].z * rinv, v[j].w * rinv); o[64 * j] = w; }
        }
    }
    {
        float* C1 = (float*)(ws + WS_CTL + CTL_C1);
        for (int o = gw; o < 256; o += NGW) {
            const int ty = o >> 7, f = o & 127; const float* pe = a.in[ty ? 10 : 6]; const float* w1 = a.in[ty ? 7 : 3]; const float* b1 = a.in[ty ? 8 : 4];
            float s = 0.f;
            for (int k = lane; k < 2048; k += 64) s += pe[k] * w1[(size_t)k * 128 + f];
            s = wave_sum(s);
            if (lane == 0) C1[o] = s + b1[f];
        }
    }
    {
        const float* wsp = a.in[13]; bf16_t* WT = (bf16_t*)(ws + WS_WTRIL);
        for (int i = gw * 64 + lane; i < 8 * 128 * 128; i += NGW * 64) { const int t = (i >> 7) & 127, s = i & 127; WT[i] = f2bf(s <= t ? wsp[i] : 0.f); }
    }
}

typedef pg8::f32x4 pf4;
struct Epi1 {
    static constexpr bool PERM = true, AFTER_DRAIN = false;
    bf16_t *Q, *KV, *U, *V, *MG; float* NG;
    DI void operator()(const pf4 (&acc)[2][2][4][2], const pg8::Unit& u, int wr, int wc, int fr, int fq) const {
        const int row0 = u.pm * 256 + wr * 64 + fr, pn = u.pn, c0 = wc * 32 + 8 * fq;
        if (pn == 17) {
            if (wc == 0 && fq < 3) {
#pragma unroll
                for (int ai = 0; ai < 2; ++ai)
#pragma unroll
                    for (int m = 0; m < 4; ++m) { float* p = NG + (size_t)(row0 + ai * 128 + m * 16) * 24 + c0; const pf4 v0 = acc[ai][0][m][0], v1 = acc[ai][0][m][1];
                        *(f32x4*)p = (f32x4){sigm(v0[0]), sigm(v0[1]), sigm(v0[2]), sigm(v0[3])}; *(f32x4*)(p + 4) = (f32x4){sigm(v1[0]), sigm(v1[1]), sigm(v1[2]), sigm(v1[3])}; }
            }
            return;
        }
        bf16_t* base; int ldc, ct, mode;
        float sc = 1.f;
        if (pn < 2) { base = Q; ldc = 512; ct = pn; mode = 0; sc = QSCALE; }
        else if (pn < 5) { base = KV; ldc = 768; ct = pn - 2; mode = 0; }
        else if (pn < 7) { base = U; ldc = 512; ct = pn - 5; mode = 1; }
        else if (pn < 9) { base = V; ldc = 512; ct = pn - 7; mode = 1; }
        else { base = MG; ldc = 2048; ct = pn - 9; mode = 2; }
#pragma unroll
        for (int ai = 0; ai < 2; ++ai)
#pragma unroll
            for (int m = 0; m < 4; ++m) {
                bf16_t* rowp = base + (size_t)(row0 + ai * 128 + m * 16) * ldc + ct * 256 + c0;
#pragma unroll
                for (int bj = 0; bj < 2; ++bj) {
                    pf4 v0 = acc[ai][bj][m][0], v1 = acc[ai][bj][m][1];
                    if (mode == 0) { v0 = v0 * sc; v1 = v1 * sc; }
                    else if (mode == 1) { v0 = (pf4){gelu_t(v0[0]), gelu_t(v0[1]), gelu_t(v0[2]), gelu_t(v0[3])}; v1 = (pf4){gelu_t(v1[0]), gelu_t(v1[1]), gelu_t(v1[2]), gelu_t(v1[3])}; }
                    else { v0 = (pf4){sigm(v0[0]), sigm(v0[1]), sigm(v0[2]), sigm(v0[3])}; v1 = (pf4){sigm(v1[0]), sigm(v1[1]), sigm(v1[2]), sigm(v1[3])}; }
                    u32x4 w; w.x = pk2(v0[0], v0[1]); w.y = pk2(v0[2], v0[3]); w.z = pk2(v1[0], v1[1]); w.w = pk2(v1[2], v1[3]);
                    *(u32x4*)(rowp + bj * 128) = w;
                }
            }
    }
};
struct PairOrder {
    int G, c;
    DI bool next(int i, pg8::Unit& u) const {
        const int L = (i >> 1) * G + c; if (L >= 512) return false;
        const int br = i & 1; u.pm = br * 128 + (L >> 2); u.pn = br * 4 + (L & 3); return true;
    }
    DI void a_ready(const pg8::Unit&) const {}
    DI void done(const pg8::Unit&) const {}
};
struct Epi4 {
    static constexpr bool PERM = true, AFTER_DRAIN = false;
    const bf16_t* MG; bf16_t* OUT;
    DI void operator()(const pf4 (&acc)[2][2][4][2], const pg8::Unit& u, int wr, int wc, int fr, int fq) const {
        const int br = u.pn >> 2, pn = u.pn & 3, pm = u.pm & 127;
        const int row0 = pm * 256 + wr * 64 + fr, c0 = pn * 256 + wc * 32 + 8 * fq;
#pragma unroll
        for (int ai = 0; ai < 2; ++ai)
#pragma unroll
            for (int m = 0; m < 4; ++m) {
                const size_t row = (size_t)(row0 + ai * 128 + m * 16);
#pragma unroll
                for (int bj = 0; bj < 2; ++bj) {
                    const int col = c0 + bj * 128;
                    const u32x4 gw = *(const u32x4*)(MG + row * 2048 + br * 1024 + col);
                    const pf4 v0 = acc[ai][bj][m][0], v1 = acc[ai][bj][m][1];
                    float r[8];
                    r[0] = v0[0] * bf2f(gw.x & 0xffffu); r[1] = v0[1] * bf2f(gw.x >> 16); r[2] = v0[2] * bf2f(gw.y & 0xffffu); r[3] = v0[3] * bf2f(gw.y >> 16);
                    r[4] = v1[0] * bf2f(gw.z & 0xffffu); r[5] = v1[1] * bf2f(gw.z >> 16); r[6] = v1[2] * bf2f(gw.w & 0xffffu); r[7] = v1[3] * bf2f(gw.w >> 16);
                    u32x4* op = (u32x4*)(OUT + row * 1024 + col);
                    if (br == 1) { const u32x4 pv = *op;
                        r[0] += bf2f(pv.x & 0xffffu); r[1] += bf2f(pv.x >> 16); r[2] += bf2f(pv.y & 0xffffu); r[3] += bf2f(pv.y >> 16);
                        r[4] += bf2f(pv.z & 0xffffu); r[5] += bf2f(pv.z >> 16); r[6] += bf2f(pv.w & 0xffffu); r[7] += bf2f(pv.w >> 16); }
                    u32x4 w; w.x = pk2(r[0], r[1]); w.y = pk2(r[2], r[3]); w.z = pk2(r[4], r[5]); w.w = pk2(r[6], r[7]);
                    *op = w;
                }
            }
    }
};
struct Epi5 {
    static constexpr bool PERM = false, AFTER_DRAIN = false;
    const float* X; float* X2;
    DI void operator()(const pf4 (&acc)[2][2][4][2], const pg8::Unit& u, int wr, int wc, int fr, int fq) const {
        const int row0 = u.pm * 256 + wr * 64 + fr, c0 = u.pn * 256 + wc * 32 + 4 * fq;
#pragma unroll
        for (int ai = 0; ai < 2; ++ai)
#pragma unroll
            for (int m = 0; m < 4; ++m) {
                const size_t off = (size_t)(row0 + ai * 128 + m * 16) * DM + c0;
#pragma unroll
                for (int bj = 0; bj < 2; ++bj)
#pragma unroll
                    for (int n = 0; n < 2; ++n) { const f32x4 xv = *(const f32x4*)(X + off + bj * 128 + n * 16); const pf4 v = acc[ai][bj][m][n];
                        *(f32x4*)(X2 + off + bj * 128 + n * 16) = (f32x4){xv[0] + v[0], xv[1] + v[1], xv[2] + v[2], xv[3] + v[3]}; }
            }
    }
};
struct MoeOrder {
    const int* TE; int NT, npn, G, c;
    DI bool next(int i, pg8::Unit& u) const {
        int mt, pn;
        if ((G & 7) == 0) { const int x = c & 7, jj = i * (G >> 3) + (c >> 3); mt = x + 8 * (jj / npn); pn = jj % npn; }
        else { const int L = i * G + c; mt = L / npn; pn = L % npn; }
        if (mt >= NT) return false;
        const int e = __builtin_amdgcn_readfirstlane(TE[mt]);
        u.pm = mt; u.pn = e * npn + pn; return true;
    }
    DI void a_ready(const pg8::Unit&) const {}
    DI void done(const pg8::Unit&) const {}
};
struct Epi7 {
    static constexpr bool PERM = true, AFTER_DRAIN = false;
    const float* BGU; bf16_t* ACT;
    DI void operator()(const pf4 (&acc)[2][2][4][2], const pg8::Unit& u, int wr, int wc, int fr, int fq) const {
        const int e = u.pn >> 3, pn = u.pn & 7, row0 = u.pm * 256 + wr * 64 + fr, c0 = pn * 128 + wc * 32 + 8 * fq;
        const float* bg = BGU + (size_t)e * 2048 + c0; const float* bu = bg + 1024;
        const f32x4 bg0 = *(const f32x4*)bg, bg1 = *(const f32x4*)(bg + 4), bu0 = *(const f32x4*)bu, bu1 = *(const f32x4*)(bu + 4);
#pragma unroll
        for (int ai = 0; ai < 2; ++ai)
#pragma unroll
            for (int m = 0; m < 4; ++m) {
                float r[8];
#pragma unroll
                for (int n = 0; n < 2; ++n)
#pragma unroll
                    for (int k = 0; k < 4; ++k) {
                        const float gt = fminf(acc[ai][0][m][n][k] + (n ? bg1[k] : bg0[k]), 7.0f);
                        const float up = fminf(fmaxf(acc[ai][1][m][n][k] + (n ? bu1[k] : bu0[k]), -7.0f), 7.0f);
                        r[n * 4 + k] = gt * rcpf_(1.f + ex2(-1.702f * LOG2E * gt)) * (up + 1.0f);
                    }
                u32x4 w; w.x = pk2(r[0], r[1]); w.y = pk2(r[2], r[3]); w.z = pk2(r[4], r[5]); w.w = pk2(r[6], r[7]);
                *(u32x4*)(ACT + (size_t)(row0 + ai * 128 + m * 16) * DFF + c0) = w;
            }
    }
};
struct Epi8 {
    static constexpr bool PERM = true, AFTER_DRAIN = false;
    const float* BD; const float* WSLOT; bf16_t* Y;
    DI void operator()(const pf4 (&acc)[2][2][4][2], const pg8::Unit& u, int wr, int wc, int fr, int fq) const {
        const int e = u.pn >> 2, pn = u.pn & 3, row0 = u.pm * 256 + wr * 64 + fr, c0 = pn * 256 + wc * 32 + 8 * fq;
        f32x4 bv[2][2];
#pragma unroll
        for (int bj = 0; bj < 2; ++bj)
#pragma unroll
            for (int n = 0; n < 2; ++n) bv[bj][n] = *(const f32x4*)(BD + (size_t)e * DM + c0 + bj * 128 + 4 * n);
#pragma unroll
        for (int ai = 0; ai < 2; ++ai)
#pragma unroll
            for (int m = 0; m < 4; ++m) {
                const size_t row = (size_t)(row0 + ai * 128 + m * 16); const float wt = WSLOT[row];
#pragma unroll
                for (int bj = 0; bj < 2; ++bj) {
                    const pf4 v0 = acc[ai][bj][m][0], v1 = acc[ai][bj][m][1]; const f32x4 b0 = bv[bj][0], b1 = bv[bj][1];
                    u32x4 w; w.x = pk2((v0[0] + b0[0]) * wt, (v0[1] + b0[1]) * wt); w.y = pk2((v0[2] + b0[2]) * wt, (v0[3] + b0[3]) * wt);
                    w.z = pk2((v1[0] + b1[0]) * wt, (v1[1] + b1[1]) * wt); w.w = pk2((v1[2] + b1[2]) * wt, (v1[3] + b1[3]) * wt);
                    *(u32x4*)(Y + row * DM + c0 + bj * 128) = w;
                }
            }
    }
};

DI void p2_compress_item(const Args& a, LAS unsigned char* lds, int item, int tid, int wave, int lane) {
    unsigned char* ws = a.ws;
    const int nt = item & 15, ty = (item >> 4) & 1, g = (item >> 5) & 1, b = item >> 6;
    const bf16_t* KV = (const bf16_t*)(ws + WS_KV);
    const bf16_t* W1 = (const bf16_t*)(ws + (ty ? WS_W1V : WS_W1K));
    const bf16_t* W2 = (const bf16_t*)(ws + (ty ? WS_W2V : WS_W2K));
    const float* C1 = (const float*)(ws + WS_CTL + CTL_C1) + ty * 128;
    bf16_t* OUT = (bf16_t*)(ws + (ty ? WS_VCMP : WS_KCMP)) + (size_t)((b * 2 + g) * 512 + nt * 32) * 64;
    LAS unsigned char* Xs = lds;
    LAS float* Hs = (LAS float*)(lds + 76032);
    LAS unsigned char* Hb = lds + 76032 + 32768;
    const int r = lane & 31, h = lane >> 5;
    const int p0 = 512 * nt, colsrc = ty * 128 + g * 64;
    for (int i = tid; i < 528 * 8; i += NTHREADS) {
        const int pr = i >> 3, ch = i & 7; int pos = p0 + pr; pos = pos > SEQ - 1 ? SEQ - 1 : pos;
        const u32x4 v = *(const u32x4*)(KV + (size_t)(b * SEQ + pos) * 768 + colsrc + ch * 8);
        *(LAS u32x4*)(Xs + pr * 144 + ch * 16) = v;
    }
    __syncthreads();
    {
        const int ft = wave & 3, kh = wave >> 2;
        f32x16 acc; for (int i = 0; i < 16; ++i) acc[i] = 0.f;
        const bf16_t* wrow = W1 + (size_t)(ft * 32 + r) * 2048 + 8 * h;
#pragma unroll 4
        for (int s = kh * 64; s < kh * 64 + 64; ++s) {
            const int l = s >> 2, d0 = (s & 3) * 16;
            const bf16x8 af = *(const LAS bf16x8*)(Xs + (16 * r + l) * 144 + (d0 + 8 * h) * 2);
            const bf16x8 bfr = *(const bf16x8*)(wrow + 16 * s);
            acc = MFMA32(af, bfr, acc);
        }
#pragma unroll
        for (int i = 0; i < 16; ++i) Hs[(kh * 32 + crow(i, h)) * 128 + ft * 32 + r] = acc[i];
    }
    __syncthreads();
    for (int i = tid; i < 32 * 128; i += NTHREADS) {
        const int n = i >> 7, f = i & 127;
        const float v = Hs[n * 128 + f] + Hs[(32 + n) * 128 + f] + C1[f];
        *(LAS unsigned short*)(Hb + n * 272 + f * 2) = f2bf(gelu_t(v));
    }
    __syncthreads();
    if (wave < 2) {
        f32x16 acc; for (int i = 0; i < 16; ++i) acc[i] = 0.f;
        const bf16_t* wrow = W2 + (size_t)(wave * 32 + r) * 128 + 8 * h;
#pragma unroll
        for (int s = 0; s < 8; ++s) {
            const bf16x8 af = *(const LAS bf16x8*)(Hb + r * 272 + (16 * s + 8 * h) * 2);
            const bf16x8 bfr = *(const bf16x8*)(wrow + 16 * s);
            acc = MFMA32(af, bfr, acc);
        }
#pragma unroll
        for (int i = 0; i < 16; ++i) OUT[(size_t)crow(i, h) * 64 + wave * 32 + r] = f2bf(acc[i]);
    }
    __syncthreads();
}

DI void p2_sgu_item(const Args& a, LAS unsigned char* lds, int item, int tid, int wave, int lane) {
    unsigned char* ws = a.ws;
    const bf16_t* U = (const bf16_t*)(ws + WS_U); const bf16_t* V = (const bf16_t*)(ws + WS_V);
    const bf16_t* WT = (const bf16_t*)(ws + WS_WTRIL);
    bf16_t* YB = (bf16_t*)(ws + WS_YAB) + (size_t)MTOK * 512;
    const float* lng = a.in[11]; const float* lnb = a.in[12]; const float* bs = a.in[14];
    const size_t row0 = (size_t)item * 128;
    LAS unsigned char* VnT = lds;
    const int r = lane & 31, h = lane >> 5;
    {
        float gg[8], bb[8];
#pragma unroll
        for (int e = 0; e < 8; ++e) { gg[e] = lng[8 * lane + e]; bb[e] = lnb[8 * lane + e]; }
        for (int pp = 0; pp < 16; ++pp) {
            const int pos = wave * 16 + pp;
            const u32x4 raw = *(const u32x4*)(V + (row0 + pos) * 512 + 8 * lane);
            float x[8]; x[0] = bf2f(raw.x & 0xffffu); x[1] = bf2f(raw.x >> 16); x[2] = bf2f(raw.y & 0xffffu); x[3] = bf2f(raw.y >> 16);
            x[4] = bf2f(raw.z & 0xffffu); x[5] = bf2f(raw.z >> 16); x[6] = bf2f(raw.w & 0xffffu); x[7] = bf2f(raw.w >> 16);
            float s = 0.f;
#pragma unroll
            for (int e = 0; e < 8; ++e) s += x[e];
            const float mu = wave_sum(s) * (1.f / 512.f); float q = 0.f;
#pragma unroll
            for (int e = 0; e < 8; ++e) { x[e] -= mu; q += x[e] * x[e]; }
            const float rstd = 1.0f / sqrtf(wave_sum(q) * (1.f / 512.f) + 1e-5f);
#pragma unroll
            for (int e = 0; e < 8; ++e) *(LAS unsigned short*)(VnT + (8 * lane + e) * 272 + pos * 2) = f2bf(x[e] * rstd * gg[e] + bb[e]);
        }
    }
    __syncthreads();
    {
        const int grp = wave;
        for (int tt = 0; tt < 4; ++tt) {
            f32x16 acc[2];
#pragma unroll
            for (int i = 0; i < 16; ++i) { acc[0][i] = 0.f; acc[1][i] = 0.f; }
            const bf16_t* wrow = WT + (size_t)(grp * 128 + tt * 32 + r) * 128 + 8 * h;
            const int nst = 2 * tt + 2;
            for (int s = 0; s < nst; ++s) {
                const bf16x8 bfr = *(const bf16x8*)(wrow + 16 * s);
#pragma unroll
                for (int dt = 0; dt < 2; ++dt) {
                    const bf16x8 af = *(const LAS bf16x8*)(VnT + (grp * 64 + dt * 32 + r) * 272 + (16 * s + 8 * h) * 2);
                    acc[dt] = MFMA32(af, bfr, acc[dt]);
                }
            }
            const int t = tt * 32 + r; const float bt = bs[grp * 128 + t];
            const size_t rowt = row0 + t;
#pragma unroll
            for (int dt = 0; dt < 2; ++dt)
#pragma unroll
                for (int q4 = 0; q4 < 4; ++q4) {
                    const int d = dt * 32 + 8 * q4 + 4 * h;
                    const u32x2 uu = *(const u32x2*)(U + rowt * 512 + grp * 64 + d);
                    const float y0 = bf2f(uu.x & 0xffffu) * (acc[dt][4 * q4 + 0] + bt), y1 = bf2f(uu.x >> 16) * (acc[dt][4 * q4 + 1] + bt);
                    const float y2 = bf2f(uu.y & 0xffffu) * (acc[dt][4 * q4 + 2] + bt), y3 = bf2f(uu.y >> 16) * (acc[dt][4 * q4 + 3] + bt);
                    u32x2 w; w.x = pk2(y0, y1); w.y = pk2(y2, y3);
                    *(u32x2*)(YB + rowt * 512 + grp * 64 + d) = w;
                }
        }
    }
    __syncthreads();
}

constexpr int AL_K0 = 0, AL_K1 = 9216, AL_V0 = 18432, AL_V1 = 27136, AL_PB = 35840, AL_IMP = 102400, AL_SELM = 135424, AL_UNI = 136448, AL_BL = 136512, AL_NBL = 137024, AL_THR = 137088;
static_assert(AL_THR + 256 <= LDS_BYTES, "attention LDS map");
struct KVSrc { const bf16_t* k; const bf16_t* v; int pitch; };

template <int MODE, class F>
DI void attn_block(const LAS unsigned char* Ks, const LAS unsigned char* Vs, const bf16x8 (&qf)[4], f32x16 (&o)[2], float& m, float& l, float invl, LAS float* pbrow, F f, int r, int h) {
    f32x16 p0, p1;
#pragma unroll
    for (int i = 0; i < 16; ++i) { p0[i] = 0.f; p1[i] = 0.f; }
#pragma unroll
    for (int s = 0; s < 4; ++s) {
        const bf16x8 a0 = *(const LAS bf16x8*)(Ks + r * 144 + s * 32 + h * 16);
        const bf16x8 a1 = *(const LAS bf16x8*)(Ks + (32 + r) * 144 + s * 32 + h * 16);
        p0 = MFMA32(a0, qf[s], p0); p1 = MFMA32(a1, qf[s], p1);
    }
#pragma unroll
    for (int i = 0; i < 16; ++i) { const int kv = crow(i, h); p0[i] = f(kv, p0[i]); p1[i] = f(kv + 32, p1[i]); }
    if (MODE == 0 || MODE == 1) {
        float mx = fmaxf(p0[0], p1[0]);
#pragma unroll
        for (int i = 1; i < 16; ++i) mx = fmaxf(mx, fmaxf(p0[i], p1[i]));
        mx = fmaxf(mx, __shfl_xor(mx, 32));
        const float mn = fmaxf(m, mx), alpha = ex2(m - mn); m = mn;
        float sum = 0.f;
#pragma unroll
        for (int i = 0; i < 16; ++i) { p0[i] = ex2(p0[i] - mn); p1[i] = ex2(p1[i] - mn); sum += p0[i] + p1[i]; }
        l = l * alpha + sum;
        if (MODE == 0) {
#pragma unroll
            for (int i = 0; i < 16; ++i) { o[0][i] *= alpha; o[1][i] *= alpha; }
        }
    } else {
#pragma unroll
        for (int i = 0; i < 16; ++i) {
            p0[i] = p0[i] > -1e29f ? ex2(p0[i] - m) * invl : 0.f; p1[i] = p1[i] > -1e29f ? ex2(p1[i] - m) * invl : 0.f;
            pbrow[crow(i, h)] = p0[i]; pbrow[32 + crow(i, h)] = p1[i];
        }
    }
    if (MODE != 1) {
        bf16x8 pf[4];
#pragma unroll
        for (int ks = 0; ks < 2; ++ks) {
            u32x4 w0, w1;
            w0.x = pk2(p0[8 * ks + 0], p0[8 * ks + 1]); w0.y = pk2(p0[8 * ks + 2], p0[8 * ks + 3]); w0.z = pk2(p0[8 * ks + 4], p0[8 * ks + 5]); w0.w = pk2(p0[8 * ks + 6], p0[8 * ks + 7]);
            w1.x = pk2(p1[8 * ks + 0], p1[8 * ks + 1]); w1.y = pk2(p1[8 * ks + 2], p1[8 * ks + 3]); w1.z = pk2(p1[8 * ks + 4], p1[8 * ks + 5]); w1.w = pk2(p1[8 * ks + 6], p1[8 * ks + 7]);
            pf[ks] = __builtin_bit_cast(bf16x8, w0); pf[2 + ks] = __builtin_bit_cast(bf16x8, w1);
        }
#pragma unroll
        for (int dh = 0; dh < 2; ++dh) {
            __builtin_amdgcn_sched_barrier(0);
#pragma unroll
            for (int ks = 0; ks < 4; ++ks) {
                const LAS unsigned char* vp = Vs + (dh * 32 + r) * 136 + ks * 32 + h * 8;
                const s16x4 lo = *(const LAS s16x4*)vp, hi = *(const LAS s16x4*)(vp + 16);
                const bf16x8 af = __builtin_shufflevector(lo, hi, 0, 1, 2, 3, 4, 5, 6, 7);
                o[dh] = MFMA32(af, pf[ks], o[dh]);
            }
        }
        __builtin_amdgcn_sched_barrier(0);
    }
}

DI void kv_load(const KVSrc& s, int tid, int wave, int lane, u32x4& kreg, u32x4& vreg) {
    kreg = *(const u32x4*)(s.k + (size_t)(tid >> 3) * s.pitch + (tid & 7) * 8);
    vreg = *(const u32x4*)(s.v + (size_t)lane * s.pitch + wave * 8);
}
DI void kv_store(LAS unsigned char* Kb, LAS unsigned char* Vb, int tid, int wave, int lane, const u32x4& kreg, const u32x4& vreg) {
    *(LAS u32x4*)(Kb + (tid >> 3) * 144 + (tid & 7) * 16) = kreg;
    LAS unsigned char* vp = Vb + (wave * 8) * 136 + lane * 2;
    *(LAS unsigned short*)(vp + 0 * 136) = (unsigned short)(vreg.x & 0xffffu); *(LAS unsigned short*)(vp + 1 * 136) = (unsigned short)(vreg.x >> 16);
    *(LAS unsigned short*)(vp + 2 * 136) = (unsigned short)(vreg.y & 0xffffu); *(LAS unsigned short*)(vp + 3 * 136) = (unsigned short)(vreg.y >> 16);
    *(LAS unsigned short*)(vp + 4 * 136) = (unsigned short)(vreg.z & 0xffffu); *(LAS unsigned short*)(vp + 5 * 136) = (unsigned short)(vreg.z >> 16);
    *(LAS unsigned short*)(vp + 6 * 136) = (unsigned short)(vreg.w & 0xffffu); *(LAS unsigned short*)(vp + 7 * 136) = (unsigned short)(vreg.w >> 16);
}

template <int MODE, class SrcF, class MaskF, class PostF>
DI void attn_run(int nb, SrcF src, MaskF mk, PostF post, LAS unsigned char* lds, const bf16x8 (&qf)[4], f32x16 (&o)[2], float& m, float& l, float invl, LAS float* pbrow,
                 int tid, int wave, int lane, int r, int h) {
    u32x4 kreg, vreg;
    kv_load(src(0), tid, wave, lane, kreg, vreg);
    kv_store(lds + AL_K0, lds + AL_V0, tid, wave, lane, kreg, vreg);
    __syncthreads();
    for (int i = 0; i < nb; ++i) {
        const int cur = i & 1;
        if (i + 1 < nb) kv_load(src(i + 1), tid, wave, lane, kreg, vreg);
        attn_block<MODE>(lds + (cur ? AL_K1 : AL_K0), lds + (cur ? AL_V1 : AL_V0), qf, o, m, l, invl, pbrow, mk(i), r, h);
        if (MODE == 2) { __syncthreads(); post(i); }
        if (i + 1 < nb) kv_store(lds + (cur ? AL_K0 : AL_K1), lds + (cur ? AL_V0 : AL_V1), tid, wave, lane, kreg, vreg);
        __syncthreads();
    }
}

#define CE_DESC(a, b) do { const unsigned _x = (a), _y = (b); (a) = _x > _y ? _x : _y; (b) = _x > _y ? _y : _x; } while (0)
DI void sort16_desc(unsigned (&k)[16]) {
#pragma unroll
    for (int kk = 2; kk <= 16; kk <<= 1)
#pragma unroll
        for (int j = kk >> 1; j > 0; j >>= 1)
#pragma unroll
            for (int i = 0; i < 16; ++i) { const int p = i ^ j; if (p > i) { if ((i & kk) == 0) CE_DESC(k[i], k[p]); else CE_DESC(k[p], k[i]); } }
}
DI void merge16_desc(unsigned (&k)[16]) {
#pragma unroll
    for (int j = 8; j > 0; j >>= 1)
#pragma unroll
        for (int i = 0; i < 16; ++i) { const int p = i ^ j; if (p > i) CE_DESC(k[i], k[p]); }
}

DI void attn_tile(const Args& a, LAS unsigned char* lds, int b, int g, int c, int tid, int wave, int lane) {
    asm volatile("" : "+v"(tid), "+v"(lane));
    unsigned char* ws = a.ws;
    const bf16_t* Q = (const bf16_t*)(ws + WS_Q); const bf16_t* KV = (const bf16_t*)(ws + WS_KV);
    const bf16_t* KC = (const bf16_t*)(ws + WS_KCMP) + (size_t)(b * 2 + g) * 512 * 64; const bf16_t* VC = (const bf16_t*)(ws + WS_VCMP) + (size_t)(b * 2 + g) * 512 * 64;
    const float* NG = (const float*)(ws + WS_NG); bf16_t* YA = (bf16_t*)(ws + WS_YAB);
    const int r = lane & 31, h = lane >> 5, hd = wave >> 1, th = wave & 1, tl = th * 32 + r, t = 64 * c + tl;
    const size_t row = (size_t)b * SEQ + t;
    const float slope2 = ex2(-(float)(g * 4 + hd + 1)) * LOG2E;
    const float tf = (float)t;
    bf16x8 qf[4];
#pragma unroll
    for (int s = 0; s < 4; ++s) qf[s] = *(const bf16x8*)(Q + row * 512 + g * 256 + hd * 64 + 16 * s + 8 * h);
    const float gate_c = NG[row * 24 + g * 12 + hd * 3 + 0], gate_s = NG[row * 24 + g * 12 + hd * 3 + 1], gate_w = NG[row * 24 + g * 12 + hd * 3 + 2];
    f32x16 tot[2];
#pragma unroll
    for (int i = 0; i < 16; ++i) { tot[0][i] = 0.f; tot[1][i] = 0.f; }
    LAS float* IMP = (LAS float*)(lds + AL_IMP);
    LAS float* PB = (LAS float*)(lds + AL_PB);
    LAS float* pbrow = PB + (hd * 64 + tl) * 65;
    const bf16_t* kvb = KV + (size_t)b * SEQ * 768 + g * 64;
    auto nopost = [](int) {};

    if (ATTN_BRANCHES & 1) {
        const int jb0 = c > 8 ? c - 8 : 0, nb = c - jb0 + 1;
        f32x16 o[2];
#pragma unroll
        for (int i = 0; i < 16; ++i) { o[0][i] = 0.f; o[1][i] = 0.f; }
        float m = NEGBIG, l = 0.f;
        auto src = [=](int i) { KVSrc s; s.k = kvb + (size_t)(64 * (jb0 + i)) * 768 + 4 * 128; s.v = s.k + 128; s.pitch = 768; return s; };
        auto mk = [=](int i) { const int pos0 = 64 * (jb0 + i); return [=](int kv, float s) { const int dist = t - (pos0 + kv); return (dist >= 0 && dist < 512) ? s - slope2 * (float)dist : NEGBIG; }; };
        attn_run<0>(nb, src, mk, nopost, lds, qf, o, m, l, 0.f, pbrow, tid, wave, lane, r, h);
        const float sc = gate_w * rcpf_(l + __shfl_xor(l, 32));
#pragma unroll
        for (int i = 0; i < 16; ++i) { tot[0][i] += sc * o[0][i]; tot[1][i] += sc * o[1][i]; }
    }
    for (int i = tid; i < 64 * 129; i += NTHREADS) IMP[i] = 0.f;
    if (ATTN_BRANCHES & 2) {
        const int nbc = (4 * c + 3 + 63) >> 6;
        auto src = [=](int i) { KVSrc s; s.k = KC + (size_t)(64 * i) * 64; s.v = VC + (size_t)(64 * i) * 64; s.pitch = 64; return s; };
        auto mk = [=](int i) { const int n0 = 64 * i; return [=](int kv, float s) { const int n = n0 + kv; return (16 * n + 31 <= t) ? s - slope2 * (tf - (float)(16 * n) - 15.5f) : NEGBIG; }; };
        f32x16 o[2];
#pragma unroll
        for (int i = 0; i < 16; ++i) { o[0][i] = 0.f; o[1][i] = 0.f; }
        float m = NEGBIG, l = 0.f;
        attn_run<1>(nbc, src, mk, nopost, lds, qf, o, m, l, 0.f, pbrow, tid, wave, lane, r, h);
        const float invl = rcpf_(l + __shfl_xor(l, 32));
        auto post = [=](int i) {
            for (int q = tid; q < 64 * 17; q += NTHREADS) {
                const int tok = q & 63, jj = q >> 6, j = 16 * i + jj;
                float acc = 0.f;
                if (jj < 16) {
#pragma unroll
                    for (int hh = 0; hh < 4; ++hh) { const LAS float* p = PB + (hh * 64 + tok) * 65 + 4 * jj; acc += (p[0] + p[1]) + (p[2] + 0.5f * p[3]); if (jj > 0) acc += 0.5f * p[-1]; }
                } else {
#pragma unroll
                    for (int hh = 0; hh < 4; ++hh) acc += 0.5f * PB[(hh * 64 + tok) * 65 + 63];
                }
                if (j < 128) IMP[tok * 129 + j] += acc;
            }
        };
        attn_run<2>(nbc, src, mk, post, lds, qf, o, m, l, invl, pbrow, tid, wave, lane, r, h);
#pragma unroll
        for (int i = 0; i < 16; ++i) { tot[0][i] += gate_c * o[0][i]; tot[1][i] += gate_c * o[1][i]; }
    }
    __syncthreads();
    if (ATTN_BRANCHES & 4) {
        LAS unsigned* L0 = (LAS unsigned*)(lds + AL_PB);
        LAS unsigned* L1 = L0 + 8 * 16 * 64;
        LAS unsigned* L2 = L1 + 4 * 16 * 64;
        LAS unsigned* THR = (LAS unsigned*)(lds + AL_THR);
        LAS unsigned short* SELM = (LAS unsigned short*)(lds + AL_SELM);
        LAS unsigned* UNI = (LAS unsigned*)(lds + AL_UNI);
        LAS int* BL = (LAS int*)(lds + AL_BL);
        LAS int* NBL = (LAS int*)(lds + AL_NBL);
        const int tok = lane, seg = wave;
        unsigned key[16];
#pragma unroll
        for (int i = 0; i < 16; ++i) {
            const int j = 16 * seg + i;
            const bool forced = (j == 0) || (j == c) || (j == c - 1);
            const unsigned kvv = forced ? 0x1FFFFFFu : (j <= c ? (__float_as_uint(IMP[tok * 129 + j]) >> 7) + 1u : 0u);
            key[i] = (kvv << 7) | (unsigned)(127 - j);
        }
        sort16_desc(key);
#pragma unroll
        for (int i = 0; i < 16; ++i) L0[(seg * 16 + i) * 64 + tok] = key[i];
        __syncthreads();
        if (wave < 4) {
            unsigned kk[16];
#pragma unroll
            for (int i = 0; i < 16; ++i) { const unsigned x = L0[((2 * wave) * 16 + i) * 64 + tok], y = L0[((2 * wave + 1) * 16 + 15 - i) * 64 + tok]; kk[i] = x > y ? x : y; }
            merge16_desc(kk);
#pragma unroll
            for (int i = 0; i < 16; ++i) L1[(wave * 16 + i) * 64 + tok] = kk[i];
        }
        __syncthreads();
        if (wave < 2) {
            unsigned kk[16];
#pragma unroll
            for (int i = 0; i < 16; ++i) { const unsigned x = L1[((2 * wave) * 16 + i) * 64 + tok], y = L1[((2 * wave + 1) * 16 + 15 - i) * 64 + tok]; kk[i] = x > y ? x : y; }
            merge16_desc(kk);
#pragma unroll
            for (int i = 0; i < 16; ++i) L2[(wave * 16 + i) * 64 + tok] = kk[i];
        }
        __syncthreads();
        if (wave == 0) {
            unsigned mn = 0xffffffffu;
#pragma unroll
            for (int i = 0; i < 16; ++i) { const unsigned x = L2[i * 64 + tok], y = L2[(16 + 15 - i) * 64 + tok]; const unsigned z = x > y ? x : y; mn = z < mn ? z : mn; }
            THR[tok] = mn;
        }
        __syncthreads();
        {
            const unsigned T = THR[tok]; unsigned m16 = 0;
#pragma unroll
            for (int i = 0; i < 16; ++i) m16 |= (key[i] >= T) ? (1u << (15 - (key[i] & 15u))) : 0u;
            SELM[tok * 8 + seg] = (unsigned short)m16;
            unsigned uni = 0;
#pragma unroll
            for (int bb = 0; bb < 16; ++bb) uni |= (__ballot((m16 >> bb) & 1u) != 0ull) ? (1u << bb) : 0u;
            if (lane == 0) UNI[seg] = uni;
        }
        __syncthreads();
        if (wave == 0) {
            int base = 0;
#pragma unroll
            for (int half = 0; half < 2; ++half) {
                const int j = half * 64 + lane;
                const bool on = ((UNI[j >> 4] >> (j & 15)) & 1u) && (j <= c);
                const unsigned long long bal = __ballot(on);
                const int pos = base + __builtin_popcountll(bal & ((1ull << lane) - 1ull));
                if (on) BL[pos] = j;
                base += __builtin_popcountll(bal);
            }
            if (lane == 0) NBL[0] = base;
        }
        __syncthreads();
        const int nbs = __builtin_amdgcn_readfirstlane(NBL[0]);
        f32x16 o[2];
#pragma unroll
        for (int i = 0; i < 16; ++i) { o[0][i] = 0.f; o[1][i] = 0.f; }
        float m = NEGBIG, l = 0.f;
        auto src = [=](int i) { const int j = __builtin_amdgcn_readfirstlane(BL[i]); KVSrc s; s.k = kvb + (size_t)(64 * j) * 768 + 2 * 128; s.v = s.k + 128; s.pitch = 768; return s; };
        auto mk = [=](int i) { const int j = __builtin_amdgcn_readfirstlane(BL[i]); const bool sel = (SELM[tl * 8 + (j >> 4)] >> (j & 15)) & 1; const int pos0 = 64 * j;
            return [=](int kv, float s) { const int dist = t - (pos0 + kv); return (sel && dist >= 0) ? s - slope2 * (float)dist : NEGBIG; }; };
        attn_run<0>(nbs, src, mk, nopost, lds, qf, o, m, l, 0.f, pbrow, tid, wave, lane, r, h);
        const float sc = gate_s * rcpf_(l + __shfl_xor(l, 32));
#pragma unroll
        for (int i = 0; i < 16; ++i) { tot[0][i] += sc * o[0][i]; tot[1][i] += sc * o[1][i]; }
    }
#pragma unroll
    for (int dh = 0; dh < 2; ++dh)
#pragma unroll
        for (int q4 = 0; q4 < 4; ++q4) {
            const int d = dh * 32 + 8 * q4 + 4 * h;
            u32x2 w; w.x = pk2(tot[dh][4 * q4 + 0], tot[dh][4 * q4 + 1]); w.y = pk2(tot[dh][4 * q4 + 2], tot[dh][4 * q4 + 3]);
            *(u32x2*)(YA + row * 512 + g * 256 + hd * 64 + d) = w;
        }
    __syncthreads();
}

DI void p6a_route(const Args& a, LAS unsigned char* lds, int tid, int wave, int lane) {
    unsigned char* ws = a.ws;
    const float* X2 = (const float*)(ws + WS_X2);
    const float* gm = a.in[18]; const float* wr = a.in[19]; const float* br = a.in[20];
    int* TOKE = (int*)(ws + WS_TOKE); float* TOKW = (float*)(ws + WS_TOKW); int* CNT = (int*)(ws + WS_CTL + CTL_CNT); float* RINV = (float*)(ws + WS_RINV);
    LAS unsigned char* WR = lds; LAS int* CNTL = (LAS int*)(lds + 131072);
    for (int i = tid; i < 1024 * 8; i += NTHREADS) { const int k = i >> 3, q = i & 7; const float gk = gm[k]; const f32x4 w = *(const f32x4*)(wr + k * 32 + q * 4);
        *(LAS f32x4*)(WR + k * 128 + ((q ^ ((k >> 1) & 7)) * 16)) = (f32x4){w[0] * gk, w[1] * gk, w[2] * gk, w[3] * gk}; }
    const float myb = br[lane >> 1];
    for (int blk = blockIdx.x; blk < 256; blk += gridDim.x) {
        if (tid < 32) CNTL[tid] = 0;
        __syncthreads();
        int mycnt = 0;
        for (int it = 0; it < 16; ++it) {
            const int t0 = blk * 128 + wave * 16 + it;
            const float* xpa = X2 + (size_t)t0 * DM + lane;
            float pa[32]; float sa = 0.f;
#pragma unroll
            for (int e = 0; e < 32; ++e) pa[e] = 0.f;
#pragma unroll 1
            for (int i0 = 0; i0 < 16; i0 += 4) {
                float xa[4];
#pragma unroll
                for (int ii = 0; ii < 4; ++ii) xa[ii] = xpa[64 * (i0 + ii)];
#pragma unroll
                for (int ii = 0; ii < 4; ++ii) {
                    sa += xa[ii] * xa[ii];
                    const int k = lane + 64 * (i0 + ii); const LAS unsigned char* wrow = WR + k * 128; const int sw = (k >> 1) & 7;
#pragma unroll
                    for (int q = 0; q < 8; ++q) { const f32x4 w4 = *(const LAS f32x4*)(wrow + ((q ^ sw) * 16));
#pragma unroll
                        for (int j = 0; j < 4; ++j) pa[4 * q + j] += xa[ii] * w4[j]; }
                }
            }
            const float ra = 1.0f / sqrtf(wave_sum(sa) * (1.f / DM) + 1e-5f);
            if (lane == 0) RINV[t0] = ra;
#pragma unroll
            for (int st = 0; st < 5; ++st) {
                const int n = 16 >> st, xo = 32 >> st; const bool up = (lane & xo) != 0;
#pragma unroll
                for (int e = 0; e < n; ++e) {
                    float a0 = pa[e], a1 = pa[e + n];
                    asm volatile("" : "+v"(a0), "+v"(a1));
                    const float sa_ = up ? a0 : a1, ka = up ? a1 : a0; pa[e] = ka + __shfl_xor(sa_, xo);
                }
            }
            float v = (pa[0] + __shfl_xor(pa[0], 1)) * ra + myb;
            if (lane & 1) v = -3e38f;
            {
                int es0, es1, es2, es3; float vs0, vs1, vs2, vs3;
#define TOPK_ROUND(ES, VS) { const float mx = wave_max(v); const unsigned long long bal = __ballot(v == mx); const int ln = __builtin_ctzll(bal); ES = ln >> 1; VS = mx; if (lane == ln) v = -3e38f; mycnt += (lane == (ln >> 1)) ? 1 : 0; }
                TOPK_ROUND(es0, vs0) TOPK_ROUND(es1, vs1) TOPK_ROUND(es2, vs2) TOPK_ROUND(es3, vs3)
#undef TOPK_ROUND
                const float e1 = ex2((vs1 - vs0) * LOG2E), e2 = ex2((vs2 - vs0) * LOG2E), e3 = ex2((vs3 - vs0) * LOG2E);
                const float inv = 1.0f / (1.0f + e1 + e2 + e3);
                if (lane == 0) {
                    const size_t o = (size_t)t0 * 4;
                    TOKE[o] = es0; TOKE[o + 1] = es1; TOKE[o + 2] = es2; TOKE[o + 3] = es3;
                    TOKW[o] = inv; TOKW[o + 1] = e1 * inv; TOKW[o + 2] = e2 * inv; TOKW[o + 3] = e3 * inv;
                }
            }
        }
        if (lane < 32) atomicAdd((int*)(CNTL + lane), mycnt);
        __syncthreads();
        if (tid < 32) CNT[blk * 32 + tid] = CNTL[tid];
        __syncthreads();
    }
}
DI void p6b_place(const Args& a, LAS unsigned char* lds, int tid, int wave, int lane) {
    unsigned char* ws = a.ws;
    const float* X2 = (const float*)(ws + WS_X2); const float* RINV = (const float*)(ws + WS_RINV); bf16_t* AS = (bf16_t*)(ws + WS_AS);
    const float* gm = a.in[18];
    const f32x4 g00 = *(const f32x4*)(gm + lane * 8), g01 = *(const f32x4*)(gm + lane * 8 + 4), g10 = *(const f32x4*)(gm + 512 + lane * 8), g11 = *(const f32x4*)(gm + 512 + lane * 8 + 4);
    const int* TOKE = (const int*)(ws + WS_TOKE); const float* TOKW = (const float*)(ws + WS_TOKW); const int* CNT = (const int*)(ws + WS_CTL + CTL_CNT);
    int* SLOT = (int*)(ws + WS_SLOT); float* WSLOT = (float*)(ws + WS_WSLOT); int* TE = (int*)(ws + WS_CTL + CTL_TE); int* NT = (int*)(ws + WS_CTL + CTL_NT);
    LAS int* TOT = (LAS int*)lds; LAS int* OFFS = TOT + 32; LAS int* PADS = TOT + 64; LAS int* CUR = TOT + 96;
    for (int blk = blockIdx.x; blk < 256; blk += gridDim.x) {
        if (tid < 32) { int tot = 0, mine = 0; for (int bb = 0; bb < 256; ++bb) { const int cc = CNT[bb * 32 + tid]; tot += cc; mine += (bb < blk) ? cc : 0; } TOT[tid] = tot; OFFS[tid] = mine; CUR[tid] = 0; }
        __syncthreads();
        if (tid == 0) {
            int ps = 0;
            for (int e = 0; e < 32; ++e) { PADS[e] = ps; ps += (TOT[e] + 255) & ~255; }
            if (blk == 0) { int tile = 0; for (int e = 0; e < 32; ++e) { const int n = (TOT[e] + 255) >> 8; for (int q = 0; q < n; ++q) TE[tile++] = e; } NT[0] = tile; }
        }
        __syncthreads();
        for (int it = 0; it < 16; ++it) {
            const int t = blk * 128 + wave * 16 + it;
            const float rv = RINV[t];
            u32x4 r0, r1;
            { const f32x4 a0 = *(const f32x4*)(X2 + (size_t)t * DM + lane * 8), a1 = *(const f32x4*)(X2 + (size_t)t * DM + lane * 8 + 4);
              const f32x4 b0 = *(const f32x4*)(X2 + (size_t)t * DM + 512 + lane * 8), b1 = *(const f32x4*)(X2 + (size_t)t * DM + 512 + lane * 8 + 4);
              r0.x = pk2(a0[0] * rv * g00[0], a0[1] * rv * g00[1]); r0.y = pk2(a0[2] * rv * g00[2], a0[3] * rv * g00[3]); r0.z = pk2(a1[0] * rv * g01[0], a1[1] * rv * g01[1]); r0.w = pk2(a1[2] * rv * g01[2], a1[3] * rv * g01[3]);
              r1.x = pk2(b0[0] * rv * g10[0], b0[1] * rv * g10[1]); r1.y = pk2(b0[2] * rv * g10[2], b0[3] * rv * g10[3]); r1.z = pk2(b1[0] * rv * g11[0], b1[1] * rv * g11[1]); r1.w = pk2(b1[2] * rv * g11[2], b1[3] * rv * g11[3]); }
#pragma unroll
            for (int k = 0; k < 4; ++k) {
                const int e = TOKE[(size_t)t * 4 + k];
                int p = 0; if (lane == 0) p = atomicAdd((int*)(CUR + e), 1);
                p = __builtin_amdgcn_readfirstlane(p);
                const int pos = PADS[e] + OFFS[e] + p;
                *(u32x4*)(AS + (size_t)pos * DM + lane * 8) = r0; *(u32x4*)(AS + (size_t)pos * DM + 512 + lane * 8) = r1;
                if (lane == 0) { SLOT[(size_t)t * 4 + k] = pos; WSLOT[pos] = TOKW[(size_t)t * 4 + k]; }
            }
        }
        __syncthreads();
    }
}
DI void p9_final(const Args& a, int gw, int NGW, int lane) {
    unsigned char* ws = a.ws;
    const float* X2 = (const float*)(ws + WS_X2); const bf16_t* Y = (const bf16_t*)(ws + WS_Y); const int* SLOT = (const int*)(ws + WS_SLOT);
    const float* gf = a.in[25]; float* out = a.out;
    f32x4 gv[4];
#pragma unroll
    for (int j = 0; j < 4; ++j) gv[j] = *((const f32x4*)gf + lane + 64 * j);
    for (int t = gw; t < MTOK; t += NGW) {
        f32x4 v[4];
#pragma unroll
        for (int j = 0; j < 4; ++j) v[j] = *((const f32x4*)(X2 + (size_t)t * DM) + lane + 64 * j);
        if (!SKIP_MOE) {
#pragma unroll
            for (int k = 0; k < 4; ++k) {
                const int pos = SLOT[(size_t)t * 4 + k];
#pragma unroll
                for (int j = 0; j < 4; ++j) { const u32x2 y = *((const u32x2*)(Y + (size_t)pos * DM) + lane + 64 * j);
                    v[j].x += bf2f(y.x & 0xffffu); v[j].y += bf2f(y.x >> 16); v[j].z += bf2f(y.y & 0xffffu); v[j].w += bf2f(y.y >> 16); }
            }
        }
        float s = 0.f;
#pragma unroll
        for (int j = 0; j < 4; ++j) s += (v[j].x * v[j].x + v[j].y * v[j].y) + (v[j].z * v[j].z + v[j].w * v[j].w);
        const float rinv = 1.0f / sqrtf(wave_sum(s) * (1.f / DM) + 1e-5f);
#pragma unroll
        for (int j = 0; j < 4; ++j) *((f32x4*)(out + (size_t)t * DM) + lane + 64 * j) = (f32x4){v[j].x * rinv * gv[j].x, v[j].y * rinv * gv[j].y, v[j].z * rinv * gv[j].z, v[j].w * rinv * gv[j].w};
    }
}

__global__ void __launch_bounds__(NTHREADS, 2) hybrid_fwd(Args args) {
    extern __shared__ __attribute__((aligned(16))) unsigned char lds_raw[];
    LAS unsigned char* lds = (LAS unsigned char*)lds_raw;
    cg::grid_group grid = cg::this_grid();
    const int tid = threadIdx.x, lane = tid & 63, wave = __builtin_amdgcn_readfirstlane(tid >> 6);
    volatile LAS unsigned* bst = (volatile LAS unsigned*)(lds_raw_las(lds_raw) + LDS_BYTES - 16);
    if (tid < 4) bst[tid] = 0u;
    __syncthreads();
    const XcdBarrier xbar = xcd_barrier_post((unsigned*)(args.ws + WS_CTL + CTL_BAR), bst);
#define SYNC() xcd_barrier(xbar)
    const int G = gridDim.x, bx = blockIdx.x;
    const int gw = bx * NWAVES + wave, NGW = G * NWAVES;
    unsigned char* ws = args.ws;

    for (int rep = 0; rep < NREP(0); ++rep) p0_prep(args, lds, gw, NGW, wave, lane);
    grid.sync();
    for (int rep = 0; rep < NREP(1); ++rep) {
        pg8::Gemm g{(const pg8::bf16_t*)(ws + WS_H1), (const pg8::bf16_t*)(ws + WS_WIN), MTOK, NPROJ, DM};
        pg8::StaticOrder S; S.init(MTOK, NPROJ, G, bx);
        Epi1 E{(bf16_t*)(ws + WS_Q), (bf16_t*)(ws + WS_KV), (bf16_t*)(ws + WS_U), (bf16_t*)(ws + WS_V), (bf16_t*)(ws + WS_MG), (float*)(ws + WS_NG)};
        pg8::gemm_phase<Epi1, pg8::StaticOrder, true, true>(lds, g, S, E);
    }
    SYNC();
    for (int rep = 0; rep < NREP(2); ++rep)
    for (int it = bx; it < 512; it += G) {
        if (it < 256) p2_compress_item(args, lds, it, tid, wave, lane);
        else p2_sgu_item(args, lds, it - 256, tid, wave, lane);
    }
    SYNC();
    for (int rep = 0; rep < NREP(3); ++rep) {
        for (int it = bx; it < 1024; it += G) {
            const int w = it & 255, i = it >> 8, s = w & 31, bg = w >> 5;
            const int c = (i == 0) ? s : (i == 1) ? 63 - s : (i == 2) ? 64 + s : 127 - s;
            attn_tile(args, lds, bg >> 1, bg & 1, c, tid, wave, lane);
        }
    }
    SYNC();
    for (int rep = 0; rep < NREP(4); ++rep) {
        pg8::Gemm g{(const pg8::bf16_t*)(ws + WS_YAB), (const pg8::bf16_t*)(ws + WS_WAB), 2 * MTOK, 2048, 512};
        PairOrder S{G, bx};
        Epi4 E{(const bf16_t*)(ws + WS_MG), (bf16_t*)(ws + WS_MERGED)};
        pg8::gemm_phase<Epi4, PairOrder, true, true>(lds, g, S, E);
    }
    SYNC();
    for (int rep = 0; rep < NREP(5); ++rep) {
        pg8::Gemm g{(const pg8::bf16_t*)(ws + WS_MERGED), (const pg8::bf16_t*)(ws + WS_WOUT), MTOK, DM, DM};
        pg8::StaticOrder S; S.init(MTOK, DM, G, bx);
        Epi5 E{args.in[0], (float*)(ws + WS_X2)};
        pg8::gemm_phase<Epi5, pg8::StaticOrder, true, true>(lds, g, S, E);
    }
    SYNC();
    for (int rep = 0; rep < NREP(6); ++rep) { p6a_route(args, lds, tid, wave, lane); }
    SYNC();
    for (int rep = 0; rep < NREP(10); ++rep) { p6b_place(args, lds, tid, wave, lane); }
    SYNC();
    const int* TE = (const int*)(ws + WS_CTL + CTL_TE);
    const int NT = __builtin_amdgcn_readfirstlane(*(const int*)(ws + WS_CTL + CTL_NT));
    for (int rep = 0; rep < NREP(7); ++rep) {
        pg8::Gemm g{(const pg8::bf16_t*)(ws + WS_AS), (const pg8::bf16_t*)(ws + WS_WGU), MPAD, NEXP * 2048, DM};
        MoeOrder S{TE, NT, 8, G, bx};
        Epi7 E{args.in[22], (bf16_t*)(ws + WS_ACT)};
        pg8::gemm_phase<Epi7, MoeOrder, true, true>(lds, g, S, E);
    }
    SYNC();
    for (int rep = 0; rep < NREP(8); ++rep) {
        pg8::Gemm g{(const pg8::bf16_t*)(ws + WS_ACT), (const pg8::bf16_t*)(ws + WS_WD), MPAD, NEXP * 1024, DFF};
        MoeOrder S{TE, NT, 4, G, bx};
        Epi8 E{args.in[24], (const float*)(ws + WS_WSLOT), (bf16_t*)(ws + WS_Y)};
        pg8::gemm_phase<Epi8, MoeOrder, true, true>(lds, g, S, E);
    }
    SYNC();
    for (int rep = 0; rep < NREP(9); ++rep) p9_final(args, gw, NGW, lane);
}

extern "C" void kernel_launch(void* const* d_in, const int* in_sizes, int n_in, void* d_out, int out_size, void* d_ws, size_t ws_size, hipStream_t stream) {
    static int grid = 0;
    if (grid == 0) {
        if (n_in != 26 || in_sizes[0] != MTOK * DM || out_size != MTOK * DM || ws_size < WS_END) {
            fprintf(stderr, "kernel_launch: unexpected shapes (n_in %d, in0 %d, out %d, ws %zu < %zu)\n", n_in, n_in > 0 ? in_sizes[0] : -1, out_size, ws_size, (size_t)WS_END); grid = -1; return; }
        int dev = 0, cus = 0, per_cu = 0;
        hipGetDevice(&dev);
        hipDeviceGetAttribute(&cus, hipDeviceAttributeMultiprocessorCount, dev);
        if (hipFuncSetAttribute((const void*)hybrid_fwd, hipFuncAttributeMaxDynamicSharedMemorySize, LDS_BYTES) != hipSuccess) { fprintf(stderr, "kernel_launch: hipFuncSetAttribute failed\n"); grid = -1; return; }
        if (hipOccupancyMaxActiveBlocksPerMultiprocessor(&per_cu, (const void*)hybrid_fwd, NTHREADS, LDS_BYTES) != hipSuccess || per_cu < 1) { fprintf(stderr, "kernel_launch: occupancy query says %d\n", per_cu); per_cu = 1; }
        (void)hipGetLastError();
        grid = cus * 1;
        if (grid > cus * per_cu) grid = cus * per_cu;
    }
    if (grid < 0) return;
    if (hipMemsetAsync((unsigned char*)d_ws + WS_CTL + CTL_BAR, 0, XCD_BAR_WORDS * 4, stream) != hipSuccess) { fprintf(stderr, "kernel_launch: memset failed\n"); return; }
    Args a{};
    for (int i = 0; i < 26; ++i) a.in[i] = (const float*)d_in[i];
    a.out = (float*)d_out; a.ws = (unsigned char*)d_ws;
    void* kargs[] = {&a};
    hipError_t e = hipLaunchCooperativeKernel((const void*)hybrid_fwd, dim3(grid), dim3(NTHREADS), kargs, LDS_BYTES, stream);
    if (e != hipSuccess) fprintf(stderr, "kernel_launch: cooperative launch failed: %s (grid %d)\n", hipGetErrorString(e), grid);
}
```

```cpp
#include <hip/hip_runtime.h>
#include <hip/hip_cooperative_groups.h>
#include <cstdio>
#include <cstdint>
namespace cg = cooperative_groups;
namespace pg8 {
#define PG8_LAS __attribute__((address_space(3)))
typedef unsigned short bf16_t;
typedef short bf16x8 __attribute__((ext_vector_type(8)));
typedef float f32x4 __attribute__((ext_vector_type(4)));
typedef unsigned u32x4 __attribute__((ext_vector_type(4)));
typedef int v4i32_t __attribute__((ext_vector_type(4)));
typedef int v8i32_t __attribute__((ext_vector_type(8)));
constexpr int BM = 256, BK = 64, HALF = 128, HTB = HALF * BK * 2  , STAGE_BYTES = 8 * HTB, NXCD = 8, WGM = 8;

__host__ __device__ __forceinline__ int lds_byte(int r, int c) { const int st = (r >> 4) * 2 + (c >> 5), rr = r & 15, cc = c & 31, ob = rr * 64 + cc * 2; return st * 1024 + (ob ^ (((ob >> 9) & 1) << 5)); }
__host__ __device__ __forceinline__ void stage_rc(int b, int& R, int& C) { const int st = b / 1024, sb = b % 1024, swz = sb ^ (((sb >> 9) & 1) << 5); R = (st >> 1) * 16 + swz / 64; C = (st & 1) * 32 + (swz % 64) / 2; }
__host__ __device__ __forceinline__ int perm32(int rho) { const int n = rho >> 4, i = rho & 15; return 8 * (i >> 2) + 4 * n + (i & 3); }

struct Unit { int pm, pn; };
struct Gemm { const bf16_t* A; const bf16_t* Bt; int M, N, K; };

struct StaticOrder {
    int nM, nN, nwg, G, c;
    __host__ __device__ void init(int M, int N, int G_, int c_) { nM = M / BM; nN = N / BM; nwg = nM * nN; G = G_; c = c_; }
    __host__ __device__ bool next(int i, Unit& u) const {
        const long L = (long)i * G + c; if (L >= nwg) return false;
        int wgid = (int)L; { const int q = nwg / NXCD, r = nwg % NXCD, xcd = wgid % NXCD, off = wgid / NXCD; wgid = (xcd < r ? xcd * (q + 1) : r * (q + 1) + (xcd - r) * q) + off; }
        const int nig = WGM * nN, gid = wgid / nig, fm = gid * WGM, gsz = (nM - fm) < WGM ? (nM - fm) : WGM;
        u.pm = fm + ((wgid % nig) % gsz); u.pn = (wgid % nig) / gsz; return true;
    }
    __device__ __forceinline__ void a_ready(const Unit&) const {}
    __device__ __forceinline__ void done(const Unit&) const {}
};

__device__ __forceinline__ unsigned cvt_pk_bf16(float lo, float hi) { unsigned r; asm volatile("v_cvt_pk_bf16_f32 %0, %1, %2" : "=v"(r) : "v"(lo), "v"(hi)); return r; }
typedef float f32x2 __attribute__((ext_vector_type(2)));
template <class Epi, class Sched, bool ALIGN_EPI = false, bool SP2 = false, bool FP8 = false>
__device__ __forceinline__ void gemm_phase(PG8_LAS unsigned char* lds, const Gemm g, const Sched& S, const Epi& E) {
    int tid_ = threadIdx.x; asm volatile("" : "+v"(tid_));
    const int tid = tid_, wid = __builtin_amdgcn_readfirstlane(tid >> 6), lane = tid & 63, wr = wid >> 2, wc = wid & 3, fr = lane & 15, fq = lane >> 4;
    const int K = g.K, nt = K / BK;
    unsigned voffA[2], voffB[2];
#pragma unroll
    for (int i = 0; i < 2; ++i) { int R, C; stage_rc(tid * 16 + i * 8192, R, C); const int Rb = Epi::PERM ? ((R & ~31) + perm32(R & 31)) : R;
        voffA[i] = (unsigned)(R * K + C) * 2u; voffB[i] = (unsigned)(Rb * K + C) * 2u; }
    const size_t kstep = (size_t)(BK * 2);
    const size_t hstep = (size_t)HALF * K * 2;
    const size_t tstep = 2 * hstep;
    const unsigned ldsw = (unsigned)wid * 1024u;
    const int aoff = lds_byte(wr * 64 + fr, fq * 8), boff = lds_byte(wc * 32 + fr, fq * 8);
#define PG8_SA(b, h) (((b) * 2 + (h)) * HTB)
#define PG8_SB(b, h) ((4 + (b) * 2 + (h)) * HTB)
#define PG8_STAGE(bufoff, gbase, voff) do { _Pragma("unroll") for (int _i = 0; _i < 2; ++_i) \
        __builtin_amdgcn_global_load_lds((const unsigned*)((const char*)(gbase) + (voff)[_i]), (PG8_LAS unsigned*)(lds + (bufoff) + ldsw + _i * 8192), 16, 0, 0); } while (0)
#define PG8_LDA(dst, b, h) do { _Pragma("unroll") for (int m = 0; m < 4; ++m) _Pragma("unroll") for (int k = 0; k < 2; ++k) dst[m][k] = *(const PG8_LAS bf16x8*)(lds + PG8_SA(b, h) + aoff + m * 2048 + k * 1024); } while (0)
#define PG8_LDB(dst, b, h) do { _Pragma("unroll") for (int n = 0; n < 2; ++n) _Pragma("unroll") for (int k = 0; k < 2; ++k) dst[n][k] = *(const PG8_LAS bf16x8*)(lds + PG8_SB(b, h) + boff + n * 2048 + k * 1024); } while (0)
#define PG8_CAT8(x) __builtin_shufflevector(__builtin_bit_cast(v4i32_t, (x)[0]), __builtin_bit_cast(v4i32_t, (x)[1]), 0, 1, 2, 3, 4, 5, 6, 7)
#define PG8_MMA(ai, bj, At, Bt) do { __builtin_amdgcn_s_setprio(1); \
        if constexpr (FP8) { _Pragma("unroll") for (int m = 0; m < 4; ++m) _Pragma("unroll") for (int n = 0; n < 2; ++n) \
            { const v8i32_t a8_ = PG8_CAT8(Bt[n]), b8_ = PG8_CAT8(At[m]); asm volatile("v_mfma_scale_f32_16x16x128_f8f6f4 %0, %1, %2, %0, %3, %3 op_sel_hi:[0,0,0]" : "+v"(acc[ai][bj][m][n]) : "v"(a8_), "v"(b8_), "v"(0x7f7f7f7f)); } } \
        else { _Pragma("unroll") for (int m = 0; m < 4; ++m) _Pragma("unroll") for (int n = 0; n < 2; ++n) _Pragma("unroll") for (int k = 0; k < 2; ++k) \
            acc[ai][bj][m][n] = __builtin_amdgcn_mfma_f32_16x16x32_bf16(Bt[n][k], At[m][k], acc[ai][bj][m][n], 0, 0, 0); } \
        __builtin_amdgcn_s_setprio(0); } while (0)
#define PG8_WAIT_V(n) asm volatile("s_waitcnt vmcnt(" #n ")" ::: "memory")
#define PG8_WAIT_L(n) asm volatile("s_waitcnt lgkmcnt(" #n ")" ::: "memory")
#define PG8_BAR __builtin_amdgcn_s_barrier()
#define PG8_SCHED __builtin_amdgcn_sched_barrier(0)
    Unit cur, nxt; int ui = 0;
    if (!S.next(0, cur)) return;
    f32x4 acc[2][2][4][2];
#pragma unroll
    for (int a = 0; a < 2; ++a)
#pragma unroll
        for (int b = 0; b < 2; ++b)
#pragma unroll
            for (int m = 0; m < 4; ++m)
#pragma unroll
                for (int n = 0; n < 2; ++n) acc[a][b][m][n] = (f32x4){0.f, 0.f, 0.f, 0.f};
    bf16x8 At[4][2], B0[2][2], B1[2][2];
    const char* cA = (const char*)g.A + (size_t)cur.pm * tstep; const char* cB = (const char*)g.Bt + (size_t)cur.pn * tstep;
    S.a_ready(cur);
    if constexpr (SP2) {
        PG8_STAGE(PG8_SB(0, 0), cB, voffB); PG8_STAGE(PG8_SB(0, 1), cB + hstep, voffB); PG8_STAGE(PG8_SA(0, 0), cA, voffA); PG8_STAGE(PG8_SA(0, 1), cA + hstep, voffA);
        if (wr == 1) PG8_BAR;
        PG8_WAIT_V(2); PG8_BAR;
        PG8_STAGE(PG8_SB(1, 0), cB + kstep, voffB); PG8_STAGE(PG8_SA(1, 0), cA + kstep, voffA); PG8_STAGE(PG8_SB(1, 1), cB + hstep + kstep, voffB);
        PG8_WAIT_V(6); PG8_BAR;
    } else {
        PG8_STAGE(PG8_SB(0, 0), cB, voffB); PG8_STAGE(PG8_SA(0, 0), cA, voffA); PG8_STAGE(PG8_SB(0, 1), cB + hstep, voffB); PG8_STAGE(PG8_SA(0, 1), cA + hstep, voffA);
        if (wr == 1) PG8_BAR;
        PG8_WAIT_V(4); PG8_BAR;
        PG8_STAGE(PG8_SB(1, 0), cB + kstep, voffB); PG8_STAGE(PG8_SA(1, 0), cA + kstep, voffA); PG8_STAGE(PG8_SB(1, 1), cB + hstep + kstep, voffB);
        PG8_WAIT_V(6); PG8_BAR;
    }
    for (;;) {
        const bool has_next = S.next(ui + 1, nxt);
        const char* nA = has_next ? (const char*)g.A + (size_t)nxt.pm * tstep : cA; const char* nB = has_next ? (const char*)g.Bt + (size_t)nxt.pn * tstep : cB;
        for (int t = 0; t < nt; t += 2) {
            const bool last = (t == nt - 2);
            const char* a1 = cA + (size_t)(t + 1) * kstep;
            const char* a2 = last ? nA : cA + (size_t)(t + 2) * kstep; const char* b2 = last ? nB : cB + (size_t)(t + 2) * kstep;
            const char* a3 = a2 + kstep; const char* b3 = b2 + kstep;
            if (last && has_next) S.a_ready(nxt);
            if constexpr (SP2) {
            PG8_LDB(B0, 0, 0); PG8_LDB(B1, 0, 1); PG8_SCHED; PG8_LDA(At, 0, 0); PG8_STAGE(PG8_SA(1, 1), a1 + hstep, voffA);
            PG8_WAIT_V(8); PG8_WAIT_L(0); PG8_BAR; PG8_MMA(0, 0, At, B0); PG8_MMA(0, 1, At, B1); PG8_BAR; PG8_SCHED;
            PG8_LDA(At, 0, 1); PG8_STAGE(PG8_SB(0, 0), b2, voffB); PG8_STAGE(PG8_SB(0, 1), b2 + hstep, voffB); PG8_STAGE(PG8_SA(0, 0), a2, voffA);
            PG8_WAIT_V(8); PG8_WAIT_L(0); PG8_BAR; PG8_MMA(1, 0, At, B0); PG8_MMA(1, 1, At, B1); PG8_BAR; PG8_SCHED;
            PG8_LDB(B0, 1, 0); PG8_LDB(B1, 1, 1); PG8_SCHED; PG8_LDA(At, 1, 0); PG8_STAGE(PG8_SA(0, 1), a2 + hstep, voffA);
            PG8_WAIT_V(8); PG8_WAIT_L(0); PG8_BAR; PG8_MMA(0, 0, At, B0); PG8_MMA(0, 1, At, B1); PG8_BAR; PG8_SCHED;
            PG8_LDA(At, 1, 1); PG8_STAGE(PG8_SB(1, 0), b3, voffB); PG8_STAGE(PG8_SB(1, 1), b3 + hstep, voffB); PG8_STAGE(PG8_SA(1, 0), a3, voffA);
            PG8_WAIT_V(8); PG8_WAIT_L(0); PG8_BAR; PG8_MMA(1, 0, At, B0); PG8_MMA(1, 1, At, B1); PG8_BAR; PG8_SCHED;
            } else {
            PG8_LDB(B0, 0, 0); PG8_SCHED; PG8_LDA(At, 0, 0); PG8_STAGE(PG8_SA(1, 1), a1 + hstep, voffA);
            PG8_WAIT_L(8); PG8_BAR; PG8_WAIT_L(0); PG8_MMA(0, 0, At, B0); PG8_BAR; PG8_SCHED;
            PG8_LDB(B1, 0, 1); PG8_STAGE(PG8_SB(0, 0), b2, voffB);
            PG8_BAR; PG8_WAIT_L(0); PG8_MMA(0, 1, At, B1); PG8_BAR;
            PG8_LDA(At, 0, 1); PG8_STAGE(PG8_SA(0, 0), a2, voffA);
            PG8_BAR; PG8_WAIT_L(0); PG8_MMA(1, 0, At, B0); PG8_BAR; PG8_SCHED;
            PG8_STAGE(PG8_SB(0, 1), b2 + hstep, voffB);
            PG8_WAIT_V(6); PG8_BAR; PG8_MMA(1, 1, At, B1); PG8_BAR;
            PG8_LDB(B0, 1, 0); PG8_SCHED; PG8_LDA(At, 1, 0); PG8_STAGE(PG8_SA(0, 1), a2 + hstep, voffA);
            PG8_WAIT_L(8); PG8_BAR; PG8_WAIT_L(0); PG8_MMA(0, 0, At, B0); PG8_BAR; PG8_SCHED;
            PG8_LDB(B1, 1, 1); PG8_STAGE(PG8_SB(1, 0), b3, voffB);
            PG8_BAR; PG8_WAIT_L(0); PG8_MMA(0, 1, At, B1); PG8_BAR;
            PG8_LDA(At, 1, 1); PG8_STAGE(PG8_SA(1, 0), a3, voffA);
            PG8_BAR; PG8_WAIT_L(0); PG8_MMA(1, 0, At, B0); PG8_BAR; PG8_SCHED;
            PG8_STAGE(PG8_SB(1, 1), b3 + hstep, voffB);
            PG8_WAIT_V(6); PG8_BAR; PG8_MMA(1, 1, At, B1); PG8_BAR;
            }
        }
        if constexpr (FP8) asm volatile("s_nop 15\n\ts_nop 15\n\ts_nop 15\n\ts_nop 15" ::: "memory");
        if constexpr (ALIGN_EPI) { if (wr == 0) PG8_BAR; }
        if constexpr (!Epi::AFTER_DRAIN) { int fr_ = fr, fq_ = fq; asm volatile("" : "+v"(fr_), "+v"(fq_));
            E(acc, cur, wr, wc, fr_, fq_); S.done(cur); }
        if (!has_next) break;
#pragma unroll
        for (int a = 0; a < 2; ++a)
#pragma unroll
            for (int b = 0; b < 2; ++b)
#pragma unroll
                for (int m = 0; m < 4; ++m)
#pragma unroll
                    for (int n = 0; n < 2; ++n) acc[a][b][m][n] = (f32x4){0.f, 0.f, 0.f, 0.f};
        cur = nxt; cA = nA; cB = nB; ++ui;
        if constexpr (ALIGN_EPI) { if (wr == 1) PG8_BAR; }
    }
    PG8_WAIT_V(0);
    if constexpr (!ALIGN_EPI) { if (wr == 0) PG8_BAR; }
    PG8_BAR;
    if constexpr (Epi::AFTER_DRAIN) { E.fused(acc, cur, wr, wc, fr, fq, lds, wid, lane); S.done(cur); }
#undef PG8_SA
#undef PG8_SB
#undef PG8_STAGE
#undef PG8_LDA
#undef PG8_LDB
#undef PG8_MMA
#undef PG8_CAT8
#undef PG8_WAIT_V
#undef PG8_WAIT_L
#undef PG8_BAR
#undef PG8_SCHED
}
}
#define LAS __attribute__((address_space(3)))
#define XB_TMO      128
#define XB_XCNT(j)  (256  + 64 * (j))
#define XB_XSUB(j)  (1280 + 64 * (j))
#define XB_XGEN(j)  (2304 + 64 * (j))
#define XB_TOP      3328
#define XB_TOPGEN   3392
#define XCD_BAR_WORDS 3456
#define XB_SPIN_CAP (1u << 18)

__device__ __forceinline__ unsigned xb_ld(unsigned* p)              { return __hip_atomic_load(p, __ATOMIC_RELAXED, __HIP_MEMORY_SCOPE_AGENT); }
__device__ __forceinline__ unsigned xb_add(unsigned* p, unsigned v) { return __hip_atomic_fetch_add(p, v, __ATOMIC_RELAXED, __HIP_MEMORY_SCOPE_AGENT); }
__device__ __forceinline__ unsigned xb_xcc_id() { return (unsigned)__builtin_amdgcn_s_getreg((3 << 11) | 20) & 0xFu; }
#define XB_SPIN(cond, bar) do { unsigned _sp = 0; while (cond) { __builtin_amdgcn_s_sleep(1); \
    if ((++_sp & 255u) == 0u) { if (xb_ld(&(bar)[XB_TMO])) break; if (_sp > XB_SPIN_CAP) { atomicAdd(&(bar)[XB_TMO], 1u); break; } } } } while (0)

struct XcdBarrier {
    unsigned* bar; unsigned x;
    volatile LAS unsigned* st;
};

__device__ __forceinline__ XcdBarrier xcd_barrier_post(unsigned* bar, volatile LAS unsigned* st) {
    XcdBarrier b; b.bar = bar; b.x = xb_xcc_id(); b.st = st;
    if (threadIdx.x == 0) (void)xb_add(&bar[XB_XCNT(b.x)], 1u);
    return b;
}
__device__ __forceinline__ void xcd_barrier_complete(unsigned* bar, unsigned x, unsigned& nloc, unsigned& nx) {
    const unsigned G = gridDim.x * gridDim.y * gridDim.z;
    unsigned sum, cnt, mine, sp = 0u;
    for (;;) {
        sum = 0u; cnt = 0u; mine = 0u;
#pragma unroll
        for (unsigned j = 0; j < 16; ++j) { const unsigned c = xb_ld(&bar[XB_XCNT(j)]); sum += c; cnt += (c > 0u) ? 1u : 0u; mine = (j == x) ? c : mine; }
        if (sum == G) break;
        __builtin_amdgcn_s_sleep(1);
        if ((++sp & 255u) == 0u) { if (xb_ld(&bar[XB_TMO])) break; if (sp > XB_SPIN_CAP) { atomicAdd(&bar[XB_TMO], 1u); break; } }
    }
    nloc = mine > 0u ? mine : 1u; nx = cnt > 0u ? cnt : 1u;
}

__device__ __forceinline__ void xcd_barrier(const XcdBarrier& b) {
    asm volatile("s_waitcnt vmcnt(0)" ::: "memory");
    __syncthreads();
    if (threadIdx.x == 0) {
        unsigned* bar = b.bar;
        __builtin_amdgcn_s_waitcnt(0);
        unsigned nloc = b.st[0], nx = b.st[1];
        if (nloc == 0u) { xcd_barrier_complete(bar, b.x, nloc, nx); b.st[0] = nloc; b.st[1] = nx; }
        const unsigned old = xb_add(&bar[XB_XSUB(b.x)], 1u);
        const unsigned gen = old / nloc;
        if (old + 1u == (gen + 1u) * nloc) {
            __builtin_amdgcn_fence(__ATOMIC_RELEASE, "agent");
            asm volatile("s_waitcnt vmcnt(0)" ::: "memory");
            const unsigned og = xb_add(&bar[XB_TOP], 1u);
            const unsigned tg = og / nx;
            if (og + 1u == (tg + 1u) * nx) xb_add(&bar[XB_TOPGEN], 1u);
            else XB_SPIN(xb_ld(&bar[XB_TOPGEN]) == tg, bar);
            __builtin_amdgcn_fence(__ATOMIC_ACQUIRE, "agent");
            xb_add(&bar[XB_XGEN(b.x)], 1u);
            asm volatile("s_waitcnt vmcnt(0)" ::: "memory");
        } else {
            XB_SPIN(xb_ld(&bar[XB_XGEN(b.x)]) == gen, bar);
            __builtin_amdgcn_fence(__ATOMIC_ACQUIRE, "agent");
            asm volatile("s_waitcnt vmcnt(0)" ::: "memory");
        }
    }
    __syncthreads();
}

#define DI __device__ __forceinline__
typedef unsigned short bf16_t;
typedef short bf16x8 __attribute__((ext_vector_type(8)));
typedef short s16x4 __attribute__((ext_vector_type(4)));
typedef float f32x4 __attribute__((ext_vector_type(4)));
typedef float f32x16 __attribute__((ext_vector_type(16)));
typedef unsigned u32x4 __attribute__((ext_vector_type(4)));
typedef unsigned u32x2 __attribute__((ext_vector_type(2)));

#ifndef SKIP_ATTN
#define SKIP_ATTN 0
#endif
#ifndef SKIP_SGU
#define SKIP_SGU 0
#endif
#ifndef SKIP_MOE
#define SKIP_MOE 0
#endif
#ifndef PH_MASK
#define PH_MASK 0x3ff
#endif
#define PH(x) ((PH_MASK >> (x)) & 1)
#ifndef REP_PH
#define REP_PH -1
#endif
#define NREP(x) ((x) == REP_PH ? 2 : 1)
#ifndef NO_P6A
#define NO_P6A 0
#endif
#ifndef NO_P6B
#define NO_P6B 0
#endif
#ifndef MOE_FP8
#define MOE_FP8 1
#endif
#ifndef ATTN_BRANCHES
#define ATTN_BRANCHES 7
#endif

constexpr int NB = 4, SEQ = 8192, MTOK = NB * SEQ, DM = 1024;
constexpr int DIN = 4376, NPROJ = 4608;
constexpr int NEXP = 32, DFF = 1024;
constexpr int MPAD = 131072 + 32 * 256;
constexpr float LOG2E = 1.4426950408889634f;
constexpr float QSCALE = 0.125f * LOG2E;
constexpr float NEGBIG = -1e30f;
constexpr float SC_W8 = 64.f, SC_A8 = 8.f, SC_ACT8 = 4.f;

constexpr size_t MiB = 1u << 20;
constexpr size_t WS_CTL = 0;
constexpr size_t CTL_CNT = 0;
constexpr size_t CTL_TE = 64 * 1024;
constexpr size_t CTL_NT = 96 * 1024;
constexpr size_t CTL_C1 = 128 * 1024;
constexpr size_t CTL_BAR = 256 * 1024;
constexpr size_t WS_WIN = 1 * MiB, WS_WAB = 10 * MiB, WS_WOUT = 12 * MiB, WS_W1K = 14 * MiB, WS_W1V = 14 * MiB + 512 * 1024;
constexpr size_t WS_W2K = 15 * MiB, WS_W2V = 15 * MiB + 64 * 1024, WS_WTRIL = 15 * MiB + 512 * 1024;
constexpr size_t WS_WGU = 16 * MiB, WS_WD = 144 * MiB, WS_X2 = 208 * MiB;
constexpr size_t WS_H1 = 336 * MiB, WS_Q = 400 * MiB, WS_KV = 432 * MiB, WS_U = 480 * MiB, WS_V = 512 * MiB, WS_MG = 544 * MiB;
constexpr size_t WS_NG = 672 * MiB, WS_KCMP = 676 * MiB, WS_VCMP = 676 * MiB + 512 * 1024, WS_YAB = 678 * MiB, WS_MERGED = 742 * MiB;
constexpr size_t WS_VT = 806 * MiB;
constexpr size_t WS_AS = 336 * MiB, WS_Y = 336 * MiB, WS_ACT = 608 * MiB, WS_H2 = 608 * MiB;
constexpr size_t WS_TOKE = 880 * MiB, WS_TOKW = 881 * MiB, WS_SLOT = 882 * MiB, WS_WSLOT = 883 * MiB;
constexpr size_t WS_RINV = 884 * MiB;
constexpr size_t WS_END = 885 * MiB;

constexpr int LDS_BYTES = 147456;
constexpr int NWAVES = 8, NTHREADS = 512;

struct Args { const float* in[26]; float* out; unsigned char* ws; };

DI float bf2f(unsigned b) { return __uint_as_float(b << 16); }
DI unsigned pk2(float lo, float hi) {
    typedef float f2_t __attribute__((ext_vector_type(2))); typedef __bf16 b2_t __attribute__((ext_vector_type(2)));
    f2_t v = {lo, hi}; b2_t b = __builtin_convertvector(v, b2_t); return __builtin_bit_cast(unsigned, b);
}
DI unsigned pk4_fp8(float a, float b, float c, float d) { int w = 0; w = __builtin_amdgcn_cvt_pk_fp8_f32(a, b, w, false); w = __builtin_amdgcn_cvt_pk_fp8_f32(c, d, w, true); return (unsigned)w; }
DI unsigned short f2bf(float x) { return (unsigned short)(pk2(x, 0.f) & 0xffffu); }
DI float ex2(float x) { return __builtin_amdgcn_exp2f(x); }
DI float rcpf_(float x) { return __builtin_amdgcn_rcpf(x); }
DI float sigm(float x) { return rcpf_(1.f + ex2(-LOG2E * x)); }
DI float gelu_t(float x) { const float u = 0.7978845608028654f * (x + 0.044715f * x * x * x); return x * rcpf_(1.f + ex2(-2.f * LOG2E * u)); }
DI float wave_sum(float v) {
#pragma unroll
    for (int o = 1; o < 64; o <<= 1) v += __shfl_xor(v, o);
    return v;
}
DI float wave_max(float v) {
#pragma unroll
    for (int o = 1; o < 64; o <<= 1) v = fmaxf(v, __shfl_xor(v, o));
    return v;
}
DI int crow(int i, int h) { return (i & 3) + 8 * (i >> 2) + 4 * h; }
#define MFMA32(a, b, c) __builtin_amdgcn_mfma_f32_32x32x16_bf16((a), (b), (c), 0, 0, 0)
DI LAS unsigned char* lds_raw_las(unsigned char* p) { return (LAS unsigned char*)p; }
DI void lds_wait() { asm volatile("s_waitcnt lgkmcnt(0)" ::: "memory"); }

struct TItem { const float* W; bf16_t* WT; const float* ks; int K, N, k0, n0, map, f8; };
DI int map_row(int map, int n) {
    if (map == 0) return n;
    if (map == 1) return n + 1024;
    if (map == 2) return n < 1280 ? n : (n < 1304 ? n + 3072 : n - 24);
    return n < 1024 ? ((n >> 7) * 256 + (n & 127)) : ((((n - 1024) >> 7) * 256) + 128 + (n & 127));
}
DI void titem_decode(const Args& a, int it, TItem& t) {
    unsigned char* ws = a.ws;
    constexpr int I_WIN = 16 * 137, I_WA = 8 * 32, I_WO = 16 * 32, I_W1 = 32 * 4, I_W2 = 2 * 2, I_GU1 = 16 * 64, I_GU = 32 * I_GU1, I_D1 = 16 * 32, I_D = 32 * I_D1;
    int r = it; t.ks = nullptr; t.map = 0; t.f8 = 0;
    if (r < I_GU) { const int e = r / I_GU1; r -= e * I_GU1; t.W = a.in[21] + (size_t)e * 1024 * 2048; t.WT = (bf16_t*)(ws + WS_WGU + (size_t)e * 2048 * 1024 * (MOE_FP8 ? 1 : 2)); t.K = 1024; t.N = 2048; t.map = 3; t.f8 = MOE_FP8; }
    else if ((r -= I_GU) < I_D) { const int e = r / I_D1; r -= e * I_D1; t.W = a.in[23] + (size_t)e * 1024 * 1024; t.WT = (bf16_t*)(ws + WS_WD + (size_t)e * 1024 * 1024 * (MOE_FP8 ? 1 : 2)); t.K = 1024; t.N = 1024; t.f8 = MOE_FP8; }
    else if ((r -= I_D) < I_WIN) { t.W = a.in[2]; t.WT = (bf16_t*)(ws + WS_WIN); t.K = 1024; t.N = DIN; t.map = 2; t.ks = a.in[1]; }
    else if ((r -= I_WIN) < I_WA) { t.W = a.in[15]; t.WT = (bf16_t*)(ws + WS_WAB); t.K = 512; t.N = 1024; }
    else if ((r -= I_WA) < I_WA) { t.W = a.in[16]; t.WT = (bf16_t*)(ws + WS_WAB); t.K = 512; t.N = 1024; t.map = 1; }
    else if ((r -= I_WA) < I_WO) { t.W = a.in[17]; t.WT = (bf16_t*)(ws + WS_WOUT); t.K = 1024; t.N = 1024; }
    else if ((r -= I_WO) < I_W1) { t.W = a.in[3]; t.WT = (bf16_t*)(ws + WS_W1K); t.K = 2048; t.N = 128; }
    else if ((r -= I_W1) < I_W1) { t.W = a.in[7]; t.WT = (bf16_t*)(ws + WS_W1V); t.K = 2048; t.N = 128; }
    else if ((r -= I_W1) < I_W2) { t.W = a.in[5]; t.WT = (bf16_t*)(ws + WS_W2K); t.K = 128; t.N = 64; }
    else { r -= I_W2; t.W = a.in[9]; t.WT = (bf16_t*)(ws + WS_W2V); t.K = 128; t.N = 64; }
    const int nblk = (t.N + 31) >> 5, kb = r / nblk, nb = r - kb * nblk; t.k0 = 64 * kb; t.n0 = 32 * nb;
}
DI void titem_load(const TItem& t, int lane, float (&v)[32]) {
    const int ncol = t.n0 + (lane & 31); const bool ok = ncol < t.N;
    const float* p = t.W + (size_t)(t.k0 + (lane >> 5)) * t.N + (ok ? ncol : 0);
#pragma unroll
    for (int i = 0; i < 32; ++i) v[i] = p[(size_t)(2 * i) * t.N];
    if (!ok) {
#pragma unroll
        for (int i = 0; i < 32; ++i) v[i] = 0.f;
    }
}
DI void titem_process(const TItem& t, int lane, float (&v)[32], LAS float* scr) {
    if (t.ks) {
#pragma unroll
        for (int i = 0; i < 32; ++i) v[i] *= t.ks[t.k0 + 2 * i + (lane >> 5)];
    }
#pragma unroll
    for (int i = 0; i < 32; ++i) scr[(2 * i + (lane >> 5)) * 33 + (lane & 31)] = v[i];
    lds_wait();
    const int c = lane & 7;
#pragma unroll
    for (int j = 0; j < 4; ++j) {
        const int nl = (lane >> 3) + 8 * j, n = t.n0 + nl;
        const LAS float* s = scr + (8 * c) * 33 + nl;
        if (t.f8) {
            u32x2 o; o.x = pk4_fp8(s[0 * 33] * SC_W8, s[1 * 33] * SC_W8, s[2 * 33] * SC_W8, s[3 * 33] * SC_W8); o.y = pk4_fp8(s[4 * 33] * SC_W8, s[5 * 33] * SC_W8, s[6 * 33] * SC_W8, s[7 * 33] * SC_W8);
            if (n < t.N) *(u32x2*)((unsigned char*)t.WT + (size_t)map_row(t.map, n) * t.K + t.k0 + 8 * c) = o;
        } else {
            u32x4 o; o.x = pk2(s[0 * 33], s[1 * 33]); o.y = pk2(s[2 * 33], s[3 * 33]); o.z = pk2(s[4 * 33], s[5 * 33]); o.w = pk2(s[6 * 33], s[7 * 33]);
            if (n < t.N) *(u32x4*)(t.WT + (size_t)map_row(t.map, n) * t.K + t.k0 + 8 * c) = o;
        }
    }
    lds_wait();
}

DI void p0_prep(const Args& a, LAS unsigned char* lds, int gw, int NGW, int wave, int lane) {
    unsigned char* ws = a.ws;
    LAS float* scr = (LAS float*)(lds + wave * 8704);
    {
        constexpr int NIT = 16 * 137 + 2 * 8 * 32 + 16 * 32 + 2 * 32 * 4 + 2 * 2 * 2 + 32 * 16 * 64 + 32 * 16 * 32;
        TItem ta, tb; float va[32], vb[32];
        int it = gw;
        if (it < NIT) { titem_decode(a, it, ta); titem_load(ta, lane, va); }
        while (it < NIT) {
            int nx = it + NGW;
            if (nx < NIT) { titem_decode(a, nx, tb); titem_load(tb, lane, vb); }
            titem_process(ta, lane, va, scr);
            it = nx; if (it >= NIT) break;
            nx = it + NGW;
            if (nx < NIT) { titem_decode(a, nx, ta); titem_load(ta, lane, va); }
            titem_process(tb, lane, vb, scr);
            it = nx;
        }
    }
    {
        const float* x = a.in[0]; bf16_t* H1 = (bf16_t*)(ws + WS_H1);
        for (int m = 2 * gw; m < MTOK; m += 2 * NGW) {
            const f32x4* xr = (const f32x4*)(x + (size_t)m * DM) + lane;
            f32x4 v[8]; float s0 = 0.f, s1 = 0.f;
#pragma unroll
            for (int j = 0; j < 8; ++j) v[j] = xr[64 * j];
#pragma unroll
            for (int j = 0; j < 4; ++j) { s0 += (v[j].x * v[j].x + v[j].y * v[j].y) + (v[j].z * v[j].z + v[j].w * v[j].w); s1 += (v[4 + j].x * v[4 + j].x + v[4 + j].y * v[4 + j].y) + (v[4 + j].z * v[4 + j].z + v[4 + j].w * v[4 + j].w); }
            const float r0 = 1.0f / sqrtf(wave_sum(s0) * (1.f / DM) + 1e-5f), r1 = 1.0f / sqrtf(wave_sum(s1) * (1.f / DM) + 1e-5f);
            u32x2* o = (u32x2*)(H1 + (size_t)m * DM) + lane;
#pragma unroll
            for (int j = 0; j < 8; ++j) { const float rr = j < 4 ? r0 : r1; u32x2 w; w.x = pk2(v[j].x * rr, v[j].y * rr); w.y = pk2(v[j].z * rr, v[j].w * rr); o[64 * j] = w; }
        }
    }
    {
        float* C1 = (float*)(ws + WS_CTL + CTL_C1);
        for (int o = gw; o < 256; o += NGW) {
            const int ty = o >> 7, f = o & 127; const float* pe = a.in[ty ? 10 : 6]; const float* w1 = a.in[ty ? 7 : 3]; const float* b1 = a.in[ty ? 8 : 4];
            float s = 0.f;
            for (int k = lane; k < 2048; k += 64) s += pe[k] * w1[(size_t)k * 128 + f];
            s = wave_sum(s);
            if (lane == 0) C1[o] = s + b1[f];
        }
    }
    {
        const float* wsp = a.in[13]; bf16_t* WT = (bf16_t*)(ws + WS_WTRIL);
        for (int i = gw * 64 + lane; i < 8 * 128 * 128; i += NGW * 64) { const int t = (i >> 7) & 127, s = i & 127; WT[i] = f2bf(s <= t ? wsp[i] : 0.f); }
    }
}

typedef pg8::f32x4 pf4;
struct Epi1 {
    static constexpr bool PERM = true, AFTER_DRAIN = false;
    bf16_t *Q, *KV, *U, *V, *MG; float* NG;
    DI void operator()(const pf4 (&acc)[2][2][4][2], const pg8::Unit& u, int wr, int wc, int fr, int fq) const {
        const int row0 = u.pm * 256 + wr * 64 + fr, pn = u.pn, c0 = wc * 32 + 8 * fq;
        if (pn == 17) {
            if (wc == 0 && fq < 3) {
#pragma unroll
                for (int ai = 0; ai < 2; ++ai)
#pragma unroll
                    for (int m = 0; m < 4; ++m) { float* p = NG + (size_t)(row0 + ai * 128 + m * 16) * 24 + c0; const pf4 v0 = acc[ai][0][m][0], v1 = acc[ai][0][m][1];
                        *(f32x4*)p = (f32x4){sigm(v0[0]), sigm(v0[1]), sigm(v0[2]), sigm(v0[3])}; *(f32x4*)(p + 4) = (f32x4){sigm(v1[0]), sigm(v1[1]), sigm(v1[2]), sigm(v1[3])}; }
            }
            return;
        }
        bf16_t* base; int ldc, ct, mode;
        float sc = 1.f;
        if (pn < 2) { base = Q; ldc = 512; ct = pn; mode = 0; sc = QSCALE; }
        else if (pn < 5) { base = KV; ldc = 768; ct = pn - 2; mode = 0; }
        else if (pn < 7) { base = U; ldc = 512; ct = pn - 5; mode = 1; }
        else if (pn < 9) { base = V; ldc = 512; ct = pn - 7; mode = 1; }
        else { base = MG; ldc = 2048; ct = pn - 9; mode = 2; }
#pragma unroll
        for (int ai = 0; ai < 2; ++ai)
#pragma unroll
            for (int m = 0; m < 4; ++m) {
                bf16_t* rowp = base + (size_t)(row0 + ai * 128 + m * 16) * ldc + ct * 256 + c0;
#pragma unroll
                for (int bj = 0; bj < 2; ++bj) {
                    pf4 v0 = acc[ai][bj][m][0], v1 = acc[ai][bj][m][1];
                    if (mode == 0) { v0 = v0 * sc; v1 = v1 * sc; }
                    else if (mode == 1) { v0 = (pf4){gelu_t(v0[0]), gelu_t(v0[1]), gelu_t(v0[2]), gelu_t(v0[3])}; v1 = (pf4){gelu_t(v1[0]), gelu_t(v1[1]), gelu_t(v1[2]), gelu_t(v1[3])}; }
                    else { v0 = (pf4){sigm(v0[0]), sigm(v0[1]), sigm(v0[2]), sigm(v0[3])}; v1 = (pf4){sigm(v1[0]), sigm(v1[1]), sigm(v1[2]), sigm(v1[3])}; }
                    u32x4 w; w.x = pk2(v0[0], v0[1]); w.y = pk2(v0[2], v0[3]); w.z = pk2(v1[0], v1[1]); w.w = pk2(v1[2], v1[3]);
                    *(u32x4*)(rowp + bj * 128) = w;
                }
            }
    }
};
struct PairOrder {
    int G, c;
    DI bool next(int i, pg8::Unit& u) const {
        const int L = (i >> 1) * G + c; if (L >= 512) return false;
        const int br = i & 1; u.pm = br * 128 + (L >> 2); u.pn = br * 4 + (L & 3); return true;
    }
    DI void a_ready(const pg8::Unit&) const {}
    DI void done(const pg8::Unit&) const {}
};
struct Epi4 {
    static constexpr bool PERM = true, AFTER_DRAIN = false;
    const bf16_t* MG; bf16_t* OUT;
    DI void operator()(const pf4 (&acc)[2][2][4][2], const pg8::Unit& u, int wr, int wc, int fr, int fq) const {
        const int br = u.pn >> 2, pn = u.pn & 3, pm = u.pm & 127;
        const int row0 = pm * 256 + wr * 64 + fr, c0 = pn * 256 + wc * 32 + 8 * fq;
#pragma unroll
        for (int ai = 0; ai < 2; ++ai)
#pragma unroll
            for (int m = 0; m < 4; ++m) {
                const size_t row = (size_t)(row0 + ai * 128 + m * 16);
#pragma unroll
                for (int bj = 0; bj < 2; ++bj) {
                    const int col = c0 + bj * 128;
                    const u32x4 gw = *(const u32x4*)(MG + row * 2048 + br * 1024 + col);
                    const pf4 v0 = acc[ai][bj][m][0], v1 = acc[ai][bj][m][1];
                    float r[8];
                    r[0] = v0[0] * bf2f(gw.x & 0xffffu); r[1] = v0[1] * bf2f(gw.x >> 16); r[2] = v0[2] * bf2f(gw.y & 0xffffu); r[3] = v0[3] * bf2f(gw.y >> 16);
                    r[4] = v1[0] * bf2f(gw.z & 0xffffu); r[5] = v1[1] * bf2f(gw.z >> 16); r[6] = v1[2] * bf2f(gw.w & 0xffffu); r[7] = v1[3] * bf2f(gw.w >> 16);
                    u32x4* op = (u32x4*)(OUT + row * 1024 + col);
                    if (br == 1) { const u32x4 pv = *op;
                        r[0] += bf2f(pv.x & 0xffffu); r[1] += bf2f(pv.x >> 16); r[2] += bf2f(pv.y & 0xffffu); r[3] += bf2f(pv.y >> 16);
                        r[4] += bf2f(pv.z & 0xffffu); r[5] += bf2f(pv.z >> 16); r[6] += bf2f(pv.w & 0xffffu); r[7] += bf2f(pv.w >> 16); }
                    u32x4 w; w.x = pk2(r[0], r[1]); w.y = pk2(r[2], r[3]); w.z = pk2(r[4], r[5]); w.w = pk2(r[6], r[7]);
                    *op = w;
                }
            }
    }
};
struct Epi5 {
    static constexpr bool PERM = false, AFTER_DRAIN = false;
    const float* X; float* X2;
    DI void operator()(const pf4 (&acc)[2][2][4][2], const pg8::Unit& u, int wr, int wc, int fr, int fq) const {
        const int row0 = u.pm * 256 + wr * 64 + fr, c0 = u.pn * 256 + wc * 32 + 4 * fq;
#pragma unroll
        for (int ai = 0; ai < 2; ++ai)
#pragma unroll
            for (int m = 0; m < 4; ++m) {
                const size_t off = (size_t)(row0 + ai * 128 + m * 16) * DM + c0;
#pragma unroll
                for (int bj = 0; bj < 2; ++bj)
#pragma unroll
                    for (int n = 0; n < 2; ++n) { const f32x4 xv = *(const f32x4*)(X + off + bj * 128 + n * 16); const pf4 v = acc[ai][bj][m][n];
                        *(f32x4*)(X2 + off + bj * 128 + n * 16) = (f32x4){xv[0] + v[0], xv[1] + v[1], xv[2] + v[2], xv[3] + v[3]}; }
            }
    }
};
struct MoeOrder {
    const int* TE; int NT, npn, G, c;
    DI bool next(int i, pg8::Unit& u) const {
        int mt, pn;
        if ((G & 7) == 0) { const int x = c & 7, jj = i * (G >> 3) + (c >> 3); mt = x + 8 * (jj / npn); pn = jj % npn; }
        else { const int L = i * G + c; mt = L / npn; pn = L % npn; }
        if (mt >= NT) return false;
        const int e = __builtin_amdgcn_readfirstlane(TE[mt]);
        u.pm = mt; u.pn = e * npn + pn; return true;
    }
    DI void a_ready(const pg8::Unit&) const {}
    DI void done(const pg8::Unit&) const {}
};
struct Epi7 {
    static constexpr bool PERM = true, AFTER_DRAIN = false;
    const float* BGU; bf16_t* ACT;
    DI void operator()(const pf4 (&acc)[2][2][4][2], const pg8::Unit& u, int wr, int wc, int fr, int fq) const {
        const int e = u.pn >> 3, pn = u.pn & 7, row0 = u.pm * 256 + wr * 64 + fr, c0 = pn * 128 + wc * 32 + 8 * fq;
        const float* bg = BGU + (size_t)e * 2048 + c0; const float* bu = bg + 1024;
        const f32x4 bg0 = *(const f32x4*)bg, bg1 = *(const f32x4*)(bg + 4), bu0 = *(const f32x4*)bu, bu1 = *(const f32x4*)(bu + 4);
        constexpr float ASC = MOE_FP8 ? 1.0f / (SC_A8 * SC_W8) : 1.0f;
#pragma unroll
        for (int ai = 0; ai < 2; ++ai)
#pragma unroll
            for (int m = 0; m < 4; ++m) {
                float r[8];
#pragma unroll
                for (int n = 0; n < 2; ++n)
#pragma unroll
                    for (int k = 0; k < 4; ++k) {
                        const float gt = fminf(acc[ai][0][m][n][k] * ASC + (n ? bg1[k] : bg0[k]), 7.0f);
                        const float up = fminf(fmaxf(acc[ai][1][m][n][k] * ASC + (n ? bu1[k] : bu0[k]), -7.0f), 7.0f);
                        r[n * 4 + k] = gt * rcpf_(1.f + ex2(-1.702f * LOG2E * gt)) * (up + 1.0f);
                    }
                if (MOE_FP8) { u32x2 w; w.x = pk4_fp8(r[0] * SC_ACT8, r[1] * SC_ACT8, r[2] * SC_ACT8, r[3] * SC_ACT8); w.y = pk4_fp8(r[4] * SC_ACT8, r[5] * SC_ACT8, r[6] * SC_ACT8, r[7] * SC_ACT8);
                    *(u32x2*)((unsigned char*)ACT + (size_t)(row0 + ai * 128 + m * 16) * DFF + c0) = w; }
                else { u32x4 w; w.x = pk2(r[0], r[1]); w.y = pk2(r[2], r[3]); w.z = pk2(r[4], r[5]); w.w = pk2(r[6], r[7]);
                    *(u32x4*)(ACT + (size_t)(row0 + ai * 128 + m * 16) * DFF + c0) = w; }
            }
    }
};
struct Epi8 {
    static constexpr bool PERM = true, AFTER_DRAIN = false;
    const float* BD; const float* WSLOT; bf16_t* Y;
    DI void operator()(const pf4 (&acc)[2][2][4][2], const pg8::Unit& u, int wr, int wc, int fr, int fq) const {
        const int e = u.pn >> 2, pn = u.pn & 3, row0 = u.pm * 256 + wr * 64 + fr, c0 = pn * 256 + wc * 32 + 8 * fq;
        f32x4 bv[2][2];
#pragma unroll
        for (int bj = 0; bj < 2; ++bj)
#pragma unroll
            for (int n = 0; n < 2; ++n) bv[bj][n] = *(const f32x4*)(BD + (size_t)e * DM + c0 + bj * 128 + 4 * n);
#pragma unroll
        for (int ai = 0; ai < 2; ++ai)
#pragma unroll
            for (int m = 0; m < 4; ++m) {
                const size_t row = (size_t)(row0 + ai * 128 + m * 16); const float wt = WSLOT[row];
#pragma unroll
                for (int bj = 0; bj < 2; ++bj) {
                    const pf4 v0 = acc[ai][bj][m][0], v1 = acc[ai][bj][m][1]; const f32x4 b0 = bv[bj][0], b1 = bv[bj][1];
                    constexpr float ASC = MOE_FP8 ? 1.0f / (SC_ACT8 * SC_W8) : 1.0f;
                    u32x4 w; w.x = pk2((v0[0] * ASC + b0[0]) * wt, (v0[1] * ASC + b0[1]) * wt); w.y = pk2((v0[2] * ASC + b0[2]) * wt, (v0[3] * ASC + b0[3]) * wt);
                    w.z = pk2((v1[0] * ASC + b1[0]) * wt, (v1[1] * ASC + b1[1]) * wt); w.w = pk2((v1[2] * ASC + b1[2]) * wt, (v1[3] * ASC + b1[3]) * wt);
                    *(u32x4*)(Y + row * DM + c0 + bj * 128) = w;
                }
            }
    }
};

DI void p2_compress_item(const Args& a, LAS unsigned char* lds, int item, int tid, int wave, int lane) {
    unsigned char* ws = a.ws;
    const int nt = item & 15, ty = (item >> 4) & 1, g = (item >> 5) & 1, b = item >> 6;
    const bf16_t* KV = (const bf16_t*)(ws + WS_KV);
    const bf16_t* W1 = (const bf16_t*)(ws + (ty ? WS_W1V : WS_W1K));
    const bf16_t* W2 = (const bf16_t*)(ws + (ty ? WS_W2V : WS_W2K));
    const float* C1 = (const float*)(ws + WS_CTL + CTL_C1) + ty * 128;
    bf16_t* OUT = (bf16_t*)(ws + (ty ? WS_VCMP : WS_KCMP)) + (size_t)((b * 2 + g) * 512 + nt * 32) * 64;
    LAS unsigned char* Xs = lds;
    LAS float* Hs = (LAS float*)(lds + 76032);
    LAS unsigned char* Hb = lds + 76032 + 32768;
    const int r = lane & 31, h = lane >> 5;
    const int p0 = 512 * nt, colsrc = ty * 128 + g * 64;
    for (int i = tid; i < 528 * 8; i += NTHREADS) {
        const int pr = i >> 3, ch = i & 7; int pos = p0 + pr; pos = pos > SEQ - 1 ? SEQ - 1 : pos;
        const u32x4 v = *(const u32x4*)(KV + (size_t)(b * SEQ + pos) * 768 + colsrc + ch * 8);
        *(LAS u32x4*)(Xs + pr * 144 + ch * 16) = v;
    }
    __syncthreads();
    {
        const int ft = wave & 3, kh = wave >> 2;
        f32x16 acc; for (int i = 0; i < 16; ++i) acc[i] = 0.f;
        const bf16_t* wrow = W1 + (size_t)(ft * 32 + r) * 2048 + 8 * h;
#pragma unroll 4
        for (int s = kh * 64; s < kh * 64 + 64; ++s) {
            const int l = s >> 2, d0 = (s & 3) * 16;
            const bf16x8 af = *(const LAS bf16x8*)(Xs + (16 * r + l) * 144 + (d0 + 8 * h) * 2);
            const bf16x8 bfr = *(const bf16x8*)(wrow + 16 * s);
            acc = MFMA32(af, bfr, acc);
        }
#pragma unroll
        for (int i = 0; i < 16; ++i) Hs[(kh * 32 + crow(i, h)) * 128 + ft * 32 + r] = acc[i];
    }
    __syncthreads();
    for (int i = tid; i < 32 * 128; i += NTHREADS) {
        const int n = i >> 7, f = i & 127;
        const float v = Hs[n * 128 + f] + Hs[(32 + n) * 128 + f] + C1[f];
        *(LAS unsigned short*)(Hb + n * 272 + f * 2) = f2bf(gelu_t(v));
    }
    __syncthreads();
    if (wave < 2) {
        f32x16 acc; for (int i = 0; i < 16; ++i) acc[i] = 0.f;
        const bf16_t* wrow = W2 + (size_t)(wave * 32 + r) * 128 + 8 * h;
#pragma unroll
        for (int s = 0; s < 8; ++s) {
            const bf16x8 af = *(const LAS bf16x8*)(Hb + r * 272 + (16 * s + 8 * h) * 2);
            const bf16x8 bfr = *(const bf16x8*)(wrow + 16 * s);
            acc = MFMA32(af, bfr, acc);
        }
        if (ty == 0) {
#pragma unroll
            for (int i = 0; i < 16; ++i) OUT[(size_t)crow(i, h) * 64 + wave * 32 + r] = f2bf(acc[i]);
        } else {
            bf16_t* OT = (bf16_t*)(ws + WS_VCMP) + (size_t)(b * 2 + g) * 64 * 512 + (size_t)(wave * 32 + r) * 512 + nt * 32;
#pragma unroll
            for (int i = 0; i < 16; ++i) OT[crow(i, h)] = f2bf(acc[i]);
        }
    }
    __syncthreads();
}

DI void p2_sgu_item(const Args& a, LAS unsigned char* lds, int item, int tid, int wave, int lane) {
    unsigned char* ws = a.ws;
    const bf16_t* U = (const bf16_t*)(ws + WS_U); const bf16_t* V = (const bf16_t*)(ws + WS_V);
    const bf16_t* WT = (const bf16_t*)(ws + WS_WTRIL);
    bf16_t* YB = (bf16_t*)(ws + WS_YAB) + (size_t)MTOK * 512;
    const float* lng = a.in[11]; const float* lnb = a.in[12]; const float* bs = a.in[14];
    const size_t row0 = (size_t)item * 128;
    LAS unsigned char* VnT = lds;
    const int r = lane & 31, h = lane >> 5;
    {
        float gg[8], bb[8];
#pragma unroll
        for (int e = 0; e < 8; ++e) { gg[e] = lng[8 * lane + e]; bb[e] = lnb[8 * lane + e]; }
        for (int pp = 0; pp < 16; ++pp) {
            const int pos = wave * 16 + pp;
            const u32x4 raw = *(const u32x4*)(V + (row0 + pos) * 512 + 8 * lane);
            float x[8]; x[0] = bf2f(raw.x & 0xffffu); x[1] = bf2f(raw.x >> 16); x[2] = bf2f(raw.y & 0xffffu); x[3] = bf2f(raw.y >> 16);
            x[4] = bf2f(raw.z & 0xffffu); x[5] = bf2f(raw.z >> 16); x[6] = bf2f(raw.w & 0xffffu); x[7] = bf2f(raw.w >> 16);
            float s = 0.f;
#pragma unroll
            for (int e = 0; e < 8; ++e) s += x[e];
            const float mu = wave_sum(s) * (1.f / 512.f); float q = 0.f;
#pragma unroll
            for (int e = 0; e < 8; ++e) { x[e] -= mu; q += x[e] * x[e]; }
            const float rstd = 1.0f / sqrtf(wave_sum(q) * (1.f / 512.f) + 1e-5f);
#pragma unroll
            for (int e = 0; e < 8; ++e) *(LAS unsigned short*)(VnT + (8 * lane + e) * 272 + pos * 2) = f2bf(x[e] * rstd * gg[e] + bb[e]);
        }
    }
    __syncthreads();
    {
        const int grp = wave;
        for (int tt = 0; tt < 4; ++tt) {
            f32x16 acc[2];
#pragma unroll
            for (int i = 0; i < 16; ++i) { acc[0][i] = 0.f; acc[1][i] = 0.f; }
            const bf16_t* wrow = WT + (size_t)(grp * 128 + tt * 32 + r) * 128 + 8 * h;
            const int nst = 2 * tt + 2;
            for (int s = 0; s < nst; ++s) {
                const bf16x8 bfr = *(const bf16x8*)(wrow + 16 * s);
#pragma unroll
                for (int dt = 0; dt < 2; ++dt) {
                    const bf16x8 af = *(const LAS bf16x8*)(VnT + (grp * 64 + dt * 32 + r) * 272 + (16 * s + 8 * h) * 2);
                    acc[dt] = MFMA32(af, bfr, acc[dt]);
                }
            }
            const int t = tt * 32 + r; const float bt = bs[grp * 128 + t];
            const size_t rowt = row0 + t;
#pragma unroll
            for (int dt = 0; dt < 2; ++dt)
#pragma unroll
                for (int q4 = 0; q4 < 4; ++q4) {
                    const int d = dt * 32 + 8 * q4 + 4 * h;
                    const u32x2 uu = *(const u32x2*)(U + rowt * 512 + grp * 64 + d);
                    const float y0 = bf2f(uu.x & 0xffffu) * (acc[dt][4 * q4 + 0] + bt), y1 = bf2f(uu.x >> 16) * (acc[dt][4 * q4 + 1] + bt);
                    const float y2 = bf2f(uu.y & 0xffffu) * (acc[dt][4 * q4 + 2] + bt), y3 = bf2f(uu.y >> 16) * (acc[dt][4 * q4 + 3] + bt);
                    u32x2 w; w.x = pk2(y0, y1); w.y = pk2(y2, y3);
                    *(u32x2*)(YB + rowt * 512 + grp * 64 + d) = w;
                }
        }
    }
    __syncthreads();
    {
        const bf16_t* KV = (const bf16_t*)(ws + WS_KV); bf16_t* VT = (bf16_t*)(ws + WS_VT);
        LAS unsigned char* T = lds;
        const int bb = item >> 6, posc = (item & 63) * 128;
        for (int i = tid; i < 128 * 32; i += NTHREADS) {
            const int pos = i & 127, ch = i >> 7;
            const int ty = ch >> 4, c8 = (ch & 15) * 8;
            const u32x4 v = *(const u32x4*)(KV + (row0 + pos) * 768 + (ty ? 5 : 3) * 128 + c8);
            LAS unsigned char* tp = T + (ty * 128 + c8) * 272 + pos * 2;
            *(LAS unsigned short*)(tp + 0 * 272) = (unsigned short)(v.x & 0xffffu); *(LAS unsigned short*)(tp + 1 * 272) = (unsigned short)(v.x >> 16);
            *(LAS unsigned short*)(tp + 2 * 272) = (unsigned short)(v.y & 0xffffu); *(LAS unsigned short*)(tp + 3 * 272) = (unsigned short)(v.y >> 16);
            *(LAS unsigned short*)(tp + 4 * 272) = (unsigned short)(v.z & 0xffffu); *(LAS unsigned short*)(tp + 5 * 272) = (unsigned short)(v.z >> 16);
            *(LAS unsigned short*)(tp + 6 * 272) = (unsigned short)(v.w & 0xffffu); *(LAS unsigned short*)(tp + 7 * 272) = (unsigned short)(v.w >> 16);
        }
        __syncthreads();
        for (int i = tid; i < 256 * 16; i += NTHREADS) {
            const int rw = i >> 4, ch = i & 15, ty = rw >> 7, gd = rw & 127;
            const u32x4 v = *(const LAS u32x4*)(T + rw * 272 + ch * 16);
            *(u32x4*)(VT + ((size_t)(ty * 4 + bb) * 128 + gd) * SEQ + posc + ch * 8) = v;
        }
        __syncthreads();
    }
}

constexpr int AL_K0 = 0, AL_K1 = 9216, AL_V0 = 18432, AL_V1 = 27136, AL_PB = 35840, AL_IMP = 102400, AL_SELM = 135424, AL_UNI = 136448, AL_BL = 136512, AL_NBL = 137024, AL_THR = 137088;
static_assert(AL_THR + 256 <= LDS_BYTES, "attention LDS map");
struct KVSrc { const bf16_t* k; const bf16_t* v; int kp, vp; };
struct BlkPar { float base, ksl; int lo, hi; };

template <int MODE>
DI void attn_block(const LAS unsigned char* Ks, const LAS unsigned char* Vs, const bf16x8 (&qf)[4], f32x16 (&o)[2], float& m, float& l, float invl, LAS float* pbrow, const BlkPar bp, const bool MASK, int r, int h) {
    f32x16 p0, p1;
    {
        const float bh = bp.base + bp.ksl * (float)(4 * h), bh1 = bh + 32.f * bp.ksl;
#pragma unroll
        for (int i = 0; i < 16; ++i) { const float kc = (float)((i & 3) + 8 * (i >> 2)); p0[i] = bp.ksl * kc + bh; p1[i] = bp.ksl * kc + bh1; }
    }
#pragma unroll
    for (int s = 0; s < 4; ++s) {
        const bf16x8 a0 = *(const LAS bf16x8*)(Ks + r * 144 + s * 32 + h * 16);
        const bf16x8 a1 = *(const LAS bf16x8*)(Ks + (32 + r) * 144 + s * 32 + h * 16);
        p0 = MFMA32(a0, qf[s], p0); p1 = MFMA32(a1, qf[s], p1);
    }
    if (MASK) {
        const int lo = bp.lo - 4 * h, hi = bp.hi - 4 * h;
#pragma unroll
        for (int i = 0; i < 16; ++i) { const int kc = (i & 3) + 8 * (i >> 2); p0[i] = (kc >= lo && kc <= hi) ? p0[i] : NEGBIG; p1[i] = (kc + 32 >= lo && kc + 32 <= hi) ? p1[i] : NEGBIG; }
    }
    if (MODE == 0 || MODE == 1) {
        float mx = fmaxf(p0[0], p1[0]);
#pragma unroll
        for (int i = 1; i < 16; ++i) mx = fmaxf(mx, fmaxf(p0[i], p1[i]));
        mx = fmaxf(mx, __shfl_xor(mx, 32));
        if (__any(mx > m)) {
            const float mn = fmaxf(m, mx), alpha = ex2(m - mn); m = mn; l *= alpha;
            if (MODE == 0) {
#pragma unroll
                for (int i = 0; i < 16; ++i) { o[0][i] *= alpha; o[1][i] *= alpha; }
            }
        }
        float sum = 0.f;
#pragma unroll
        for (int i = 0; i < 16; ++i) { p0[i] = ex2(p0[i] - m); p1[i] = ex2(p1[i] - m); sum += p0[i] + p1[i]; }
        l += sum;
    } else {
#pragma unroll
        for (int i = 0; i < 16; ++i) {
            p0[i] = p0[i] > -1e29f ? ex2(p0[i] - m) * invl : 0.f; p1[i] = p1[i] > -1e29f ? ex2(p1[i] - m) * invl : 0.f;
            pbrow[crow(i, h)] = p0[i]; pbrow[32 + crow(i, h)] = p1[i];
        }
    }
    if (MODE != 1) {
        bf16x8 pf[4];
#pragma unroll
        for (int ks = 0; ks < 2; ++ks) {
            u32x4 w0, w1;
            w0.x = pk2(p0[8 * ks + 0], p0[8 * ks + 1]); w0.y = pk2(p0[8 * ks + 2], p0[8 * ks + 3]); w0.z = pk2(p0[8 * ks + 4], p0[8 * ks + 5]); w0.w = pk2(p0[8 * ks + 6], p0[8 * ks + 7]);
            w1.x = pk2(p1[8 * ks + 0], p1[8 * ks + 1]); w1.y = pk2(p1[8 * ks + 2], p1[8 * ks + 3]); w1.z = pk2(p1[8 * ks + 4], p1[8 * ks + 5]); w1.w = pk2(p1[8 * ks + 6], p1[8 * ks + 7]);
            pf[ks] = __builtin_bit_cast(bf16x8, w0); pf[2 + ks] = __builtin_bit_cast(bf16x8, w1);
        }
#pragma unroll
        for (int dh = 0; dh < 2; ++dh) {
            __builtin_amdgcn_sched_barrier(0);
#pragma unroll
            for (int ks = 0; ks < 4; ++ks) {
                const LAS unsigned char* vp = Vs + (dh * 32 + r) * 136 + ks * 32 + h * 8;
                const s16x4 lo = *(const LAS s16x4*)vp, hi = *(const LAS s16x4*)(vp + 16);
                const bf16x8 af = __builtin_shufflevector(lo, hi, 0, 1, 2, 3, 4, 5, 6, 7);
                o[dh] = MFMA32(af, pf[ks], o[dh]);
            }
        }
        __builtin_amdgcn_sched_barrier(0);
    }
}

DI void kv_load(const KVSrc& s, int tid, u32x4& kreg, u32x4& vreg) {
    const int ko = (tid >> 3) * s.kp + (tid & 7) * 8, vo = (tid >> 3) * s.vp + (tid & 7) * 8;
    kreg = *(const u32x4*)(s.k + ko);
    vreg = *(const u32x4*)(s.v + vo);
}
DI void kv_store(LAS unsigned char* Kb, LAS unsigned char* Vb, int tid, const u32x4& kreg, const u32x4& vreg) {
    *(LAS u32x4*)(Kb + (tid >> 3) * 144 + (tid & 7) * 16) = kreg;
    LAS unsigned char* vp = Vb + (tid >> 3) * 136 + (tid & 7) * 16;
    *(LAS u32x2*)vp = (u32x2){vreg.x, vreg.y}; *(LAS u32x2*)(vp + 8) = (u32x2){vreg.z, vreg.w};
}

template <int MODE, class SrcF, class ParF, class PostF>
DI void attn_run(int nb, SrcF src, ParF par, PostF post, LAS unsigned char* lds, const bf16x8 (&qf)[4], f32x16 (&o)[2], float& m, float& l, float invl, LAS float* pbrow,
                 int tid, int r, int h) {
    u32x4 kreg, vreg;
    kv_load(src(0), tid, kreg, vreg);
    kv_store(lds + AL_K0, lds + AL_V0, tid, kreg, vreg);
    __syncthreads();
    for (int i = 0; i < nb; ++i) {
        const int cur = i & 1;
        if (i + 1 < nb) kv_load(src(i + 1), tid, kreg, vreg);
        bool msk; const BlkPar bp = par(i, msk);
        attn_block<MODE>(lds + (cur ? AL_K1 : AL_K0), lds + (cur ? AL_V1 : AL_V0), qf, o, m, l, invl, pbrow, bp, msk, r, h);
        if (MODE == 2) { __syncthreads(); post(i); }
        if (i + 1 < nb) kv_store(lds + (cur ? AL_K0 : AL_K1), lds + (cur ? AL_V0 : AL_V1), tid, kreg, vreg);
        __syncthreads();
    }
}

#define CE_DESC(a, b) do { const unsigned _x = (a), _y = (b); (a) = _x > _y ? _x : _y; (b) = _x > _y ? _y : _x; } while (0)
DI void sort16_desc(unsigned (&k)[16]) {
#pragma unroll
    for (int kk = 2; kk <= 16; kk <<= 1)
#pragma unroll
        for (int j = kk >> 1; j > 0; j >>= 1)
#pragma unroll
            for (int i = 0; i < 16; ++i) { const int p = i ^ j; if (p > i) { if ((i & kk) == 0) CE_DESC(k[i], k[p]); else CE_DESC(k[p], k[i]); } }
}
DI void merge16_desc(unsigned (&k)[16]) {
#pragma unroll
    for (int j = 8; j > 0; j >>= 1)
#pragma unroll
        for (int i = 0; i < 16; ++i) { const int p = i ^ j; if (p > i) CE_DESC(k[i], k[p]); }
}

DI void attn_tile(const Args& a, LAS unsigned char* lds, int b, int g, int c, int tid, int wave, int lane) {
    asm volatile("" : "+v"(tid), "+v"(lane));
    unsigned char* ws = a.ws;
    const bf16_t* Q = (const bf16_t*)(ws + WS_Q); const bf16_t* KV = (const bf16_t*)(ws + WS_KV);
    const bf16_t* KC = (const bf16_t*)(ws + WS_KCMP) + (size_t)(b * 2 + g) * 512 * 64; const bf16_t* VC = (const bf16_t*)(ws + WS_VCMP) + (size_t)(b * 2 + g) * 64 * 512;
    const float* NG = (const float*)(ws + WS_NG); bf16_t* YA = (bf16_t*)(ws + WS_YAB); const bf16_t* VT = (const bf16_t*)(ws + WS_VT);
    const int r = lane & 31, h = lane >> 5, hd = wave >> 1, th = wave & 1, tl = th * 32 + r, t = 64 * c + tl;
    const size_t row = (size_t)b * SEQ + t;
    const float slope2 = ex2(-(float)(g * 4 + hd + 1)) * LOG2E;
    const float tf = (float)t;
    bf16x8 qf[4];
#pragma unroll
    for (int s = 0; s < 4; ++s) qf[s] = *(const bf16x8*)(Q + row * 512 + g * 256 + hd * 64 + 16 * s + 8 * h);
    const float gate_c = NG[row * 24 + g * 12 + hd * 3 + 0], gate_s = NG[row * 24 + g * 12 + hd * 3 + 1], gate_w = NG[row * 24 + g * 12 + hd * 3 + 2];
    float* YF = (float*)(ws + WS_H1) + row * 512 + g * 256 + hd * 64 + 4 * h;
    LAS float* IMP = (LAS float*)(lds + AL_IMP);
    LAS float* PB = (LAS float*)(lds + AL_PB);
    LAS float* pbrow = PB + (hd * 64 + tl) * 65;
    const bf16_t* kvb = KV + (size_t)b * SEQ * 768 + g * 64;
    auto nopost = [](int) {};

    const bf16_t* vtw = VT + ((size_t)(4 + b) * 128 + g * 64) * SEQ;
    const bf16_t* vts = VT + ((size_t)(0 + b) * 128 + g * 64) * SEQ;
    if (ATTN_BRANCHES & 1) {
        const int nb = (c > 8 ? 8 : c) + 1;
        f32x16 o[2];
#pragma unroll
        for (int i = 0; i < 16; ++i) { o[0][i] = 0.f; o[1][i] = 0.f; }
        float m = NEGBIG, l = 0.f;
        auto src = [=](int i) { const int j = c - i; KVSrc s; s.k = kvb + (size_t)(64 * j) * 768 + 4 * 128; s.v = vtw + 64 * j; s.kp = 768; s.vp = SEQ; return s; };
        auto par = [=](int i, bool& msk) { const int d0 = t - 64 * (c - i); msk = (i == 0) || (i == 8); BlkPar bp; bp.base = -slope2 * (float)d0; bp.ksl = slope2; bp.lo = d0 - 511; bp.hi = d0; return bp; };
        attn_run<0>(nb, src, par, nopost, lds, qf, o, m, l, 0.f, pbrow, tid, r, h);
        const float sc = gate_w * rcpf_(l + __shfl_xor(l, 32));
#pragma unroll
        for (int dh = 0; dh < 2; ++dh)
#pragma unroll
            for (int q4 = 0; q4 < 4; ++q4) *(f32x4*)(YF + dh * 32 + 8 * q4) = (f32x4){sc * o[dh][4 * q4], sc * o[dh][4 * q4 + 1], sc * o[dh][4 * q4 + 2], sc * o[dh][4 * q4 + 3]};
    }
    for (int i = tid; i < 64 * 129; i += NTHREADS) IMP[i] = 0.f;
    if (ATTN_BRANCHES & 2) {
        const int nbc = (4 * c + 3 + 63) >> 6;
        auto src = [=](int i) { KVSrc s; s.k = KC + (size_t)(64 * i) * 64; s.v = VC + 64 * i; s.kp = 64; s.vp = 512; return s; };
        const int nvalid = ((t - 31) >> 4);
        auto par = [=](int i, bool& msk) { const int n0 = 64 * i; msk = (n0 + 63) > ((64 * c - 31) >> 4);
            BlkPar bp; bp.base = -slope2 * (tf - (float)(16 * n0) - 15.5f); bp.ksl = 16.f * slope2; bp.lo = -1000000; bp.hi = nvalid - n0; return bp; };
        f32x16 o[2];
#pragma unroll
        for (int i = 0; i < 16; ++i) { o[0][i] = 0.f; o[1][i] = 0.f; }
        float m = NEGBIG, l = 0.f;
        attn_run<1>(nbc, src, par, nopost, lds, qf, o, m, l, 0.f, pbrow, tid, r, h);
        const float invl = rcpf_(l + __shfl_xor(l, 32));
        auto post = [=](int i) {
            for (int q = tid; q < 64 * 17; q += NTHREADS) {
                const int tok = q & 63, jj = q >> 6, j = 16 * i + jj;
                float acc = 0.f;
                if (jj < 16) {
#pragma unroll
                    for (int hh = 0; hh < 4; ++hh) { const LAS float* p = PB + (hh * 64 + tok) * 65 + 4 * jj; acc += (p[0] + p[1]) + (p[2] + 0.5f * p[3]); if (jj > 0) acc += 0.5f * p[-1]; }
                } else {
#pragma unroll
                    for (int hh = 0; hh < 4; ++hh) acc += 0.5f * PB[(hh * 64 + tok) * 65 + 63];
                }
                if (j < 128) IMP[tok * 129 + j] += acc;
            }
        };
        attn_run<2>(nbc, src, par, post, lds, qf, o, m, l, invl, pbrow, tid, r, h);
#pragma unroll
        for (int dh = 0; dh < 2; ++dh)
#pragma unroll
            for (int q4 = 0; q4 < 4; ++q4) { f32x4 v = *(f32x4*)(YF + dh * 32 + 8 * q4);
                v[0] += gate_c * o[dh][4 * q4]; v[1] += gate_c * o[dh][4 * q4 + 1]; v[2] += gate_c * o[dh][4 * q4 + 2]; v[3] += gate_c * o[dh][4 * q4 + 3]; *(f32x4*)(YF + dh * 32 + 8 * q4) = v; }
    }
    __syncthreads();
    if (ATTN_BRANCHES & 4) {
        LAS unsigned* L0 = (LAS unsigned*)(lds + AL_PB);
        LAS unsigned* L1 = L0 + 8 * 16 * 64;
        LAS unsigned* L2 = L1 + 4 * 16 * 64;
        LAS unsigned* THR = (LAS unsigned*)(lds + AL_THR);
        LAS unsigned short* SELM = (LAS unsigned short*)(lds + AL_SELM);
        LAS unsigned* UNI = (LAS unsigned*)(lds + AL_UNI);
        LAS int* BL = (LAS int*)(lds + AL_BL);
        LAS int* NBL = (LAS int*)(lds + AL_NBL);
        const int tok = lane, seg = wave;
        unsigned key[16];
#pragma unroll
        for (int i = 0; i < 16; ++i) {
            const int j = 16 * seg + i;
            const bool forced = (j == 0) || (j == c) || (j == c - 1);
            const unsigned kvv = forced ? 0x1FFFFFFu : (j <= c ? (__float_as_uint(IMP[tok * 129 + j]) >> 7) + 1u : 0u);
            key[i] = (kvv << 7) | (unsigned)(127 - j);
        }
        sort16_desc(key);
#pragma unroll
        for (int i = 0; i < 16; ++i) L0[(seg * 16 + i) * 64 + tok] = key[i];
        __syncthreads();
        if (wave < 4) {
            unsigned kk[16];
#pragma unroll
            for (int i = 0; i < 16; ++i) { const unsigned x = L0[((2 * wave) * 16 + i) * 64 + tok], y = L0[((2 * wave + 1) * 16 + 15 - i) * 64 + tok]; kk[i] = x > y ? x : y; }
            merge16_desc(kk);
#pragma unroll
            for (int i = 0; i < 16; ++i) L1[(wave * 16 + i) * 64 + tok] = kk[i];
        }
        __syncthreads();
        if (wave < 2) {
            unsigned kk[16];
#pragma unroll
            for (int i = 0; i < 16; ++i) { const unsigned x = L1[((2 * wave) * 16 + i) * 64 + tok], y = L1[((2 * wave + 1) * 16 + 15 - i) * 64 + tok]; kk[i] = x > y ? x : y; }
            merge16_desc(kk);
#pragma unroll
            for (int i = 0; i < 16; ++i) L2[(wave * 16 + i) * 64 + tok] = kk[i];
        }
        __syncthreads();
        if (wave == 0) {
            unsigned mn = 0xffffffffu;
#pragma unroll
            for (int i = 0; i < 16; ++i) { const unsigned x = L2[i * 64 + tok], y = L2[(16 + 15 - i) * 64 + tok]; const unsigned z = x > y ? x : y; mn = z < mn ? z : mn; }
            THR[tok] = mn;
        }
        __syncthreads();
        {
            const unsigned T = THR[tok]; unsigned m16 = 0;
#pragma unroll
            for (int i = 0; i < 16; ++i) m16 |= (key[i] >= T) ? (1u << (15 - (key[i] & 15u))) : 0u;
            SELM[tok * 8 + seg] = (unsigned short)m16;
            unsigned uni = 0;
#pragma unroll
            for (int bb = 0; bb < 16; ++bb) uni |= (__ballot((m16 >> bb) & 1u) != 0ull) ? (1u << bb) : 0u;
            if (lane == 0) UNI[seg] = uni;
        }
        __syncthreads();
        if (wave == 0) {
            int base = 0;
#pragma unroll
            for (int half = 0; half < 2; ++half) {
                const int j = half * 64 + lane;
                const bool on = ((UNI[j >> 4] >> (j & 15)) & 1u) && (j <= c);
                const unsigned long long bal = __ballot(on);
                const int pos = base + __builtin_popcountll(bal & ((1ull << lane) - 1ull));
                if (on) BL[pos] = j;
                base += __builtin_popcountll(bal);
            }
            if (lane == 0) NBL[0] = base;
        }
        __syncthreads();
        const int nbs = __builtin_amdgcn_readfirstlane(NBL[0]);
        f32x16 o[2];
#pragma unroll
        for (int i = 0; i < 16; ++i) { o[0][i] = 0.f; o[1][i] = 0.f; }
        float m = NEGBIG, l = 0.f;
        auto src = [=](int i) { const int j = __builtin_amdgcn_readfirstlane(BL[nbs - 1 - i]); KVSrc s; s.k = kvb + (size_t)(64 * j) * 768 + 2 * 128; s.v = vts + 64 * j; s.kp = 768; s.vp = SEQ; return s; };
        auto par = [=](int i, bool& msk) { const int j = __builtin_amdgcn_readfirstlane(BL[nbs - 1 - i]); const bool sel = (SELM[tl * 8 + (j >> 4)] >> (j & 15)) & 1; const int d0 = t - 64 * j;
            msk = (j == c); BlkPar bp; bp.base = sel ? -slope2 * (float)d0 : NEGBIG; bp.ksl = slope2; bp.lo = -1000000; bp.hi = d0; return bp; };
        attn_run<0>(nbs, src, par, nopost, lds, qf, o, m, l, 0.f, pbrow, tid, r, h);
        const float sc = gate_s * rcpf_(l + __shfl_xor(l, 32));
#pragma unroll
        for (int dh = 0; dh < 2; ++dh)
#pragma unroll
            for (int q4 = 0; q4 < 4; ++q4) {
                const int d = dh * 32 + 8 * q4 + 4 * h;
                const f32x4 v = *(const f32x4*)(YF + dh * 32 + 8 * q4);
                u32x2 w; w.x = pk2(v[0] + sc * o[dh][4 * q4 + 0], v[1] + sc * o[dh][4 * q4 + 1]); w.y = pk2(v[2] + sc * o[dh][4 * q4 + 2], v[3] + sc * o[dh][4 * q4 + 3]);
                *(u32x2*)(YA + row * 512 + g * 256 + hd * 64 + d) = w;
            }
    }
    __syncthreads();
}

DI void p6a_route(const Args& a, LAS unsigned char* lds, int tid, int wave, int lane) {
    unsigned char* ws = a.ws;
    const float* X2 = (const float*)(ws + WS_X2);
    const float* gm = a.in[18]; const float* wr = a.in[19]; const float* br = a.in[20];
    int* TOKE = (int*)(ws + WS_TOKE); float* TOKW = (float*)(ws + WS_TOKW); int* CNT = (int*)(ws + WS_CTL + CTL_CNT); float* RINV = (float*)(ws + WS_RINV);
    LAS unsigned char* WR = lds; LAS int* CNTL = (LAS int*)(lds + 131072);
    for (int i = tid; i < 1024 * 8; i += NTHREADS) { const int k = i >> 3, q = i & 7; const float gk = gm[k]; const f32x4 w = *(const f32x4*)(wr + k * 32 + q * 4);
        *(LAS f32x4*)(WR + k * 128 + ((q ^ ((k >> 1) & 7)) * 16)) = (f32x4){w[0] * gk, w[1] * gk, w[2] * gk, w[3] * gk}; }
    const float myb = br[lane >> 1];
    for (int blk = blockIdx.x; blk < 256; blk += gridDim.x) {
        if (tid < 32) CNTL[tid] = 0;
        __syncthreads();
        int mycnt = 0;
        for (int it = 0; it < 16; ++it) {
            const int t0 = blk * 128 + wave * 16 + it;
            const float* xpa = X2 + (size_t)t0 * DM + lane;
            float pa[32]; float sa = 0.f;
#pragma unroll
            for (int e = 0; e < 32; ++e) pa[e] = 0.f;
#pragma unroll 1
            for (int i0 = 0; i0 < 16; i0 += 4) {
                float xa[4];
#pragma unroll
                for (int ii = 0; ii < 4; ++ii) xa[ii] = xpa[64 * (i0 + ii)];
#pragma unroll
                for (int ii = 0; ii < 4; ++ii) {
                    sa += xa[ii] * xa[ii];
                    const int k = lane + 64 * (i0 + ii); const LAS unsigned char* wrow = WR + k * 128; const int sw = (k >> 1) & 7;
#pragma unroll
                    for (int q = 0; q < 8; ++q) { const f32x4 w4 = *(const LAS f32x4*)(wrow + ((q ^ sw) * 16));
#pragma unroll
                        for (int j = 0; j < 4; ++j) pa[4 * q + j] += xa[ii] * w4[j]; }
                }
            }
            const float ra = 1.0f / sqrtf(wave_sum(sa) * (1.f / DM) + 1e-5f);
            if (lane == 0) RINV[t0] = ra;
#pragma unroll
            for (int st = 0; st < 5; ++st) {
                const int n = 16 >> st, xo = 32 >> st; const bool up = (lane & xo) != 0;
#pragma unroll
                for (int e = 0; e < n; ++e) {
                    float a0 = pa[e], a1 = pa[e + n];
                    asm volatile("" : "+v"(a0), "+v"(a1));
                    const float sa_ = up ? a0 : a1, ka = up ? a1 : a0; pa[e] = ka + __shfl_xor(sa_, xo);
                }
            }
            float v = (pa[0] + __shfl_xor(pa[0], 1)) * ra + myb;
            if (lane & 1) v = -3e38f;
            {
                int es0, es1, es2, es3; float vs0, vs1, vs2, vs3;
#define TOPK_ROUND(ES, VS) { const float mx = wave_max(v); const unsigned long long bal = __ballot(v == mx); const int ln = __builtin_ctzll(bal); ES = ln >> 1; VS = mx; if (lane == ln) v = -3e38f; mycnt += (lane == (ln >> 1)) ? 1 : 0; }
                TOPK_ROUND(es0, vs0) TOPK_ROUND(es1, vs1) TOPK_ROUND(es2, vs2) TOPK_ROUND(es3, vs3)
#undef TOPK_ROUND
                const float e1 = ex2((vs1 - vs0) * LOG2E), e2 = ex2((vs2 - vs0) * LOG2E), e3 = ex2((vs3 - vs0) * LOG2E);
                const float inv = 1.0f / (1.0f + e1 + e2 + e3);
                if (lane == 0) {
                    const size_t o = (size_t)t0 * 4;
                    TOKE[o] = es0; TOKE[o + 1] = es1; TOKE[o + 2] = es2; TOKE[o + 3] = es3;
                    TOKW[o] = inv; TOKW[o + 1] = e1 * inv; TOKW[o + 2] = e2 * inv; TOKW[o + 3] = e3 * inv;
                }
            }
        }
        if (lane < 32) atomicAdd((int*)(CNTL + lane), mycnt);
        __syncthreads();
        if (tid < 32) CNT[blk * 32 + tid] = CNTL[tid];
        __syncthreads();
    }
}
DI void p6b_place(const Args& a, LAS unsigned char* lds, int tid, int wave, int lane) {
    unsigned char* ws = a.ws;
    const float* X2 = (const float*)(ws + WS_X2); const float* RINV = (const float*)(ws + WS_RINV); bf16_t* AS = (bf16_t*)(ws + WS_AS);
    const float* gm = a.in[18];
    const f32x4 g00 = *(const f32x4*)(gm + lane * 8), g01 = *(const f32x4*)(gm + lane * 8 + 4), g10 = *(const f32x4*)(gm + 512 + lane * 8), g11 = *(const f32x4*)(gm + 512 + lane * 8 + 4);
    const int* TOKE = (const int*)(ws + WS_TOKE); const float* TOKW = (const float*)(ws + WS_TOKW); const int* CNT = (const int*)(ws + WS_CTL + CTL_CNT);
    int* SLOT = (int*)(ws + WS_SLOT); float* WSLOT = (float*)(ws + WS_WSLOT); int* TE = (int*)(ws + WS_CTL + CTL_TE); int* NT = (int*)(ws + WS_CTL + CTL_NT);
    LAS int* TOT = (LAS int*)lds; LAS int* OFFS = TOT + 32; LAS int* PADS = TOT + 64; LAS int* CUR = TOT + 96;
    for (int blk = blockIdx.x; blk < 256; blk += gridDim.x) {
        if (tid < 32) { int tot = 0, mine = 0; for (int bb = 0; bb < 256; ++bb) { const int cc = CNT[bb * 32 + tid]; tot += cc; mine += (bb < blk) ? cc : 0; } TOT[tid] = tot; OFFS[tid] = mine; CUR[tid] = 0; }
        __syncthreads();
        if (tid == 0) {
            int ps = 0;
            for (int e = 0; e < 32; ++e) { PADS[e] = ps; ps += (TOT[e] + 255) & ~255; }
            if (blk == 0) { int tile = 0; for (int e = 0; e < 32; ++e) { const int n = (TOT[e] + 255) >> 8; for (int q = 0; q < n; ++q) TE[tile++] = e; } NT[0] = tile; }
        }
        __syncthreads();
        for (int it = 0; it < 16; ++it) {
            const int t = blk * 128 + wave * 16 + it;
            const float rv = RINV[t];
            u32x4 r0, r1; u32x2 q0, q1;
            { const f32x4 a0 = *(const f32x4*)(X2 + (size_t)t * DM + lane * 8), a1 = *(const f32x4*)(X2 + (size_t)t * DM + lane * 8 + 4);
              const f32x4 b0 = *(const f32x4*)(X2 + (size_t)t * DM + 512 + lane * 8), b1 = *(const f32x4*)(X2 + (size_t)t * DM + 512 + lane * 8 + 4);
              r0.x = pk2(a0[0] * rv * g00[0], a0[1] * rv * g00[1]); r0.y = pk2(a0[2] * rv * g00[2], a0[3] * rv * g00[3]); r0.z = pk2(a1[0] * rv * g01[0], a1[1] * rv * g01[1]); r0.w = pk2(a1[2] * rv * g01[2], a1[3] * rv * g01[3]);
              r1.x = pk2(b0[0] * rv * g10[0], b0[1] * rv * g10[1]); r1.y = pk2(b0[2] * rv * g10[2], b0[3] * rv * g10[3]); r1.z = pk2(b1[0] * rv * g11[0], b1[1] * rv * g11[1]); r1.w = pk2(b1[2] * rv * g11[2], b1[3] * rv * g11[3]);
              const float r8 = rv * SC_A8;
              q0.x = pk4_fp8(a0[0] * r8 * g00[0], a0[1] * r8 * g00[1], a0[2] * r8 * g00[2], a0[3] * r8 * g00[3]); q0.y = pk4_fp8(a1[0] * r8 * g01[0], a1[1] * r8 * g01[1], a1[2] * r8 * g01[2], a1[3] * r8 * g01[3]);
              q1.x = pk4_fp8(b0[0] * r8 * g10[0], b0[1] * r8 * g10[1], b0[2] * r8 * g10[2], b0[3] * r8 * g10[3]); q1.y = pk4_fp8(b1[0] * r8 * g11[0], b1[1] * r8 * g11[1], b1[2] * r8 * g11[2], b1[3] * r8 * g11[3]); }
#pragma unroll
            for (int k = 0; k < 4; ++k) {
                const int e = TOKE[(size_t)t * 4 + k];
                int p = 0; if (lane == 0) p = atomicAdd((int*)(CUR + e), 1);
                p = __builtin_amdgcn_readfirstlane(p);
                const int pos = PADS[e] + OFFS[e] + p;
                if (MOE_FP8) { *(u32x2*)((unsigned char*)AS + (size_t)pos * DM + lane * 8) = q0; *(u32x2*)((unsigned char*)AS + (size_t)pos * DM + 512 + lane * 8) = q1; }
                else { *(u32x4*)(AS + (size_t)pos * DM + lane * 8) = r0; *(u32x4*)(AS + (size_t)pos * DM + 512 + lane * 8) = r1; }
                if (lane == 0) { SLOT[(size_t)t * 4 + k] = pos; WSLOT[pos] = TOKW[(size_t)t * 4 + k]; }
            }
        }
        __syncthreads();
    }
}
DI void p9_final(const Args& a, int gw, int NGW, int lane) {
    unsigned char* ws = a.ws;
    const float* X2 = (const float*)(ws + WS_X2); const bf16_t* Y = (const bf16_t*)(ws + WS_Y); const int* SLOT = (const int*)(ws + WS_SLOT);
    const float* gf = a.in[25]; float* out = a.out;
    f32x4 gv[4];
#pragma unroll
    for (int j = 0; j < 4; ++j) gv[j] = *((const f32x4*)gf + lane + 64 * j);
    for (int t = gw; t < MTOK; t += NGW) {
        f32x4 v[4];
#pragma unroll
        for (int j = 0; j < 4; ++j) v[j] = *((const f32x4*)(X2 + (size_t)t * DM) + lane + 64 * j);
        if (!SKIP_MOE) {
#pragma unroll
            for (int k = 0; k < 4; ++k) {
                const int pos = SLOT[(size_t)t * 4 + k];
#pragma unroll
                for (int j = 0; j < 4; ++j) { const u32x2 y = *((const u32x2*)(Y + (size_t)pos * DM) + lane + 64 * j);
                    v[j].x += bf2f(y.x & 0xffffu); v[j].y += bf2f(y.x >> 16); v[j].z += bf2f(y.y & 0xffffu); v[j].w += bf2f(y.y >> 16); }
            }
        }
        float s = 0.f;
#pragma unroll
        for (int j = 0; j < 4; ++j) s += (v[j].x * v[j].x + v[j].y * v[j].y) + (v[j].z * v[j].z + v[j].w * v[j].w);
        const float rinv = 1.0f / sqrtf(wave_sum(s) * (1.f / DM) + 1e-5f);
#pragma unroll
        for (int j = 0; j < 4; ++j) *((f32x4*)(out + (size_t)t * DM) + lane + 64 * j) = (f32x4){v[j].x * rinv * gv[j].x, v[j].y * rinv * gv[j].y, v[j].z * rinv * gv[j].z, v[j].w * rinv * gv[j].w};
    }
}

__global__ void __launch_bounds__(NTHREADS, 2) hybrid_fwd(Args args) {
    extern __shared__ __attribute__((aligned(16))) unsigned char lds_raw[];
    LAS unsigned char* lds = (LAS unsigned char*)lds_raw;
    cg::grid_group grid = cg::this_grid();
    const int tid = threadIdx.x, lane = tid & 63, wave = __builtin_amdgcn_readfirstlane(tid >> 6);
    volatile LAS unsigned* bst = (volatile LAS unsigned*)(lds_raw_las(lds_raw) + LDS_BYTES - 16);
    if (tid < 4) bst[tid] = 0u;
    __syncthreads();
    const XcdBarrier xbar = xcd_barrier_post((unsigned*)(args.ws + WS_CTL + CTL_BAR), bst);
#define SYNC() xcd_barrier(xbar)
    const int G = gridDim.x, bx = blockIdx.x;
    const int gw = bx * NWAVES + wave, NGW = G * NWAVES;
    unsigned char* ws = args.ws;

    for (int rep = 0; rep < NREP(0); ++rep) p0_prep(args, lds, gw, NGW, wave, lane);
    grid.sync();
    for (int rep = 0; rep < NREP(1); ++rep) {
        pg8::Gemm g{(const pg8::bf16_t*)(ws + WS_H1), (const pg8::bf16_t*)(ws + WS_WIN), MTOK, NPROJ, DM};
        pg8::StaticOrder S; S.init(MTOK, NPROJ, G, bx);
        Epi1 E{(bf16_t*)(ws + WS_Q), (bf16_t*)(ws + WS_KV), (bf16_t*)(ws + WS_U), (bf16_t*)(ws + WS_V), (bf16_t*)(ws + WS_MG), (float*)(ws + WS_NG)};
        pg8::gemm_phase<Epi1, pg8::StaticOrder, true, true>(lds, g, S, E);
    }
    SYNC();
    for (int rep = 0; rep < NREP(2); ++rep)
    for (int it = bx; it < 512; it += G) {
        if (it < 256) p2_compress_item(args, lds, it, tid, wave, lane);
        else p2_sgu_item(args, lds, it - 256, tid, wave, lane);
    }
    SYNC();
    for (int rep = 0; rep < NREP(3); ++rep) {
        for (int it = bx; it < 1024; it += G) {
            const int w = it & 255, i = it >> 8, s = w & 31, bg = w >> 5;
            const int c = (i == 0) ? s : (i == 1) ? 63 - s : (i == 2) ? 64 + s : 127 - s;
            attn_tile(args, lds, bg >> 1, bg & 1, c, tid, wave, lane);
        }
    }
    SYNC();
    for (int rep = 0; rep < NREP(4); ++rep) {
        pg8::Gemm g{(const pg8::bf16_t*)(ws + WS_YAB), (const pg8::bf16_t*)(ws + WS_WAB), 2 * MTOK, 2048, 512};
        PairOrder S{G, bx};
        Epi4 E{(const bf16_t*)(ws + WS_MG), (bf16_t*)(ws + WS_MERGED)};
        pg8::gemm_phase<Epi4, PairOrder, true, true>(lds, g, S, E);
    }
    SYNC();
    for (int rep = 0; rep < NREP(5); ++rep) {
        pg8::Gemm g{(const pg8::bf16_t*)(ws + WS_MERGED), (const pg8::bf16_t*)(ws + WS_WOUT), MTOK, DM, DM};
        pg8::StaticOrder S; S.init(MTOK, DM, G, bx);
        Epi5 E{args.in[0], (float*)(ws + WS_X2)};
        pg8::gemm_phase<Epi5, pg8::StaticOrder, true, true>(lds, g, S, E);
    }
    SYNC();
    for (int rep = 0; rep < NREP(6); ++rep) { p6a_route(args, lds, tid, wave, lane); }
    SYNC();
    for (int rep = 0; rep < NREP(10); ++rep) { p6b_place(args, lds, tid, wave, lane); }
    SYNC();
    const int* TE = (const int*)(ws + WS_CTL + CTL_TE);
    const int NT = __builtin_amdgcn_readfirstlane(*(const int*)(ws + WS_CTL + CTL_NT));
    for (int rep = 0; rep < NREP(7); ++rep) {
        int kq = MOE_FP8 ? DM / 2 : DM; asm volatile("" : "+s"(kq));
        pg8::Gemm g{(const pg8::bf16_t*)(ws + WS_AS), (const pg8::bf16_t*)(ws + WS_WGU), MPAD, NEXP * 2048, kq};
        MoeOrder S{TE, NT, 8, G, bx};
        Epi7 E{args.in[22], (bf16_t*)(ws + WS_ACT)};
        pg8::gemm_phase<Epi7, MoeOrder, true, true, MOE_FP8 != 0>(lds, g, S, E);
    }
    SYNC();
    for (int rep = 0; rep < NREP(8); ++rep) {
        int kq = MOE_FP8 ? DFF / 2 : DFF; asm volatile("" : "+s"(kq));
        pg8::Gemm g{(const pg8::bf16_t*)(ws + WS_ACT), (const pg8::bf16_t*)(ws + WS_WD), MPAD, NEXP * 1024, kq};
        MoeOrder S{TE, NT, 4, G, bx};
        Epi8 E{args.in[24], (const float*)(ws + WS_WSLOT), (bf16_t*)(ws + WS_Y)};
        pg8::gemm_phase<Epi8, MoeOrder, true, true, MOE_FP8 != 0>(lds, g, S, E);
    }
    SYNC();
    for (int rep = 0; rep < NREP(9); ++rep) p9_final(args, gw, NGW, lane);
}

extern "C" void kernel_launch(void* const* d_in, const int* in_sizes, int n_in, void* d_out, int out_size, void* d_ws, size_t ws_size, hipStream_t stream) {
    static int grid = 0;
    if (grid == 0) {
        if (n_in != 26 || in_sizes[0] != MTOK * DM || out_size != MTOK * DM || ws_size < WS_END) {
            fprintf(stderr, "kernel_launch: unexpected shapes (n_in %d, in0 %d, out %d, ws %zu < %zu)\n", n_in, n_in > 0 ? in_sizes[0] : -1, out_size, ws_size, (size_t)WS_END); grid = -1; return; }
        int dev = 0, cus = 0, per_cu = 0;
        hipGetDevice(&dev);
        hipDeviceGetAttribute(&cus, hipDeviceAttributeMultiprocessorCount, dev);
        if (hipFuncSetAttribute((const void*)hybrid_fwd, hipFuncAttributeMaxDynamicSharedMemorySize, LDS_BYTES) != hipSuccess) { fprintf(stderr, "kernel_launch: hipFuncSetAttribute failed\n"); grid = -1; return; }
        if (hipOccupancyMaxActiveBlocksPerMultiprocessor(&per_cu, (const void*)hybrid_fwd, NTHREADS, LDS_BYTES) != hipSuccess || per_cu < 1) { fprintf(stderr, "kernel_launch: occupancy query says %d\n", per_cu); per_cu = 1; }
        (void)hipGetLastError();
        grid = cus * 1;
        if (grid > cus * per_cu) grid = cus * per_cu;
    }
    if (grid < 0) return;
    if (hipMemsetAsync((unsigned char*)d_ws + WS_CTL + CTL_BAR, 0, XCD_BAR_WORDS * 4, stream) != hipSuccess) { fprintf(stderr, "kernel_launch: memset failed\n"); return; }
    Args a{};
    for (int i = 0; i < 26; ++i) a.in[i] = (const float*)d_in[i];
    a.out = (float*)d_out; a.ws = (unsigned char*)d_ws;
    void* kargs[] = {&a};
    hipError_t e = hipLaunchCooperativeKernel((const void*)hybrid_fwd, dim3(grid), dim3(NTHREADS), kargs, LDS_BYTES, stream);
    if (e != hipSuccess) fprintf(stderr, "kernel_launch: cooperative launch failed: %s (grid %d)\n", hipGetErrorString(e), grid);
}
```

```cpp
#include <hip/hip_runtime.h>
#include <hip/hip_cooperative_groups.h>
#include <cstdio>
#include <cstdint>
namespace cg = cooperative_groups;
namespace pg8 {
#define PG8_LAS __attribute__((address_space(3)))
typedef unsigned short bf16_t;
typedef short bf16x8 __attribute__((ext_vector_type(8)));
typedef float f32x4 __attribute__((ext_vector_type(4)));
typedef unsigned u32x4 __attribute__((ext_vector_type(4)));
typedef int v4i32_t __attribute__((ext_vector_type(4)));
typedef int v8i32_t __attribute__((ext_vector_type(8)));
constexpr int BM = 256, BK = 64, HALF = 128, HTB = HALF * BK * 2  , STAGE_BYTES = 8 * HTB, NXCD = 8, WGM = 8;

__host__ __device__ __forceinline__ int lds_byte(int r, int c) { const int st = (r >> 4) * 2 + (c >> 5), rr = r & 15, cc = c & 31, ob = rr * 64 + cc * 2; return st * 1024 + (ob ^ (((ob >> 9) & 1) << 5)); }
__host__ __device__ __forceinline__ void stage_rc(int b, int& R, int& C) { const int st = b / 1024, sb = b % 1024, swz = sb ^ (((sb >> 9) & 1) << 5); R = (st >> 1) * 16 + swz / 64; C = (st & 1) * 32 + (swz % 64) / 2; }
__host__ __device__ __forceinline__ int perm32(int rho) { const int n = rho >> 4, i = rho & 15; return 8 * (i >> 2) + 4 * n + (i & 3); }

struct Unit { int pm, pn; };
struct Gemm { const bf16_t* A; const bf16_t* Bt; int M, N, K; };

struct StaticOrder {
    int nM, nN, nwg, G, c;
    __host__ __device__ void init(int M, int N, int G_, int c_) { nM = M / BM; nN = N / BM; nwg = nM * nN; G = G_; c = c_; }
    __host__ __device__ bool next(int i, Unit& u) const {
        const long L = (long)i * G + c; if (L >= nwg) return false;
        int wgid = (int)L; { const int q = nwg / NXCD, r = nwg % NXCD, xcd = wgid % NXCD, off = wgid / NXCD; wgid = (xcd < r ? xcd * (q + 1) : r * (q + 1) + (xcd - r) * q) + off; }
        const int nig = WGM * nN, gid = wgid / nig, fm = gid * WGM, gsz = (nM - fm) < WGM ? (nM - fm) : WGM;
        u.pm = fm + ((wgid % nig) % gsz); u.pn = (wgid % nig) / gsz; return true;
    }
    __device__ __forceinline__ void a_ready(const Unit&) const {}
    __device__ __forceinline__ void done(const Unit&) const {}
};

__device__ __forceinline__ unsigned cvt_pk_bf16(float lo, float hi) { unsigned r; asm volatile("v_cvt_pk_bf16_f32 %0, %1, %2" : "=v"(r) : "v"(lo), "v"(hi)); return r; }
typedef float f32x2 __attribute__((ext_vector_type(2)));
template <class Epi, class Sched, bool ALIGN_EPI = false, bool SP2 = false, bool FP8 = false>
__device__ __forceinline__ void gemm_phase(PG8_LAS unsigned char* lds, const Gemm g, const Sched& S, const Epi& E) {
    int tid_ = threadIdx.x; asm volatile("" : "+v"(tid_));
    const int tid = tid_, wid = __builtin_amdgcn_readfirstlane(tid >> 6), lane = tid & 63, wr = wid >> 2, wc = wid & 3, fr = lane & 15, fq = lane >> 4;
    const int K = g.K, nt = K / BK;
    unsigned voffA[2], voffB[2];
#pragma unroll
    for (int i = 0; i < 2; ++i) { int R, C; stage_rc(tid * 16 + i * 8192, R, C); const int Rb = Epi::PERM ? ((R & ~31) + perm32(R & 31)) : R;
        voffA[i] = (unsigned)(R * K + C) * 2u; voffB[i] = (unsigned)(Rb * K + C) * 2u; }
    const size_t kstep = (size_t)(BK * 2);
    const size_t hstep = (size_t)HALF * K * 2;
    const size_t tstep = 2 * hstep;
    const unsigned ldsw = (unsigned)wid * 1024u;
    const int aoff = lds_byte(wr * 64 + fr, fq * 8), boff = lds_byte(wc * 32 + fr, fq * 8);
#define PG8_SA(b, h) (((b) * 2 + (h)) * HTB)
#define PG8_SB(b, h) ((4 + (b) * 2 + (h)) * HTB)
#define PG8_STAGE(bufoff, gbase, voff) do { _Pragma("unroll") for (int _i = 0; _i < 2; ++_i) \
        __builtin_amdgcn_global_load_lds((const unsigned*)((const char*)(gbase) + (voff)[_i]), (PG8_LAS unsigned*)(lds + (bufoff) + ldsw + _i * 8192), 16, 0, 0); } while (0)
#define PG8_LDA(dst, b, h) do { _Pragma("unroll") for (int m = 0; m < 4; ++m) _Pragma("unroll") for (int k = 0; k < 2; ++k) dst[m][k] = *(const PG8_LAS bf16x8*)(lds + PG8_SA(b, h) + aoff + m * 2048 + k * 1024); } while (0)
#define PG8_LDB(dst, b, h) do { _Pragma("unroll") for (int n = 0; n < 2; ++n) _Pragma("unroll") for (int k = 0; k < 2; ++k) dst[n][k] = *(const PG8_LAS bf16x8*)(lds + PG8_SB(b, h) + boff + n * 2048 + k * 1024); } while (0)
#define PG8_CAT8(x) __builtin_shufflevector(__builtin_bit_cast(v4i32_t, (x)[0]), __builtin_bit_cast(v4i32_t, (x)[1]), 0, 1, 2, 3, 4, 5, 6, 7)
#define PG8_MMA(ai, bj, At, Bt) do { __builtin_amdgcn_s_setprio(1); \
        if constexpr (FP8) { _Pragma("unroll") for (int m = 0; m < 4; ++m) _Pragma("unroll") for (int n = 0; n < 2; ++n) \
            { const v8i32_t a8_ = PG8_CAT8(Bt[n]), b8_ = PG8_CAT8(At[m]); asm volatile("v_mfma_scale_f32_16x16x128_f8f6f4 %0, %1, %2, %0, %3, %3 op_sel_hi:[0,0,0]" : "+v"(acc[ai][bj][m][n]) : "v"(a8_), "v"(b8_), "v"(0x7f7f7f7f)); } } \
        else { _Pragma("unroll") for (int m = 0; m < 4; ++m) _Pragma("unroll") for (int n = 0; n < 2; ++n) _Pragma("unroll") for (int k = 0; k < 2; ++k) \
            acc[ai][bj][m][n] = __builtin_amdgcn_mfma_f32_16x16x32_bf16(Bt[n][k], At[m][k], acc[ai][bj][m][n], 0, 0, 0); } \
        __builtin_amdgcn_s_setprio(0); } while (0)
#define PG8_WAIT_V(n) asm volatile("s_waitcnt vmcnt(" #n ")" ::: "memory")
#define PG8_WAIT_L(n) asm volatile("s_waitcnt lgkmcnt(" #n ")" ::: "memory")
#define PG8_BAR __builtin_amdgcn_s_barrier()
#define PG8_SCHED __builtin_amdgcn_sched_barrier(0)
    Unit cur, nxt; int ui = 0;
    if (!S.next(0, cur)) return;
    f32x4 acc[2][2][4][2];
#pragma unroll
    for (int a = 0; a < 2; ++a)
#pragma unroll
        for (int b = 0; b < 2; ++b)
#pragma unroll
            for (int m = 0; m < 4; ++m)
#pragma unroll
                for (int n = 0; n < 2; ++n) acc[a][b][m][n] = (f32x4){0.f, 0.f, 0.f, 0.f};
    bf16x8 At[4][2], B0[2][2], B1[2][2];
    const char* cA = (const char*)g.A + (size_t)cur.pm * tstep; const char* cB = (const char*)g.Bt + (size_t)cur.pn * tstep;
    S.a_ready(cur);
    if constexpr (SP2) {
        PG8_STAGE(PG8_SB(0, 0), cB, voffB); PG8_STAGE(PG8_SB(0, 1), cB + hstep, voffB); PG8_STAGE(PG8_SA(0, 0), cA, voffA); PG8_STAGE(PG8_SA(0, 1), cA + hstep, voffA);
        if (wr == 1) PG8_BAR;
        PG8_WAIT_V(2); PG8_BAR;
        PG8_STAGE(PG8_SB(1, 0), cB + kstep, voffB); PG8_STAGE(PG8_SA(1, 0), cA + kstep, voffA); PG8_STAGE(PG8_SB(1, 1), cB + hstep + kstep, voffB);
        PG8_WAIT_V(6); PG8_BAR;
    } else {
        PG8_STAGE(PG8_SB(0, 0), cB, voffB); PG8_STAGE(PG8_SA(0, 0), cA, voffA); PG8_STAGE(PG8_SB(0, 1), cB + hstep, voffB); PG8_STAGE(PG8_SA(0, 1), cA + hstep, voffA);
        if (wr == 1) PG8_BAR;
        PG8_WAIT_V(4); PG8_BAR;
        PG8_STAGE(PG8_SB(1, 0), cB + kstep, voffB); PG8_STAGE(PG8_SA(1, 0), cA + kstep, voffA); PG8_STAGE(PG8_SB(1, 1), cB + hstep + kstep, voffB);
        PG8_WAIT_V(6); PG8_BAR;
    }
    for (;;) {
        const bool has_next = S.next(ui + 1, nxt);
        const char* nA = has_next ? (const char*)g.A + (size_t)nxt.pm * tstep : cA; const char* nB = has_next ? (const char*)g.Bt + (size_t)nxt.pn * tstep : cB;
        for (int t = 0; t < nt; t += 2) {
            const bool last = (t == nt - 2);
            const char* a1 = cA + (size_t)(t + 1) * kstep;
            const char* a2 = last ? nA : cA + (size_t)(t + 2) * kstep; const char* b2 = last ? nB : cB + (size_t)(t + 2) * kstep;
            const char* a3 = a2 + kstep; const char* b3 = b2 + kstep;
            if (last && has_next) S.a_ready(nxt);
            if constexpr (SP2) {
            PG8_LDB(B0, 0, 0); PG8_LDB(B1, 0, 1); PG8_SCHED; PG8_LDA(At, 0, 0); PG8_STAGE(PG8_SA(1, 1), a1 + hstep, voffA);
            PG8_WAIT_V(8); PG8_WAIT_L(0); PG8_BAR; PG8_MMA(0, 0, At, B0); PG8_MMA(0, 1, At, B1); PG8_BAR; PG8_SCHED;
            PG8_LDA(At, 0, 1); PG8_STAGE(PG8_SB(0, 0), b2, voffB); PG8_STAGE(PG8_SB(0, 1), b2 + hstep, voffB); PG8_STAGE(PG8_SA(0, 0), a2, voffA);
            PG8_WAIT_V(8); PG8_WAIT_L(0); PG8_BAR; PG8_MMA(1, 0, At, B0); PG8_MMA(1, 1, At, B1); PG8_BAR; PG8_SCHED;
            PG8_LDB(B0, 1, 0); PG8_LDB(B1, 1, 1); PG8_SCHED; PG8_LDA(At, 1, 0); PG8_STAGE(PG8_SA(0, 1), a2 + hstep, voffA);
            PG8_WAIT_V(8); PG8_WAIT_L(0); PG8_BAR; PG8_MMA(0, 0, At, B0); PG8_MMA(0, 1, At, B1); PG8_BAR; PG8_SCHED;
            PG8_LDA(At, 1, 1); PG8_STAGE(PG8_SB(1, 0), b3, voffB); PG8_STAGE(PG8_SB(1, 1), b3 + hstep, voffB); PG8_STAGE(PG8_SA(1, 0), a3, voffA);
            PG8_WAIT_V(8); PG8_WAIT_L(0); PG8_BAR; PG8_MMA(1, 0, At, B0); PG8_MMA(1, 1, At, B1); PG8_BAR; PG8_SCHED;
            } else {
            PG8_LDB(B0, 0, 0); PG8_SCHED; PG8_LDA(At, 0, 0); PG8_STAGE(PG8_SA(1, 1), a1 + hstep, voffA);
            PG8_WAIT_L(8); PG8_BAR; PG8_WAIT_L(0); PG8_MMA(0, 0, At, B0); PG8_BAR; PG8_SCHED;
            PG8_LDB(B1, 0, 1); PG8_STAGE(PG8_SB(0, 0), b2, voffB);
            PG8_BAR; PG8_WAIT_L(0); PG8_MMA(0, 1, At, B1); PG8_BAR;
            PG8_LDA(At, 0, 1); PG8_STAGE(PG8_SA(0, 0), a2, voffA);
            PG8_BAR; PG8_WAIT_L(0); PG8_MMA(1, 0, At, B0); PG8_BAR; PG8_SCHED;
            PG8_STAGE(PG8_SB(0, 1), b2 + hstep, voffB);
            PG8_WAIT_V(6); PG8_BAR; PG8_MMA(1, 1, At, B1); PG8_BAR;
            PG8_LDB(B0, 1, 0); PG8_SCHED; PG8_LDA(At, 1, 0); PG8_STAGE(PG8_SA(0, 1), a2 + hstep, voffA);
            PG8_WAIT_L(8); PG8_BAR; PG8_WAIT_L(0); PG8_MMA(0, 0, At, B0); PG8_BAR; PG8_SCHED;
            PG8_LDB(B1, 1, 1); PG8_STAGE(PG8_SB(1, 0), b3, voffB);
            PG8_BAR; PG8_WAIT_L(0); PG8_MMA(0, 1, At, B1); PG8_BAR;
            PG8_LDA(At, 1, 1); PG8_STAGE(PG8_SA(1, 0), a3, voffA);
            PG8_BAR; PG8_WAIT_L(0); PG8_MMA(1, 0, At, B0); PG8_BAR; PG8_SCHED;
            PG8_STAGE(PG8_SB(1, 1), b3 + hstep, voffB);
            PG8_WAIT_V(6); PG8_BAR; PG8_MMA(1, 1, At, B1); PG8_BAR;
            }
        }
        if constexpr (FP8) asm volatile("s_nop 15\n\ts_nop 15\n\ts_nop 15\n\ts_nop 15" ::: "memory");
        if constexpr (ALIGN_EPI) { if (wr == 0) PG8_BAR; }
        if constexpr (!Epi::AFTER_DRAIN) { int fr_ = fr, fq_ = fq; asm volatile("" : "+v"(fr_), "+v"(fq_));
            E(acc, cur, wr, wc, fr_, fq_); S.done(cur); }
        if (!has_next) break;
#pragma unroll
        for (int a = 0; a < 2; ++a)
#pragma unroll
            for (int b = 0; b < 2; ++b)
#pragma unroll
                for (int m = 0; m < 4; ++m)
#pragma unroll
                    for (int n = 0; n < 2; ++n) acc[a][b][m][n] = (f32x4){0.f, 0.f, 0.f, 0.f};
        cur = nxt; cA = nA; cB = nB; ++ui;
        if constexpr (ALIGN_EPI) { if (wr == 1) PG8_BAR; }
    }
    PG8_WAIT_V(0);
    if constexpr (!ALIGN_EPI) { if (wr == 0) PG8_BAR; }
    PG8_BAR;
    if constexpr (Epi::AFTER_DRAIN) { E.fused(acc, cur, wr, wc, fr, fq, lds, wid, lane); S.done(cur); }
#undef PG8_SA
#undef PG8_SB
#undef PG8_STAGE
#undef PG8_LDA
#undef PG8_LDB
#undef PG8_MMA
#undef PG8_CAT8
#undef PG8_WAIT_V
#undef PG8_WAIT_L
#undef PG8_BAR
#undef PG8_SCHED
}
}
#define LAS __attribute__((address_space(3)))
#define XB_TMO      128
#define XB_XCNT(j)  (256  + 64 * (j))
#define XB_XSUB(j)  (1280 + 64 * (j))
#define XB_XGEN(j)  (2304 + 64 * (j))
#define XB_TOP      3328
#define XB_TOPGEN   3392
#define XCD_BAR_WORDS 3456
#define XB_SPIN_CAP (1u << 18)

__device__ __forceinline__ unsigned xb_ld(unsigned* p)              { return __hip_atomic_load(p, __ATOMIC_RELAXED, __HIP_MEMORY_SCOPE_AGENT); }
__device__ __forceinline__ unsigned xb_add(unsigned* p, unsigned v) { return __hip_atomic_fetch_add(p, v, __ATOMIC_RELAXED, __HIP_MEMORY_SCOPE_AGENT); }
__device__ __forceinline__ unsigned xb_xcc_id() { return (unsigned)__builtin_amdgcn_s_getreg((3 << 11) | 20) & 0xFu; }
#define XB_SPIN(cond, bar) do { unsigned _sp = 0; while (cond) { __builtin_amdgcn_s_sleep(1); \
    if ((++_sp & 255u) == 0u) { if (xb_ld(&(bar)[XB_TMO])) break; if (_sp > XB_SPIN_CAP) { atomicAdd(&(bar)[XB_TMO], 1u); break; } } } } while (0)

struct XcdBarrier {
    unsigned* bar; unsigned x;
    volatile LAS unsigned* st;
};

__device__ __forceinline__ XcdBarrier xcd_barrier_post(unsigned* bar, volatile LAS unsigned* st) {
    XcdBarrier b; b.bar = bar; b.x = xb_xcc_id(); b.st = st;
    if (threadIdx.x == 0) (void)xb_add(&bar[XB_XCNT(b.x)], 1u);
    return b;
}
__device__ __forceinline__ void xcd_barrier_complete(unsigned* bar, unsigned x, unsigned& nloc, unsigned& nx) {
    const unsigned G = gridDim.x * gridDim.y * gridDim.z;
    unsigned sum, cnt, mine, sp = 0u;
    for (;;) {
        sum = 0u; cnt = 0u; mine = 0u;
#pragma unroll
        for (unsigned j = 0; j < 16; ++j) { const unsigned c = xb_ld(&bar[XB_XCNT(j)]); sum += c; cnt += (c > 0u) ? 1u : 0u; mine = (j == x) ? c : mine; }
        if (sum == G) break;
        __builtin_amdgcn_s_sleep(1);
        if ((++sp & 255u) == 0u) { if (xb_ld(&bar[XB_TMO])) break; if (sp > XB_SPIN_CAP) { atomicAdd(&bar[XB_TMO], 1u); break; } }
    }
    nloc = mine > 0u ? mine : 1u; nx = cnt > 0u ? cnt : 1u;
}

__device__ __forceinline__ void xcd_barrier(const XcdBarrier& b) {
    asm volatile("s_waitcnt vmcnt(0)" ::: "memory");
    __syncthreads();
    if (threadIdx.x == 0) {
        unsigned* bar = b.bar;
        __builtin_amdgcn_s_waitcnt(0);
        unsigned nloc = b.st[0], nx = b.st[1];
        if (nloc == 0u) { xcd_barrier_complete(bar, b.x, nloc, nx); b.st[0] = nloc; b.st[1] = nx; }
        const unsigned old = xb_add(&bar[XB_XSUB(b.x)], 1u);
        const unsigned gen = old / nloc;
        if (old + 1u == (gen + 1u) * nloc) {
            __builtin_amdgcn_fence(__ATOMIC_RELEASE, "agent");
            asm volatile("s_waitcnt vmcnt(0)" ::: "memory");
            const unsigned og = xb_add(&bar[XB_TOP], 1u);
            const unsigned tg = og / nx;
            if (og + 1u == (tg + 1u) * nx) xb_add(&bar[XB_TOPGEN], 1u);
            else XB_SPIN(xb_ld(&bar[XB_TOPGEN]) == tg, bar);
            __builtin_amdgcn_fence(__ATOMIC_ACQUIRE, "agent");
            xb_add(&bar[XB_XGEN(b.x)], 1u);
            asm volatile("s_waitcnt vmcnt(0)" ::: "memory");
        } else {
            XB_SPIN(xb_ld(&bar[XB_XGEN(b.x)]) == gen, bar);
            __builtin_amdgcn_fence(__ATOMIC_ACQUIRE, "agent");
            asm volatile("s_waitcnt vmcnt(0)" ::: "memory");
        }
    }
    __syncthreads();
}

#define DI __device__ __forceinline__
typedef unsigned short bf16_t;
typedef short bf16x8 __attribute__((ext_vector_type(8)));
typedef short s16x4 __attribute__((ext_vector_type(4)));
typedef float f32x4 __attribute__((ext_vector_type(4)));
typedef float f32x16 __attribute__((ext_vector_type(16)));
typedef unsigned u32x4 __attribute__((ext_vector_type(4)));
typedef unsigned u32x2 __attribute__((ext_vector_type(2)));

#ifndef SKIP_ATTN
#define SKIP_ATTN 0
#endif
#ifndef SKIP_SGU
#define SKIP_SGU 0
#endif
#ifndef SKIP_MOE
#define SKIP_MOE 0
#endif
#ifndef PH_MASK
#define PH_MASK 0x3ff
#endif
#define PH(x) ((PH_MASK >> (x)) & 1)
#ifndef REP_PH
#define REP_PH -1
#endif
#define NREP(x) ((x) == REP_PH ? 2 : 1)
#ifndef NO_P6A
#define NO_P6A 0
#endif
#ifndef NO_P6B
#define NO_P6B 0
#endif
#ifndef ATT_TWICE
#define ATT_TWICE 1
#endif
#ifndef PROBE_PH
#define PROBE_PH -1
#endif
#define DBL(x) ((x) == PROBE_PH ? 2 : 1)
#ifndef MOE_FP8
#define MOE_FP8 1
#endif
#ifndef ATTN_BRANCHES
#define ATTN_BRANCHES 7
#endif

constexpr int NB = 4, SEQ = 8192, MTOK = NB * SEQ, DM = 1024;
constexpr int DIN = 4376, NPROJ = 4608;
constexpr int NEXP = 32, DFF = 1024;
constexpr int MPAD = 131072 + 32 * 256;
constexpr float LOG2E = 1.4426950408889634f;
constexpr float QSCALE = 0.125f * LOG2E;
constexpr float NEGBIG = -1e30f;
constexpr float SC_W8 = 64.f, SC_A8 = 8.f, SC_ACT8 = 4.f;

constexpr size_t MiB = 1u << 20;
constexpr size_t WS_CTL = 0;
constexpr size_t CTL_CNT = 0;
constexpr size_t CTL_TE = 64 * 1024;
constexpr size_t CTL_NT = 96 * 1024;
constexpr size_t CTL_C1 = 128 * 1024;
constexpr size_t CTL_BAR = 256 * 1024;
constexpr size_t WS_WIN = 1 * MiB, WS_WAB = 10 * MiB, WS_WOUT = 12 * MiB, WS_W1K = 14 * MiB, WS_W1V = 14 * MiB + 512 * 1024;
constexpr size_t WS_W2K = 15 * MiB, WS_W2V = 15 * MiB + 64 * 1024, WS_WTRIL = 15 * MiB + 512 * 1024;
constexpr size_t WS_WGU = 16 * MiB, WS_WD = 144 * MiB, WS_X2 = 208 * MiB;
constexpr size_t WS_H1 = 336 * MiB, WS_Q = 400 * MiB, WS_KV = 432 * MiB, WS_U = 480 * MiB, WS_V = 512 * MiB, WS_MG = 544 * MiB;
constexpr size_t WS_NG = 672 * MiB, WS_KCMP = 676 * MiB, WS_VCMP = 676 * MiB + 512 * 1024, WS_YAB = 678 * MiB, WS_MERGED = 742 * MiB;
constexpr size_t WS_VT = 806 * MiB;
constexpr size_t WS_AS = 336 * MiB, WS_Y = 336 * MiB, WS_ACT = 608 * MiB, WS_H2 = 608 * MiB;
constexpr size_t WS_TOKE = 880 * MiB, WS_TOKW = 881 * MiB, WS_SLOT = 882 * MiB, WS_WSLOT = 883 * MiB;
constexpr size_t WS_RINV = 884 * MiB;
constexpr size_t WS_WRT = 885 * MiB;
constexpr size_t WS_END = 886 * MiB;

constexpr int LDS_BYTES = 147456;
constexpr int NWAVES = 8, NTHREADS = 512;

struct Args { const float* in[26]; float* out; unsigned char* ws; };

DI float bf2f(unsigned b) { return __uint_as_float(b << 16); }
DI unsigned pk2(float lo, float hi) {
    typedef float f2_t __attribute__((ext_vector_type(2))); typedef __bf16 b2_t __attribute__((ext_vector_type(2)));
    f2_t v = {lo, hi}; b2_t b = __builtin_convertvector(v, b2_t); return __builtin_bit_cast(unsigned, b);
}
DI unsigned pk4_fp8(float a, float b, float c, float d) { int w = 0; w = __builtin_amdgcn_cvt_pk_fp8_f32(a, b, w, false); w = __builtin_amdgcn_cvt_pk_fp8_f32(c, d, w, true); return (unsigned)w; }
DI unsigned short f2bf(float x) { return (unsigned short)(pk2(x, 0.f) & 0xffffu); }
DI float ex2(float x) { return __builtin_amdgcn_exp2f(x); }
DI float rcpf_(float x) { return __builtin_amdgcn_rcpf(x); }
DI float sigm(float x) { return rcpf_(1.f + ex2(-LOG2E * x)); }
DI float gelu_t(float x) { const float u = 0.7978845608028654f * (x + 0.044715f * x * x * x); return x * rcpf_(1.f + ex2(-2.f * LOG2E * u)); }
DI float wave_sum(float v) {
#pragma unroll
    for (int o = 1; o < 64; o <<= 1) v += __shfl_xor(v, o);
    return v;
}
DI float wave_max(float v) {
#pragma unroll
    for (int o = 1; o < 64; o <<= 1) v = fmaxf(v, __shfl_xor(v, o));
    return v;
}
DI int crow(int i, int h) { return (i & 3) + 8 * (i >> 2) + 4 * h; }
#define MFMA32(a, b, c) __builtin_amdgcn_mfma_f32_32x32x16_bf16((a), (b), (c), 0, 0, 0)
DI LAS unsigned char* lds_raw_las(unsigned char* p) { return (LAS unsigned char*)p; }
DI void lds_wait() { asm volatile("s_waitcnt lgkmcnt(0)" ::: "memory"); }

struct TItem { const float* W; bf16_t* WT; const float* ks; int K, N, k0, n0, map, f8; };
DI int map_row(int map, int n) {
    if (map == 0) return n;
    if (map == 1) return n + 1024;
    if (map == 2) return n < 1280 ? n : (n < 1304 ? n + 3072 : n - 24);
    return n < 1024 ? ((n >> 7) * 256 + (n & 127)) : ((((n - 1024) >> 7) * 256) + 128 + (n & 127));
}
DI void titem_decode(const Args& a, int it, TItem& t) {
    unsigned char* ws = a.ws;
    constexpr int I_WIN = 16 * 137, I_WA = 8 * 32, I_WO = 16 * 32, I_W1 = 32 * 4, I_W2 = 2 * 2, I_GU1 = 16 * 64, I_GU = 32 * I_GU1, I_D1 = 16 * 32, I_D = 32 * I_D1;
    int r = it; t.ks = nullptr; t.map = 0; t.f8 = 0;
    if (r < I_GU) { const int e = r / I_GU1; r -= e * I_GU1; t.W = a.in[21] + (size_t)e * 1024 * 2048; t.WT = (bf16_t*)(ws + WS_WGU + (size_t)e * 2048 * 1024 * (MOE_FP8 ? 1 : 2)); t.K = 1024; t.N = 2048; t.map = 3; t.f8 = MOE_FP8; }
    else if ((r -= I_GU) < I_D) { const int e = r / I_D1; r -= e * I_D1; t.W = a.in[23] + (size_t)e * 1024 * 1024; t.WT = (bf16_t*)(ws + WS_WD + (size_t)e * 1024 * 1024 * (MOE_FP8 ? 1 : 2)); t.K = 1024; t.N = 1024; t.f8 = MOE_FP8; }
    else if ((r -= I_D) < I_WIN) { t.W = a.in[2]; t.WT = (bf16_t*)(ws + WS_WIN); t.K = 1024; t.N = DIN; t.map = 2; t.ks = a.in[1]; }
    else if ((r -= I_WIN) < I_WA) { t.W = a.in[15]; t.WT = (bf16_t*)(ws + WS_WAB); t.K = 512; t.N = 1024; }
    else if ((r -= I_WA) < I_WA) { t.W = a.in[16]; t.WT = (bf16_t*)(ws + WS_WAB); t.K = 512; t.N = 1024; t.map = 1; }
    else if ((r -= I_WA) < I_WO) { t.W = a.in[17]; t.WT = (bf16_t*)(ws + WS_WOUT); t.K = 1024; t.N = 1024; }
    else if ((r -= I_WO) < I_W1) { t.W = a.in[3]; t.WT = (bf16_t*)(ws + WS_W1K); t.K = 2048; t.N = 128; }
    else if ((r -= I_W1) < I_W1) { t.W = a.in[7]; t.WT = (bf16_t*)(ws + WS_W1V); t.K = 2048; t.N = 128; }
    else if ((r -= I_W1) < I_W2) { t.W = a.in[5]; t.WT = (bf16_t*)(ws + WS_W2K); t.K = 128; t.N = 64; }
    else { r -= I_W2; t.W = a.in[9]; t.WT = (bf16_t*)(ws + WS_W2V); t.K = 128; t.N = 64; }
    const int nblk = (t.N + 31) >> 5, kb = r / nblk, nb = r - kb * nblk; t.k0 = 64 * kb; t.n0 = 32 * nb;
}
DI void titem_load(const TItem& t, int lane, float (&v)[32]) {
    const int ncol = t.n0 + (lane & 31); const bool ok = ncol < t.N;
    const float* p = t.W + (size_t)(t.k0 + (lane >> 5)) * t.N + (ok ? ncol : 0);
#pragma unroll
    for (int i = 0; i < 32; ++i) v[i] = p[(size_t)(2 * i) * t.N];
    if (!ok) {
#pragma unroll
        for (int i = 0; i < 32; ++i) v[i] = 0.f;
    }
}
DI void titem_process(const TItem& t, int lane, float (&v)[32], LAS float* scr) {
    if (t.ks) {
#pragma unroll
        for (int i = 0; i < 32; ++i) v[i] *= t.ks[t.k0 + 2 * i + (lane >> 5)];
    }
#pragma unroll
    for (int i = 0; i < 32; ++i) scr[(2 * i + (lane >> 5)) * 33 + (lane & 31)] = v[i];
    lds_wait();
    const int c = lane & 7;
#pragma unroll
    for (int j = 0; j < 4; ++j) {
        const int nl = (lane >> 3) + 8 * j, n = t.n0 + nl;
        const LAS float* s = scr + (8 * c) * 33 + nl;
        if (t.f8) {
            u32x2 o; o.x = pk4_fp8(s[0 * 33] * SC_W8, s[1 * 33] * SC_W8, s[2 * 33] * SC_W8, s[3 * 33] * SC_W8); o.y = pk4_fp8(s[4 * 33] * SC_W8, s[5 * 33] * SC_W8, s[6 * 33] * SC_W8, s[7 * 33] * SC_W8);
            if (n < t.N) *(u32x2*)((unsigned char*)t.WT + (size_t)map_row(t.map, n) * t.K + t.k0 + 8 * c) = o;
        } else {
            u32x4 o; o.x = pk2(s[0 * 33], s[1 * 33]); o.y = pk2(s[2 * 33], s[3 * 33]); o.z = pk2(s[4 * 33], s[5 * 33]); o.w = pk2(s[6 * 33], s[7 * 33]);
            if (n < t.N) *(u32x4*)(t.WT + (size_t)map_row(t.map, n) * t.K + t.k0 + 8 * c) = o;
        }
    }
    lds_wait();
}

DI void p0_prep(const Args& a, LAS unsigned char* lds, int gw, int NGW, int wave, int lane) {
    asm volatile("" : "+v"(lane));
    unsigned char* ws = a.ws;
    LAS float* scr = (LAS float*)(lds + wave * 8704);
    {
        constexpr int NIT = 16 * 137 + 2 * 8 * 32 + 16 * 32 + 2 * 32 * 4 + 2 * 2 * 2 + 32 * 16 * 64 + 32 * 16 * 32;
        TItem ta, tb; float va[32], vb[32];
        constexpr int NITX = NIT * DBL(0);
        int it = gw;
        if (it < NITX) { titem_decode(a, it % NIT, ta); titem_load(ta, lane, va); }
        while (it < NITX) {
            int nx = it + NGW;
            if (nx < NITX) { titem_decode(a, nx % NIT, tb); titem_load(tb, lane, vb); }
            titem_process(ta, lane, va, scr);
            it = nx; if (it >= NITX) break;
            nx = it + NGW;
            if (nx < NITX) { titem_decode(a, nx % NIT, ta); titem_load(ta, lane, va); }
            titem_process(tb, lane, vb, scr);
            it = nx;
        }
    }
    {
        const float* x = a.in[0]; bf16_t* H1 = (bf16_t*)(ws + WS_H1);
        for (int m0 = 2 * gw; m0 < MTOK * DBL(0); m0 += 2 * NGW) {
            const int m = m0 % MTOK;
            const f32x4* xr = (const f32x4*)(x + (size_t)m * DM) + lane;
            f32x4 v[8]; float s0 = 0.f, s1 = 0.f;
#pragma unroll
            for (int j = 0; j < 8; ++j) v[j] = xr[64 * j];
#pragma unroll
            for (int j = 0; j < 4; ++j) { s0 += (v[j].x * v[j].x + v[j].y * v[j].y) + (v[j].z * v[j].z + v[j].w * v[j].w); s1 += (v[4 + j].x * v[4 + j].x + v[4 + j].y * v[4 + j].y) + (v[4 + j].z * v[4 + j].z + v[4 + j].w * v[4 + j].w); }
            const float r0 = 1.0f / sqrtf(wave_sum(s0) * (1.f / DM) + 1e-5f), r1 = 1.0f / sqrtf(wave_sum(s1) * (1.f / DM) + 1e-5f);
            u32x2* o = (u32x2*)(H1 + (size_t)m * DM) + lane;
#pragma unroll
            for (int j = 0; j < 8; ++j) { const float rr = j < 4 ? r0 : r1; u32x2 w; w.x = pk2(v[j].x * rr, v[j].y * rr); w.y = pk2(v[j].z * rr, v[j].w * rr); o[64 * j] = w; }
        }
    }
    {
        float* C1 = (float*)(ws + WS_CTL + CTL_C1);
        for (int o = gw; o < 256; o += NGW) {
            const int ty = o >> 7, f = o & 127; const float* pe = a.in[ty ? 10 : 6]; const float* w1 = a.in[ty ? 7 : 3]; const float* b1 = a.in[ty ? 8 : 4];
            float s = 0.f;
            for (int k = lane; k < 2048; k += 64) s += pe[k] * w1[(size_t)k * 128 + f];
            s = wave_sum(s);
            if (lane == 0) C1[o] = s + b1[f];
        }
    }
    {
        const float* wr = a.in[19]; const float* gm = a.in[18]; bf16_t* WRT = (bf16_t*)(ws + WS_WRT);
        for (int i = gw * 64 + lane; i < 32 * 1024; i += NGW * 64) { const int e = i >> 10, k = i & 1023; const float w = wr[k * 32 + e] * gm[k];
            const unsigned short hi = f2bf(w); WRT[i] = hi; WRT[32 * 1024 + i] = f2bf(w - bf2f(hi)); }
    }
    {
        const float* wsp = a.in[13]; bf16_t* WT = (bf16_t*)(ws + WS_WTRIL);
        for (int i = gw * 64 + lane; i < 8 * 128 * 128; i += NGW * 64) { const int t = (i >> 7) & 127, s = i & 127; WT[i] = f2bf(s <= t ? wsp[i] : 0.f); }
    }
}

typedef pg8::f32x4 pf4;
template <class S> struct Twice {
    S s; int n, rep;
    DI void init() { pg8::Unit u; n = 0; while (s.next(n, u)) ++n; }
    DI bool next(int i, pg8::Unit& u) const { return i < rep * n && s.next(i >= n ? i - n : i, u); }
    DI void a_ready(const pg8::Unit&) const {}
    DI void done(const pg8::Unit&) const {}
};
struct Epi1 {
    static constexpr bool PERM = true, AFTER_DRAIN = false;
    bf16_t *Q, *KV, *U, *V, *MG; float* NG;
    DI void operator()(const pf4 (&acc)[2][2][4][2], const pg8::Unit& u, int wr, int wc, int fr, int fq) const {
        const int row0 = u.pm * 256 + wr * 64 + fr, pn = u.pn, c0 = wc * 32 + 8 * fq;
        if (pn == 17) {
            if (wc == 0 && fq < 3) {
#pragma unroll
                for (int ai = 0; ai < 2; ++ai)
#pragma unroll
                    for (int m = 0; m < 4; ++m) { float* p = NG + (size_t)(row0 + ai * 128 + m * 16) * 24 + c0; const pf4 v0 = acc[ai][0][m][0], v1 = acc[ai][0][m][1];
                        *(f32x4*)p = (f32x4){sigm(v0[0]), sigm(v0[1]), sigm(v0[2]), sigm(v0[3])}; *(f32x4*)(p + 4) = (f32x4){sigm(v1[0]), sigm(v1[1]), sigm(v1[2]), sigm(v1[3])}; }
            }
            return;
        }
        bf16_t* base; int ldc, ct, mode;
        float sc = 1.f;
        if (pn < 2) { base = Q; ldc = 512; ct = pn; mode = 0; sc = QSCALE; }
        else if (pn < 5) { base = KV; ldc = 768; ct = pn - 2; mode = 0; }
        else if (pn < 7) { base = U; ldc = 512; ct = pn - 5; mode = 1; }
        else if (pn < 9) { base = V; ldc = 512; ct = pn - 7; mode = 1; }
        else { base = MG; ldc = 2048; ct = pn - 9; mode = 2; }
#pragma unroll
        for (int ai = 0; ai < 2; ++ai)
#pragma unroll
            for (int m = 0; m < 4; ++m) {
                bf16_t* rowp = base + (size_t)(row0 + ai * 128 + m * 16) * ldc + ct * 256 + c0;
#pragma unroll
                for (int bj = 0; bj < 2; ++bj) {
                    pf4 v0 = acc[ai][bj][m][0], v1 = acc[ai][bj][m][1];
                    if (mode == 0) { v0 = v0 * sc; v1 = v1 * sc; }
                    else if (mode == 1) { v0 = (pf4){gelu_t(v0[0]), gelu_t(v0[1]), gelu_t(v0[2]), gelu_t(v0[3])}; v1 = (pf4){gelu_t(v1[0]), gelu_t(v1[1]), gelu_t(v1[2]), gelu_t(v1[3])}; }
                    else { v0 = (pf4){sigm(v0[0]), sigm(v0[1]), sigm(v0[2]), sigm(v0[3])}; v1 = (pf4){sigm(v1[0]), sigm(v1[1]), sigm(v1[2]), sigm(v1[3])}; }
                    u32x4 w; w.x = pk2(v0[0], v0[1]); w.y = pk2(v0[2], v0[3]); w.z = pk2(v1[0], v1[1]); w.w = pk2(v1[2], v1[3]);
                    *(u32x4*)(rowp + bj * 128) = w;
                }
            }
    }
};
struct PairOrder {
    int G, c;
    DI bool next(int i, pg8::Unit& u) const {
        const int L = (i >> 1) * G + c; if (L >= 512) return false;
        const int br = i & 1; u.pm = br * 128 + (L >> 2); u.pn = br * 4 + (L & 3); return true;
    }
    DI void a_ready(const pg8::Unit&) const {}
    DI void done(const pg8::Unit&) const {}
};
struct Epi4 {
    static constexpr bool PERM = true, AFTER_DRAIN = false;
    const bf16_t* MG; bf16_t* OUT;
    DI void operator()(const pf4 (&acc)[2][2][4][2], const pg8::Unit& u, int wr, int wc, int fr, int fq) const {
        const int br = u.pn >> 2, pn = u.pn & 3, pm = u.pm & 127;
        const int row0 = pm * 256 + wr * 64 + fr, c0 = pn * 256 + wc * 32 + 8 * fq;
#pragma unroll
        for (int ai = 0; ai < 2; ++ai)
#pragma unroll
            for (int m = 0; m < 4; ++m) {
                const size_t row = (size_t)(row0 + ai * 128 + m * 16);
#pragma unroll
                for (int bj = 0; bj < 2; ++bj) {
                    const int col = c0 + bj * 128;
                    const u32x4 gw = *(const u32x4*)(MG + row * 2048 + br * 1024 + col);
                    const pf4 v0 = acc[ai][bj][m][0], v1 = acc[ai][bj][m][1];
                    float r[8];
                    r[0] = v0[0] * bf2f(gw.x & 0xffffu); r[1] = v0[1] * bf2f(gw.x >> 16); r[2] = v0[2] * bf2f(gw.y & 0xffffu); r[3] = v0[3] * bf2f(gw.y >> 16);
                    r[4] = v1[0] * bf2f(gw.z & 0xffffu); r[5] = v1[1] * bf2f(gw.z >> 16); r[6] = v1[2] * bf2f(gw.w & 0xffffu); r[7] = v1[3] * bf2f(gw.w >> 16);
                    u32x4* op = (u32x4*)(OUT + row * 1024 + col);
                    if (br == 1) { const u32x4 pv = *op;
                        r[0] += bf2f(pv.x & 0xffffu); r[1] += bf2f(pv.x >> 16); r[2] += bf2f(pv.y & 0xffffu); r[3] += bf2f(pv.y >> 16);
                        r[4] += bf2f(pv.z & 0xffffu); r[5] += bf2f(pv.z >> 16); r[6] += bf2f(pv.w & 0xffffu); r[7] += bf2f(pv.w >> 16); }
                    u32x4 w; w.x = pk2(r[0], r[1]); w.y = pk2(r[2], r[3]); w.z = pk2(r[4], r[5]); w.w = pk2(r[6], r[7]);
                    *op = w;
                }
            }
    }
};
struct Epi5 {
    static constexpr bool PERM = false, AFTER_DRAIN = false;
    const float* X; float* X2;
    DI void operator()(const pf4 (&acc)[2][2][4][2], const pg8::Unit& u, int wr, int wc, int fr, int fq) const {
        const int row0 = u.pm * 256 + wr * 64 + fr, c0 = u.pn * 256 + wc * 32 + 4 * fq;
#pragma unroll
        for (int ai = 0; ai < 2; ++ai)
#pragma unroll
            for (int m = 0; m < 4; ++m) {
                const size_t off = (size_t)(row0 + ai * 128 + m * 16) * DM + c0;
#pragma unroll
                for (int bj = 0; bj < 2; ++bj)
#pragma unroll
                    for (int n = 0; n < 2; ++n) { const f32x4 xv = *(const f32x4*)(X + off + bj * 128 + n * 16); const pf4 v = acc[ai][bj][m][n];
                        *(f32x4*)(X2 + off + bj * 128 + n * 16) = (f32x4){xv[0] + v[0], xv[1] + v[1], xv[2] + v[2], xv[3] + v[3]}; }
            }
    }
};
struct MoeOrder {
    const int* TE; int NT, npn, G, c;
    DI bool next(int i, pg8::Unit& u) const {
        int mt, pn;
        if ((G & 7) == 0) { const int x = c & 7, jj = i * (G >> 3) + (c >> 3); mt = x + 8 * (jj / npn); pn = jj % npn; }
        else { const int L = i * G + c; mt = L / npn; pn = L % npn; }
        if (mt >= NT) return false;
        const int e = __builtin_amdgcn_readfirstlane(TE[mt]);
        u.pm = mt; u.pn = e * npn + pn; return true;
    }
    DI void a_ready(const pg8::Unit&) const {}
    DI void done(const pg8::Unit&) const {}
};
struct Epi7 {
    static constexpr bool PERM = true, AFTER_DRAIN = false;
    const float* BGU; bf16_t* ACT;
    DI void operator()(const pf4 (&acc)[2][2][4][2], const pg8::Unit& u, int wr, int wc, int fr, int fq) const {
        const int e = u.pn >> 3, pn = u.pn & 7, row0 = u.pm * 256 + wr * 64 + fr, c0 = pn * 128 + wc * 32 + 8 * fq;
        const float* bg = BGU + (size_t)e * 2048 + c0; const float* bu = bg + 1024;
        const f32x4 bg0 = *(const f32x4*)bg, bg1 = *(const f32x4*)(bg + 4), bu0 = *(const f32x4*)bu, bu1 = *(const f32x4*)(bu + 4);
        constexpr float ASC = MOE_FP8 ? 1.0f / (SC_A8 * SC_W8) : 1.0f;
#pragma unroll
        for (int ai = 0; ai < 2; ++ai)
#pragma unroll
            for (int m = 0; m < 4; ++m) {
                float r[8];
#pragma unroll
                for (int n = 0; n < 2; ++n)
#pragma unroll
                    for (int k = 0; k < 4; ++k) {
                        const float gt = fminf(acc[ai][0][m][n][k] * ASC + (n ? bg1[k] : bg0[k]), 7.0f);
                        const float up = fminf(fmaxf(acc[ai][1][m][n][k] * ASC + (n ? bu1[k] : bu0[k]), -7.0f), 7.0f);
                        r[n * 4 + k] = gt * rcpf_(1.f + ex2(-1.702f * LOG2E * gt)) * (up + 1.0f);
                    }
                if (MOE_FP8) { u32x2 w; w.x = pk4_fp8(r[0] * SC_ACT8, r[1] * SC_ACT8, r[2] * SC_ACT8, r[3] * SC_ACT8); w.y = pk4_fp8(r[4] * SC_ACT8, r[5] * SC_ACT8, r[6] * SC_ACT8, r[7] * SC_ACT8);
                    *(u32x2*)((unsigned char*)ACT + (size_t)(row0 + ai * 128 + m * 16) * DFF + c0) = w; }
                else { u32x4 w; w.x = pk2(r[0], r[1]); w.y = pk2(r[2], r[3]); w.z = pk2(r[4], r[5]); w.w = pk2(r[6], r[7]);
                    *(u32x4*)(ACT + (size_t)(row0 + ai * 128 + m * 16) * DFF + c0) = w; }
            }
    }
};
struct Epi8 {
    static constexpr bool PERM = true, AFTER_DRAIN = false;
    const float* BD; const float* WSLOT; bf16_t* Y;
    DI void operator()(const pf4 (&acc)[2][2][4][2], const pg8::Unit& u, int wr, int wc, int fr, int fq) const {
        const int e = u.pn >> 2, pn = u.pn & 3, row0 = u.pm * 256 + wr * 64 + fr, c0 = pn * 256 + wc * 32 + 8 * fq;
        f32x4 bv[2][2];
#pragma unroll
        for (int bj = 0; bj < 2; ++bj)
#pragma unroll
            for (int n = 0; n < 2; ++n) bv[bj][n] = *(const f32x4*)(BD + (size_t)e * DM + c0 + bj * 128 + 4 * n);
#pragma unroll
        for (int ai = 0; ai < 2; ++ai)
#pragma unroll
            for (int m = 0; m < 4; ++m) {
                const size_t row = (size_t)(row0 + ai * 128 + m * 16); const float wt = WSLOT[row];
#pragma unroll
                for (int bj = 0; bj < 2; ++bj) {
                    const pf4 v0 = acc[ai][bj][m][0], v1 = acc[ai][bj][m][1]; const f32x4 b0 = bv[bj][0], b1 = bv[bj][1];
                    constexpr float ASC = MOE_FP8 ? 1.0f / (SC_ACT8 * SC_W8) : 1.0f;
                    u32x4 w; w.x = pk2((v0[0] * ASC + b0[0]) * wt, (v0[1] * ASC + b0[1]) * wt); w.y = pk2((v0[2] * ASC + b0[2]) * wt, (v0[3] * ASC + b0[3]) * wt);
                    w.z = pk2((v1[0] * ASC + b1[0]) * wt, (v1[1] * ASC + b1[1]) * wt); w.w = pk2((v1[2] * ASC + b1[2]) * wt, (v1[3] * ASC + b1[3]) * wt);
                    *(u32x4*)(Y + row * DM + c0 + bj * 128) = w;
                }
            }
    }
};

DI void p2_compress_item(const Args& a, LAS unsigned char* lds, int item, int tid, int wave, int lane) {
    asm volatile("" : "+v"(tid), "+v"(lane));
    unsigned char* ws = a.ws;
    const int nt = item & 15, ty = (item >> 4) & 1, g = (item >> 5) & 1, b = item >> 6;
    const bf16_t* KV = (const bf16_t*)(ws + WS_KV);
    const bf16_t* W1 = (const bf16_t*)(ws + (ty ? WS_W1V : WS_W1K));
    const bf16_t* W2 = (const bf16_t*)(ws + (ty ? WS_W2V : WS_W2K));
    const float* C1 = (const float*)(ws + WS_CTL + CTL_C1) + ty * 128;
    bf16_t* OUT = (bf16_t*)(ws + (ty ? WS_VCMP : WS_KCMP)) + (size_t)((b * 2 + g) * 512 + nt * 32) * 64;
    LAS unsigned char* Xs = lds;
    LAS float* Hs = (LAS float*)(lds + 76032);
    LAS unsigned char* Hb = lds + 76032 + 32768;
    const int r = lane & 31, h = lane >> 5;
    const int p0 = 512 * nt, colsrc = ty * 128 + g * 64;
    for (int i = tid; i < 528 * 8; i += NTHREADS) {
        const int pr = i >> 3, ch = i & 7; int pos = p0 + pr; pos = pos > SEQ - 1 ? SEQ - 1 : pos;
        const u32x4 v = *(const u32x4*)(KV + (size_t)(b * SEQ + pos) * 768 + colsrc + ch * 8);
        *(LAS u32x4*)(Xs + pr * 144 + ch * 16) = v;
    }
    __syncthreads();
    {
        const int ft = wave & 3, kh = wave >> 2;
        f32x16 acc; for (int i = 0; i < 16; ++i) acc[i] = 0.f;
        const bf16_t* wrow = W1 + (size_t)(ft * 32 + r) * 2048 + 8 * h;
#pragma unroll 4
        for (int s = kh * 64; s < kh * 64 + 64; ++s) {
            const int l = s >> 2, d0 = (s & 3) * 16;
            const bf16x8 af = *(const LAS bf16x8*)(Xs + (16 * r + l) * 144 + (d0 + 8 * h) * 2);
            const bf16x8 bfr = *(const bf16x8*)(wrow + 16 * s);
            acc = MFMA32(af, bfr, acc);
        }
#pragma unroll
        for (int i = 0; i < 16; ++i) Hs[(kh * 32 + crow(i, h)) * 128 + ft * 32 + r] = acc[i];
    }
    __syncthreads();
    for (int i = tid; i < 32 * 128; i += NTHREADS) {
        const int n = i >> 7, f = i & 127;
        const float v = Hs[n * 128 + f] + Hs[(32 + n) * 128 + f] + C1[f];
        *(LAS unsigned short*)(Hb + n * 272 + f * 2) = f2bf(gelu_t(v));
    }
    __syncthreads();
    if (wave < 2) {
        f32x16 acc; for (int i = 0; i < 16; ++i) acc[i] = 0.f;
        const bf16_t* wrow = W2 + (size_t)(wave * 32 + r) * 128 + 8 * h;
#pragma unroll
        for (int s = 0; s < 8; ++s) {
            const bf16x8 af = *(const LAS bf16x8*)(Hb + r * 272 + (16 * s + 8 * h) * 2);
            const bf16x8 bfr = *(const bf16x8*)(wrow + 16 * s);
            acc = MFMA32(af, bfr, acc);
        }
        if (ty == 0) {
#pragma unroll
            for (int i = 0; i < 16; ++i) OUT[(size_t)crow(i, h) * 64 + wave * 32 + r] = f2bf(acc[i]);
        } else {
            bf16_t* OT = (bf16_t*)(ws + WS_VCMP) + (size_t)(b * 2 + g) * 64 * 512 + (size_t)(wave * 32 + r) * 512 + nt * 32;
#pragma unroll
            for (int i = 0; i < 16; ++i) OT[crow(i, h)] = f2bf(acc[i]);
        }
    }
    __syncthreads();
}

DI void p2_sgu_item(const Args& a, LAS unsigned char* lds, int item, int tid, int wave, int lane) {
    asm volatile("" : "+v"(tid), "+v"(lane));
    unsigned char* ws = a.ws;
    const bf16_t* U = (const bf16_t*)(ws + WS_U); const bf16_t* V = (const bf16_t*)(ws + WS_V);
    const bf16_t* WT = (const bf16_t*)(ws + WS_WTRIL);
    bf16_t* YB = (bf16_t*)(ws + WS_YAB) + (size_t)MTOK * 512;
    const float* lng = a.in[11]; const float* lnb = a.in[12]; const float* bs = a.in[14];
    const size_t row0 = (size_t)item * 128;
    LAS unsigned char* VnT = lds;
    const int r = lane & 31, h = lane >> 5;
    {
        float gg[8], bb[8];
#pragma unroll
        for (int e = 0; e < 8; ++e) { gg[e] = lng[8 * lane + e]; bb[e] = lnb[8 * lane + e]; }
        for (int pp = 0; pp < 16; ++pp) {
            const int pos = wave * 16 + pp;
            const u32x4 raw = *(const u32x4*)(V + (row0 + pos) * 512 + 8 * lane);
            float x[8]; x[0] = bf2f(raw.x & 0xffffu); x[1] = bf2f(raw.x >> 16); x[2] = bf2f(raw.y & 0xffffu); x[3] = bf2f(raw.y >> 16);
            x[4] = bf2f(raw.z & 0xffffu); x[5] = bf2f(raw.z >> 16); x[6] = bf2f(raw.w & 0xffffu); x[7] = bf2f(raw.w >> 16);
            float s = 0.f;
#pragma unroll
            for (int e = 0; e < 8; ++e) s += x[e];
            const float mu = wave_sum(s) * (1.f / 512.f); float q = 0.f;
#pragma unroll
            for (int e = 0; e < 8; ++e) { x[e] -= mu; q += x[e] * x[e]; }
            const float rstd = 1.0f / sqrtf(wave_sum(q) * (1.f / 512.f) + 1e-5f);
#pragma unroll
            for (int e = 0; e < 8; ++e) *(LAS unsigned short*)(VnT + (8 * lane + e) * 272 + pos * 2) = f2bf(x[e] * rstd * gg[e] + bb[e]);
        }
    }
    __syncthreads();
    {
        const int grp = wave;
        for (int tt = 0; tt < 4; ++tt) {
            f32x16 acc[2];
#pragma unroll
            for (int i = 0; i < 16; ++i) { acc[0][i] = 0.f; acc[1][i] = 0.f; }
            const bf16_t* wrow = WT + (size_t)(grp * 128 + tt * 32 + r) * 128 + 8 * h;
            const int nst = 2 * tt + 2;
            for (int s = 0; s < nst; ++s) {
                const bf16x8 bfr = *(const bf16x8*)(wrow + 16 * s);
#pragma unroll
                for (int dt = 0; dt < 2; ++dt) {
                    const bf16x8 af = *(const LAS bf16x8*)(VnT + (grp * 64 + dt * 32 + r) * 272 + (16 * s + 8 * h) * 2);
                    acc[dt] = MFMA32(af, bfr, acc[dt]);
                }
            }
            const int t = tt * 32 + r; const float bt = bs[grp * 128 + t];
            const size_t rowt = row0 + t;
#pragma unroll
            for (int dt = 0; dt < 2; ++dt)
#pragma unroll
                for (int q4 = 0; q4 < 4; ++q4) {
                    const int d = dt * 32 + 8 * q4 + 4 * h;
                    const u32x2 uu = *(const u32x2*)(U + rowt * 512 + grp * 64 + d);
                    const float y0 = bf2f(uu.x & 0xffffu) * (acc[dt][4 * q4 + 0] + bt), y1 = bf2f(uu.x >> 16) * (acc[dt][4 * q4 + 1] + bt);
                    const float y2 = bf2f(uu.y & 0xffffu) * (acc[dt][4 * q4 + 2] + bt), y3 = bf2f(uu.y >> 16) * (acc[dt][4 * q4 + 3] + bt);
                    u32x2 w; w.x = pk2(y0, y1); w.y = pk2(y2, y3);
                    *(u32x2*)(YB + rowt * 512 + grp * 64 + d) = w;
                }
        }
    }
    __syncthreads();
    {
        const bf16_t* KV = (const bf16_t*)(ws + WS_KV); bf16_t* VT = (bf16_t*)(ws + WS_VT);
        LAS unsigned char* T = lds;
        const int bb = item >> 6, posc = (item & 63) * 128;
        for (int i = tid; i < 128 * 32; i += NTHREADS) {
            const int pos = i & 127, ch = i >> 7;
            const int ty = ch >> 4, c8 = (ch & 15) * 8;
            const u32x4 v = *(const u32x4*)(KV + (row0 + pos) * 768 + (ty ? 5 : 3) * 128 + c8);
            LAS unsigned char* tp = T + (ty * 128 + c8) * 272 + pos * 2;
            *(LAS unsigned short*)(tp + 0 * 272) = (unsigned short)(v.x & 0xffffu); *(LAS unsigned short*)(tp + 1 * 272) = (unsigned short)(v.x >> 16);
            *(LAS unsigned short*)(tp + 2 * 272) = (unsigned short)(v.y & 0xffffu); *(LAS unsigned short*)(tp + 3 * 272) = (unsigned short)(v.y >> 16);
            *(LAS unsigned short*)(tp + 4 * 272) = (unsigned short)(v.z & 0xffffu); *(LAS unsigned short*)(tp + 5 * 272) = (unsigned short)(v.z >> 16);
            *(LAS unsigned short*)(tp + 6 * 272) = (unsigned short)(v.w & 0xffffu); *(LAS unsigned short*)(tp + 7 * 272) = (unsigned short)(v.w >> 16);
        }
        __syncthreads();
        for (int i = tid; i < 256 * 16; i += NTHREADS) {
            const int rw = i >> 4, ch = i & 15, ty = rw >> 7, gd = rw & 127;
            const u32x4 v = *(const LAS u32x4*)(T + rw * 272 + ch * 16);
            *(u32x4*)(VT + ((size_t)(ty * 4 + bb) * 128 + gd) * SEQ + posc + ch * 8) = v;
        }
        __syncthreads();
    }
}

constexpr int AL_K0 = 0, AL_K1 = 9216, AL_V0 = 18432, AL_V1 = 27136, AL_PB = 35840, AL_IMP = 102400, AL_SELM = 135424, AL_UNI = 136448, AL_BL = 136512, AL_NBL = 137024, AL_THR = 137088;
static_assert(AL_THR + 256 <= LDS_BYTES, "attention LDS map");
struct KVSrc { const bf16_t* k; const bf16_t* v; int kp, vp; };
struct BlkPar { float base, ksl; int lo, hi; };

template <int MODE>
DI void attn_block(const LAS unsigned char* Ks, const LAS unsigned char* Vs, const bf16x8 (&qf)[4], f32x16 (&o)[2], float& m, float& l, float invl, LAS float* pbrow, const BlkPar bp, const bool MASK, const bool first, int r, int h) {
    f32x16 p0, p1;
    {
        const float bh = bp.base + bp.ksl * (float)(4 * h) - m, bh1 = bh + 32.f * bp.ksl;
#pragma unroll
        for (int i = 0; i < 16; ++i) { const float kc = (float)((i & 3) + 8 * (i >> 2)); p0[i] = bp.ksl * kc + bh; p1[i] = bp.ksl * kc + bh1; }
    }
    {
        bf16x8 kf[8];
#pragma unroll
        for (int s = 0; s < 4; ++s) { kf[2 * s] = *(const LAS bf16x8*)(Ks + r * 144 + s * 32 + h * 16); kf[2 * s + 1] = *(const LAS bf16x8*)(Ks + (32 + r) * 144 + s * 32 + h * 16); }
        __builtin_amdgcn_sched_barrier(0);
#pragma unroll
        for (int s = 0; s < 4; ++s) { p0 = MFMA32(kf[2 * s], qf[s], p0); p1 = MFMA32(kf[2 * s + 1], qf[s], p1); }
    }
    s16x4 vlo[8], vhi[8];
    if (MODE != 1) {
#pragma unroll
        for (int dh = 0; dh < 2; ++dh)
#pragma unroll
            for (int ks = 0; ks < 4; ++ks) { const LAS unsigned char* vp = Vs + (dh * 32 + r) * 136 + ks * 32 + h * 8; vlo[dh * 4 + ks] = *(const LAS s16x4*)vp; vhi[dh * 4 + ks] = *(const LAS s16x4*)(vp + 16); }
        __builtin_amdgcn_sched_barrier(0);
    }
    if (MASK) {
        const int lo = bp.lo - 4 * h, hi = bp.hi - 4 * h;
#pragma unroll
        for (int i = 0; i < 16; ++i) { const int kc = (i & 3) + 8 * (i >> 2); p0[i] = (kc >= lo && kc <= hi) ? p0[i] : NEGBIG; p1[i] = (kc + 32 >= lo && kc + 32 <= hi) ? p1[i] : NEGBIG; }
    }
    if (MODE == 0 || MODE == 1) {
        float mx = fmaxf(p0[0], p1[0]);
#pragma unroll
        for (int i = 1; i < 16; ++i) mx = fmaxf(fmaxf(mx, p0[i]), p1[i]);
        mx = fmaxf(mx, __shfl_xor(mx, 32));
        if (first) {
            m += mx;
#pragma unroll
            for (int i = 0; i < 16; ++i) { p0[i] -= mx; p1[i] -= mx; }
        } else if (__any(mx > 0.f)) {
            const float dl = fmaxf(mx, 0.f), alpha = ex2(-dl); m += dl; l *= alpha;
#pragma unroll
            for (int i = 0; i < 16; ++i) { p0[i] -= dl; p1[i] -= dl; }
            if (MODE == 0) {
#pragma unroll
                for (int i = 0; i < 16; ++i) { o[0][i] *= alpha; o[1][i] *= alpha; }
            }
        }
        if (!first && __all(mx < -40.f)) return;
        float s0 = 0.f, s1 = 0.f;
#pragma unroll
        for (int i = 0; i < 16; ++i) { p0[i] = ex2(p0[i]); p1[i] = ex2(p1[i]); s0 += p0[i]; s1 += p1[i]; }
        l += s0 + s1;
    } else {
#pragma unroll
        for (int i = 0; i < 16; ++i) {
            p0[i] = p0[i] > -1e29f ? ex2(p0[i]) * invl : 0.f; p1[i] = p1[i] > -1e29f ? ex2(p1[i]) * invl : 0.f;
            pbrow[crow(i, h)] = p0[i]; pbrow[32 + crow(i, h)] = p1[i];
        }
    }
    if (MODE != 1) {
        bf16x8 pf[4];
#pragma unroll
        for (int ks = 0; ks < 2; ++ks) {
            u32x4 w0, w1;
            w0.x = pk2(p0[8 * ks + 0], p0[8 * ks + 1]); w0.y = pk2(p0[8 * ks + 2], p0[8 * ks + 3]); w0.z = pk2(p0[8 * ks + 4], p0[8 * ks + 5]); w0.w = pk2(p0[8 * ks + 6], p0[8 * ks + 7]);
            w1.x = pk2(p1[8 * ks + 0], p1[8 * ks + 1]); w1.y = pk2(p1[8 * ks + 2], p1[8 * ks + 3]); w1.z = pk2(p1[8 * ks + 4], p1[8 * ks + 5]); w1.w = pk2(p1[8 * ks + 6], p1[8 * ks + 7]);
            pf[ks] = __builtin_bit_cast(bf16x8, w0); pf[2 + ks] = __builtin_bit_cast(bf16x8, w1);
        }
#pragma unroll
        for (int ks = 0; ks < 4; ++ks)
#pragma unroll
            for (int dh = 0; dh < 2; ++dh) {
                const bf16x8 af = __builtin_shufflevector(vlo[dh * 4 + ks], vhi[dh * 4 + ks], 0, 1, 2, 3, 4, 5, 6, 7);
                o[dh] = MFMA32(af, pf[ks], o[dh]);
            }
    }
}

DI void kv_load(const KVSrc& s, int tid, u32x4& kreg, u32x4& vreg) {
    const int ko = (tid >> 3) * s.kp + (tid & 7) * 8, vo = (tid >> 3) * s.vp + (tid & 7) * 8;
    kreg = *(const u32x4*)(s.k + ko);
    vreg = *(const u32x4*)(s.v + vo);
}
DI void kv_store(LAS unsigned char* Kb, LAS unsigned char* Vb, int tid, const u32x4& kreg, const u32x4& vreg) {
    *(LAS u32x4*)(Kb + (tid >> 3) * 144 + (tid & 7) * 16) = kreg;
    LAS unsigned char* vp = Vb + (tid >> 3) * 136 + (tid & 7) * 16;
    *(LAS u32x2*)vp = (u32x2){vreg.x, vreg.y}; *(LAS u32x2*)(vp + 8) = (u32x2){vreg.z, vreg.w};
}

template <int MODE, class SrcF, class ParF, class PostF>
DI void attn_run(int nb, SrcF src, ParF par, PostF post, LAS unsigned char* lds, const bf16x8 (&qf)[4], f32x16 (&o)[2], float& m, float& l, float invl, LAS float* pbrow,
                 int tid, int r, int h) {
    u32x4 kreg, vreg;
    kv_load(src(0), tid, kreg, vreg);
    kv_store(lds + AL_K0, lds + AL_V0, tid, kreg, vreg);
    __syncthreads();
    for (int i = 0; i < nb; ++i) {
        const int cur = i & 1;
        if (i + 1 < nb) kv_load(src(i + 1), tid, kreg, vreg);
        bool msk; const BlkPar bp = par(i, msk);
        attn_block<MODE>(lds + (cur ? AL_K1 : AL_K0), lds + (cur ? AL_V1 : AL_V0), qf, o, m, l, invl, pbrow, bp, msk, i == 0, r, h);
        if (MODE == 2) { __syncthreads(); post(i); }
        if (i + 1 < nb) kv_store(lds + (cur ? AL_K0 : AL_K1), lds + (cur ? AL_V0 : AL_V1), tid, kreg, vreg);
        __syncthreads();
    }
}

#define CE_DESC(a, b) do { const unsigned _x = (a), _y = (b); (a) = _x > _y ? _x : _y; (b) = _x > _y ? _y : _x; } while (0)
DI void sort16_desc(unsigned (&k)[16]) {
#pragma unroll
    for (int kk = 2; kk <= 16; kk <<= 1)
#pragma unroll
        for (int j = kk >> 1; j > 0; j >>= 1)
#pragma unroll
            for (int i = 0; i < 16; ++i) { const int p = i ^ j; if (p > i) { if ((i & kk) == 0) CE_DESC(k[i], k[p]); else CE_DESC(k[p], k[i]); } }
}
DI void merge16_desc(unsigned (&k)[16]) {
#pragma unroll
    for (int j = 8; j > 0; j >>= 1)
#pragma unroll
        for (int i = 0; i < 16; ++i) { const int p = i ^ j; if (p > i) CE_DESC(k[i], k[p]); }
}

DI void attn_tile(const Args& a, LAS unsigned char* lds, int b, int g, int c, int tid, int wave, int lane) {
    asm volatile("" : "+v"(tid), "+v"(lane));
    unsigned char* ws = a.ws;
    const bf16_t* Q = (const bf16_t*)(ws + WS_Q); const bf16_t* KV = (const bf16_t*)(ws + WS_KV);
    const bf16_t* KC = (const bf16_t*)(ws + WS_KCMP) + (size_t)(b * 2 + g) * 512 * 64; const bf16_t* VC = (const bf16_t*)(ws + WS_VCMP) + (size_t)(b * 2 + g) * 64 * 512;
    const float* NG = (const float*)(ws + WS_NG); bf16_t* YA = (bf16_t*)(ws + WS_YAB); const bf16_t* VT = (const bf16_t*)(ws + WS_VT);
    const int r = lane & 31, h = lane >> 5, hd = wave >> 1, th = wave & 1, tl = th * 32 + r, t = 64 * c + tl;
    const size_t row = (size_t)b * SEQ + t;
    const float slope2 = ex2(-(float)(g * 4 + hd + 1)) * LOG2E;
    const float tf = (float)t;
    bf16x8 qf[4];
#pragma unroll
    for (int s = 0; s < 4; ++s) qf[s] = *(const bf16x8*)(Q + row * 512 + g * 256 + hd * 64 + 16 * s + 8 * h);
    const float gate_c = NG[row * 24 + g * 12 + hd * 3 + 0], gate_s = NG[row * 24 + g * 12 + hd * 3 + 1], gate_w = NG[row * 24 + g * 12 + hd * 3 + 2];
    float* YF = (float*)(ws + WS_H1) + row * 512 + g * 256 + hd * 64 + 4 * h;
    LAS float* IMP = (LAS float*)(lds + AL_IMP);
    LAS float* PB = (LAS float*)(lds + AL_PB);
    LAS float* pbrow = PB + (hd * 64 + tl) * 65;
    const bf16_t* kvb = KV + (size_t)b * SEQ * 768 + g * 64;
    auto nopost = [](int) {};

    const bf16_t* vtw = VT + ((size_t)(4 + b) * 128 + g * 64) * SEQ;
    const bf16_t* vts = VT + ((size_t)(0 + b) * 128 + g * 64) * SEQ;
    if (ATTN_BRANCHES & 1) {
        const int nb = (c > 8 ? 8 : c) + 1;
        f32x16 o[2];
#pragma unroll
        for (int i = 0; i < 16; ++i) { o[0][i] = 0.f; o[1][i] = 0.f; }
        float m = 0.f, l = 0.f;
        auto src = [=](int i) { const int j = c - i; KVSrc s; s.k = kvb + (size_t)(64 * j) * 768 + 4 * 128; s.v = vtw + 64 * j; s.kp = 768; s.vp = SEQ; return s; };
        auto par = [=](int i, bool& msk) { const int d0 = t - 64 * (c - i); msk = (i == 0) || (i == 8); BlkPar bp; bp.base = -slope2 * (float)d0; bp.ksl = slope2; bp.lo = d0 - 511; bp.hi = d0; return bp; };
        attn_run<0>(nb, src, par, nopost, lds, qf, o, m, l, 0.f, pbrow, tid, r, h);
        const float sc = gate_w * rcpf_(l + __shfl_xor(l, 32));
#pragma unroll
        for (int dh = 0; dh < 2; ++dh)
#pragma unroll
            for (int q4 = 0; q4 < 4; ++q4) *(f32x4*)(YF + dh * 32 + 8 * q4) = (f32x4){sc * o[dh][4 * q4], sc * o[dh][4 * q4 + 1], sc * o[dh][4 * q4 + 2], sc * o[dh][4 * q4 + 3]};
    }
    for (int i = tid; i < 64 * 129; i += NTHREADS) IMP[i] = 0.f;
    if (ATTN_BRANCHES & 2) {
        const int nbc = (4 * c + 3 + 63) >> 6;
        auto src = [=](int i) { KVSrc s; s.k = KC + (size_t)(64 * i) * 64; s.v = VC + 64 * i; s.kp = 64; s.vp = 512; return s; };
        const int nvalid = ((t - 31) >> 4);
        auto par = [=](int i, bool& msk) { const int n0 = 64 * i; msk = (n0 + 63) > ((64 * c - 31) >> 4);
            BlkPar bp; bp.base = -slope2 * (tf - (float)(16 * n0) - 15.5f); bp.ksl = 16.f * slope2; bp.lo = -1000000; bp.hi = nvalid - n0; return bp; };
        f32x16 o[2];
#pragma unroll
        for (int i = 0; i < 16; ++i) { o[0][i] = 0.f; o[1][i] = 0.f; }
        float m = 0.f, l = 0.f;
        attn_run<1>(nbc, src, par, nopost, lds, qf, o, m, l, 0.f, pbrow, tid, r, h);
        const float invl = rcpf_(l + __shfl_xor(l, 32));
        auto post = [=](int i) {
            for (int q = tid; q < 64 * 17; q += NTHREADS) {
                const int tok = q & 63, jj = q >> 6, j = 16 * i + jj;
                float acc = 0.f;
                if (jj < 16) {
#pragma unroll
                    for (int hh = 0; hh < 4; ++hh) { const LAS float* p = PB + (hh * 64 + tok) * 65 + 4 * jj; acc += (p[0] + p[1]) + (p[2] + 0.5f * p[3]); if (jj > 0) acc += 0.5f * p[-1]; }
                } else {
#pragma unroll
                    for (int hh = 0; hh < 4; ++hh) acc += 0.5f * PB[(hh * 64 + tok) * 65 + 63];
                }
                if (j < 128) IMP[tok * 129 + j] += acc;
            }
        };
        attn_run<2>(nbc, src, par, post, lds, qf, o, m, l, invl, pbrow, tid, r, h);
#pragma unroll
        for (int dh = 0; dh < 2; ++dh)
#pragma unroll
            for (int q4 = 0; q4 < 4; ++q4) { f32x4 v = *(f32x4*)(YF + dh * 32 + 8 * q4);
                v[0] += gate_c * o[dh][4 * q4]; v[1] += gate_c * o[dh][4 * q4 + 1]; v[2] += gate_c * o[dh][4 * q4 + 2]; v[3] += gate_c * o[dh][4 * q4 + 3]; *(f32x4*)(YF + dh * 32 + 8 * q4) = v; }
    }
    __syncthreads();
    if (ATTN_BRANCHES & 4) {
        LAS unsigned* L0 = (LAS unsigned*)(lds + AL_PB);
        LAS unsigned* L1 = L0 + 8 * 16 * 64;
        LAS unsigned* L2 = L1 + 4 * 16 * 64;
        LAS unsigned* THR = (LAS unsigned*)(lds + AL_THR);
        LAS unsigned short* SELM = (LAS unsigned short*)(lds + AL_SELM);
        LAS unsigned* UNI = (LAS unsigned*)(lds + AL_UNI);
        LAS int* BL = (LAS int*)(lds + AL_BL);
        LAS int* NBL = (LAS int*)(lds + AL_NBL);
        const int tok = lane, seg = wave;
        unsigned key[16];
#pragma unroll
        for (int i = 0; i < 16; ++i) {
            const int j = 16 * seg + i;
            const bool forced = (j == 0) || (j == c) || (j == c - 1);
            const unsigned kvv = forced ? 0x1FFFFFFu : (j <= c ? (__float_as_uint(IMP[tok * 129 + j]) >> 7) + 1u : 0u);
            key[i] = (kvv << 7) | (unsigned)(127 - j);
        }
        sort16_desc(key);
#pragma unroll
        for (int i = 0; i < 16; ++i) L0[(seg * 16 + i) * 64 + tok] = key[i];
        __syncthreads();
        if (wave < 4) {
            unsigned kk[16];
#pragma unroll
            for (int i = 0; i < 16; ++i) { const unsigned x = L0[((2 * wave) * 16 + i) * 64 + tok], y = L0[((2 * wave + 1) * 16 + 15 - i) * 64 + tok]; kk[i] = x > y ? x : y; }
            merge16_desc(kk);
#pragma unroll
            for (int i = 0; i < 16; ++i) L1[(wave * 16 + i) * 64 + tok] = kk[i];
        }
        __syncthreads();
        if (wave < 2) {
            unsigned kk[16];
#pragma unroll
            for (int i = 0; i < 16; ++i) { const unsigned x = L1[((2 * wave) * 16 + i) * 64 + tok], y = L1[((2 * wave + 1) * 16 + 15 - i) * 64 + tok]; kk[i] = x > y ? x : y; }
            merge16_desc(kk);
#pragma unroll
            for (int i = 0; i < 16; ++i) L2[(wave * 16 + i) * 64 + tok] = kk[i];
        }
        __syncthreads();
        if (wave == 0) {
            unsigned mn = 0xffffffffu;
#pragma unroll
            for (int i = 0; i < 16; ++i) { const unsigned x = L2[i * 64 + tok], y = L2[(16 + 15 - i) * 64 + tok]; const unsigned z = x > y ? x : y; mn = z < mn ? z : mn; }
            THR[tok] = mn;
        }
        __syncthreads();
        {
            const unsigned T = THR[tok]; unsigned m16 = 0;
#pragma unroll
            for (int i = 0; i < 16; ++i) m16 |= (key[i] >= T) ? (1u << (15 - (key[i] & 15u))) : 0u;
            SELM[tok * 8 + seg] = (unsigned short)m16;
            unsigned uni = 0;
#pragma unroll
            for (int bb = 0; bb < 16; ++bb) uni |= (__ballot((m16 >> bb) & 1u) != 0ull) ? (1u << bb) : 0u;
            if (lane == 0) UNI[seg] = uni;
        }
        __syncthreads();
        if (wave == 0) {
            int base = 0;
#pragma unroll
            for (int half = 0; half < 2; ++half) {
                const int j = half * 64 + lane;
                const bool on = ((UNI[j >> 4] >> (j & 15)) & 1u) && (j <= c);
                const unsigned long long bal = __ballot(on);
                const int pos = base + __builtin_popcountll(bal & ((1ull << lane) - 1ull));
                if (on) BL[pos] = j;
                base += __builtin_popcountll(bal);
            }
            if (lane == 0) NBL[0] = base;
        }
        __syncthreads();
        const int nbs = __builtin_amdgcn_readfirstlane(NBL[0]);
        f32x16 o[2];
#pragma unroll
        for (int i = 0; i < 16; ++i) { o[0][i] = 0.f; o[1][i] = 0.f; }
        float m = 0.f, l = 0.f;
        auto src = [=](int i) { const int j = __builtin_amdgcn_readfirstlane(BL[nbs - 1 - i]); KVSrc s; s.k = kvb + (size_t)(64 * j) * 768 + 2 * 128; s.v = vts + 64 * j; s.kp = 768; s.vp = SEQ; return s; };
        auto par = [=](int i, bool& msk) { const int j = __builtin_amdgcn_readfirstlane(BL[nbs - 1 - i]); const bool sel = (SELM[tl * 8 + (j >> 4)] >> (j & 15)) & 1; const int d0 = t - 64 * j;
            msk = (j == c); BlkPar bp; bp.base = sel ? -slope2 * (float)d0 : NEGBIG; bp.ksl = slope2; bp.lo = -1000000; bp.hi = d0; return bp; };
        attn_run<0>(nbs, src, par, nopost, lds, qf, o, m, l, 0.f, pbrow, tid, r, h);
        const float sc = gate_s * rcpf_(l + __shfl_xor(l, 32));
#pragma unroll
        for (int dh = 0; dh < 2; ++dh)
#pragma unroll
            for (int q4 = 0; q4 < 4; ++q4) {
                const int d = dh * 32 + 8 * q4 + 4 * h;
                const f32x4 v = *(const f32x4*)(YF + dh * 32 + 8 * q4);
                u32x2 w; w.x = pk2(v[0] + sc * o[dh][4 * q4 + 0], v[1] + sc * o[dh][4 * q4 + 1]); w.y = pk2(v[2] + sc * o[dh][4 * q4 + 2], v[3] + sc * o[dh][4 * q4 + 3]);
                *(u32x2*)(YA + row * 512 + g * 256 + hd * 64 + d) = w;
            }
    }
    __syncthreads();
}

DI void p6a_route(const Args& a, LAS unsigned char* lds, int tid, int wave, int lane) {
    asm volatile("" : "+v"(tid), "+v"(lane));
    unsigned char* ws = a.ws;
    const float* X2 = (const float*)(ws + WS_X2); const float* br = a.in[20];
    const bf16_t* WH = (const bf16_t*)(ws + WS_WRT); const bf16_t* WL = WH + 32 * 1024;
    int* TOKE = (int*)(ws + WS_TOKE); float* TOKW = (float*)(ws + WS_TOKW); int* CNT = (int*)(ws + WS_CTL + CTL_CNT); float* RINV = (float*)(ws + WS_RINV);
    LAS float* CS = (LAS float*)(lds + wave * 2304);
    LAS int* CNTL = (LAS int*)(lds + 8 * 2304);
    const int tk = lane & 15, kq = lane >> 4;
    for (int blk0 = blockIdx.x; blk0 < 256 * DBL(6); blk0 += gridDim.x) {
        const int blk = blk0 & 255;
        if (tid < 32) CNTL[tid] = 0;
        __syncthreads();
        const int t0 = blk * 128 + wave * 16;
        const float* xp = X2 + (size_t)(t0 + tk) * DM + 8 * kq;
        const bf16_t* wh0 = WH + (size_t)tk * 1024 + 8 * kq; const bf16_t* wl0 = WL + (size_t)tk * 1024 + 8 * kq;
        f32x4 acc0 = {0.f, 0.f, 0.f, 0.f}, acc1 = {0.f, 0.f, 0.f, 0.f}; float ss = 0.f;
#pragma unroll 4
        for (int s = 0; s < 32; ++s) {
            const f32x4 xa = *(const f32x4*)(xp + 32 * s), xb = *(const f32x4*)(xp + 32 * s + 4);
            const bf16x8 bh0 = *(const bf16x8*)(wh0 + 32 * s), bl0 = *(const bf16x8*)(wl0 + 32 * s), bh1 = *(const bf16x8*)(wh0 + 16 * 1024 + 32 * s), bl1 = *(const bf16x8*)(wl0 + 16 * 1024 + 32 * s);
            ss += (xa[0] * xa[0] + xa[1] * xa[1]) + (xa[2] * xa[2] + xa[3] * xa[3]) + (xb[0] * xb[0] + xb[1] * xb[1]) + (xb[2] * xb[2] + xb[3] * xb[3]);
            u32x4 hh; hh.x = pk2(xa[0], xa[1]); hh.y = pk2(xa[2], xa[3]); hh.z = pk2(xb[0], xb[1]); hh.w = pk2(xb[2], xb[3]);
            u32x4 lo; lo.x = pk2(xa[0] - bf2f(hh.x & 0xffffu), xa[1] - bf2f(hh.x >> 16)); lo.y = pk2(xa[2] - bf2f(hh.y & 0xffffu), xa[3] - bf2f(hh.y >> 16));
            lo.z = pk2(xb[0] - bf2f(hh.z & 0xffffu), xb[1] - bf2f(hh.z >> 16)); lo.w = pk2(xb[2] - bf2f(hh.w & 0xffffu), xb[3] - bf2f(hh.w >> 16));
            const bf16x8 ah = __builtin_bit_cast(bf16x8, hh), al = __builtin_bit_cast(bf16x8, lo);
            acc0 = __builtin_amdgcn_mfma_f32_16x16x32_bf16(bh0, ah, acc0, 0, 0, 0); acc0 = __builtin_amdgcn_mfma_f32_16x16x32_bf16(bl0, ah, acc0, 0, 0, 0); acc0 = __builtin_amdgcn_mfma_f32_16x16x32_bf16(bh0, al, acc0, 0, 0, 0);
            acc1 = __builtin_amdgcn_mfma_f32_16x16x32_bf16(bh1, ah, acc1, 0, 0, 0); acc1 = __builtin_amdgcn_mfma_f32_16x16x32_bf16(bl1, ah, acc1, 0, 0, 0); acc1 = __builtin_amdgcn_mfma_f32_16x16x32_bf16(bh1, al, acc1, 0, 0, 0);
        }
#pragma unroll
        for (int i = 0; i < 4; ++i) { CS[tk * 33 + 4 * kq + i] = acc0[i]; CS[tk * 33 + 16 + 4 * kq + i] = acc1[i]; }
        ss += __shfl_xor(ss, 16); ss += __shfl_xor(ss, 32);
        const float rinv = 1.0f / sqrtf(ss * (1.f / DM) + 1e-5f);
        lds_wait();
        if (lane < 16) {
            float lg[32];
#pragma unroll
            for (int e = 0; e < 32; ++e) lg[e] = CS[lane * 33 + e] * rinv + br[e];
            int es0 = 0, es1 = 0, es2 = 0, es3 = 0; float vs0 = 0.f, vs1 = 0.f, vs2 = 0.f, vs3 = 0.f;
#define TOP1(ES, VS) { float mx = lg[0]; int ix = 0; _Pragma("unroll") for (int e = 1; e < 32; ++e) { const bool gt = lg[e] > mx; mx = gt ? lg[e] : mx; ix = gt ? e : ix; } ES = ix; VS = mx; \
                _Pragma("unroll") for (int e = 0; e < 32; ++e) lg[e] = (e == ix) ? -3e38f : lg[e]; }
            TOP1(es0, vs0) TOP1(es1, vs1) TOP1(es2, vs2) TOP1(es3, vs3)
#undef TOP1
            const float e1 = ex2((vs1 - vs0) * LOG2E), e2 = ex2((vs2 - vs0) * LOG2E), e3 = ex2((vs3 - vs0) * LOG2E);
            const float inv = 1.0f / (1.0f + e1 + e2 + e3);
            const int t = t0 + lane;
            *(u32x4*)(TOKE + (size_t)t * 4) = (u32x4){(unsigned)es0, (unsigned)es1, (unsigned)es2, (unsigned)es3};
            *(f32x4*)(TOKW + (size_t)t * 4) = (f32x4){inv, e1 * inv, e2 * inv, e3 * inv};
            RINV[t] = rinv;
            atomicAdd((int*)(CNTL + es0), 1); atomicAdd((int*)(CNTL + es1), 1); atomicAdd((int*)(CNTL + es2), 1); atomicAdd((int*)(CNTL + es3), 1);
        }
        __syncthreads();
        if (tid < 32) CNT[blk * 32 + tid] = CNTL[tid];
        __syncthreads();
    }
}
DI void p6b_place(const Args& a, LAS unsigned char* lds, int tid, int wave, int lane) {
    asm volatile("" : "+v"(tid), "+v"(lane));
    unsigned char* ws = a.ws;
    const float* X2 = (const float*)(ws + WS_X2); const float* RINV = (const float*)(ws + WS_RINV); bf16_t* AS = (bf16_t*)(ws + WS_AS);
    const float* gm = a.in[18];
    const f32x4 g00 = *(const f32x4*)(gm + lane * 8), g01 = *(const f32x4*)(gm + lane * 8 + 4), g10 = *(const f32x4*)(gm + 512 + lane * 8), g11 = *(const f32x4*)(gm + 512 + lane * 8 + 4);
    const int* TOKE = (const int*)(ws + WS_TOKE); const float* TOKW = (const float*)(ws + WS_TOKW); const int* CNT = (const int*)(ws + WS_CTL + CTL_CNT);
    int* SLOT = (int*)(ws + WS_SLOT); float* WSLOT = (float*)(ws + WS_WSLOT); int* TE = (int*)(ws + WS_CTL + CTL_TE); int* NT = (int*)(ws + WS_CTL + CTL_NT);
    LAS int* TOT = (LAS int*)lds; LAS int* OFFS = TOT + 32; LAS int* PADS = TOT + 64; LAS int* CUR = TOT + 96;
    for (int blk0 = blockIdx.x; blk0 < 256 * DBL(10); blk0 += gridDim.x) {
        const int blk = blk0 & 255;
        if (tid < 32) { int tot = 0, mine = 0; for (int bb = 0; bb < 256; ++bb) { const int cc = CNT[bb * 32 + tid]; tot += cc; mine += (bb < blk) ? cc : 0; } TOT[tid] = tot; OFFS[tid] = mine; CUR[tid] = 0; }
        __syncthreads();
        if (tid == 0) {
            int ps = 0;
            for (int e = 0; e < 32; ++e) { PADS[e] = ps; ps += (TOT[e] + 255) & ~255; }
            if (blk == 0) { int tile = 0; for (int e = 0; e < 32; ++e) { const int n = (TOT[e] + 255) >> 8; for (int q = 0; q < n; ++q) TE[tile++] = e; } NT[0] = tile; }
        }
        __syncthreads();
        {
            const int tb = blk * 128 + wave * 16;
            f32x4 a0, a1, b0, b1, na0, na1, nb0, nb1; float rv, nrv; int e0, e1, e2, e3, ne0, ne1, ne2, ne3; float w0, w1, w2, w3, nw0, nw1, nw2, nw3;
#define P6B_LOAD(T, A0, A1, B0, B1, RV, E0, E1, E2, E3, W0, W1, W2, W3) { const float* xp = X2 + (size_t)(T) * DM + lane * 8; A0 = *(const f32x4*)xp; A1 = *(const f32x4*)(xp + 4); B0 = *(const f32x4*)(xp + 512); B1 = *(const f32x4*)(xp + 516); RV = RINV[T]; \
                const int* ep = TOKE + (size_t)(T) * 4; E0 = ep[0]; E1 = ep[1]; E2 = ep[2]; E3 = ep[3]; const float* wp = TOKW + (size_t)(T) * 4; W0 = wp[0]; W1 = wp[1]; W2 = wp[2]; W3 = wp[3]; }
            P6B_LOAD(tb, a0, a1, b0, b1, rv, e0, e1, e2, e3, w0, w1, w2, w3)
            for (int it = 0; it < 16; ++it) {
                const int t = tb + it;
                if (it + 1 < 16) P6B_LOAD(t + 1, na0, na1, nb0, nb1, nrv, ne0, ne1, ne2, ne3, nw0, nw1, nw2, nw3)
                u32x4 r0, r1; u32x2 q0, q1;
                if (MOE_FP8) { const float r8 = rv * SC_A8;
                    q0.x = pk4_fp8(a0[0] * r8 * g00[0], a0[1] * r8 * g00[1], a0[2] * r8 * g00[2], a0[3] * r8 * g00[3]); q0.y = pk4_fp8(a1[0] * r8 * g01[0], a1[1] * r8 * g01[1], a1[2] * r8 * g01[2], a1[3] * r8 * g01[3]);
                    q1.x = pk4_fp8(b0[0] * r8 * g10[0], b0[1] * r8 * g10[1], b0[2] * r8 * g10[2], b0[3] * r8 * g10[3]); q1.y = pk4_fp8(b1[0] * r8 * g11[0], b1[1] * r8 * g11[1], b1[2] * r8 * g11[2], b1[3] * r8 * g11[3]);
                } else {
                    r0.x = pk2(a0[0] * rv * g00[0], a0[1] * rv * g00[1]); r0.y = pk2(a0[2] * rv * g00[2], a0[3] * rv * g00[3]); r0.z = pk2(a1[0] * rv * g01[0], a1[1] * rv * g01[1]); r0.w = pk2(a1[2] * rv * g01[2], a1[3] * rv * g01[3]);
                    r1.x = pk2(b0[0] * rv * g10[0], b0[1] * rv * g10[1]); r1.y = pk2(b0[2] * rv * g10[2], b0[3] * rv * g10[3]); r1.z = pk2(b1[0] * rv * g11[0], b1[1] * rv * g11[1]); r1.w = pk2(b1[2] * rv * g11[2], b1[3] * rv * g11[3]);
                }
#pragma unroll
                for (int k = 0; k < 4; ++k) {
                    const int e = k == 0 ? e0 : k == 1 ? e1 : k == 2 ? e2 : e3; const float wk = k == 0 ? w0 : k == 1 ? w1 : k == 2 ? w2 : w3;
                    int p = 0; if (lane == 0) p = atomicAdd((int*)(CUR + e), 1);
                    p = __builtin_amdgcn_readfirstlane(p);
                    const int pos = PADS[e] + OFFS[e] + p;
                    if (MOE_FP8) { *(u32x2*)((unsigned char*)AS + (size_t)pos * DM + lane * 8) = q0; *(u32x2*)((unsigned char*)AS + (size_t)pos * DM + 512 + lane * 8) = q1; }
                    else { *(u32x4*)(AS + (size_t)pos * DM + lane * 8) = r0; *(u32x4*)(AS + (size_t)pos * DM + 512 + lane * 8) = r1; }
                    if (lane == 0) { SLOT[(size_t)t * 4 + k] = pos; WSLOT[pos] = wk; }
                }
                a0 = na0; a1 = na1; b0 = nb0; b1 = nb1; rv = nrv; e0 = ne0; e1 = ne1; e2 = ne2; e3 = ne3; w0 = nw0; w1 = nw1; w2 = nw2; w3 = nw3;
            }
#undef P6B_LOAD
        }
        __syncthreads();
    }
}
DI void p9_final(const Args& a, int gw, int NGW, int lane) {
    asm volatile("" : "+v"(lane));
    unsigned char* ws = a.ws;
    const float* X2 = (const float*)(ws + WS_X2); const bf16_t* Y = (const bf16_t*)(ws + WS_Y); const int* SLOT = (const int*)(ws + WS_SLOT);
    const float* gf = a.in[25]; float* out = a.out;
    f32x4 gv[4];
#pragma unroll
    for (int j = 0; j < 4; ++j) gv[j] = *((const f32x4*)gf + lane + 64 * j);
    int t0 = gw;
    int p0 = 0, p1 = 0, p2 = 0, p3 = 0;
    constexpr int TX = MTOK * DBL(9);
    if (t0 < TX) { const int t = t0 % MTOK; p0 = SLOT[(size_t)t * 4]; p1 = SLOT[(size_t)t * 4 + 1]; p2 = SLOT[(size_t)t * 4 + 2]; p3 = SLOT[(size_t)t * 4 + 3]; }
    for (; t0 < TX; t0 += NGW) {
        const int t = t0 % MTOK; const int tn0 = t0 + NGW, tn = tn0 % MTOK;
        int q0 = 0, q1 = 0, q2 = 0, q3 = 0;
        if (tn0 < TX) { q0 = SLOT[(size_t)tn * 4]; q1 = SLOT[(size_t)tn * 4 + 1]; q2 = SLOT[(size_t)tn * 4 + 2]; q3 = SLOT[(size_t)tn * 4 + 3]; }
        f32x4 v[4]; u32x2 y0[4], y1[4], y2[4], y3[4];
#pragma unroll
        for (int j = 0; j < 4; ++j) v[j] = *((const f32x4*)(X2 + (size_t)t * DM) + lane + 64 * j);
#pragma unroll
        for (int j = 0; j < 4; ++j) { y0[j] = *((const u32x2*)(Y + (size_t)p0 * DM) + lane + 64 * j); y1[j] = *((const u32x2*)(Y + (size_t)p1 * DM) + lane + 64 * j);
            y2[j] = *((const u32x2*)(Y + (size_t)p2 * DM) + lane + 64 * j); y3[j] = *((const u32x2*)(Y + (size_t)p3 * DM) + lane + 64 * j); }
        float s = 0.f;
#pragma unroll
        for (int j = 0; j < 4; ++j) {
            v[j].x += ((bf2f(y0[j].x & 0xffffu) + bf2f(y1[j].x & 0xffffu)) + bf2f(y2[j].x & 0xffffu)) + bf2f(y3[j].x & 0xffffu);
            v[j].y += ((bf2f(y0[j].x >> 16) + bf2f(y1[j].x >> 16)) + bf2f(y2[j].x >> 16)) + bf2f(y3[j].x >> 16);
            v[j].z += ((bf2f(y0[j].y & 0xffffu) + bf2f(y1[j].y & 0xffffu)) + bf2f(y2[j].y & 0xffffu)) + bf2f(y3[j].y & 0xffffu);
            v[j].w += ((bf2f(y0[j].y >> 16) + bf2f(y1[j].y >> 16)) + bf2f(y2[j].y >> 16)) + bf2f(y3[j].y >> 16);
            s += (v[j].x * v[j].x + v[j].y * v[j].y) + (v[j].z * v[j].z + v[j].w * v[j].w);
        }
        const float rinv = 1.0f / sqrtf(wave_sum(s) * (1.f / DM) + 1e-5f);
#pragma unroll
        for (int j = 0; j < 4; ++j) *((f32x4*)(out + (size_t)t * DM) + lane + 64 * j) = (f32x4){v[j].x * rinv * gv[j].x, v[j].y * rinv * gv[j].y, v[j].z * rinv * gv[j].z, v[j].w * rinv * gv[j].w};
        p0 = q0; p1 = q1; p2 = q2; p3 = q3;
    }
}

__global__ void __launch_bounds__(NTHREADS, 2) hybrid_fwd(Args args) {
    extern __shared__ __attribute__((aligned(16))) unsigned char lds_raw[];
    LAS unsigned char* lds = (LAS unsigned char*)lds_raw;
    cg::grid_group grid = cg::this_grid();
    const int tid = threadIdx.x, lane = tid & 63, wave = __builtin_amdgcn_readfirstlane(tid >> 6);
    volatile LAS unsigned* bst = (volatile LAS unsigned*)(lds_raw_las(lds_raw) + LDS_BYTES - 16);
    if (tid < 4) bst[tid] = 0u;
    __syncthreads();
    const XcdBarrier xbar = xcd_barrier_post((unsigned*)(args.ws + WS_CTL + CTL_BAR), bst);
#define SYNC() xcd_barrier(xbar)
    const int G = gridDim.x, bx = blockIdx.x;
    const int gw = bx * NWAVES + wave, NGW = G * NWAVES;
    unsigned char* ws = args.ws;

    if (args.ws == nullptr) grid.sync();
    for (int rep = 0; rep < NREP(0); ++rep) p0_prep(args, lds, gw, NGW, wave, lane);
    SYNC();
    for (int rep = 0; rep < NREP(1); ++rep) {
        pg8::Gemm g{(const pg8::bf16_t*)(ws + WS_H1), (const pg8::bf16_t*)(ws + WS_WIN), MTOK, NPROJ, DM};
        pg8::StaticOrder S; S.init(MTOK, NPROJ, G, bx);
        Epi1 E{(bf16_t*)(ws + WS_Q), (bf16_t*)(ws + WS_KV), (bf16_t*)(ws + WS_U), (bf16_t*)(ws + WS_V), (bf16_t*)(ws + WS_MG), (float*)(ws + WS_NG)};
        pg8::gemm_phase<Epi1, pg8::StaticOrder, true, true>(lds, g, S, E);
    }
    SYNC();
    for (int rep = 0; rep < NREP(2); ++rep)
    for (int it0 = bx; it0 < 512 * DBL(2); it0 += G) {
        const int it = it0 & 511;
        if (it < 256) p2_compress_item(args, lds, it, tid, wave, lane);
        else p2_sgu_item(args, lds, it - 256, tid, wave, lane);
    }
    SYNC();
    for (int rep = 0; rep < NREP(3); ++rep) {
        for (int it0 = bx; it0 < 1024 * ATT_TWICE; it0 += G) {
            const int it = it0 & 1023;
            const int w = it & 255, i = it >> 8, s = w & 31, bg = w >> 5;
            const int c = (i == 0) ? s : (i == 1) ? 63 - s : (i == 2) ? 64 + s : 127 - s;
            attn_tile(args, lds, bg >> 1, bg & 1, c, tid, wave, lane);
        }
    }
    SYNC();
    for (int rep = 0; rep < NREP(4); ++rep) {
        pg8::Gemm g{(const pg8::bf16_t*)(ws + WS_YAB), (const pg8::bf16_t*)(ws + WS_WAB), 2 * MTOK, 2048, 512};
        PairOrder S{G, bx};
        Epi4 E{(const bf16_t*)(ws + WS_MG), (bf16_t*)(ws + WS_MERGED)};
        pg8::gemm_phase<Epi4, PairOrder, true, true>(lds, g, S, E);
    }
    SYNC();
    for (int rep = 0; rep < NREP(5); ++rep) {
        pg8::Gemm g{(const pg8::bf16_t*)(ws + WS_MERGED), (const pg8::bf16_t*)(ws + WS_WOUT), MTOK, DM, DM};
        pg8::StaticOrder S; S.init(MTOK, DM, G, bx);
        Epi5 E{args.in[0], (float*)(ws + WS_X2)};
        pg8::gemm_phase<Epi5, pg8::StaticOrder, true, true>(lds, g, S, E);
    }
    SYNC();
    for (int rep = 0; rep < NREP(6); ++rep) { p6a_route(args, lds, tid, wave, lane); }
    SYNC();
    for (int rep = 0; rep < NREP(10); ++rep) { p6b_place(args, lds, tid, wave, lane); }
    SYNC();
    const int* TE = (const int*)(ws + WS_CTL + CTL_TE);
    const int NT = __builtin_amdgcn_readfirstlane(*(const int*)(ws + WS_CTL + CTL_NT));
    for (int rep = 0; rep < NREP(7); ++rep) {
        int kq = MOE_FP8 ? DM / 2 : DM; asm volatile("" : "+s"(kq));
        pg8::Gemm g{(const pg8::bf16_t*)(ws + WS_AS), (const pg8::bf16_t*)(ws + WS_WGU), MPAD, NEXP * 2048, kq};
        MoeOrder S{TE, NT, 8, G, bx};
        Epi7 E{args.in[22], (bf16_t*)(ws + WS_ACT)};
        pg8::gemm_phase<Epi7, MoeOrder, true, true, MOE_FP8 != 0>(lds, g, S, E);
    }
    SYNC();
    for (int rep = 0; rep < NREP(8); ++rep) {
        int kq = MOE_FP8 ? DFF / 2 : DFF; asm volatile("" : "+s"(kq));
        pg8::Gemm g{(const pg8::bf16_t*)(ws + WS_ACT), (const pg8::bf16_t*)(ws + WS_WD), MPAD, NEXP * 1024, kq};
        MoeOrder S{TE, NT, 4, G, bx};
        Epi8 E{args.in[24], (const float*)(ws + WS_WSLOT), (bf16_t*)(ws + WS_Y)};
        pg8::gemm_phase<Epi8, MoeOrder, true, true, MOE_FP8 != 0>(lds, g, S, E);
    }
    SYNC();
    for (int rep = 0; rep < NREP(9); ++rep) p9_final(args, gw, NGW, lane);
}

extern "C" void kernel_launch(void* const* d_in, const int* in_sizes, int n_in, void* d_out, int out_size, void* d_ws, size_t ws_size, hipStream_t stream) {
    static int grid = 0;
    if (grid == 0) {
        if (n_in != 26 || in_sizes[0] != MTOK * DM || out_size != MTOK * DM || ws_size < WS_END) {
            fprintf(stderr, "kernel_launch: unexpected shapes (n_in %d, in0 %d, out %d, ws %zu < %zu)\n", n_in, n_in > 0 ? in_sizes[0] : -1, out_size, ws_size, (size_t)WS_END); grid = -1; return; }
        int dev = 0, cus = 0, per_cu = 0;
        hipGetDevice(&dev);
        hipDeviceGetAttribute(&cus, hipDeviceAttributeMultiprocessorCount, dev);
        if (hipFuncSetAttribute((const void*)hybrid_fwd, hipFuncAttributeMaxDynamicSharedMemorySize, LDS_BYTES) != hipSuccess) { fprintf(stderr, "kernel_launch: hipFuncSetAttribute failed\n"); grid = -1; return; }
        if (hipOccupancyMaxActiveBlocksPerMultiprocessor(&per_cu, (const void*)hybrid_fwd, NTHREADS, LDS_BYTES) != hipSuccess || per_cu < 1) { fprintf(stderr, "kernel_launch: occupancy query says %d\n", per_cu); per_cu = 1; }
        (void)hipGetLastError();
        grid = cus * 1;
        if (grid > cus * per_cu) grid = cus * per_cu;
    }
    if (grid < 0) return;
    if (hipMemsetAsync((unsigned char*)d_ws + WS_CTL + CTL_BAR, 0, XCD_BAR_WORDS * 4, stream) != hipSuccess) { fprintf(stderr, "kernel_launch: memset failed\n"); return; }
    Args a{};
    for (int i = 0; i < 26; ++i) a.in[i] = (const float*)d_in[i];
    a.out = (float*)d_out; a.ws = (unsigned char*)d_ws;
    void* kargs[] = {&a};
    hipError_t e = hipLaunchCooperativeKernel((const void*)hybrid_fwd, dim3(grid), dim3(NTHREADS), kargs, LDS_BYTES, stream);
    if (e != hipSuccess) fprintf(stderr, "kernel_launch: cooperative launch failed: %s (grid %d)\n", hipGetErrorString(e), grid);
}
```

```cpp
#include <hip/hip_runtime.h>
#include <hip/hip_cooperative_groups.h>
#include <cstdio>
#include <cstdint>
namespace cg = cooperative_groups;
namespace pg8 {
#define PG8_LAS __attribute__((address_space(3)))
typedef unsigned short bf16_t;
typedef short bf16x8 __attribute__((ext_vector_type(8)));
typedef float f32x4 __attribute__((ext_vector_type(4)));
typedef unsigned u32x4 __attribute__((ext_vector_type(4)));
typedef int v4i32_t __attribute__((ext_vector_type(4)));
typedef int v8i32_t __attribute__((ext_vector_type(8)));
constexpr int BM = 256, BK = 64, HALF = 128, HTB = HALF * BK * 2  , STAGE_BYTES = 8 * HTB, NXCD = 8, WGM = 8;

__host__ __device__ __forceinline__ int lds_byte(int r, int c) { const int st = (r >> 4) * 2 + (c >> 5), rr = r & 15, cc = c & 31, ob = rr * 64 + cc * 2; return st * 1024 + (ob ^ (((ob >> 9) & 1) << 5)); }
__host__ __device__ __forceinline__ void stage_rc(int b, int& R, int& C) { const int st = b / 1024, sb = b % 1024, swz = sb ^ (((sb >> 9) & 1) << 5); R = (st >> 1) * 16 + swz / 64; C = (st & 1) * 32 + (swz % 64) / 2; }
__host__ __device__ __forceinline__ int perm32(int rho) { const int n = rho >> 4, i = rho & 15; return 8 * (i >> 2) + 4 * n + (i & 3); }

struct Unit { int pm, pn; };
struct Gemm { const bf16_t* A; const bf16_t* Bt; int M, N, K; const int* rowmap = nullptr; };

struct StaticOrder {
    int nM, nN, nwg, G, c;
    __host__ __device__ void init(int M, int N, int G_, int c_) { nM = M / BM; nN = N / BM; nwg = nM * nN; G = G_; c = c_; }
    __host__ __device__ bool next(int i, Unit& u) const {
        const long L = (long)i * G + c; if (L >= nwg) return false;
        int wgid = (int)L; { const int q = nwg / NXCD, r = nwg % NXCD, xcd = wgid % NXCD, off = wgid / NXCD; wgid = (xcd < r ? xcd * (q + 1) : r * (q + 1) + (xcd - r) * q) + off; }
        const int nig = WGM * nN, gid = wgid / nig, fm = gid * WGM, gsz = (nM - fm) < WGM ? (nM - fm) : WGM;
        u.pm = fm + ((wgid % nig) % gsz); u.pn = (wgid % nig) / gsz; return true;
    }
    __device__ __forceinline__ void a_ready(const Unit&) const {}
    __device__ __forceinline__ void done(const Unit&) const {}
};

__device__ __forceinline__ unsigned cvt_pk_bf16(float lo, float hi) { unsigned r; asm volatile("v_cvt_pk_bf16_f32 %0, %1, %2" : "=v"(r) : "v"(lo), "v"(hi)); return r; }
typedef float f32x2 __attribute__((ext_vector_type(2)));
template <class Epi, class Sched, bool ALIGN_EPI = false, bool SP2 = false, bool FP8 = false, bool GATHER = false>
__device__ __forceinline__ void gemm_phase(PG8_LAS unsigned char* lds, const Gemm g, const Sched& S, const Epi& E) {
    int tid_ = threadIdx.x; asm volatile("" : "+v"(tid_));
    const int tid = tid_, wid = __builtin_amdgcn_readfirstlane(tid >> 6), lane = tid & 63, wr = wid >> 2, wc = wid & 3, fr = lane & 15, fq = lane >> 4;
    const int K = g.K, nt = K / BK;
    unsigned voffA[2], voffB[2];
    int rA[2]; unsigned cA2[2];
#pragma unroll
    for (int i = 0; i < 2; ++i) { int R, C; stage_rc(tid * 16 + i * 8192, R, C); const int Rb = Epi::PERM ? ((R & ~31) + perm32(R & 31)) : R;
        voffA[i] = (unsigned)(R * K + C) * 2u; voffB[i] = (unsigned)(Rb * K + C) * 2u; rA[i] = R; cA2[i] = (unsigned)C * 2u; }
    static_assert(!GATHER || SP2, "GATHER is wired into the SP2 loop only");
    unsigned gcu0[2], gcu1[2], gnx0[2], gnx1[2]; int ix2[4] = {0, 0, 0, 0};
#define PG8_GIDX(u, h, i) (g.rowmap[(u).pm * BM + (h) * HALF + rA[i]])
#define PG8_GOFF(ix, i) ((unsigned)(ix) * (unsigned)(K * 2) + cA2[i])
    const size_t kstep = (size_t)(BK * 2);
    const size_t hstep = (size_t)HALF * K * 2;
    const size_t tstep = 2 * hstep;
    const unsigned ldsw = (unsigned)wid * 1024u;
    const int aoff = lds_byte(wr * 64 + fr, fq * 8), boff = lds_byte(wc * 32 + fr, fq * 8);
#define PG8_SA(b, h) (((b) * 2 + (h)) * HTB)
#define PG8_SB(b, h) ((4 + (b) * 2 + (h)) * HTB)
#define PG8_STAGE(bufoff, gbase, voff) do { _Pragma("unroll") for (int _i = 0; _i < 2; ++_i) \
        __builtin_amdgcn_global_load_lds((const unsigned*)((const char*)(gbase) + (voff)[_i]), (PG8_LAS unsigned*)(lds + (bufoff) + ldsw + _i * 8192), 16, 0, 0); } while (0)
#define PG8_STAGE_O(bufoff, gbase, o0, o1) do { \
        __builtin_amdgcn_global_load_lds((const unsigned*)((const char*)(gbase) + (o0)), (PG8_LAS unsigned*)(lds + (bufoff) + ldsw), 16, 0, 0); \
        __builtin_amdgcn_global_load_lds((const unsigned*)((const char*)(gbase) + (o1)), (PG8_LAS unsigned*)(lds + (bufoff) + ldsw + 8192), 16, 0, 0); } while (0)
#define PG8_STAGE_A(bufoff, gbase, h, nx) do { if constexpr (GATHER) { if (h) PG8_STAGE_O(bufoff, gbase, (nx) ? gnx1[0] : gcu1[0], (nx) ? gnx1[1] : gcu1[1]); else PG8_STAGE_O(bufoff, gbase, (nx) ? gnx0[0] : gcu0[0], (nx) ? gnx0[1] : gcu0[1]); } \
        else { PG8_STAGE(bufoff, (gbase) + ((h) ? hstep : 0), voffA); } } while (0)
#define PG8_LDA(dst, b, h) do { _Pragma("unroll") for (int m = 0; m < 4; ++m) _Pragma("unroll") for (int k = 0; k < 2; ++k) dst[m][k] = *(const PG8_LAS bf16x8*)(lds + PG8_SA(b, h) + aoff + m * 2048 + k * 1024); } while (0)
#define PG8_LDB(dst, b, h) do { _Pragma("unroll") for (int n = 0; n < 2; ++n) _Pragma("unroll") for (int k = 0; k < 2; ++k) dst[n][k] = *(const PG8_LAS bf16x8*)(lds + PG8_SB(b, h) + boff + n * 2048 + k * 1024); } while (0)
#define PG8_CAT8(x) __builtin_shufflevector(__builtin_bit_cast(v4i32_t, (x)[0]), __builtin_bit_cast(v4i32_t, (x)[1]), 0, 1, 2, 3, 4, 5, 6, 7)
#define PG8_MMA(ai, bj, At, Bt) do { __builtin_amdgcn_s_setprio(1); \
        if constexpr (FP8) { _Pragma("unroll") for (int m = 0; m < 4; ++m) _Pragma("unroll") for (int n = 0; n < 2; ++n) \
            { const v8i32_t a8_ = PG8_CAT8(Bt[n]), b8_ = PG8_CAT8(At[m]); asm volatile("v_mfma_scale_f32_16x16x128_f8f6f4 %0, %1, %2, %0, %3, %3 op_sel_hi:[0,0,0]" : "+v"(acc[ai][bj][m][n]) : "v"(a8_), "v"(b8_), "v"(0x7f7f7f7f)); } } \
        else { _Pragma("unroll") for (int m = 0; m < 4; ++m) _Pragma("unroll") for (int n = 0; n < 2; ++n) _Pragma("unroll") for (int k = 0; k < 2; ++k) \
            acc[ai][bj][m][n] = __builtin_amdgcn_mfma_f32_16x16x32_bf16(Bt[n][k], At[m][k], acc[ai][bj][m][n], 0, 0, 0); } \
        __builtin_amdgcn_s_setprio(0); } while (0)
#define PG8_WAIT_V(n) asm volatile("s_waitcnt vmcnt(" #n ")" ::: "memory")
#define PG8_WAIT_L(n) asm volatile("s_waitcnt lgkmcnt(" #n ")" ::: "memory")
#define PG8_BAR __builtin_amdgcn_s_barrier()
#define PG8_SCHED __builtin_amdgcn_sched_barrier(0)
    Unit cur, nxt; int ui = 0;
    if (!S.next(0, cur)) return;
    f32x4 acc[2][2][4][2];
#pragma unroll
    for (int a = 0; a < 2; ++a)
#pragma unroll
        for (int b = 0; b < 2; ++b)
#pragma unroll
            for (int m = 0; m < 4; ++m)
#pragma unroll
                for (int n = 0; n < 2; ++n) acc[a][b][m][n] = (f32x4){0.f, 0.f, 0.f, 0.f};
    bf16x8 At[4][2], B0[2][2], B1[2][2];
    const char* cA = (const char*)g.A + (GATHER ? (size_t)0 : (size_t)cur.pm * tstep); const char* cB = (const char*)g.Bt + (size_t)cur.pn * tstep;
    if constexpr (GATHER) { gcu0[0] = PG8_GOFF(PG8_GIDX(cur, 0, 0), 0); gcu0[1] = PG8_GOFF(PG8_GIDX(cur, 0, 1), 1); gcu1[0] = PG8_GOFF(PG8_GIDX(cur, 1, 0), 0); gcu1[1] = PG8_GOFF(PG8_GIDX(cur, 1, 1), 1);
        gnx0[0] = gcu0[0]; gnx0[1] = gcu0[1]; gnx1[0] = gcu1[0]; gnx1[1] = gcu1[1]; }
    S.a_ready(cur);
    if constexpr (Epi::PREFETCH) E.prefetch(cur, lds + STAGE_BYTES, tid);
    if constexpr (SP2) {
        PG8_STAGE(PG8_SB(0, 0), cB, voffB); PG8_STAGE(PG8_SB(0, 1), cB + hstep, voffB); PG8_STAGE_A(PG8_SA(0, 0), cA, 0, false); PG8_STAGE_A(PG8_SA(0, 1), cA, 1, false);
        if (wr == 1) PG8_BAR;
        PG8_WAIT_V(2); PG8_BAR;
        PG8_STAGE(PG8_SB(1, 0), cB + kstep, voffB); PG8_STAGE_A(PG8_SA(1, 0), cA + kstep, 0, false); PG8_STAGE(PG8_SB(1, 1), cB + hstep + kstep, voffB);
        PG8_WAIT_V(6); PG8_BAR;
    } else {
        PG8_STAGE(PG8_SB(0, 0), cB, voffB); PG8_STAGE(PG8_SA(0, 0), cA, voffA); PG8_STAGE(PG8_SB(0, 1), cB + hstep, voffB); PG8_STAGE(PG8_SA(0, 1), cA + hstep, voffA);
        if (wr == 1) PG8_BAR;
        PG8_WAIT_V(4); PG8_BAR;
        PG8_STAGE(PG8_SB(1, 0), cB + kstep, voffB); PG8_STAGE(PG8_SA(1, 0), cA + kstep, voffA); PG8_STAGE(PG8_SB(1, 1), cB + hstep + kstep, voffB);
        PG8_WAIT_V(6); PG8_BAR;
    }
    for (;;) {
        const bool has_next = S.next(ui + 1, nxt);
        const char* nA = GATHER ? cA : (has_next ? (const char*)g.A + (size_t)nxt.pm * tstep : cA); const char* nB = has_next ? (const char*)g.Bt + (size_t)nxt.pn * tstep : cB;
        if constexpr (GATHER) { if (ui == 0 && has_next) { gnx0[0] = PG8_GOFF(PG8_GIDX(nxt, 0, 0), 0); gnx0[1] = PG8_GOFF(PG8_GIDX(nxt, 0, 1), 1); gnx1[0] = PG8_GOFF(PG8_GIDX(nxt, 1, 0), 0); gnx1[1] = PG8_GOFF(PG8_GIDX(nxt, 1, 1), 1); } }
        for (int t = 0; t < nt; t += 2) {
            if constexpr (Epi::MIDK) { if (t == nt / 2) { int fr_ = fr, fq_ = fq; asm volatile("" : "+v"(fr_), "+v"(fq_)); E.midk(acc, cur, wr, wc, fr_, fq_); } }
            const bool last = (t == nt - 2);
            const char* a1 = cA + (size_t)(t + 1) * kstep;
            const char* a2 = last ? nA : cA + (size_t)(t + 2) * kstep; const char* b2 = last ? nB : cB + (size_t)(t + 2) * kstep;
            const char* a3 = a2 + kstep; const char* b3 = b2 + kstep;
            if (last && has_next) S.a_ready(nxt);
            if constexpr (SP2) {
            PG8_LDB(B0, 0, 0); PG8_LDB(B1, 0, 1); PG8_SCHED; PG8_LDA(At, 0, 0); PG8_STAGE_A(PG8_SA(1, 1), a1, 1, false);
            PG8_WAIT_V(8); PG8_WAIT_L(0); PG8_BAR; PG8_MMA(0, 0, At, B0); PG8_MMA(0, 1, At, B1); PG8_BAR; PG8_SCHED;
            PG8_LDA(At, 0, 1); PG8_STAGE(PG8_SB(0, 0), b2, voffB); PG8_STAGE(PG8_SB(0, 1), b2 + hstep, voffB); PG8_STAGE_A(PG8_SA(0, 0), a2, 0, last);
            PG8_WAIT_V(8); PG8_WAIT_L(0); PG8_BAR; PG8_MMA(1, 0, At, B0); PG8_MMA(1, 1, At, B1); PG8_BAR; PG8_SCHED;
            PG8_LDB(B0, 1, 0); PG8_LDB(B1, 1, 1); PG8_SCHED; PG8_LDA(At, 1, 0); PG8_STAGE_A(PG8_SA(0, 1), a2, 1, last);
            PG8_WAIT_V(8); PG8_WAIT_L(0); PG8_BAR; PG8_MMA(0, 0, At, B0); PG8_MMA(0, 1, At, B1); PG8_BAR; PG8_SCHED;
            PG8_LDA(At, 1, 1); PG8_STAGE(PG8_SB(1, 0), b3, voffB); PG8_STAGE(PG8_SB(1, 1), b3 + hstep, voffB); PG8_STAGE_A(PG8_SA(1, 0), a3, 0, last);
            PG8_WAIT_V(8); PG8_WAIT_L(0); PG8_BAR; PG8_MMA(1, 0, At, B0); PG8_MMA(1, 1, At, B1); PG8_BAR; PG8_SCHED;
            } else {
            PG8_LDB(B0, 0, 0); PG8_SCHED; PG8_LDA(At, 0, 0); PG8_STAGE(PG8_SA(1, 1), a1 + hstep, voffA);
            PG8_WAIT_L(8); PG8_BAR; PG8_WAIT_L(0); PG8_MMA(0, 0, At, B0); PG8_BAR; PG8_SCHED;
            PG8_LDB(B1, 0, 1); PG8_STAGE(PG8_SB(0, 0), b2, voffB);
            PG8_BAR; PG8_WAIT_L(0); PG8_MMA(0, 1, At, B1); PG8_BAR;
            PG8_LDA(At, 0, 1); PG8_STAGE(PG8_SA(0, 0), a2, voffA);
            PG8_BAR; PG8_WAIT_L(0); PG8_MMA(1, 0, At, B0); PG8_BAR; PG8_SCHED;
            PG8_STAGE(PG8_SB(0, 1), b2 + hstep, voffB);
            PG8_WAIT_V(6); PG8_BAR; PG8_MMA(1, 1, At, B1); PG8_BAR;
            PG8_LDB(B0, 1, 0); PG8_SCHED; PG8_LDA(At, 1, 0); PG8_STAGE(PG8_SA(0, 1), a2 + hstep, voffA);
            PG8_WAIT_L(8); PG8_BAR; PG8_WAIT_L(0); PG8_MMA(0, 0, At, B0); PG8_BAR; PG8_SCHED;
            PG8_LDB(B1, 1, 1); PG8_STAGE(PG8_SB(1, 0), b3, voffB);
            PG8_BAR; PG8_WAIT_L(0); PG8_MMA(0, 1, At, B1); PG8_BAR;
            PG8_LDA(At, 1, 1); PG8_STAGE(PG8_SA(1, 0), a3, voffA);
            PG8_BAR; PG8_WAIT_L(0); PG8_MMA(1, 0, At, B0); PG8_BAR; PG8_SCHED;
            PG8_STAGE(PG8_SB(1, 1), b3 + hstep, voffB);
            PG8_WAIT_V(6); PG8_BAR; PG8_MMA(1, 1, At, B1); PG8_BAR;
            }
        }
        if constexpr (FP8) asm volatile("s_nop 15\n\ts_nop 15\n\ts_nop 15\n\ts_nop 15" ::: "memory");
        if constexpr (ALIGN_EPI) { if (wr == 0) PG8_BAR; }
        bool has2 = false;
        if constexpr (GATHER) { Unit n2; has2 = has_next && S.next(ui + 2, n2);
            if (has2) { ix2[0] = PG8_GIDX(n2, 0, 0); ix2[1] = PG8_GIDX(n2, 0, 1); ix2[2] = PG8_GIDX(n2, 1, 0); ix2[3] = PG8_GIDX(n2, 1, 1); } }
        if constexpr (!Epi::AFTER_DRAIN) { int fr_ = fr, fq_ = fq; asm volatile("" : "+v"(fr_), "+v"(fq_));
            E(acc, cur, wr, wc, fr_, fq_); S.done(cur); }
        if (!has_next) break;
#pragma unroll
        for (int a = 0; a < 2; ++a)
#pragma unroll
            for (int b = 0; b < 2; ++b)
#pragma unroll
                for (int m = 0; m < 4; ++m)
#pragma unroll
                    for (int n = 0; n < 2; ++n) acc[a][b][m][n] = (f32x4){0.f, 0.f, 0.f, 0.f};
        cur = nxt; cA = nA; cB = nB; ++ui;
        if constexpr (Epi::PREFETCH) E.prefetch(cur, lds + STAGE_BYTES, tid);
        if constexpr (GATHER) { gcu0[0] = gnx0[0]; gcu0[1] = gnx0[1]; gcu1[0] = gnx1[0]; gcu1[1] = gnx1[1];
            if (has2) { gnx0[0] = PG8_GOFF(ix2[0], 0); gnx0[1] = PG8_GOFF(ix2[1], 1); gnx1[0] = PG8_GOFF(ix2[2], 0); gnx1[1] = PG8_GOFF(ix2[3], 1); } }
        if constexpr (ALIGN_EPI) { if (wr == 1) PG8_BAR; }
    }
    PG8_WAIT_V(0);
    if constexpr (!ALIGN_EPI) { if (wr == 0) PG8_BAR; }
    PG8_BAR;
    if constexpr (Epi::AFTER_DRAIN) { E.fused(acc, cur, wr, wc, fr, fq, lds, wid, lane); S.done(cur); }
#undef PG8_SA
#undef PG8_SB
#undef PG8_STAGE
#undef PG8_STAGE_O
#undef PG8_STAGE_A
#undef PG8_GIDX
#undef PG8_GOFF
#undef PG8_LDA
#undef PG8_LDB
#undef PG8_MMA
#undef PG8_CAT8
#undef PG8_WAIT_V
#undef PG8_WAIT_L
#undef PG8_BAR
#undef PG8_SCHED
}
}
#define LAS __attribute__((address_space(3)))
#define XB_TMO      128
#define XB_XCNT(j)  (256  + 64 * (j))
#define XB_XSUB(j)  (1280 + 64 * (j))
#define XB_XGEN(j)  (2304 + 64 * (j))
#define XB_TOP      3328
#define XB_TOPGEN   3392
#define XCD_BAR_WORDS 3456
#define XB_SPIN_CAP (1u << 18)

__device__ __forceinline__ unsigned xb_ld(unsigned* p)              { return __hip_atomic_load(p, __ATOMIC_RELAXED, __HIP_MEMORY_SCOPE_AGENT); }
__device__ __forceinline__ unsigned xb_add(unsigned* p, unsigned v) { return __hip_atomic_fetch_add(p, v, __ATOMIC_RELAXED, __HIP_MEMORY_SCOPE_AGENT); }
__device__ __forceinline__ unsigned xb_xcc_id() { return (unsigned)__builtin_amdgcn_s_getreg((3 << 11) | 20) & 0xFu; }
#define XB_SPIN(cond, bar) do { unsigned _sp = 0; while (cond) { __builtin_amdgcn_s_sleep(1); \
    if ((++_sp & 255u) == 0u) { if (xb_ld(&(bar)[XB_TMO])) break; if (_sp > XB_SPIN_CAP) { atomicAdd(&(bar)[XB_TMO], 1u); break; } } } } while (0)

struct XcdBarrier {
    unsigned* bar; unsigned x;
    volatile LAS unsigned* st;
};

__device__ __forceinline__ XcdBarrier xcd_barrier_post(unsigned* bar, volatile LAS unsigned* st) {
    XcdBarrier b; b.bar = bar; b.x = xb_xcc_id(); b.st = st;
    if (threadIdx.x == 0) (void)xb_add(&bar[XB_XCNT(b.x)], 1u);
    return b;
}
__device__ __forceinline__ void xcd_barrier_complete(unsigned* bar, unsigned x, unsigned& nloc, unsigned& nx) {
    const unsigned G = gridDim.x * gridDim.y * gridDim.z;
    unsigned sum, cnt, mine, sp = 0u;
    for (;;) {
        sum = 0u; cnt = 0u; mine = 0u;
#pragma unroll
        for (unsigned j = 0; j < 16; ++j) { const unsigned c = xb_ld(&bar[XB_XCNT(j)]); sum += c; cnt += (c > 0u) ? 1u : 0u; mine = (j == x) ? c : mine; }
        if (sum == G) break;
        __builtin_amdgcn_s_sleep(1);
        if ((++sp & 255u) == 0u) { if (xb_ld(&bar[XB_TMO])) break; if (sp > XB_SPIN_CAP) { atomicAdd(&bar[XB_TMO], 1u); break; } }
    }
    nloc = mine > 0u ? mine : 1u; nx = cnt > 0u ? cnt : 1u;
}

__device__ __forceinline__ void xcd_barrier(const XcdBarrier& b) {
    asm volatile("s_waitcnt vmcnt(0)" ::: "memory");
    __syncthreads();
    if (threadIdx.x == 0) {
        unsigned* bar = b.bar;
        __builtin_amdgcn_s_waitcnt(0);
        unsigned nloc = b.st[0], nx = b.st[1];
        if (nloc == 0u) { xcd_barrier_complete(bar, b.x, nloc, nx); b.st[0] = nloc; b.st[1] = nx; }
        const unsigned old = xb_add(&bar[XB_XSUB(b.x)], 1u);
        const unsigned gen = old / nloc;
        if (old + 1u == (gen + 1u) * nloc) {
            __builtin_amdgcn_fence(__ATOMIC_RELEASE, "agent");
            asm volatile("s_waitcnt vmcnt(0)" ::: "memory");
            const unsigned og = xb_add(&bar[XB_TOP], 1u);
            const unsigned tg = og / nx;
            if (og + 1u == (tg + 1u) * nx) xb_add(&bar[XB_TOPGEN], 1u);
            else XB_SPIN(xb_ld(&bar[XB_TOPGEN]) == tg, bar);
            __builtin_amdgcn_fence(__ATOMIC_ACQUIRE, "agent");
            xb_add(&bar[XB_XGEN(b.x)], 1u);
            asm volatile("s_waitcnt vmcnt(0)" ::: "memory");
        } else {
            XB_SPIN(xb_ld(&bar[XB_XGEN(b.x)]) == gen, bar);
            __builtin_amdgcn_fence(__ATOMIC_ACQUIRE, "agent");
            asm volatile("s_waitcnt vmcnt(0)" ::: "memory");
        }
    }
    __syncthreads();
}

#define DI __device__ __forceinline__
typedef unsigned short bf16_t;
typedef short bf16x8 __attribute__((ext_vector_type(8)));
typedef short s16x4 __attribute__((ext_vector_type(4)));
typedef float f32x4 __attribute__((ext_vector_type(4)));
typedef float f32x16 __attribute__((ext_vector_type(16)));
typedef unsigned u32x4 __attribute__((ext_vector_type(4)));
typedef unsigned u32x2 __attribute__((ext_vector_type(2)));

#ifndef SKIP_ATTN
#define SKIP_ATTN 0
#endif
#ifndef SKIP_SGU
#define SKIP_SGU 0
#endif
#ifndef SKIP_MOE
#define SKIP_MOE 0
#endif
#ifndef PH_MASK
#define PH_MASK 0x3ff
#endif
#define PH(x) ((PH_MASK >> (x)) & 1)
#ifndef REP_PH
#define REP_PH -1
#endif
#define NREP(x) ((x) == REP_PH ? 2 : 1)
#ifndef NO_P6A
#define NO_P6A 0
#endif
#ifndef NO_P6B
#define NO_P6B 0
#endif
#ifndef STAG1
#define STAG1 0
#endif
#ifndef STAG8
#define STAG8 0
#endif
#ifndef STAG4
#define STAG4 0
#endif
#ifndef STAG5
#define STAG5 0
#endif
#ifndef ATT_TWICE
#define ATT_TWICE 1
#endif
#ifndef ATT_REP_W
#define ATT_REP_W 1
#endif
#ifndef ATT_REP_C
#define ATT_REP_C 1
#endif
#ifndef ATT_REP_S
#define ATT_REP_S 1
#endif
#ifndef PROBE_PH
#define PROBE_PH -1
#endif
#define DBL(x) ((x) == PROBE_PH ? 2 : 1)
#ifndef MOE_GATHER
#define MOE_GATHER 1
#endif
#ifndef Y_FP8
#define Y_FP8 1
#endif
#ifndef MOE_FP8
#define MOE_FP8 1
#endif
#ifndef ATTN_BRANCHES
#define ATTN_BRANCHES 7
#endif

constexpr int NB = 4, SEQ = 8192, MTOK = NB * SEQ, DM = 1024;
constexpr int DIN = 4376, NPROJ = 4608;
constexpr int NEXP = 32, DFF = 1024;
constexpr int MPAD = 131072 + 32 * 256;
constexpr float LOG2E = 1.4426950408889634f;
constexpr float QSCALE = 0.125f * LOG2E;
constexpr float NEGBIG = -1e30f;
constexpr float SC_W8 = 64.f, SC_A8 = 8.f, SC_ACT8 = 4.f, SC_Y8 = 32.f;

constexpr size_t MiB = 1u << 20;
constexpr size_t WS_CTL = 0;
constexpr size_t CTL_CNT = 0;
constexpr size_t CTL_TE = 64 * 1024;
constexpr size_t CTL_NT = 96 * 1024;
constexpr size_t CTL_C1 = 128 * 1024;
constexpr size_t CTL_BAR = 256 * 1024;
constexpr size_t WS_WIN = 1 * MiB, WS_WAB = 10 * MiB, WS_WOUT = 12 * MiB, WS_W1K = 14 * MiB, WS_W1V = 14 * MiB + 512 * 1024;
constexpr size_t WS_W2K = 15 * MiB, WS_W2V = 15 * MiB + 64 * 1024, WS_WTRIL = 15 * MiB + 512 * 1024;
constexpr size_t WS_WGU = 16 * MiB, WS_WD = 144 * MiB, WS_X2 = 208 * MiB;
constexpr size_t WS_H1 = 336 * MiB, WS_Q = 400 * MiB, WS_KV = 432 * MiB, WS_U = 480 * MiB, WS_V = 512 * MiB, WS_MG = 544 * MiB;
constexpr size_t WS_NG = 672 * MiB, WS_KCMP = 676 * MiB, WS_VCMP = 676 * MiB + 512 * 1024, WS_YAB = 678 * MiB, WS_MERGED = 742 * MiB;
constexpr size_t WS_VT = 806 * MiB;
constexpr size_t WS_AS = 336 * MiB, WS_Y = 336 * MiB, WS_ACT = 608 * MiB, WS_H2 = 608 * MiB;
constexpr size_t WS_TOKE = 880 * MiB, WS_TOKW = 881 * MiB, WS_SLOT = 882 * MiB, WS_WSLOT = 883 * MiB;
constexpr size_t WS_RINV = 884 * MiB;
constexpr size_t WS_WRT = 885 * MiB;
constexpr size_t WS_STOK = 886 * MiB;
constexpr size_t WS_RSLOT = 887 * MiB;
constexpr size_t WS_END = 888 * MiB;

constexpr int LDS_BYTES = 155648;
constexpr int NWAVES = 8, NTHREADS = 512;

struct Args { const float* in[26]; float* out; unsigned char* ws; };

DI float bf2f(unsigned b) { return __uint_as_float(b << 16); }
DI unsigned pk2(float lo, float hi) {
    typedef float f2_t __attribute__((ext_vector_type(2))); typedef __bf16 b2_t __attribute__((ext_vector_type(2)));
    f2_t v = {lo, hi}; b2_t b = __builtin_convertvector(v, b2_t); return __builtin_bit_cast(unsigned, b);
}
DI unsigned pk4_fp8(float a, float b, float c, float d) { int w = 0; w = __builtin_amdgcn_cvt_pk_fp8_f32(a, b, w, false); w = __builtin_amdgcn_cvt_pk_fp8_f32(c, d, w, true); return (unsigned)w; }
DI unsigned short f2bf(float x) { return (unsigned short)(pk2(x, 0.f) & 0xffffu); }
DI float ex2(float x) { return __builtin_amdgcn_exp2f(x); }
DI float rcpf_(float x) { return __builtin_amdgcn_rcpf(x); }
DI float sigm(float x) { return rcpf_(1.f + ex2(-LOG2E * x)); }
DI float gelu_t(float x) { const float u = 0.7978845608028654f * (x + 0.044715f * x * x * x); return x * rcpf_(1.f + ex2(-2.f * LOG2E * u)); }
typedef float f32x2 __attribute__((ext_vector_type(2)));
DI f32x2 ex2_2(f32x2 x) { f32x2 r; r.x = ex2(x.x); r.y = ex2(x.y); return r; }
DI f32x2 rcp_2(f32x2 x) { f32x2 r; r.x = rcpf_(x.x); r.y = rcpf_(x.y); return r; }
DI f32x2 sigm2(f32x2 x) { return rcp_2(ex2_2(x * (-LOG2E)) + 1.0f); }
DI f32x2 gelu_t2(f32x2 x) { const f32x2 x2 = x * x; const f32x2 u = x * (x2 * (0.7978845608028654f * 0.044715f * -2.f * LOG2E) + (0.7978845608028654f * -2.f * LOG2E)); return x * rcp_2(ex2_2(u) + 1.0f); }
DI float wave_sum(float v) {
#pragma unroll
    for (int o = 1; o < 64; o <<= 1) v += __shfl_xor(v, o);
    return v;
}
DI float wave_max(float v) {
#pragma unroll
    for (int o = 1; o < 64; o <<= 1) v = fmaxf(v, __shfl_xor(v, o));
    return v;
}
DI float xmax32(float v) {
    const unsigned u = __float_as_uint(v); auto rr = __builtin_amdgcn_permlane32_swap(u, u, false, false);
    return fmaxf(__uint_as_float(rr[0]), __uint_as_float(rr[1]));
}
DI float xsum32(float v) {
    const unsigned u = __float_as_uint(v); auto rr = __builtin_amdgcn_permlane32_swap(u, u, false, false);
    return __uint_as_float(rr[0]) + __uint_as_float(rr[1]);
}
DI int crow(int i, int h) { return (i & 3) + 8 * (i >> 2) + 4 * h; }
#define MFMA32(a, b, c) __builtin_amdgcn_mfma_f32_32x32x16_bf16((a), (b), (c), 0, 0, 0)
DI LAS unsigned char* lds_raw_las(unsigned char* p) { return (LAS unsigned char*)p; }
DI void stagger_us(int bx, int us) {
    if ((bx >> 3) & 1) {
        const unsigned long long t0 = __builtin_amdgcn_s_memrealtime();
        while (__builtin_amdgcn_s_memrealtime() - t0 < (unsigned long long)(us * 100)) __builtin_amdgcn_s_sleep(8);
    }
}
DI void lds_wait() { asm volatile("s_waitcnt lgkmcnt(0)" ::: "memory"); }

struct TItem { const float* W; bf16_t* WT; const float* ks; int K, N, k0, n0, map, f8, ldk, koff; };
DI int map_row(int map, int n) {
    if (map == 0) return n;
    if (map == 1) return n + 1024;
    if (map == 2) return n < 1280 ? n : (n < 1304 ? n + 3072 : n - 24);
    return n < 1024 ? ((n >> 7) * 256 + (n & 127)) : ((((n - 1024) >> 7) * 256) + 128 + (n & 127));
}
DI void titem_decode(const Args& a, int it, TItem& t) {
    unsigned char* ws = a.ws;
    constexpr int I_WIN = 16 * 137, I_WA = 8 * 32, I_WO = 16 * 32, I_W1 = 32 * 4, I_W2 = 2 * 2, I_GU1 = 16 * 64, I_GU = 32 * I_GU1, I_D1 = 16 * 32, I_D = 32 * I_D1;
    int r = it; t.ks = nullptr; t.map = 0; t.f8 = 0; t.ldk = 0; t.koff = 0;
    if (r < I_GU) { const int e = r / I_GU1; r -= e * I_GU1; t.W = a.in[21] + (size_t)e * 1024 * 2048; t.WT = (bf16_t*)(ws + WS_WGU + (size_t)e * 2048 * 1024 * (MOE_FP8 ? 1 : 2)); t.K = 1024; t.N = 2048; t.map = 3; t.f8 = MOE_FP8; }
    else if ((r -= I_GU) < I_D) { const int e = r / I_D1; r -= e * I_D1; t.W = a.in[23] + (size_t)e * 1024 * 1024; t.WT = (bf16_t*)(ws + WS_WD + (size_t)e * 1024 * 1024 * (MOE_FP8 ? 1 : 2)); t.K = 1024; t.N = 1024; t.f8 = MOE_FP8; }
    else if ((r -= I_D) < I_WIN) { t.W = a.in[2]; t.WT = (bf16_t*)(ws + WS_WIN); t.K = 1024; t.N = DIN; t.map = 2; t.ks = a.in[1]; }
    else if ((r -= I_WIN) < I_WA) { t.W = a.in[15]; t.WT = (bf16_t*)(ws + WS_WAB); t.K = 512; t.N = 1024; t.ldk = 1024; }
    else if ((r -= I_WA) < I_WA) { t.W = a.in[16]; t.WT = (bf16_t*)(ws + WS_WAB); t.K = 512; t.N = 1024; t.ldk = 1024; t.koff = 512; }
    else if ((r -= I_WA) < I_WO) { t.W = a.in[17]; t.WT = (bf16_t*)(ws + WS_WOUT); t.K = 1024; t.N = 1024; }
    else if ((r -= I_WO) < I_W1) { t.W = a.in[3]; t.WT = (bf16_t*)(ws + WS_W1K); t.K = 2048; t.N = 128; }
    else if ((r -= I_W1) < I_W1) { t.W = a.in[7]; t.WT = (bf16_t*)(ws + WS_W1V); t.K = 2048; t.N = 128; }
    else if ((r -= I_W1) < I_W2) { t.W = a.in[5]; t.WT = (bf16_t*)(ws + WS_W2K); t.K = 128; t.N = 64; }
    else { r -= I_W2; t.W = a.in[9]; t.WT = (bf16_t*)(ws + WS_W2V); t.K = 128; t.N = 64; }
    const int nblk = (t.N + 31) >> 5; int kb, nb;
    if (t.f8) { const int q = r >> 1; kb = 2 * (q / nblk) + (r & 1); nb = q % nblk; }
    else { kb = r / nblk; nb = r - kb * nblk; }
    t.k0 = 64 * kb; t.n0 = 32 * nb; if (t.ldk == 0) t.ldk = t.K;
}
DI void titem_load(const TItem& t, int lane, float (&v)[32]) {
    const int ncol = t.n0 + (lane & 31); const bool ok = ncol < t.N;
    const float* p = t.W + (size_t)(t.k0 + (lane >> 5)) * t.N + (ok ? ncol : 0);
#pragma unroll
    for (int i = 0; i < 32; ++i) v[i] = __builtin_nontemporal_load(p + (size_t)(2 * i) * t.N);
    if (!ok) {
#pragma unroll
        for (int i = 0; i < 32; ++i) v[i] = 0.f;
    }
}
DI void titem_process(const TItem& t, int lane, float (&v)[32], LAS float* scr) {
    if (t.ks) {
#pragma unroll
        for (int i = 0; i < 32; ++i) v[i] *= t.ks[t.k0 + 2 * i + (lane >> 5)];
    }
#pragma unroll
    for (int i = 0; i < 32; ++i) scr[(2 * i + (lane >> 5)) * 33 + (lane & 31)] = v[i];
    lds_wait();
    const int c = lane & 7;
#pragma unroll
    for (int j = 0; j < 4; ++j) {
        const int nl = (lane >> 3) + 8 * j, n = t.n0 + nl;
        const LAS float* s = scr + (8 * c) * 33 + nl;
        if (t.f8) {
            u32x2 o; o.x = pk4_fp8(s[0 * 33] * SC_W8, s[1 * 33] * SC_W8, s[2 * 33] * SC_W8, s[3 * 33] * SC_W8); o.y = pk4_fp8(s[4 * 33] * SC_W8, s[5 * 33] * SC_W8, s[6 * 33] * SC_W8, s[7 * 33] * SC_W8);
            if (n < t.N) *(u32x2*)((unsigned char*)t.WT + (size_t)map_row(t.map, n) * t.ldk + t.koff + t.k0 + 8 * c) = o;
        } else {
            u32x4 o; o.x = pk2(s[0 * 33], s[1 * 33]); o.y = pk2(s[2 * 33], s[3 * 33]); o.z = pk2(s[4 * 33], s[5 * 33]); o.w = pk2(s[6 * 33], s[7 * 33]);
            if (n < t.N) *(u32x4*)(t.WT + (size_t)map_row(t.map, n) * t.ldk + t.koff + t.k0 + 8 * c) = o;
        }
    }
    lds_wait();
}

DI void p0_prep(const Args& a, LAS unsigned char* lds, int gw, int NGW, int wave, int lane) {
    asm volatile("" : "+v"(lane));
    unsigned char* ws = a.ws;
    LAS float* scr = (LAS float*)(lds + wave * 8704);
    {
        constexpr int NIT = 16 * 137 + 2 * 8 * 32 + 16 * 32 + 2 * 32 * 4 + 2 * 2 * 2 + 32 * 16 * 64 + 32 * 16 * 32;
        TItem ta, tb; float va[32], vb[32];
        constexpr int NITX = NIT * DBL(0);
        int it = gw;
        if (it < NITX) { titem_decode(a, it % NIT, ta); titem_load(ta, lane, va); }
        while (it < NITX) {
            int nx = it + NGW;
            if (nx < NITX) { titem_decode(a, nx % NIT, tb); titem_load(tb, lane, vb); }
            titem_process(ta, lane, va, scr);
            it = nx; if (it >= NITX) break;
            nx = it + NGW;
            if (nx < NITX) { titem_decode(a, nx % NIT, ta); titem_load(ta, lane, va); }
            titem_process(tb, lane, vb, scr);
            it = nx;
        }
    }
    {
        const float* x = a.in[0]; bf16_t* H1 = (bf16_t*)(ws + WS_H1);
        for (int m0 = 2 * gw; m0 < MTOK * DBL(0); m0 += 2 * NGW) {
            const int m = m0 % MTOK;
            const f32x4* xr = (const f32x4*)(x + (size_t)m * DM) + lane;
            f32x4 v[8]; float s0 = 0.f, s1 = 0.f;
#pragma unroll
            for (int j = 0; j < 8; ++j) v[j] = __builtin_nontemporal_load(xr + 64 * j);
#pragma unroll
            for (int j = 0; j < 4; ++j) { s0 += (v[j].x * v[j].x + v[j].y * v[j].y) + (v[j].z * v[j].z + v[j].w * v[j].w); s1 += (v[4 + j].x * v[4 + j].x + v[4 + j].y * v[4 + j].y) + (v[4 + j].z * v[4 + j].z + v[4 + j].w * v[4 + j].w); }
            const float r0 = 1.0f / sqrtf(wave_sum(s0) * (1.f / DM) + 1e-5f), r1 = 1.0f / sqrtf(wave_sum(s1) * (1.f / DM) + 1e-5f);
            u32x2* o = (u32x2*)(H1 + (size_t)m * DM) + lane;
#pragma unroll
            for (int j = 0; j < 8; ++j) { const float rr = j < 4 ? r0 : r1; u32x2 w; w.x = pk2(v[j].x * rr, v[j].y * rr); w.y = pk2(v[j].z * rr, v[j].w * rr); o[64 * j] = w; }
        }
    }
    {
        float* C1 = (float*)(ws + WS_CTL + CTL_C1);
        for (int o = gw; o < 256; o += NGW) {
            const int ty = o >> 7, f = o & 127; const float* pe = a.in[ty ? 10 : 6]; const float* w1 = a.in[ty ? 7 : 3]; const float* b1 = a.in[ty ? 8 : 4];
            float s = 0.f;
            for (int k = lane; k < 2048; k += 64) s += pe[k] * w1[(size_t)k * 128 + f];
            s = wave_sum(s);
            if (lane == 0) C1[o] = s + b1[f];
        }
    }
    {
        const float* wr = a.in[19]; const float* gm = a.in[18]; bf16_t* WRT = (bf16_t*)(ws + WS_WRT);
        for (int i = gw * 64 + lane; i < 32 * 1024; i += NGW * 64) { const int e = i >> 10, k = i & 1023; const float w = wr[k * 32 + e] * gm[k];
            const unsigned short hi = f2bf(w); WRT[i] = hi; WRT[32 * 1024 + i] = f2bf(w - bf2f(hi)); }
    }
    {
        const float* wsp = a.in[13]; bf16_t* WT = (bf16_t*)(ws + WS_WTRIL);
        for (int i = gw * 64 + lane; i < 8 * 128 * 128; i += NGW * 64) { const int t = (i >> 7) & 127, s = i & 127; WT[i] = f2bf(s <= t ? wsp[i] : 0.f); }
    }
}

typedef pg8::f32x4 pf4;
template <class S> struct Twice {
    S s; int n, rep;
    DI void init() { pg8::Unit u; n = 0; while (s.next(n, u)) ++n; }
    DI bool next(int i, pg8::Unit& u) const { return i < rep * n && s.next(i >= n ? i - n : i, u); }
    DI void a_ready(const pg8::Unit&) const {}
    DI void done(const pg8::Unit&) const {}
};
struct Epi1 {
    static constexpr bool PERM = true, AFTER_DRAIN = false, MIDK = false, PREFETCH = false;
    bf16_t *Q, *KV, *U, *V, *MG; float* NG;
    DI void operator()(const pf4 (&acc)[2][2][4][2], const pg8::Unit& u, int wr, int wc, int fr, int fq) const {
        const int row0 = u.pm * 256 + wr * 64 + fr, pn = u.pn, c0 = wc * 32 + 8 * fq;
        if (pn == 17) {
            if (wc == 0 && fq < 3) {
#pragma unroll
                for (int ai = 0; ai < 2; ++ai)
#pragma unroll
                    for (int m = 0; m < 4; ++m) { float* p = NG + (size_t)(row0 + ai * 128 + m * 16) * 24 + c0; const pf4 v0 = acc[ai][0][m][0], v1 = acc[ai][0][m][1];
                        *(f32x4*)p = (f32x4){sigm(v0[0]), sigm(v0[1]), sigm(v0[2]), sigm(v0[3])}; *(f32x4*)(p + 4) = (f32x4){sigm(v1[0]), sigm(v1[1]), sigm(v1[2]), sigm(v1[3])}; }
            }
            return;
        }
        bf16_t* base; int ldc, ct, mode;
        float sc = 1.f;
        if (pn < 2) { base = Q; ldc = 512; ct = pn; mode = 0; sc = QSCALE; }
        else if (pn < 5) { base = KV; ldc = 768; ct = pn - 2; mode = 0; }
        else if (pn < 7) { base = U; ldc = 512; ct = pn - 5; mode = 1; }
        else if (pn < 9) { base = V; ldc = 512; ct = pn - 7; mode = 1; }
        else { base = MG; ldc = 2048; ct = pn - 9; mode = 2; }
#pragma unroll
        for (int ai = 0; ai < 2; ++ai)
#pragma unroll
            for (int m = 0; m < 4; ++m) {
                bf16_t* rowp = base + (size_t)(row0 + ai * 128 + m * 16) * ldc + ct * 256 + c0;
#pragma unroll
                for (int bj = 0; bj < 2; ++bj) {
                    pf4 v0 = acc[ai][bj][m][0], v1 = acc[ai][bj][m][1];
                    if (mode == 0) { v0 = v0 * sc; v1 = v1 * sc; }
                    else if (mode == 1) { const f32x2 a = gelu_t2((f32x2){v0[0], v0[1]}), b = gelu_t2((f32x2){v0[2], v0[3]}), c = gelu_t2((f32x2){v1[0], v1[1]}), d = gelu_t2((f32x2){v1[2], v1[3]});
                        v0 = (pf4){a.x, a.y, b.x, b.y}; v1 = (pf4){c.x, c.y, d.x, d.y}; }
                    else { const f32x2 a = sigm2((f32x2){v0[0], v0[1]}), b = sigm2((f32x2){v0[2], v0[3]}), c = sigm2((f32x2){v1[0], v1[1]}), d = sigm2((f32x2){v1[2], v1[3]});
                        v0 = (pf4){a.x, a.y, b.x, b.y}; v1 = (pf4){c.x, c.y, d.x, d.y}; }
                    u32x4 w; w.x = pk2(v0[0], v0[1]); w.y = pk2(v0[2], v0[3]); w.z = pk2(v1[0], v1[1]); w.w = pk2(v1[2], v1[3]);
                    *(u32x4*)(rowp + bj * 128) = w;
                }
            }
    }
};
struct Epi4 {
    static constexpr bool PERM = true, AFTER_DRAIN = false, MIDK = true, PREFETCH = false;
    const bf16_t* MG; bf16_t* OUT;
    DI void prefetch(const pg8::Unit& u, LAS unsigned char* scratch, int tid) const {
#pragma unroll
        for (int q = 0; q < 4; ++q) { const int ln = tid + q * NTHREADS, row = ln >> 3, part = ln & 7;
            const bf16_t* p = MG + (size_t)(u.pm * 256 + row) * 2048 + (part >> 2) * 1024 + u.pn * 256 + (part & 3) * 64;
            __builtin_amdgcn_global_load_lds((const unsigned*)p, (LAS unsigned*)(scratch + (tid >> 6) * 256), 4, 0, 0); }
    }
    DI void midk(pf4 (&acc)[2][2][4][2], const pg8::Unit& u, int wr, int wc, int fr, int fq) const {
        const int row0 = u.pm * 256 + wr * 64 + fr, c0 = u.pn * 256 + wc * 32 + 8 * fq;
#pragma unroll
        for (int ai = 0; ai < 2; ++ai)
#pragma unroll
            for (int mh = 0; mh < 2; ++mh) {
                u32x4 ga[2][2], gb[2][2];
#pragma unroll
                for (int mm = 0; mm < 2; ++mm)
#pragma unroll
                    for (int bj = 0; bj < 2; ++bj) { const bf16_t* gp = MG + (size_t)(row0 + ai * 128 + (2 * mh + mm) * 16) * 2048 + c0 + bj * 128; ga[mm][bj] = __builtin_nontemporal_load((const u32x4*)gp); gb[mm][bj] = *(const u32x4*)(gp + 1024); }
#pragma unroll
                for (int mm = 0; mm < 2; ++mm)
#pragma unroll
                    for (int bj = 0; bj < 2; ++bj) {
                        const u32x4 a = ga[mm][bj], b = gb[mm][bj]; pf4& v0 = acc[ai][bj][2 * mh + mm][0]; pf4& v1 = acc[ai][bj][2 * mh + mm][1];
                        v0[0] *= bf2f(a.x & 0xffffu) * rcpf_(fmaxf(bf2f(b.x & 0xffffu), 1e-6f)); v0[1] *= bf2f(a.x >> 16) * rcpf_(fmaxf(bf2f(b.x >> 16), 1e-6f));
                        v0[2] *= bf2f(a.y & 0xffffu) * rcpf_(fmaxf(bf2f(b.y & 0xffffu), 1e-6f)); v0[3] *= bf2f(a.y >> 16) * rcpf_(fmaxf(bf2f(b.y >> 16), 1e-6f));
                        v1[0] *= bf2f(a.z & 0xffffu) * rcpf_(fmaxf(bf2f(b.z & 0xffffu), 1e-6f)); v1[1] *= bf2f(a.z >> 16) * rcpf_(fmaxf(bf2f(b.z >> 16), 1e-6f));
                        v1[2] *= bf2f(a.w & 0xffffu) * rcpf_(fmaxf(bf2f(b.w & 0xffffu), 1e-6f)); v1[3] *= bf2f(a.w >> 16) * rcpf_(fmaxf(bf2f(b.w >> 16), 1e-6f));
                    }
            }
    }
    DI void operator()(const pf4 (&acc)[2][2][4][2], const pg8::Unit& u, int wr, int wc, int fr, int fq) const {
        const int row0 = u.pm * 256 + wr * 64 + fr, c0 = u.pn * 256 + wc * 32 + 8 * fq;
#pragma unroll
        for (int ai = 0; ai < 2; ++ai) {
            u32x4 gb[4][2];
#pragma unroll
            for (int m = 0; m < 4; ++m)
#pragma unroll
                for (int bj = 0; bj < 2; ++bj) gb[m][bj] = __builtin_nontemporal_load((const u32x4*)(MG + (size_t)(row0 + ai * 128 + m * 16) * 2048 + 1024 + c0 + bj * 128));
#pragma unroll
            for (int m = 0; m < 4; ++m)
#pragma unroll
                for (int bj = 0; bj < 2; ++bj) {
                    const u32x4 b = gb[m][bj]; const pf4 v0 = acc[ai][bj][m][0], v1 = acc[ai][bj][m][1];
                    u32x4 w; w.x = pk2(v0[0] * fmaxf(bf2f(b.x & 0xffffu), 1e-6f), v0[1] * fmaxf(bf2f(b.x >> 16), 1e-6f)); w.y = pk2(v0[2] * fmaxf(bf2f(b.y & 0xffffu), 1e-6f), v0[3] * fmaxf(bf2f(b.y >> 16), 1e-6f));
                    w.z = pk2(v1[0] * fmaxf(bf2f(b.z & 0xffffu), 1e-6f), v1[1] * fmaxf(bf2f(b.z >> 16), 1e-6f)); w.w = pk2(v1[2] * fmaxf(bf2f(b.w & 0xffffu), 1e-6f), v1[3] * fmaxf(bf2f(b.w >> 16), 1e-6f));
                    *(u32x4*)(OUT + (size_t)(row0 + ai * 128 + m * 16) * 1024 + c0 + bj * 128) = w;
                }
        }
    }
};
struct Epi5 {
    static constexpr bool PERM = false, AFTER_DRAIN = false, MIDK = false, PREFETCH = false;
    const float* X; float* X2;
    DI void prefetch(const pg8::Unit& u, LAS unsigned char* scratch, int tid) const {
#pragma unroll
        for (int q = 0; q < 4; ++q) { const int ln = tid + q * NTHREADS, row = ln >> 3, part = ln & 7;
            const float* p = X + (size_t)(u.pm * 256 + row) * DM + u.pn * 256 + part * 32;
            __builtin_amdgcn_global_load_lds((const unsigned*)p, (LAS unsigned*)(scratch + (tid >> 6) * 256), 4, 0, 0); }
    }
    DI void operator()(const pf4 (&acc)[2][2][4][2], const pg8::Unit& u, int wr, int wc, int fr, int fq) const {
        const int row0 = u.pm * 256 + wr * 64 + fr, c0 = u.pn * 256 + wc * 32 + 4 * fq;
#pragma unroll
        for (int ai = 0; ai < 2; ++ai)
#pragma unroll
            for (int mh = 0; mh < 2; ++mh) {
                f32x4 xv[2][2][2];
#pragma unroll
                for (int mm = 0; mm < 2; ++mm)
#pragma unroll
                    for (int bj = 0; bj < 2; ++bj)
#pragma unroll
                        for (int n = 0; n < 2; ++n) xv[mm][bj][n] = __builtin_nontemporal_load((const f32x4*)(X + (size_t)(row0 + ai * 128 + (2 * mh + mm) * 16) * DM + c0 + bj * 128 + n * 16));
#pragma unroll
                for (int mm = 0; mm < 2; ++mm)
#pragma unroll
                    for (int bj = 0; bj < 2; ++bj)
#pragma unroll
                        for (int n = 0; n < 2; ++n) { const pf4 v = acc[ai][bj][2 * mh + mm][n]; const f32x4 x = xv[mm][bj][n];
                            *(f32x4*)(X2 + (size_t)(row0 + ai * 128 + (2 * mh + mm) * 16) * DM + c0 + bj * 128 + n * 16) = (f32x4){x[0] + v[0], x[1] + v[1], x[2] + v[2], x[3] + v[3]}; }
            }
    }
};
struct MoeOrder {
    const int* TE; int NT, npn, G, c;
    DI bool next(int i, pg8::Unit& u) const {
        int mt, pn;
        if ((G & 7) == 0) { const int x = c & 7, jj = i * (G >> 3) + (c >> 3); mt = x + 8 * (jj / npn); pn = jj % npn; }
        else { const int L = i * G + c; mt = L / npn; pn = L % npn; }
        if (mt >= NT) return false;
        const int e = __builtin_amdgcn_readfirstlane(TE[mt]);
        u.pm = mt; u.pn = e * npn + pn; return true;
    }
    DI void a_ready(const pg8::Unit&) const {}
    DI void done(const pg8::Unit&) const {}
};
constexpr int MOE_LIST_OFF = 131072 + 1024, MOE_LIST_MAX = 64;
struct MoeOrderLds {
    const LAS int* list;
    DI bool next(int i, pg8::Unit& u) const {
        if (i >= MOE_LIST_MAX) return false;
        const int v = __builtin_amdgcn_readfirstlane(list[i]);
        if (v < 0) return false;
        u.pm = v & 0xffff; u.pn = v >> 16; return true;
    }
    DI void a_ready(const pg8::Unit&) const {}
    DI void done(const pg8::Unit&) const {}
};
DI MoeOrderLds moe_list_build(const MoeOrder& S, LAS unsigned char* lds, int tid) {
    LAS int* list = (LAS int*)(lds + MOE_LIST_OFF);
    if (tid < MOE_LIST_MAX) {
        int mt, pn;
        if ((S.G & 7) == 0) { const int x = S.c & 7, jj = tid * (S.G >> 3) + (S.c >> 3); mt = x + 8 * (jj / S.npn); pn = jj % S.npn; }
        else { const int L = tid * S.G + S.c; mt = L / S.npn; pn = L % S.npn; }
        list[tid] = (mt < S.NT) ? (mt | ((S.TE[mt] * S.npn + pn) << 16)) : -1;
    }
    __syncthreads();
    return MoeOrderLds{list};
}
struct Epi7 {
    static constexpr bool PERM = true, AFTER_DRAIN = false, MIDK = false, PREFETCH = false;
    const float* BGU; bf16_t* ACT; const float* RS;
    DI void operator()(const pf4 (&acc)[2][2][4][2], const pg8::Unit& u, int wr, int wc, int fr, int fq) const {
        const int e = u.pn >> 3, pn = u.pn & 7, row0 = u.pm * 256 + wr * 64 + fr, c0 = pn * 128 + wc * 32 + 8 * fq;
        const float* bg = BGU + (size_t)e * 2048 + c0; const float* bu = bg + 1024;
        const f32x4 bg0 = *(const f32x4*)bg, bg1 = *(const f32x4*)(bg + 4), bu0 = *(const f32x4*)bu, bu1 = *(const f32x4*)(bu + 4);
        constexpr float ASC = MOE_FP8 ? 1.0f / (SC_A8 * SC_W8) : 1.0f, OSC = MOE_FP8 ? SC_ACT8 : 1.0f;
        float rsv[2][4];
#pragma unroll
        for (int ai = 0; ai < 2; ++ai)
#pragma unroll
            for (int m = 0; m < 4; ++m) rsv[ai][m] = RS ? RS[(size_t)(row0 + ai * 128 + m * 16)] : 1.0f;
#pragma unroll
        for (int ai = 0; ai < 2; ++ai)
#pragma unroll
            for (int m = 0; m < 4; ++m) {
                float r[8];
                const float asr = RS ? ASC * rsv[ai][m] : ASC;
#pragma unroll
                for (int n = 0; n < 2; ++n)
#pragma unroll
                    for (int k2 = 0; k2 < 2; ++k2) {
                        const int k = 2 * k2;
                        const f32x2 ag = {acc[ai][0][m][n][k], acc[ai][0][m][n][k + 1]}, au = {acc[ai][1][m][n][k], acc[ai][1][m][n][k + 1]};
                        const f32x2 bgv = {n ? bg1[k] : bg0[k], n ? bg1[k + 1] : bg0[k + 1]}, buv = {n ? bu1[k] : bu0[k], n ? bu1[k + 1] : bu0[k + 1]};
                        f32x2 g = ag * asr + bgv, u = au * asr + buv;
                        g.x = fminf(g.x, 7.0f); g.y = fminf(g.y, 7.0f);
                        u.x = __builtin_amdgcn_fmed3f(u.x, -7.0f, 7.0f); u.y = __builtin_amdgcn_fmed3f(u.y, -7.0f, 7.0f);
                        const f32x2 rc = rcp_2(ex2_2(g * (-1.702f * LOG2E)) + 1.0f);
                        const f32x2 o = (g * rc) * (u * OSC + OSC);
                        r[n * 4 + k] = o.x; r[n * 4 + k + 1] = o.y;
                    }
                if (MOE_FP8) { u32x2 w; w.x = pk4_fp8(r[0], r[1], r[2], r[3]); w.y = pk4_fp8(r[4], r[5], r[6], r[7]);
                    *(u32x2*)((unsigned char*)ACT + (size_t)(row0 + ai * 128 + m * 16) * DFF + c0) = w; }
                else { u32x4 w; w.x = pk2(r[0], r[1]); w.y = pk2(r[2], r[3]); w.z = pk2(r[4], r[5]); w.w = pk2(r[6], r[7]);
                    *(u32x4*)(ACT + (size_t)(row0 + ai * 128 + m * 16) * DFF + c0) = w; }
            }
    }
};
struct Epi8 {
    static constexpr bool PERM = true, AFTER_DRAIN = false, MIDK = false, PREFETCH = false;
    const float* BD; const float* WSLOT; bf16_t* Y;
    DI void operator()(const pf4 (&acc)[2][2][4][2], const pg8::Unit& u, int wr, int wc, int fr, int fq) const {
        const int e = u.pn >> 2, pn = u.pn & 3, row0 = u.pm * 256 + wr * 64 + fr, c0 = pn * 256 + wc * 32 + 8 * fq;
        f32x4 bv[2][2];
#pragma unroll
        for (int bj = 0; bj < 2; ++bj)
#pragma unroll
            for (int n = 0; n < 2; ++n) bv[bj][n] = *(const f32x4*)(BD + (size_t)e * DM + c0 + bj * 128 + 4 * n);
        float wts[2][4];
#pragma unroll
        for (int ai = 0; ai < 2; ++ai)
#pragma unroll
            for (int m = 0; m < 4; ++m) wts[ai][m] = WSLOT[(size_t)(row0 + ai * 128 + m * 16)];
#pragma unroll
        for (int ai = 0; ai < 2; ++ai)
#pragma unroll
            for (int m = 0; m < 4; ++m) {
                const size_t row = (size_t)(row0 + ai * 128 + m * 16); const float wt = wts[ai][m];
#pragma unroll
                for (int bj = 0; bj < 2; ++bj) {
                    const pf4 v0 = acc[ai][bj][m][0], v1 = acc[ai][bj][m][1]; const f32x4 b0 = bv[bj][0], b1 = bv[bj][1];
                    constexpr float ASC = MOE_FP8 ? 1.0f / (SC_ACT8 * SC_W8) : 1.0f;
                    if (Y_FP8) { const float w8 = wt * SC_Y8; u32x2 w;
                        w.x = pk4_fp8((v0[0] * ASC + b0[0]) * w8, (v0[1] * ASC + b0[1]) * w8, (v0[2] * ASC + b0[2]) * w8, (v0[3] * ASC + b0[3]) * w8);
                        w.y = pk4_fp8((v1[0] * ASC + b1[0]) * w8, (v1[1] * ASC + b1[1]) * w8, (v1[2] * ASC + b1[2]) * w8, (v1[3] * ASC + b1[3]) * w8);
                        *(u32x2*)((unsigned char*)Y + row * DM + c0 + bj * 128) = w; }
                    else {
                    u32x4 w; w.x = pk2((v0[0] * ASC + b0[0]) * wt, (v0[1] * ASC + b0[1]) * wt); w.y = pk2((v0[2] * ASC + b0[2]) * wt, (v0[3] * ASC + b0[3]) * wt);
                    w.z = pk2((v1[0] * ASC + b1[0]) * wt, (v1[1] * ASC + b1[1]) * wt); w.w = pk2((v1[2] * ASC + b1[2]) * wt, (v1[3] * ASC + b1[3]) * wt);
                    *(u32x4*)(Y + row * DM + c0 + bj * 128) = w; }
                }
            }
    }
};

DI void p2_compress_item(const Args& a, LAS unsigned char* lds, int item, int tid, int wave, int lane) {
    asm volatile("" : "+v"(tid), "+v"(lane));
    unsigned char* ws = a.ws;
    const int nt = item & 15, ty = (item >> 4) & 1, g = (item >> 5) & 1, b = item >> 6;
    const bf16_t* KV = (const bf16_t*)(ws + WS_KV);
    const bf16_t* W1 = (const bf16_t*)(ws + (ty ? WS_W1V : WS_W1K));
    const bf16_t* W2 = (const bf16_t*)(ws + (ty ? WS_W2V : WS_W2K));
    const float* C1 = (const float*)(ws + WS_CTL + CTL_C1) + ty * 128;
    bf16_t* OUT = (bf16_t*)(ws + (ty ? WS_VCMP : WS_KCMP)) + (size_t)((b * 2 + g) * 512 + nt * 32) * 64;
    LAS unsigned char* Xs = lds;
    LAS float* Hs = (LAS float*)(lds + 81920);
    LAS unsigned char* Hb = lds + 81920 + 32768;
    const int r = lane & 31, h = lane >> 5;
    const int p0 = 512 * nt, colsrc = ty * 128 + g * 64;
    {
        u32x4 xv[9];
#pragma unroll
        for (int q = 0; q < 9; ++q) { const int i = tid + q * NTHREADS; if (i < 528 * 8) { const int pr = i >> 3, ch = i & 7; int pos = p0 + pr; pos = pos > SEQ - 1 ? SEQ - 1 : pos;
            xv[q] = *(const u32x4*)(KV + (size_t)(b * SEQ + pos) * 768 + colsrc + ch * 8); } }
#pragma unroll
        for (int q = 0; q < 9; ++q) { const int i = tid + q * NTHREADS; if (i < 528 * 8) { const int pr = i >> 3, ch = i & 7; *(LAS u32x4*)(Xs + (pr + (pr >> 4)) * 144 + ch * 16) = xv[q]; } }
    }
    __syncthreads();
    {
        const int ft = wave & 3, kh = wave >> 2;
        f32x16 acc; for (int i = 0; i < 16; ++i) acc[i] = 0.f;
        const bf16_t* wrow = W1 + (size_t)(ft * 32 + r) * 2048 + 8 * h;
        for (int s0 = kh * 64; s0 < kh * 64 + 64; s0 += 16) {
            bf16x8 bw[16];
#pragma unroll
            for (int q = 0; q < 16; ++q) bw[q] = *(const bf16x8*)(wrow + 16 * (s0 + q));
#pragma unroll
            for (int q = 0; q < 16; ++q) {
                const int s = s0 + q, l = s >> 2, d0 = (s & 3) * 16;
                const bf16x8 af = *(const LAS bf16x8*)(Xs + (17 * r + l + (l >> 4)) * 144 + (d0 + 8 * h) * 2);
                acc = MFMA32(af, bw[q], acc);
            }
        }
#pragma unroll
        for (int i = 0; i < 16; ++i) Hs[(kh * 32 + crow(i, h)) * 128 + ft * 32 + r] = acc[i];
    }
    __syncthreads();
    for (int i = tid; i < 32 * 128; i += NTHREADS) {
        const int n = i >> 7, f = i & 127;
        const float v = Hs[n * 128 + f] + Hs[(32 + n) * 128 + f] + C1[f];
        *(LAS unsigned short*)(Hb + n * 272 + f * 2) = f2bf(gelu_t(v));
    }
    __syncthreads();
    if (wave < 2) {
        f32x16 acc; for (int i = 0; i < 16; ++i) acc[i] = 0.f;
        const bf16_t* wrow = W2 + (size_t)(wave * 32 + r) * 128 + 8 * h;
#pragma unroll
        for (int s = 0; s < 8; ++s) {
            const bf16x8 af = *(const LAS bf16x8*)(Hb + r * 272 + (16 * s + 8 * h) * 2);
            const bf16x8 bfr = *(const bf16x8*)(wrow + 16 * s);
            acc = MFMA32(af, bfr, acc);
        }
        if (ty == 0) {
#pragma unroll
            for (int i = 0; i < 16; ++i) OUT[(size_t)crow(i, h) * 64 + wave * 32 + r] = f2bf(acc[i]);
        } else {
            bf16_t* OT = (bf16_t*)(ws + WS_VCMP) + (size_t)(b * 2 + g) * 64 * 512 + (size_t)(wave * 32 + r) * 512 + nt * 32;
#pragma unroll
            for (int i = 0; i < 16; ++i) OT[crow(i, h)] = f2bf(acc[i]);
        }
    }
    __syncthreads();
}

DI void p2_sgu_item(const Args& a, LAS unsigned char* lds, int item, int tid, int wave, int lane) {
    asm volatile("" : "+v"(tid), "+v"(lane));
    unsigned char* ws = a.ws;
    const bf16_t* U = (const bf16_t*)(ws + WS_U); const bf16_t* V = (const bf16_t*)(ws + WS_V);
    const bf16_t* WT = (const bf16_t*)(ws + WS_WTRIL);
    bf16_t* YB = (bf16_t*)(ws + WS_YAB) + 512;
    const float* lng = a.in[11]; const float* lnb = a.in[12]; const float* bs = a.in[14];
    const size_t row0 = (size_t)item * 128;
    LAS unsigned char* VnT = lds;
    const int r = lane & 31, h = lane >> 5;
    {
        const int p = lane & 15, cg = lane >> 4, pos = wave * 16 + p;
        const bf16_t* vrow = V + (row0 + pos) * 512 + cg * 128;
        u32x4 raw[16];
#pragma unroll
        for (int j = 0; j < 16; ++j) raw[j] = *(const u32x4*)(vrow + 8 * j);
        float sm = 0.f;
#pragma unroll
        for (int j = 0; j < 16; ++j) sm += (bf2f(raw[j].x & 0xffffu) + bf2f(raw[j].x >> 16)) + (bf2f(raw[j].y & 0xffffu) + bf2f(raw[j].y >> 16)) + (bf2f(raw[j].z & 0xffffu) + bf2f(raw[j].z >> 16)) + (bf2f(raw[j].w & 0xffffu) + bf2f(raw[j].w >> 16));
        sm += __shfl_xor(sm, 16); sm += __shfl_xor(sm, 32);
        const float mu = sm * (1.f / 512.f);
        float qq = 0.f;
#pragma unroll
        for (int j = 0; j < 16; ++j) {
            const float d0 = bf2f(raw[j].x & 0xffffu) - mu, d1 = bf2f(raw[j].x >> 16) - mu, d2 = bf2f(raw[j].y & 0xffffu) - mu, d3 = bf2f(raw[j].y >> 16) - mu;
            const float d4 = bf2f(raw[j].z & 0xffffu) - mu, d5 = bf2f(raw[j].z >> 16) - mu, d6 = bf2f(raw[j].w & 0xffffu) - mu, d7 = bf2f(raw[j].w >> 16) - mu;
            qq += (d0 * d0 + d1 * d1) + (d2 * d2 + d3 * d3) + (d4 * d4 + d5 * d5) + (d6 * d6 + d7 * d7);
        }
        qq += __shfl_xor(qq, 16); qq += __shfl_xor(qq, 32);
        const float rs = 1.0f / sqrtf(qq * (1.f / 512.f) + 1e-5f);
        const float* gp = lng + cg * 128; const float* bp = lnb + cg * 128;
        LAS unsigned char* wp = VnT + (cg * 128) * 272 + pos * 2;
#pragma unroll
        for (int j = 0; j < 16; ++j) {
            const f32x4 g0 = *(const f32x4*)(gp + 8 * j), g1 = *(const f32x4*)(gp + 8 * j + 4), b0 = *(const f32x4*)(bp + 8 * j), b1 = *(const f32x4*)(bp + 8 * j + 4);
            LAS unsigned char* w8 = wp + (8 * j) * 272;
            *(LAS unsigned short*)(w8 + 0 * 272) = f2bf((bf2f(raw[j].x & 0xffffu) - mu) * rs * g0[0] + b0[0]); *(LAS unsigned short*)(w8 + 1 * 272) = f2bf((bf2f(raw[j].x >> 16) - mu) * rs * g0[1] + b0[1]);
            *(LAS unsigned short*)(w8 + 2 * 272) = f2bf((bf2f(raw[j].y & 0xffffu) - mu) * rs * g0[2] + b0[2]); *(LAS unsigned short*)(w8 + 3 * 272) = f2bf((bf2f(raw[j].y >> 16) - mu) * rs * g0[3] + b0[3]);
            *(LAS unsigned short*)(w8 + 4 * 272) = f2bf((bf2f(raw[j].z & 0xffffu) - mu) * rs * g1[0] + b1[0]); *(LAS unsigned short*)(w8 + 5 * 272) = f2bf((bf2f(raw[j].z >> 16) - mu) * rs * g1[1] + b1[1]);
            *(LAS unsigned short*)(w8 + 6 * 272) = f2bf((bf2f(raw[j].w & 0xffffu) - mu) * rs * g1[2] + b1[2]); *(LAS unsigned short*)(w8 + 7 * 272) = f2bf((bf2f(raw[j].w >> 16) - mu) * rs * g1[3] + b1[3]);
        }
    }
    __syncthreads();
    {
        const int grp = wave;
        for (int tt = 0; tt < 4; ++tt) {
            f32x16 acc[2];
#pragma unroll
            for (int i = 0; i < 16; ++i) { acc[0][i] = 0.f; acc[1][i] = 0.f; }
            const bf16_t* wrow = WT + (size_t)(grp * 128 + tt * 32 + r) * 128 + 8 * h;
            const int nst = 2 * tt + 2;
            u32x2 uu8[2][4];
            { const size_t rowt_ = row0 + tt * 32 + r;
#pragma unroll
              for (int dt = 0; dt < 2; ++dt)
#pragma unroll
                  for (int q4 = 0; q4 < 4; ++q4) uu8[dt][q4] = *(const u32x2*)(U + rowt_ * 512 + grp * 64 + dt * 32 + 8 * q4 + 4 * h); }
            bf16x8 bw[8];
#pragma unroll
            for (int s = 0; s < 8; ++s) if (s < nst) bw[s] = *(const bf16x8*)(wrow + 16 * s);
#pragma unroll
            for (int s = 0; s < 8; ++s) if (s < nst) {
#pragma unroll
                for (int dt = 0; dt < 2; ++dt) {
                    const bf16x8 af = *(const LAS bf16x8*)(VnT + (grp * 64 + dt * 32 + r) * 272 + (16 * s + 8 * h) * 2);
                    acc[dt] = MFMA32(af, bw[s], acc[dt]);
                }
            }
            const int t = tt * 32 + r; const float bt = bs[grp * 128 + t];
            const size_t rowt = row0 + t;
#pragma unroll
            for (int dt = 0; dt < 2; ++dt)
#pragma unroll
                for (int q4 = 0; q4 < 4; ++q4) {
                    const int d = dt * 32 + 8 * q4 + 4 * h;
                    const u32x2 uu = uu8[dt][q4];
                    const float y0 = bf2f(uu.x & 0xffffu) * (acc[dt][4 * q4 + 0] + bt), y1 = bf2f(uu.x >> 16) * (acc[dt][4 * q4 + 1] + bt);
                    const float y2 = bf2f(uu.y & 0xffffu) * (acc[dt][4 * q4 + 2] + bt), y3 = bf2f(uu.y >> 16) * (acc[dt][4 * q4 + 3] + bt);
                    u32x2 w; w.x = pk2(y0, y1); w.y = pk2(y2, y3);
                    *(u32x2*)(YB + rowt * 1024 + grp * 64 + d) = w;
                }
        }
    }
    __syncthreads();
    {
        const bf16_t* KV = (const bf16_t*)(ws + WS_KV); bf16_t* VT = (bf16_t*)(ws + WS_VT);
        LAS unsigned char* T = lds;
        const int bb = item >> 6, posc = (item & 63) * 128;
        {
            u32x4 vv[8];
#pragma unroll
            for (int q = 0; q < 8; ++q) { const int i = tid + q * NTHREADS, pos = i & 127, ch = i >> 7, ty = ch >> 4, c8 = (ch & 15) * 8;
                vv[q] = *(const u32x4*)(KV + (row0 + pos) * 768 + (ty ? 5 : 3) * 128 + c8); }
#pragma unroll
            for (int q = 0; q < 8; ++q) { const int i = tid + q * NTHREADS, pos = i & 127, ch = i >> 7, ty = ch >> 4, c8 = (ch & 15) * 8; const u32x4 v = vv[q];
                LAS unsigned char* tp = T + (ty * 128 + c8) * 272 + pos * 2;
                *(LAS unsigned short*)(tp + 0 * 272) = (unsigned short)(v.x & 0xffffu); *(LAS unsigned short*)(tp + 1 * 272) = (unsigned short)(v.x >> 16);
                *(LAS unsigned short*)(tp + 2 * 272) = (unsigned short)(v.y & 0xffffu); *(LAS unsigned short*)(tp + 3 * 272) = (unsigned short)(v.y >> 16);
                *(LAS unsigned short*)(tp + 4 * 272) = (unsigned short)(v.z & 0xffffu); *(LAS unsigned short*)(tp + 5 * 272) = (unsigned short)(v.z >> 16);
                *(LAS unsigned short*)(tp + 6 * 272) = (unsigned short)(v.w & 0xffffu); *(LAS unsigned short*)(tp + 7 * 272) = (unsigned short)(v.w >> 16); }
        }
        __syncthreads();
        for (int i = tid; i < 256 * 16; i += NTHREADS) {
            const int rw = i >> 4, ch = i & 15, ty = rw >> 7, gd = rw & 127;
            const u32x4 v = *(const LAS u32x4*)(T + rw * 272 + ch * 16);
            *(u32x4*)(VT + ((size_t)(ty * 4 + bb) * 128 + gd) * SEQ + posc + ch * 8) = v;
        }
        __syncthreads();
    }
}

constexpr int AL_K0 = 0, AL_K1 = 9216, AL_V0 = 18432, AL_V1 = 27136, AL_PB = 35840, AL_IMP = 102400, AL_SELM = 135424, AL_UNI = 136448, AL_BL = 136512, AL_NBL = 137024, AL_THR = 137088;
static_assert(AL_THR + 256 <= LDS_BYTES, "attention LDS map");
struct KVSrc { const bf16_t* k; const bf16_t* v; int kp, vp; };
struct BlkPar { float base, ksl; int lo, hi; };

template <int MODE>
DI void attn_block(const LAS unsigned char* Ks, const LAS unsigned char* Vs, const bf16x8 (&qf)[4], f32x16 (&o)[2], float& m, float& l, float invl, LAS float* pbrow, const BlkPar bp, const bool MASK, const bool first, int r, int h) {
    f32x16 p0, p1;
    {
        const float bh = bp.base + bp.ksl * (float)(4 * h) - m, bh1 = bh + 32.f * bp.ksl;
        const f32x2 ks2 = {bp.ksl, bp.ksl}, b2 = {bh, bh}, b21 = {bh1, bh1};
#pragma unroll
        for (int i = 0; i < 16; i += 2) { const f32x2 kc = {(float)((i & 3) + 8 * (i >> 2)), (float)(((i + 1) & 3) + 8 * ((i + 1) >> 2))};
            const f32x2 a = ks2 * kc + b2, c = ks2 * kc + b21; p0[i] = a.x; p0[i + 1] = a.y; p1[i] = c.x; p1[i + 1] = c.y; }
    }
    {
        bf16x8 kf[8];
#pragma unroll
        for (int s = 0; s < 4; ++s) { kf[2 * s] = *(const LAS bf16x8*)(Ks + r * 144 + s * 32 + h * 16); kf[2 * s + 1] = *(const LAS bf16x8*)(Ks + (32 + r) * 144 + s * 32 + h * 16); }
        __builtin_amdgcn_sched_barrier(0);
#pragma unroll
        for (int s = 0; s < 4; ++s) { p0 = MFMA32(kf[2 * s], qf[s], p0); p1 = MFMA32(kf[2 * s + 1], qf[s], p1); }
    }
    s16x4 vlo[8], vhi[8];
    if (MODE != 1) {
#pragma unroll
        for (int dh = 0; dh < 2; ++dh)
#pragma unroll
            for (int ks = 0; ks < 4; ++ks) { const LAS unsigned char* vp = Vs + (dh * 32 + r) * 136 + ks * 32 + h * 8; vlo[dh * 4 + ks] = *(const LAS s16x4*)vp; vhi[dh * 4 + ks] = *(const LAS s16x4*)(vp + 16); }
        __builtin_amdgcn_sched_barrier(0);
    }
    if (MASK) {
        const int lo = bp.lo - 4 * h, hi = bp.hi - 4 * h;
#pragma unroll
        for (int i = 0; i < 16; ++i) { const int kc = (i & 3) + 8 * (i >> 2); p0[i] = (kc >= lo && kc <= hi) ? p0[i] : NEGBIG; p1[i] = (kc + 32 >= lo && kc + 32 <= hi) ? p1[i] : NEGBIG; }
    }
    if (MODE == 0 || MODE == 1) {
        float mx = fmaxf(p0[0], p1[0]);
#pragma unroll
        for (int i = 1; i < 16; ++i) mx = fmaxf(fmaxf(mx, p0[i]), p1[i]);
        mx = xmax32(mx);
        if (first) {
            m += mx;
#pragma unroll
            for (int i = 0; i < 16; ++i) { p0[i] -= mx; p1[i] -= mx; }
        } else if (__any(mx > 0.f)) {
            const float dl = fmaxf(mx, 0.f), alpha = ex2(-dl); m += dl; l *= alpha;
#pragma unroll
            for (int i = 0; i < 16; ++i) { p0[i] -= dl; p1[i] -= dl; }
            if (MODE == 0) {
#pragma unroll
                for (int i = 0; i < 16; ++i) { o[0][i] *= alpha; o[1][i] *= alpha; }
            }
        }
        if (!first && __all(mx < -40.f)) return;
        float s0 = 0.f, s1 = 0.f;
#pragma unroll
        for (int i = 0; i < 16; ++i) { p0[i] = ex2(p0[i]); p1[i] = ex2(p1[i]); s0 += p0[i]; s1 += p1[i]; }
        l += s0 + s1;
    } else {
#pragma unroll
        for (int i = 0; i < 16; ++i) {
            p0[i] = p0[i] > -1e29f ? ex2(p0[i]) * invl : 0.f; p1[i] = p1[i] > -1e29f ? ex2(p1[i]) * invl : 0.f;
            pbrow[crow(i, h)] = p0[i]; pbrow[32 + crow(i, h)] = p1[i];
        }
    }
    if (MODE != 1) {
        bf16x8 pf[4];
#pragma unroll
        for (int ks = 0; ks < 2; ++ks) {
            u32x4 w0, w1;
            w0.x = pk2(p0[8 * ks + 0], p0[8 * ks + 1]); w0.y = pk2(p0[8 * ks + 2], p0[8 * ks + 3]); w0.z = pk2(p0[8 * ks + 4], p0[8 * ks + 5]); w0.w = pk2(p0[8 * ks + 6], p0[8 * ks + 7]);
            w1.x = pk2(p1[8 * ks + 0], p1[8 * ks + 1]); w1.y = pk2(p1[8 * ks + 2], p1[8 * ks + 3]); w1.z = pk2(p1[8 * ks + 4], p1[8 * ks + 5]); w1.w = pk2(p1[8 * ks + 6], p1[8 * ks + 7]);
            pf[ks] = __builtin_bit_cast(bf16x8, w0); pf[2 + ks] = __builtin_bit_cast(bf16x8, w1);
        }
#pragma unroll
        for (int ks = 0; ks < 4; ++ks)
#pragma unroll
            for (int dh = 0; dh < 2; ++dh) {
                const bf16x8 af = __builtin_shufflevector(vlo[dh * 4 + ks], vhi[dh * 4 + ks], 0, 1, 2, 3, 4, 5, 6, 7);
                o[dh] = MFMA32(af, pf[ks], o[dh]);
            }
    }
}

DI void kv_load(const KVSrc& s, int tid, u32x4& kreg, u32x4& vreg) {
    const int ko = (tid >> 3) * s.kp + (tid & 7) * 8, vo = (tid >> 3) * s.vp + (tid & 7) * 8;
    kreg = *(const u32x4*)(s.k + ko);
    vreg = *(const u32x4*)(s.v + vo);
}
DI void kv_store(LAS unsigned char* Kb, LAS unsigned char* Vb, int tid, const u32x4& kreg, const u32x4& vreg) {
    *(LAS u32x4*)(Kb + (tid >> 3) * 144 + (tid & 7) * 16) = kreg;
    LAS unsigned char* vp = Vb + (tid >> 3) * 136 + (tid & 7) * 16;
    *(LAS u32x2*)vp = (u32x2){vreg.x, vreg.y}; *(LAS u32x2*)(vp + 8) = (u32x2){vreg.z, vreg.w};
}

template <int MODE, class SrcF, class ParF, class PostF>
DI void attn_run(int nb, SrcF src, ParF par, PostF post, LAS unsigned char* lds, const bf16x8 (&qf)[4], f32x16 (&o)[2], float& m, float& l, float invl, LAS float* pbrow,
                 int tid, int r, int h, const bool pre, u32x4& kp, u32x4& vp, const bool want_nxt, const KVSrc nxt) {
    u32x4& kreg = kp; u32x4& vreg = vp;
    if (!pre) kv_load(src(0), tid, kreg, vreg);
    kv_store(lds + AL_K0, lds + AL_V0, tid, kreg, vreg);
    __syncthreads();
    for (int i = 0; i < nb; ++i) {
        const int cur = i & 1;
        if (i + 1 < nb) kv_load(src(i + 1), tid, kreg, vreg);
        else if (want_nxt) kv_load(nxt, tid, kreg, vreg);
        bool msk; const BlkPar bp = par(i, msk);
        attn_block<MODE>(lds + (cur ? AL_K1 : AL_K0), lds + (cur ? AL_V1 : AL_V0), qf, o, m, l, invl, pbrow, bp, msk, i == 0, r, h);
        if (MODE == 2) { __syncthreads(); post(i); }
        if (i + 1 < nb) kv_store(lds + (cur ? AL_K0 : AL_K1), lds + (cur ? AL_V0 : AL_V1), tid, kreg, vreg);
        __syncthreads();
    }
}

#define CE_DESC(a, b) do { const unsigned _x = (a), _y = (b); (a) = _x > _y ? _x : _y; (b) = _x > _y ? _y : _x; } while (0)
DI void sort16_desc(unsigned (&k)[16]) {
#pragma unroll
    for (int kk = 2; kk <= 16; kk <<= 1)
#pragma unroll
        for (int j = kk >> 1; j > 0; j >>= 1)
#pragma unroll
            for (int i = 0; i < 16; ++i) { const int p = i ^ j; if (p > i) { if ((i & kk) == 0) CE_DESC(k[i], k[p]); else CE_DESC(k[p], k[i]); } }
}
DI void merge16_desc(unsigned (&k)[16]) {
#pragma unroll
    for (int j = 8; j > 0; j >>= 1)
#pragma unroll
        for (int i = 0; i < 16; ++i) { const int p = i ^ j; if (p > i) CE_DESC(k[i], k[p]); }
}

DI void attn_tile(const Args& a, LAS unsigned char* lds, int b, int g, int c, int tid, int wave, int lane) {
    asm volatile("" : "+v"(tid), "+v"(lane));
    unsigned char* ws = a.ws;
    const bf16_t* Q = (const bf16_t*)(ws + WS_Q); const bf16_t* KV = (const bf16_t*)(ws + WS_KV);
    const bf16_t* KC = (const bf16_t*)(ws + WS_KCMP) + (size_t)(b * 2 + g) * 512 * 64; const bf16_t* VC = (const bf16_t*)(ws + WS_VCMP) + (size_t)(b * 2 + g) * 64 * 512;
    const float* NG = (const float*)(ws + WS_NG); bf16_t* YA = (bf16_t*)(ws + WS_YAB); const bf16_t* VT = (const bf16_t*)(ws + WS_VT);
    const int r = lane & 31, h = lane >> 5, hd = wave >> 1, th = wave & 1, tl = th * 32 + r, t = 64 * c + tl;
    const size_t row = (size_t)b * SEQ + t;
    const float slope2 = ex2(-(float)(g * 4 + hd + 1)) * LOG2E;
    const float tf = (float)t;
    bf16x8 qf[4];
#pragma unroll
    for (int s = 0; s < 4; ++s) qf[s] = *(const bf16x8*)(Q + row * 512 + g * 256 + hd * 64 + 16 * s + 8 * h);
    const float gate_c = NG[row * 24 + g * 12 + hd * 3 + 0], gate_s = NG[row * 24 + g * 12 + hd * 3 + 1], gate_w = NG[row * 24 + g * 12 + hd * 3 + 2];
    f32x16 tot[2];
    LAS float* IMP = (LAS float*)(lds + AL_IMP);
    LAS float* PB = (LAS float*)(lds + AL_PB);
    LAS float* pbrow = PB + (hd * 64 + tl) * 65;
    const bf16_t* kvb = KV + (size_t)b * SEQ * 768 + g * 64;
    auto nopost = [](int) {};

    const bf16_t* vtw = VT + ((size_t)(4 + b) * 128 + g * 64) * SEQ;
    u32x4 kpre, vpre;
    KVSrc cmp0; cmp0.k = KC; cmp0.v = VC; cmp0.kp = 64; cmp0.vp = 512;
    KVSrc sel0; sel0.k = kvb + (size_t)(64 * c) * 768 + 2 * 128; sel0.v = VT + ((size_t)(0 + b) * 128 + g * 64) * SEQ + 64 * c; sel0.kp = 768; sel0.vp = SEQ;
    const bf16_t* vts = VT + ((size_t)(0 + b) * 128 + g * 64) * SEQ;
    for (int rep = 0; rep < ATT_REP_W; ++rep) {
        const int nb = (c > 8 ? 8 : c) + 1;
        f32x16 o[2];
#pragma unroll
        for (int i = 0; i < 16; ++i) { o[0][i] = 0.f; o[1][i] = 0.f; }
        float m = 0.f, l = 0.f;
        auto src = [=](int i) { const int j = c - i; KVSrc s; s.k = kvb + (size_t)(64 * j) * 768 + 4 * 128; s.v = vtw + 64 * j; s.kp = 768; s.vp = SEQ; return s; };
        auto par = [=](int i, bool& msk) { const int d0 = t - 64 * (c - i); msk = (i == 0) || (i == 8); BlkPar bp; bp.base = -slope2 * (float)d0; bp.ksl = slope2; bp.lo = d0 - 511; bp.hi = d0; return bp; };
        attn_run<0>(nb, src, par, nopost, lds, qf, o, m, l, 0.f, pbrow, tid, r, h, false, kpre, vpre, true, cmp0);
        const float sc = gate_w * rcpf_(xsum32(l));
#pragma unroll
        for (int i = 0; i < 16; ++i) { tot[0][i] = sc * o[0][i]; tot[1][i] = sc * o[1][i]; }
    }
    for (int i = tid; i < 64 * 129; i += NTHREADS) IMP[i] = 0.f;
    for (int rep = 0; rep < ATT_REP_C; ++rep) {
        if (rep > 0) { __syncthreads(); for (int i = tid; i < 64 * 129; i += NTHREADS) IMP[i] = 0.f; }
        const int nbc = (4 * c + 3 + 63) >> 6;
        auto src = [=](int i) { KVSrc s; s.k = KC + (size_t)(64 * i) * 64; s.v = VC + 64 * i; s.kp = 64; s.vp = 512; return s; };
        const int nvalid = ((t - 31) >> 4);
        auto par = [=](int i, bool& msk) { const int n0 = 64 * i; msk = (n0 + 63) > ((64 * c - 31) >> 4);
            BlkPar bp; bp.base = -slope2 * (tf - (float)(16 * n0) - 15.5f); bp.ksl = 16.f * slope2; bp.lo = -1000000; bp.hi = nvalid - n0; return bp; };
        f32x16 o[2];
#pragma unroll
        for (int i = 0; i < 16; ++i) { o[0][i] = 0.f; o[1][i] = 0.f; }
        float m = 0.f, l = 0.f;
        attn_run<1>(nbc, src, par, nopost, lds, qf, o, m, l, 0.f, pbrow, tid, r, h, true, kpre, vpre, true, cmp0);
        const float invl = rcpf_(xsum32(l));
        auto post = [=](int i) {
            for (int q = tid; q < 64 * 17; q += NTHREADS) {
                const int tok = q & 63, jj = q >> 6, j = 16 * i + jj;
                float acc = 0.f;
                if (jj < 16) {
#pragma unroll
                    for (int hh = 0; hh < 4; ++hh) { const LAS float* p = PB + (hh * 64 + tok) * 65 + 4 * jj; acc += (p[0] + p[1]) + (p[2] + 0.5f * p[3]); if (jj > 0) acc += 0.5f * p[-1]; }
                } else {
#pragma unroll
                    for (int hh = 0; hh < 4; ++hh) acc += 0.5f * PB[(hh * 64 + tok) * 65 + 63];
                }
                if (j < 128) IMP[tok * 129 + j] += acc;
            }
        };
        attn_run<2>(nbc, src, par, post, lds, qf, o, m, l, invl, pbrow, tid, r, h, true, kpre, vpre, rep == ATT_REP_C - 1, sel0);
        if (rep == ATT_REP_C - 1)
#pragma unroll
        for (int i = 0; i < 16; ++i) { tot[0][i] += gate_c * o[0][i]; tot[1][i] += gate_c * o[1][i]; }
    }
    __syncthreads();
    if (ATTN_BRANCHES & 4) {
        LAS unsigned* L0 = (LAS unsigned*)(lds + AL_PB);
        LAS unsigned* L1 = L0 + 8 * 16 * 64;
        LAS unsigned* L2 = L1 + 4 * 16 * 64;
        LAS unsigned* THR = (LAS unsigned*)(lds + AL_THR);
        LAS unsigned short* SELM = (LAS unsigned short*)(lds + AL_SELM);
        LAS unsigned* UNI = (LAS unsigned*)(lds + AL_UNI);
        LAS int* BL = (LAS int*)(lds + AL_BL);
        LAS int* NBL = (LAS int*)(lds + AL_NBL);
        const int tok = lane, seg = wave;
        unsigned key[16];
#pragma unroll
        for (int i = 0; i < 16; ++i) {
            const int j = 16 * seg + i;
            const bool forced = (j == 0) || (j == c) || (j == c - 1);
            const unsigned kvv = forced ? 0x1FFFFFFu : (j <= c ? (__float_as_uint(IMP[tok * 129 + j]) >> 7) + 1u : 0u);
            key[i] = (kvv << 7) | (unsigned)(127 - j);
        }
        sort16_desc(key);
#pragma unroll
        for (int i = 0; i < 16; ++i) L0[(seg * 16 + i) * 64 + tok] = key[i];
        __syncthreads();
        if (wave < 4) {
            unsigned kk[16];
#pragma unroll
            for (int i = 0; i < 16; ++i) { const unsigned x = L0[((2 * wave) * 16 + i) * 64 + tok], y = L0[((2 * wave + 1) * 16 + 15 - i) * 64 + tok]; kk[i] = x > y ? x : y; }
            merge16_desc(kk);
#pragma unroll
            for (int i = 0; i < 16; ++i) L1[(wave * 16 + i) * 64 + tok] = kk[i];
        }
        __syncthreads();
        if (wave < 2) {
            unsigned kk[16];
#pragma unroll
            for (int i = 0; i < 16; ++i) { const unsigned x = L1[((2 * wave) * 16 + i) * 64 + tok], y = L1[((2 * wave + 1) * 16 + 15 - i) * 64 + tok]; kk[i] = x > y ? x : y; }
            merge16_desc(kk);
#pragma unroll
            for (int i = 0; i < 16; ++i) L2[(wave * 16 + i) * 64 + tok] = kk[i];
        }
        __syncthreads();
        if (wave == 0) {
            unsigned mn = 0xffffffffu;
#pragma unroll
            for (int i = 0; i < 16; ++i) { const unsigned x = L2[i * 64 + tok], y = L2[(16 + 15 - i) * 64 + tok]; const unsigned z = x > y ? x : y; mn = z < mn ? z : mn; }
            THR[tok] = mn;
        }
        __syncthreads();
        {
            const unsigned T = THR[tok]; unsigned m16 = 0;
#pragma unroll
            for (int i = 0; i < 16; ++i) m16 |= (key[i] >= T) ? (1u << (15 - (key[i] & 15u))) : 0u;
            SELM[tok * 8 + seg] = (unsigned short)m16;
            unsigned uni = 0;
#pragma unroll
            for (int bb = 0; bb < 16; ++bb) uni |= (__ballot((m16 >> bb) & 1u) != 0ull) ? (1u << bb) : 0u;
            if (lane == 0) UNI[seg] = uni;
        }
        __syncthreads();
        if (wave == 0) {
            int base = 0;
#pragma unroll
            for (int half = 0; half < 2; ++half) {
                const int j = half * 64 + lane;
                const bool on = ((UNI[j >> 4] >> (j & 15)) & 1u) && (j <= c);
                const unsigned long long bal = __ballot(on);
                const int pos = base + __builtin_popcountll(bal & ((1ull << lane) - 1ull));
                if (on) BL[pos] = j;
                base += __builtin_popcountll(bal);
            }
            if (lane == 0) NBL[0] = base;
        }
        __syncthreads();
        const int nbs = __builtin_amdgcn_readfirstlane(NBL[0]);
        f32x16 o[2];
#pragma unroll
        for (int i = 0; i < 16; ++i) { o[0][i] = 0.f; o[1][i] = 0.f; }
        float m = 0.f, l = 0.f;
        auto src = [=](int i) { const int j = __builtin_amdgcn_readfirstlane(BL[nbs - 1 - i]); KVSrc s; s.k = kvb + (size_t)(64 * j) * 768 + 2 * 128; s.v = vts + 64 * j; s.kp = 768; s.vp = SEQ; return s; };
        auto par = [=](int i, bool& msk) { const int j = __builtin_amdgcn_readfirstlane(BL[nbs - 1 - i]); const bool sel = (SELM[tl * 8 + (j >> 4)] >> (j & 15)) & 1; const int d0 = t - 64 * j;
            msk = (j == c); BlkPar bp; bp.base = sel ? -slope2 * (float)d0 : NEGBIG; bp.ksl = slope2; bp.lo = -1000000; bp.hi = d0; return bp; };
        for (int rep = 0; rep < ATT_REP_S; ++rep) {
            if (rep > 0) { m = 0.f; l = 0.f;
#pragma unroll
                for (int i = 0; i < 16; ++i) { o[0][i] = 0.f; o[1][i] = 0.f; } }
            attn_run<0>(nbs, src, par, nopost, lds, qf, o, m, l, 0.f, pbrow, tid, r, h, rep == 0, kpre, vpre, false, sel0);
        }
        const float sc = gate_s * rcpf_(xsum32(l));
#pragma unroll
        for (int dh = 0; dh < 2; ++dh)
#pragma unroll
            for (int q4 = 0; q4 < 4; ++q4) {
                const int d = dh * 32 + 8 * q4 + 4 * h;
                u32x2 w; w.x = pk2(tot[dh][4 * q4 + 0] + sc * o[dh][4 * q4 + 0], tot[dh][4 * q4 + 1] + sc * o[dh][4 * q4 + 1]); w.y = pk2(tot[dh][4 * q4 + 2] + sc * o[dh][4 * q4 + 2], tot[dh][4 * q4 + 3] + sc * o[dh][4 * q4 + 3]);
                *(u32x2*)(YA + row * 1024 + g * 256 + hd * 64 + d) = w;
            }
    }
    __syncthreads();
}

DI void p6a_route(const Args& a, LAS unsigned char* lds, int tid, int wave, int lane) {
    asm volatile("" : "+v"(tid), "+v"(lane));
    unsigned char* ws = a.ws;
    const float* X2 = (const float*)(ws + WS_X2); const float* br = a.in[20];
    const bf16_t* WH = (const bf16_t*)(ws + WS_WRT); const bf16_t* WL = WH + 32 * 1024;
    int* TOKE = (int*)(ws + WS_TOKE); float* TOKW = (float*)(ws + WS_TOKW); int* CNT = (int*)(ws + WS_CTL + CTL_CNT); float* RINV = (float*)(ws + WS_RINV);
    LAS unsigned char* WHL = lds; LAS unsigned char* WLL = lds + 65536;
    LAS float* CS = (LAS float*)(lds + 131072 + wave * 2112);
    LAS int* CNTL = (LAS int*)(lds + 131072 + 8 * 2112);
    const int tk = lane & 15, kq = lane >> 4;
    LAS float* GSL = (LAS float*)(lds + 131072 + 8 * 2112 + 128);
    static_assert(131072 + 8 * 2112 + 128 + 4096 <= LDS_BYTES - 16, "router LDS map");
    for (int i = tid; i < DM; i += NTHREADS) GSL[i] = a.in[18][i] * SC_A8;
    for (int i = tid; i < 2 * 32 * 128; i += NTHREADS) {
        const int arr = i >> 12, e = (i >> 7) & 31, ch = i & 127;
        *(LAS u32x4*)(lds + arr * 65536 + e * 2048 + ((ch ^ (e & 15)) * 16)) = *(const u32x4*)(WH + (size_t)arr * 32 * 1024 + e * 1024 + ch * 8);
    }
    __syncthreads();
    const LAS float* GS = GSL;
    for (int blk0 = blockIdx.x; blk0 < 256 * DBL(6); blk0 += gridDim.x) {
        const int blk = blk0 & 255;
        if (tid < 32) CNTL[tid] = 0;
        __syncthreads();
        const int t0 = blk * 128 + wave * 16;
        const float* xp = X2 + (size_t)(t0 + tk) * DM + 8 * kq;
        const LAS unsigned char* wh0 = WHL + tk * 2048; const LAS unsigned char* wl0 = WLL + tk * 2048;
        f32x4 acc0 = {0.f, 0.f, 0.f, 0.f}, acc1 = {0.f, 0.f, 0.f, 0.f}; float ss = 0.f;
        unsigned char* H8 = (unsigned char*)(ws + WS_AS) + (size_t)(t0 + tk) * DM + 8 * kq; const LAS float* gmp = GS + 8 * kq;
#pragma unroll 8
        for (int s = 0; s < 32; ++s) {
            const f32x4 xa = __builtin_nontemporal_load((const f32x4*)(xp + 32 * s)), xb = __builtin_nontemporal_load((const f32x4*)(xp + 32 * s + 4));
            const int wo = ((4 * s + kq) ^ tk) * 16;
            const bf16x8 bh0 = *(const LAS bf16x8*)(wh0 + wo), bl0 = *(const LAS bf16x8*)(wl0 + wo), bh1 = *(const LAS bf16x8*)(wh0 + 16 * 2048 + wo), bl1 = *(const LAS bf16x8*)(wl0 + 16 * 2048 + wo);
            ss += (xa[0] * xa[0] + xa[1] * xa[1]) + (xa[2] * xa[2] + xa[3] * xa[3]) + (xb[0] * xb[0] + xb[1] * xb[1]) + (xb[2] * xb[2] + xb[3] * xb[3]);
            u32x4 hh; hh.x = pk2(xa[0], xa[1]); hh.y = pk2(xa[2], xa[3]); hh.z = pk2(xb[0], xb[1]); hh.w = pk2(xb[2], xb[3]);
            u32x4 lo; lo.x = pk2(xa[0] - bf2f(hh.x & 0xffffu), xa[1] - bf2f(hh.x >> 16)); lo.y = pk2(xa[2] - bf2f(hh.y & 0xffffu), xa[3] - bf2f(hh.y >> 16));
            lo.z = pk2(xb[0] - bf2f(hh.z & 0xffffu), xb[1] - bf2f(hh.z >> 16)); lo.w = pk2(xb[2] - bf2f(hh.w & 0xffffu), xb[3] - bf2f(hh.w >> 16));
            if (MOE_GATHER && MOE_FP8) {
                const f32x4 ga = *(const LAS f32x4*)(gmp + 32 * s), gb = *(const LAS f32x4*)(gmp + 32 * s + 4);
                u32x2 w; w.x = pk4_fp8(xa[0] * ga[0], xa[1] * ga[1], xa[2] * ga[2], xa[3] * ga[3]); w.y = pk4_fp8(xb[0] * gb[0], xb[1] * gb[1], xb[2] * gb[2], xb[3] * gb[3]);
                *(u32x2*)(H8 + 32 * s) = w;
            }
            const bf16x8 ah = __builtin_bit_cast(bf16x8, hh), al = __builtin_bit_cast(bf16x8, lo);
            acc0 = __builtin_amdgcn_mfma_f32_16x16x32_bf16(bh0, ah, acc0, 0, 0, 0); acc0 = __builtin_amdgcn_mfma_f32_16x16x32_bf16(bl0, ah, acc0, 0, 0, 0); acc0 = __builtin_amdgcn_mfma_f32_16x16x32_bf16(bh0, al, acc0, 0, 0, 0);
            acc1 = __builtin_amdgcn_mfma_f32_16x16x32_bf16(bh1, ah, acc1, 0, 0, 0); acc1 = __builtin_amdgcn_mfma_f32_16x16x32_bf16(bl1, ah, acc1, 0, 0, 0); acc1 = __builtin_amdgcn_mfma_f32_16x16x32_bf16(bh1, al, acc1, 0, 0, 0);
        }
#pragma unroll
        for (int i = 0; i < 4; ++i) { CS[tk * 33 + 4 * kq + i] = acc0[i]; CS[tk * 33 + 16 + 4 * kq + i] = acc1[i]; }
        ss += __shfl_xor(ss, 16); ss += __shfl_xor(ss, 32);
        const float rinv = 1.0f / sqrtf(ss * (1.f / DM) + 1e-5f);
        lds_wait();
        if (lane < 16) {
            float lg[32];
#pragma unroll
            for (int e = 0; e < 32; ++e) lg[e] = CS[lane * 33 + e] * rinv + br[e];
            int es0 = 0, es1 = 0, es2 = 0, es3 = 0; float vs0 = 0.f, vs1 = 0.f, vs2 = 0.f, vs3 = 0.f;
#define TOP1(ES, VS) { float mx = lg[0]; int ix = 0; _Pragma("unroll") for (int e = 1; e < 32; ++e) { const bool gt = lg[e] > mx; mx = gt ? lg[e] : mx; ix = gt ? e : ix; } ES = ix; VS = mx; \
                _Pragma("unroll") for (int e = 0; e < 32; ++e) lg[e] = (e == ix) ? -3e38f : lg[e]; }
            TOP1(es0, vs0) TOP1(es1, vs1) TOP1(es2, vs2) TOP1(es3, vs3)
#undef TOP1
            const float e1 = ex2((vs1 - vs0) * LOG2E), e2 = ex2((vs2 - vs0) * LOG2E), e3 = ex2((vs3 - vs0) * LOG2E);
            const float inv = 1.0f / (1.0f + e1 + e2 + e3);
            const int t = t0 + lane;
            *(u32x4*)(TOKE + (size_t)t * 4) = (u32x4){(unsigned)es0, (unsigned)es1, (unsigned)es2, (unsigned)es3};
            *(f32x4*)(TOKW + (size_t)t * 4) = (f32x4){inv, e1 * inv, e2 * inv, e3 * inv};
            RINV[t] = rinv;
            atomicAdd((int*)(CNTL + es0), 1); atomicAdd((int*)(CNTL + es1), 1); atomicAdd((int*)(CNTL + es2), 1); atomicAdd((int*)(CNTL + es3), 1);
        }
        __syncthreads();
        if (tid < 32) CNT[blk * 32 + tid] = CNTL[tid];
        __syncthreads();
    }
}
DI void p6b_place(const Args& a, LAS unsigned char* lds, int tid, int wave, int lane) {
    asm volatile("" : "+v"(tid), "+v"(lane));
    unsigned char* ws = a.ws;
    const float* X2 = (const float*)(ws + WS_X2); const float* RINV = (const float*)(ws + WS_RINV); bf16_t* AS = (bf16_t*)(ws + WS_AS);
    const float* gm = a.in[18];
    const f32x4 g00 = *(const f32x4*)(gm + lane * 8), g01 = *(const f32x4*)(gm + lane * 8 + 4), g10 = *(const f32x4*)(gm + 512 + lane * 8), g11 = *(const f32x4*)(gm + 512 + lane * 8 + 4);
    const int* TOKE = (const int*)(ws + WS_TOKE); const float* TOKW = (const float*)(ws + WS_TOKW); const int* CNT = (const int*)(ws + WS_CTL + CTL_CNT);
    int* SLOT = (int*)(ws + WS_SLOT); float* WSLOT = (float*)(ws + WS_WSLOT); int* TE = (int*)(ws + WS_CTL + CTL_TE); int* NT = (int*)(ws + WS_CTL + CTL_NT);
    LAS int* TOT = (LAS int*)lds; LAS int* OFFS = TOT + 32; LAS int* PADS = TOT + 64; LAS int* CUR = TOT + 96;
    for (int blk0 = blockIdx.x; blk0 < 256 * DBL(10); blk0 += gridDim.x) {
        const int blk = blk0 & 255;
        if (tid < 32) { int tot = 0, mine = 0; for (int bb = 0; bb < 256; ++bb) { const int cc = CNT[bb * 32 + tid]; tot += cc; mine += (bb < blk) ? cc : 0; } TOT[tid] = tot; OFFS[tid] = mine; CUR[tid] = 0; }
        __syncthreads();
        if (tid == 0) {
            int ps = 0;
            for (int e = 0; e < 32; ++e) { PADS[e] = ps; ps += (TOT[e] + 255) & ~255; }
            if (blk == 0) { int tile = 0; for (int e = 0; e < 32; ++e) { const int n = (TOT[e] + 255) >> 8; for (int q = 0; q < n; ++q) TE[tile++] = e; } NT[0] = tile; }
        }
        __syncthreads();
        if (MOE_GATHER && MOE_FP8) {
            int* STOK = (int*)(ws + WS_STOK); float* RSLOT = (float*)(ws + WS_RSLOT);
            if (blk == 0) { for (int e = wave; e < 32; e += NWAVES) { const int lo = PADS[e] + TOT[e], hi = PADS[e] + ((TOT[e] + 255) & ~255); for (int p = lo + lane; p < hi; p += 64) { STOK[p] = 0; WSLOT[p] = 0.f; RSLOT[p] = 0.f; } } }
            const int t = blk * 128 + (tid >> 2), k = tid & 3;
            const int e = TOKE[(size_t)t * 4 + k];
            const int pos = PADS[e] + OFFS[e] + atomicAdd((int*)(CUR + e), 1);
            STOK[pos] = t; SLOT[(size_t)t * 4 + k] = pos; WSLOT[pos] = TOKW[(size_t)t * 4 + k]; RSLOT[pos] = RINV[t];
        } else
        {
            const int tb = blk * 128 + wave * 16;
            f32x4 a0, a1, b0, b1, na0, na1, nb0, nb1; float rv, nrv; int e0, e1, e2, e3, ne0, ne1, ne2, ne3; float w0, w1, w2, w3, nw0, nw1, nw2, nw3;
#define P6B_LOAD(T, A0, A1, B0, B1, RV, E0, E1, E2, E3, W0, W1, W2, W3) { const float* xp = X2 + (size_t)(T) * DM + lane * 8; A0 = *(const f32x4*)xp; A1 = *(const f32x4*)(xp + 4); B0 = *(const f32x4*)(xp + 512); B1 = *(const f32x4*)(xp + 516); RV = RINV[T]; \
                const int* ep = TOKE + (size_t)(T) * 4; E0 = ep[0]; E1 = ep[1]; E2 = ep[2]; E3 = ep[3]; const float* wp = TOKW + (size_t)(T) * 4; W0 = wp[0]; W1 = wp[1]; W2 = wp[2]; W3 = wp[3]; }
            P6B_LOAD(tb, a0, a1, b0, b1, rv, e0, e1, e2, e3, w0, w1, w2, w3)
            for (int it = 0; it < 16; ++it) {
                const int t = tb + it;
                if (it + 1 < 16) P6B_LOAD(t + 1, na0, na1, nb0, nb1, nrv, ne0, ne1, ne2, ne3, nw0, nw1, nw2, nw3)
                u32x4 r0, r1; u32x2 q0, q1;
                if (MOE_FP8) { const float r8 = rv * SC_A8;
                    q0.x = pk4_fp8(a0[0] * r8 * g00[0], a0[1] * r8 * g00[1], a0[2] * r8 * g00[2], a0[3] * r8 * g00[3]); q0.y = pk4_fp8(a1[0] * r8 * g01[0], a1[1] * r8 * g01[1], a1[2] * r8 * g01[2], a1[3] * r8 * g01[3]);
                    q1.x = pk4_fp8(b0[0] * r8 * g10[0], b0[1] * r8 * g10[1], b0[2] * r8 * g10[2], b0[3] * r8 * g10[3]); q1.y = pk4_fp8(b1[0] * r8 * g11[0], b1[1] * r8 * g11[1], b1[2] * r8 * g11[2], b1[3] * r8 * g11[3]);
                } else {
                    r0.x = pk2(a0[0] * rv * g00[0], a0[1] * rv * g00[1]); r0.y = pk2(a0[2] * rv * g00[2], a0[3] * rv * g00[3]); r0.z = pk2(a1[0] * rv * g01[0], a1[1] * rv * g01[1]); r0.w = pk2(a1[2] * rv * g01[2], a1[3] * rv * g01[3]);
                    r1.x = pk2(b0[0] * rv * g10[0], b0[1] * rv * g10[1]); r1.y = pk2(b0[2] * rv * g10[2], b0[3] * rv * g10[3]); r1.z = pk2(b1[0] * rv * g11[0], b1[1] * rv * g11[1]); r1.w = pk2(b1[2] * rv * g11[2], b1[3] * rv * g11[3]);
                }
#pragma unroll
                for (int k = 0; k < 4; ++k) {
                    const int e = k == 0 ? e0 : k == 1 ? e1 : k == 2 ? e2 : e3; const float wk = k == 0 ? w0 : k == 1 ? w1 : k == 2 ? w2 : w3;
                    int p = 0; if (lane == 0) p = atomicAdd((int*)(CUR + e), 1);
                    p = __builtin_amdgcn_readfirstlane(p);
                    const int pos = PADS[e] + OFFS[e] + p;
                    if (MOE_FP8) { *(u32x2*)((unsigned char*)AS + (size_t)pos * DM + lane * 8) = q0; *(u32x2*)((unsigned char*)AS + (size_t)pos * DM + 512 + lane * 8) = q1; }
                    else { *(u32x4*)(AS + (size_t)pos * DM + lane * 8) = r0; *(u32x4*)(AS + (size_t)pos * DM + 512 + lane * 8) = r1; }
                    if (lane == 0) { SLOT[(size_t)t * 4 + k] = pos; WSLOT[pos] = wk; }
                }
                a0 = na0; a1 = na1; b0 = nb0; b1 = nb1; rv = nrv; e0 = ne0; e1 = ne1; e2 = ne2; e3 = ne3; w0 = nw0; w1 = nw1; w2 = nw2; w3 = nw3;
            }
#undef P6B_LOAD
        }
        __syncthreads();
    }
}
#if Y_FP8
DI void p9_final(const Args& a, int gw, int NGW, int lane) {
    asm volatile("" : "+v"(lane));
    unsigned char* ws = a.ws;
    const float* X2 = (const float*)(ws + WS_X2); const unsigned char* Y = (const unsigned char*)(ws + WS_Y); const int* SLOT = (const int*)(ws + WS_SLOT);
    const float* gf = a.in[25]; float* out = a.out;
    f32x4 gv[4];
#pragma unroll
    for (int j = 0; j < 4; ++j) gv[j] = *((const f32x4*)gf + lane * 4 + j);
    int t0 = gw;
    int p0 = 0, p1 = 0, p2 = 0, p3 = 0;
    constexpr int TX = MTOK * DBL(9);
    if (t0 < TX) { const int t = t0 % MTOK; p0 = SLOT[(size_t)t * 4]; p1 = SLOT[(size_t)t * 4 + 1]; p2 = SLOT[(size_t)t * 4 + 2]; p3 = SLOT[(size_t)t * 4 + 3]; }
    for (; t0 < TX; t0 += NGW) {
        const int t = t0 % MTOK; const int tn0 = t0 + NGW, tn = tn0 % MTOK;
        int q0 = 0, q1 = 0, q2 = 0, q3 = 0;
        if (tn0 < TX) { q0 = SLOT[(size_t)tn * 4]; q1 = SLOT[(size_t)tn * 4 + 1]; q2 = SLOT[(size_t)tn * 4 + 2]; q3 = SLOT[(size_t)tn * 4 + 3]; }
        f32x4 v[4]; u32x4 y[4];
#pragma unroll
        for (int j = 0; j < 4; ++j) v[j] = __builtin_nontemporal_load((const f32x4*)(X2 + (size_t)t * DM) + lane * 4 + j);
        y[0] = __builtin_nontemporal_load((const u32x4*)(Y + (size_t)p0 * DM) + lane); y[1] = __builtin_nontemporal_load((const u32x4*)(Y + (size_t)p1 * DM) + lane);
        y[2] = __builtin_nontemporal_load((const u32x4*)(Y + (size_t)p2 * DM) + lane); y[3] = __builtin_nontemporal_load((const u32x4*)(Y + (size_t)p3 * DM) + lane);
        float s = 0.f;
#pragma unroll
        for (int j = 0; j < 4; ++j) {
            f32x2 lo = {0.f, 0.f}, hi = {0.f, 0.f};
#pragma unroll
            for (int k = 0; k < 4; ++k) { const int w = (int)y[k][j]; lo += __builtin_amdgcn_cvt_pk_f32_fp8(w, false); hi += __builtin_amdgcn_cvt_pk_f32_fp8(w, true); }
            v[j].x += lo.x * (1.0f / SC_Y8); v[j].y += lo.y * (1.0f / SC_Y8); v[j].z += hi.x * (1.0f / SC_Y8); v[j].w += hi.y * (1.0f / SC_Y8);
            s += (v[j].x * v[j].x + v[j].y * v[j].y) + (v[j].z * v[j].z + v[j].w * v[j].w);
        }
        const float rinv = 1.0f / sqrtf(wave_sum(s) * (1.f / DM) + 1e-5f);
#pragma unroll
        for (int j = 0; j < 4; ++j) *((f32x4*)(out + (size_t)t * DM) + lane * 4 + j) = (f32x4){v[j].x * rinv * gv[j].x, v[j].y * rinv * gv[j].y, v[j].z * rinv * gv[j].z, v[j].w * rinv * gv[j].w};
        p0 = q0; p1 = q1; p2 = q2; p3 = q3;
    }
}
#else
DI void p9_final(const Args& a, int gw, int NGW, int lane) {
    asm volatile("" : "+v"(lane));
    unsigned char* ws = a.ws;
    const float* X2 = (const float*)(ws + WS_X2); const bf16_t* Y = (const bf16_t*)(ws + WS_Y); const int* SLOT = (const int*)(ws + WS_SLOT);
    const float* gf = a.in[25]; float* out = a.out;
    f32x4 gv[4];
#pragma unroll
    for (int j = 0; j < 4; ++j) gv[j] = *((const f32x4*)gf + lane + 64 * j);
    int t0 = gw;
    int p0 = 0, p1 = 0, p2 = 0, p3 = 0;
    constexpr int TX = MTOK * DBL(9);
    if (t0 < TX) { const int t = t0 % MTOK; p0 = SLOT[(size_t)t * 4]; p1 = SLOT[(size_t)t * 4 + 1]; p2 = SLOT[(size_t)t * 4 + 2]; p3 = SLOT[(size_t)t * 4 + 3]; }
    for (; t0 < TX; t0 += NGW) {
        const int t = t0 % MTOK; const int tn0 = t0 + NGW, tn = tn0 % MTOK;
        int q0 = 0, q1 = 0, q2 = 0, q3 = 0;
        if (tn0 < TX) { q0 = SLOT[(size_t)tn * 4]; q1 = SLOT[(size_t)tn * 4 + 1]; q2 = SLOT[(size_t)tn * 4 + 2]; q3 = SLOT[(size_t)tn * 4 + 3]; }
        f32x4 v[4]; u32x2 y0[4], y1[4], y2[4], y3[4];
#pragma unroll
        for (int j = 0; j < 4; ++j) v[j] = *((const f32x4*)(X2 + (size_t)t * DM) + lane + 64 * j);
#pragma unroll
        for (int j = 0; j < 4; ++j) { y0[j] = *((const u32x2*)(Y + (size_t)p0 * DM) + lane + 64 * j); y1[j] = *((const u32x2*)(Y + (size_t)p1 * DM) + lane + 64 * j);
            y2[j] = *((const u32x2*)(Y + (size_t)p2 * DM) + lane + 64 * j); y3[j] = *((const u32x2*)(Y + (size_t)p3 * DM) + lane + 64 * j); }
        float s = 0.f;
#pragma unroll
        for (int j = 0; j < 4; ++j) {
            v[j].x += ((bf2f(y0[j].x & 0xffffu) + bf2f(y1[j].x & 0xffffu)) + bf2f(y2[j].x & 0xffffu)) + bf2f(y3[j].x & 0xffffu);
            v[j].y += ((bf2f(y0[j].x >> 16) + bf2f(y1[j].x >> 16)) + bf2f(y2[j].x >> 16)) + bf2f(y3[j].x >> 16);
            v[j].z += ((bf2f(y0[j].y & 0xffffu) + bf2f(y1[j].y & 0xffffu)) + bf2f(y2[j].y & 0xffffu)) + bf2f(y3[j].y & 0xffffu);
            v[j].w += ((bf2f(y0[j].y >> 16) + bf2f(y1[j].y >> 16)) + bf2f(y2[j].y >> 16)) + bf2f(y3[j].y >> 16);
            s += (v[j].x * v[j].x + v[j].y * v[j].y) + (v[j].z * v[j].z + v[j].w * v[j].w);
        }
        const float rinv = 1.0f / sqrtf(wave_sum(s) * (1.f / DM) + 1e-5f);
#pragma unroll
        for (int j = 0; j < 4; ++j) *((f32x4*)(out + (size_t)t * DM) + lane + 64 * j) = (f32x4){v[j].x * rinv * gv[j].x, v[j].y * rinv * gv[j].y, v[j].z * rinv * gv[j].z, v[j].w * rinv * gv[j].w};
        p0 = q0; p1 = q1; p2 = q2; p3 = q3;
    }
}

#endif
__global__ void __launch_bounds__(NTHREADS, 2) hybrid_fwd(Args args) {
    extern __shared__ __attribute__((aligned(16))) unsigned char lds_raw[];
    LAS unsigned char* lds = (LAS unsigned char*)lds_raw;
    cg::grid_group grid = cg::this_grid();
    const int tid = threadIdx.x, lane = tid & 63, wave = __builtin_amdgcn_readfirstlane(tid >> 6);
    volatile LAS unsigned* bst = (volatile LAS unsigned*)(lds_raw_las(lds_raw) + LDS_BYTES - 16);
    if (tid < 4) bst[tid] = 0u;
    __syncthreads();
    const XcdBarrier xbar = xcd_barrier_post((unsigned*)(args.ws + WS_CTL + CTL_BAR), bst);
#define SYNC() xcd_barrier(xbar)
    const int G = gridDim.x, bx = blockIdx.x;
    const int gw = bx * NWAVES + wave, NGW = G * NWAVES;
    unsigned char* ws = args.ws;

#if PROBE_PH == 30
    for (int pass = 0; pass < 2; ++pass) {
#endif
    if (args.ws == nullptr) grid.sync();
    for (int rep = 0; rep < NREP(0); ++rep) p0_prep(args, lds, gw, NGW, wave, lane);
    SYNC();
    for (int rep = 0; rep < NREP(1); ++rep) {
        if (STAG1) stagger_us(bx, STAG1);
        pg8::Gemm g{(const pg8::bf16_t*)(ws + WS_H1), (const pg8::bf16_t*)(ws + WS_WIN), MTOK, NPROJ, DM};
        pg8::StaticOrder S; S.init(MTOK, NPROJ, G, bx);
#if PROBE_PH == 1
        Twice<pg8::StaticOrder> S2{S, 0, 2}; S2.init();
#endif
        Epi1 E{(bf16_t*)(ws + WS_Q), (bf16_t*)(ws + WS_KV), (bf16_t*)(ws + WS_U), (bf16_t*)(ws + WS_V), (bf16_t*)(ws + WS_MG), (float*)(ws + WS_NG)};

#if PROBE_PH == 1
        pg8::gemm_phase<Epi1, Twice<pg8::StaticOrder>, true, true>(lds, g, S2, E);
#else
        pg8::gemm_phase<Epi1, pg8::StaticOrder, true, true>(lds, g, S, E);
#endif
    }
    SYNC();
    for (int rep = 0; rep < NREP(2); ++rep)
    for (int it0 = bx; it0 < 512 * DBL(2); it0 += G) {
        const int it = it0 & 511;
        if (it < 256) { p2_compress_item(args, lds, it, tid, wave, lane);
#if PROBE_PH == 50
            p2_compress_item(args, lds, it, tid, wave, lane);
#endif
        } else { p2_sgu_item(args, lds, it - 256, tid, wave, lane);
#if PROBE_PH == 51
            p2_sgu_item(args, lds, it - 256, tid, wave, lane);
#endif
        }
    }
    SYNC();
    for (int rep = 0; rep < NREP(3); ++rep) {
        for (int it0 = bx; it0 < 1024 * ATT_TWICE; it0 += G) {
            const int it = it0 & 1023;
            const int w = it & 255, i = it >> 8, s = w & 63, b = w >> 6;
            const int g = i & 1, c = (i >> 1) ? 127 - s : s;
            attn_tile(args, lds, b, g, c, tid, wave, lane);
        }
    }
    SYNC();
    for (int rep = 0; rep < NREP(4); ++rep) {
        if (STAG4) stagger_us(bx, STAG4);
        pg8::Gemm g{(const pg8::bf16_t*)(ws + WS_YAB), (const pg8::bf16_t*)(ws + WS_WAB), MTOK, DM, DM};
        pg8::StaticOrder S; S.init(MTOK, DM, G, bx);
        Epi4 E{(const bf16_t*)(ws + WS_MG), (bf16_t*)(ws + WS_MERGED)};
        pg8::gemm_phase<Epi4, pg8::StaticOrder, true, true>(lds, g, S, E);
    }
    SYNC();
    for (int rep = 0; rep < NREP(5); ++rep) {
        if (STAG5) stagger_us(bx, STAG5);
        pg8::Gemm g{(const pg8::bf16_t*)(ws + WS_MERGED), (const pg8::bf16_t*)(ws + WS_WOUT), MTOK, DM, DM};
        pg8::StaticOrder S; S.init(MTOK, DM, G, bx);
#if PROBE_PH == 5
        Twice<pg8::StaticOrder> S2{S, 0, 2}; S2.init();
#endif
        Epi5 E{args.in[0], (float*)(ws + WS_X2)};

#if PROBE_PH == 5
        pg8::gemm_phase<Epi5, Twice<pg8::StaticOrder>, true, true>(lds, g, S2, E);
#else
        pg8::gemm_phase<Epi5, pg8::StaticOrder, true, true>(lds, g, S, E);
#endif
    }
    SYNC();
    for (int rep = 0; rep < NREP(6); ++rep) { p6a_route(args, lds, tid, wave, lane); }
    SYNC();
    for (int rep = 0; rep < NREP(10); ++rep) { p6b_place(args, lds, tid, wave, lane); }
    SYNC();
    const int* TE = (const int*)(ws + WS_CTL + CTL_TE);
    const int NT = __builtin_amdgcn_readfirstlane(*(const int*)(ws + WS_CTL + CTL_NT));
    for (int rep = 0; rep < NREP(7); ++rep) {
        int kq = MOE_FP8 ? DM / 2 : DM; asm volatile("" : "+s"(kq));
        pg8::Gemm g{(const pg8::bf16_t*)(ws + WS_AS), (const pg8::bf16_t*)(ws + WS_WGU), MPAD, NEXP * 2048, kq, (MOE_GATHER && MOE_FP8) ? (const int*)(ws + WS_STOK) : nullptr};
        MoeOrder S{TE, NT, 8, G, bx};
#if PROBE_PH == 7
        Twice<MoeOrder> S2{S, 0, 2}; S2.init();
#endif
        Epi7 E{args.in[22], (bf16_t*)(ws + WS_ACT), (MOE_GATHER && MOE_FP8) ? (const float*)(ws + WS_RSLOT) : nullptr};

#if PROBE_PH == 7
        pg8::gemm_phase<Epi7, Twice<MoeOrder>, true, true, MOE_FP8 != 0, (MOE_GATHER && MOE_FP8)>(lds, g, S2, E);
#else
        { const MoeOrderLds SL = moe_list_build(S, lds, tid); pg8::gemm_phase<Epi7, MoeOrderLds, true, true, MOE_FP8 != 0, (MOE_GATHER && MOE_FP8)>(lds, g, SL, E); }
#endif
    }
    SYNC();
    for (int rep = 0; rep < NREP(8); ++rep) {
        if (STAG8) stagger_us(bx, STAG8);
        int kq = MOE_FP8 ? DFF / 2 : DFF; asm volatile("" : "+s"(kq));
        pg8::Gemm g{(const pg8::bf16_t*)(ws + WS_ACT), (const pg8::bf16_t*)(ws + WS_WD), MPAD, NEXP * 1024, kq};
        MoeOrder S{TE, NT, 4, G, bx};
#if PROBE_PH == 8
        Twice<MoeOrder> S2{S, 0, 2}; S2.init();
#endif
        Epi8 E{args.in[24], (const float*)(ws + WS_WSLOT), (bf16_t*)(ws + WS_Y)};

#if PROBE_PH == 8
        pg8::gemm_phase<Epi8, Twice<MoeOrder>, true, true, MOE_FP8 != 0>(lds, g, S2, E);
#else
        { const MoeOrderLds SL = moe_list_build(S, lds, tid); pg8::gemm_phase<Epi8, MoeOrderLds, true, true, MOE_FP8 != 0>(lds, g, SL, E); }
#endif
    }
    SYNC();
#if PROBE_PH == 20
    for (int i = 0; i < 10; ++i) SYNC();
#endif
#if PROBE_PH == 40
    asm volatile(".rept 8192\n\ts_nop 0\n\t.endr" ::: "memory");
#endif
#if PROBE_PH == 41
    for (int i = 0; i < 1024; ++i) asm volatile("s_nop 0\n\ts_nop 0\n\ts_nop 0\n\ts_nop 0\n\ts_nop 0\n\ts_nop 0\n\ts_nop 0\n\ts_nop 0" ::: "memory");
#endif
#if PROBE_PH == 21 || PROBE_PH == 22 || PROBE_PH == 23
    {
        float a0 = 0.5f, a1 = 0.25f, a2 = 0.125f, a3 = 0.0625f; typedef float f2_t __attribute__((ext_vector_type(2))); f2_t b0 = {0.5f, 0.5f}, b1 = {0.25f, 0.25f}, b2 = {0.1f, 0.1f}, b3 = {0.2f, 0.2f};
        for (int i = 0; i < 4096; ++i) {
#if PROBE_PH == 21
            asm volatile("v_exp_f32 %0, %0\n\tv_exp_f32 %1, %1\n\tv_exp_f32 %2, %2\n\tv_exp_f32 %3, %3" : "+v"(a0), "+v"(a1), "+v"(a2), "+v"(a3));
#elif PROBE_PH == 22
            asm volatile("v_mul_f32 %0, %0, %0\n\tv_mul_f32 %1, %1, %1\n\tv_mul_f32 %2, %2, %2\n\tv_mul_f32 %3, %3, %3" : "+v"(a0), "+v"(a1), "+v"(a2), "+v"(a3));
#else
            asm volatile("v_pk_mul_f32 %0, %0, %0\n\tv_pk_mul_f32 %1, %1, %1\n\tv_pk_mul_f32 %2, %2, %2\n\tv_pk_mul_f32 %3, %3, %3" : "+v"(b0), "+v"(b1), "+v"(b2), "+v"(b3));
#endif
        }
        if (a0 + a1 + a2 + a3 + b0.x + b1.x + b2.x + b3.x == 123.456f) args.out[0] = 0.f;
    }
#endif
    for (int rep = 0; rep < NREP(9); ++rep) p9_final(args, gw, NGW, lane);
#if PROBE_PH == 30
    SYNC();
    }
#endif
}

extern "C" void kernel_launch(void* const* d_in, const int* in_sizes, int n_in, void* d_out, int out_size, void* d_ws, size_t ws_size, hipStream_t stream) {
    static int grid = 0;
    if (grid == 0) {
        if (n_in != 26 || in_sizes[0] != MTOK * DM || out_size != MTOK * DM || ws_size < WS_END) {
            fprintf(stderr, "kernel_launch: unexpected shapes (n_in %d, in0 %d, out %d, ws %zu < %zu)\n", n_in, n_in > 0 ? in_sizes[0] : -1, out_size, ws_size, (size_t)WS_END); grid = -1; return; }
        int dev = 0, cus = 0, per_cu = 0;
        hipGetDevice(&dev);
        hipDeviceGetAttribute(&cus, hipDeviceAttributeMultiprocessorCount, dev);
        if (hipFuncSetAttribute((const void*)hybrid_fwd, hipFuncAttributeMaxDynamicSharedMemorySize, LDS_BYTES) != hipSuccess) { fprintf(stderr, "kernel_launch: hipFuncSetAttribute failed\n"); grid = -1; return; }
        if (hipOccupancyMaxActiveBlocksPerMultiprocessor(&per_cu, (const void*)hybrid_fwd, NTHREADS, LDS_BYTES) != hipSuccess || per_cu < 1) { fprintf(stderr, "kernel_launch: occupancy query says %d\n", per_cu); per_cu = 1; }
        (void)hipGetLastError();
        grid = cus * 1;
        if (grid > cus * per_cu) grid = cus * per_cu;
    }
    if (grid < 0) return;
    if (hipMemsetAsync((unsigned char*)d_ws + WS_CTL + CTL_BAR, 0, XCD_BAR_WORDS * 4, stream) != hipSuccess) { fprintf(stderr, "kernel_launch: memset failed\n"); return; }
    Args a{};
    for (int i = 0; i < 26; ++i) a.in[i] = (const float*)d_in[i];
    a.out = (float*)d_out; a.ws = (unsigned char*)d_ws;
    void* kargs[] = {&a};
    hipError_t e = hipLaunchCooperativeKernel((const void*)hybrid_fwd, dim3(grid), dim3(NTHREADS), kargs, LDS_BYTES, stream);
    if (e != hipSuccess) fprintf(stderr, "kernel_launch: cooperative launch failed: %s (grid %d)\n", hipGetErrorString(e), grid);
}
```

```cpp
#include <hip/hip_runtime.h>
#include <hip/hip_cooperative_groups.h>
#include <cstdio>
#include <cstdint>
namespace cg = cooperative_groups;
namespace pg8 {
#define PG8_LAS __attribute__((address_space(3)))
typedef unsigned short bf16_t;
typedef short bf16x8 __attribute__((ext_vector_type(8)));
typedef float f32x4 __attribute__((ext_vector_type(4)));
typedef unsigned u32x4 __attribute__((ext_vector_type(4)));
typedef int v4i32_t __attribute__((ext_vector_type(4)));
typedef int v8i32_t __attribute__((ext_vector_type(8)));
constexpr int BM = 256, BK = 64, HALF = 128, HTB = HALF * BK * 2  , STAGE_BYTES = 8 * HTB, NXCD = 8, WGM = 8;

__host__ __device__ __forceinline__ int lds_byte(int r, int c) { const int st = (r >> 4) * 2 + (c >> 5), rr = r & 15, cc = c & 31, ob = rr * 64 + cc * 2; return st * 1024 + (ob ^ (((ob >> 9) & 1) << 5)); }
__host__ __device__ __forceinline__ void stage_rc(int b, int& R, int& C) { const int st = b / 1024, sb = b % 1024, swz = sb ^ (((sb >> 9) & 1) << 5); R = (st >> 1) * 16 + swz / 64; C = (st & 1) * 32 + (swz % 64) / 2; }
__host__ __device__ __forceinline__ int perm32(int rho) { const int n = rho >> 4, i = rho & 15; return 8 * (i >> 2) + 4 * n + (i & 3); }

struct Unit { int pm, pn; };
struct Gemm { const bf16_t* A; const bf16_t* Bt; int M, N, K; const int* rowmap = nullptr; };

struct StaticOrder {
    int nM, nN, nwg, G, c;
    __host__ __device__ void init(int M, int N, int G_, int c_) { nM = M / BM; nN = N / BM; nwg = nM * nN; G = G_; c = c_; }
    __host__ __device__ bool next(int i, Unit& u) const {
        const long L = (long)i * G + c; if (L >= nwg) return false;
        int wgid = (int)L; { const int q = nwg / NXCD, r = nwg % NXCD, xcd = wgid % NXCD, off = wgid / NXCD; wgid = (xcd < r ? xcd * (q + 1) : r * (q + 1) + (xcd - r) * q) + off; }
        const int nig = WGM * nN, gid = wgid / nig, fm = gid * WGM, gsz = (nM - fm) < WGM ? (nM - fm) : WGM;
        u.pm = fm + ((wgid % nig) % gsz); u.pn = (wgid % nig) / gsz; return true;
    }
    __device__ __forceinline__ void a_ready(const Unit&) const {}
    __device__ __forceinline__ void done(const Unit&) const {}
};

__device__ __forceinline__ unsigned cvt_pk_bf16(float lo, float hi) { unsigned r; asm volatile("v_cvt_pk_bf16_f32 %0, %1, %2" : "=v"(r) : "v"(lo), "v"(hi)); return r; }
typedef float f32x2 __attribute__((ext_vector_type(2)));
template <class Epi, class Sched, bool ALIGN_EPI = false, bool SP2 = false, bool FP8 = false, bool GATHER = false>
__device__ __forceinline__ void gemm_phase(PG8_LAS unsigned char* lds, const Gemm g, const Sched& S, const Epi& E) {
    int tid_ = threadIdx.x; asm volatile("" : "+v"(tid_));
    const int tid = tid_, wid = __builtin_amdgcn_readfirstlane(tid >> 6), lane = tid & 63, wr = wid >> 2, wc = wid & 3, fr = lane & 15, fq = lane >> 4;
    const int K = g.K, nt = K / BK;
    unsigned voffA[2], voffB[2];
    int rA[2]; unsigned cA2[2];
#pragma unroll
    for (int i = 0; i < 2; ++i) { int R, C; stage_rc(tid * 16 + i * 8192, R, C); const int Rb = Epi::PERM ? ((R & ~31) + perm32(R & 31)) : R;
        voffA[i] = (unsigned)(R * K + C) * 2u; voffB[i] = (unsigned)(Rb * K + C) * 2u; rA[i] = R; cA2[i] = (unsigned)C * 2u; }
    static_assert(!GATHER || SP2, "GATHER is wired into the SP2 loop only");
    unsigned gcu0[2], gcu1[2], gnx0[2], gnx1[2]; int ix2[4] = {0, 0, 0, 0};
#define PG8_GIDX(u, h, i) (g.rowmap[(u).pm * BM + (h) * HALF + rA[i]])
#define PG8_GOFF(ix, i) ((unsigned)(ix) * (unsigned)(K * 2) + cA2[i])
    const size_t kstep = (size_t)(BK * 2);
    const size_t hstep = (size_t)HALF * K * 2;
    const size_t tstep = 2 * hstep;
    const unsigned ldsw = (unsigned)wid * 1024u;
    const int aoff = lds_byte(wr * 64 + fr, fq * 8), boff = lds_byte(wc * 32 + fr, fq * 8);
#define PG8_SA(b, h) (((b) * 2 + (h)) * HTB)
#define PG8_SB(b, h) ((4 + (b) * 2 + (h)) * HTB)
#define PG8_STAGE(bufoff, gbase, voff) do { _Pragma("unroll") for (int _i = 0; _i < 2; ++_i) \
        __builtin_amdgcn_global_load_lds((const unsigned*)((const char*)(gbase) + (voff)[_i]), (PG8_LAS unsigned*)(lds + (bufoff) + ldsw + _i * 8192), 16, 0, 0); } while (0)
#define PG8_STAGE_O(bufoff, gbase, o0, o1) do { \
        __builtin_amdgcn_global_load_lds((const unsigned*)((const char*)(gbase) + (o0)), (PG8_LAS unsigned*)(lds + (bufoff) + ldsw), 16, 0, 0); \
        __builtin_amdgcn_global_load_lds((const unsigned*)((const char*)(gbase) + (o1)), (PG8_LAS unsigned*)(lds + (bufoff) + ldsw + 8192), 16, 0, 0); } while (0)
#define PG8_STAGE_A(bufoff, gbase, h, nx) do { if constexpr (GATHER) { if (h) PG8_STAGE_O(bufoff, gbase, (nx) ? gnx1[0] : gcu1[0], (nx) ? gnx1[1] : gcu1[1]); else PG8_STAGE_O(bufoff, gbase, (nx) ? gnx0[0] : gcu0[0], (nx) ? gnx0[1] : gcu0[1]); } \
        else { PG8_STAGE(bufoff, (gbase) + ((h) ? hstep : 0), voffA); } } while (0)
#define PG8_LDA(dst, b, h) do { _Pragma("unroll") for (int m = 0; m < 4; ++m) _Pragma("unroll") for (int k = 0; k < 2; ++k) dst[m][k] = *(const PG8_LAS bf16x8*)(lds + PG8_SA(b, h) + aoff + m * 2048 + k * 1024); } while (0)
#define PG8_LDB(dst, b, h) do { _Pragma("unroll") for (int n = 0; n < 2; ++n) _Pragma("unroll") for (int k = 0; k < 2; ++k) dst[n][k] = *(const PG8_LAS bf16x8*)(lds + PG8_SB(b, h) + boff + n * 2048 + k * 1024); } while (0)
#define PG8_CAT8(x) __builtin_shufflevector(__builtin_bit_cast(v4i32_t, (x)[0]), __builtin_bit_cast(v4i32_t, (x)[1]), 0, 1, 2, 3, 4, 5, 6, 7)
#define PG8_MMA(ai, bj, At, Bt) do { __builtin_amdgcn_s_setprio(1); \
        if constexpr (FP8) { _Pragma("unroll") for (int m = 0; m < 4; ++m) _Pragma("unroll") for (int n = 0; n < 2; ++n) \
            { const v8i32_t a8_ = PG8_CAT8(Bt[n]), b8_ = PG8_CAT8(At[m]); asm volatile("v_mfma_scale_f32_16x16x128_f8f6f4 %0, %1, %2, %0, %3, %3 op_sel_hi:[0,0,0]" : "+v"(acc[ai][bj][m][n]) : "v"(a8_), "v"(b8_), "v"(0x7f7f7f7f)); } } \
        else { _Pragma("unroll") for (int m = 0; m < 4; ++m) _Pragma("unroll") for (int n = 0; n < 2; ++n) _Pragma("unroll") for (int k = 0; k < 2; ++k) \
            acc[ai][bj][m][n] = __builtin_amdgcn_mfma_f32_16x16x32_bf16(Bt[n][k], At[m][k], acc[ai][bj][m][n], 0, 0, 0); } \
        __builtin_amdgcn_s_setprio(0); } while (0)
#define PG8_WAIT_V(n) asm volatile("s_waitcnt vmcnt(" #n ")" ::: "memory")
#define PG8_WAIT_L(n) asm volatile("s_waitcnt lgkmcnt(" #n ")" ::: "memory")
#define PG8_BAR __builtin_amdgcn_s_barrier()
#define PG8_SCHED __builtin_amdgcn_sched_barrier(0)
    Unit cur, nxt; int ui = 0;
    if (!S.next(0, cur)) return;
    f32x4 acc[2][2][4][2];
#pragma unroll
    for (int a = 0; a < 2; ++a)
#pragma unroll
        for (int b = 0; b < 2; ++b)
#pragma unroll
            for (int m = 0; m < 4; ++m)
#pragma unroll
                for (int n = 0; n < 2; ++n) acc[a][b][m][n] = (f32x4){0.f, 0.f, 0.f, 0.f};
    bf16x8 At[4][2], B0[2][2], B1[2][2];
    const char* cA = (const char*)g.A + (GATHER ? (size_t)0 : (size_t)cur.pm * tstep); const char* cB = (const char*)g.Bt + (size_t)cur.pn * tstep;
    if constexpr (GATHER) { gcu0[0] = PG8_GOFF(PG8_GIDX(cur, 0, 0), 0); gcu0[1] = PG8_GOFF(PG8_GIDX(cur, 0, 1), 1); gcu1[0] = PG8_GOFF(PG8_GIDX(cur, 1, 0), 0); gcu1[1] = PG8_GOFF(PG8_GIDX(cur, 1, 1), 1);
        gnx0[0] = gcu0[0]; gnx0[1] = gcu0[1]; gnx1[0] = gcu1[0]; gnx1[1] = gcu1[1]; }
    S.a_ready(cur);
    if constexpr (Epi::PREFETCH) E.prefetch(cur, lds + STAGE_BYTES, tid);
    if constexpr (SP2) {
        PG8_STAGE(PG8_SB(0, 0), cB, voffB); PG8_STAGE(PG8_SB(0, 1), cB + hstep, voffB); PG8_STAGE_A(PG8_SA(0, 0), cA, 0, false); PG8_STAGE_A(PG8_SA(0, 1), cA, 1, false);
        if (wr == 1) PG8_BAR;
        PG8_WAIT_V(2); PG8_BAR;
        PG8_STAGE(PG8_SB(1, 0), cB + kstep, voffB); PG8_STAGE_A(PG8_SA(1, 0), cA + kstep, 0, false); PG8_STAGE(PG8_SB(1, 1), cB + hstep + kstep, voffB);
        PG8_WAIT_V(6); PG8_BAR;
    } else {
        PG8_STAGE(PG8_SB(0, 0), cB, voffB); PG8_STAGE(PG8_SA(0, 0), cA, voffA); PG8_STAGE(PG8_SB(0, 1), cB + hstep, voffB); PG8_STAGE(PG8_SA(0, 1), cA + hstep, voffA);
        if (wr == 1) PG8_BAR;
        PG8_WAIT_V(4); PG8_BAR;
        PG8_STAGE(PG8_SB(1, 0), cB + kstep, voffB); PG8_STAGE(PG8_SA(1, 0), cA + kstep, voffA); PG8_STAGE(PG8_SB(1, 1), cB + hstep + kstep, voffB);
        PG8_WAIT_V(6); PG8_BAR;
    }
    for (;;) {
        const bool has_next = S.next(ui + 1, nxt);
        const char* nA = GATHER ? cA : (has_next ? (const char*)g.A + (size_t)nxt.pm * tstep : cA); const char* nB = has_next ? (const char*)g.Bt + (size_t)nxt.pn * tstep : cB;
        if constexpr (GATHER) { if (ui == 0 && has_next) { gnx0[0] = PG8_GOFF(PG8_GIDX(nxt, 0, 0), 0); gnx0[1] = PG8_GOFF(PG8_GIDX(nxt, 0, 1), 1); gnx1[0] = PG8_GOFF(PG8_GIDX(nxt, 1, 0), 0); gnx1[1] = PG8_GOFF(PG8_GIDX(nxt, 1, 1), 1); } }
        for (int t = 0; t < nt; t += 2) {
            if constexpr (Epi::MIDK) { if (t == nt / 2) { int fr_ = fr, fq_ = fq; asm volatile("" : "+v"(fr_), "+v"(fq_)); E.midk(acc, cur, wr, wc, fr_, fq_); } }
            const bool last = (t == nt - 2);
            const char* a1 = cA + (size_t)(t + 1) * kstep;
            const char* a2 = last ? nA : cA + (size_t)(t + 2) * kstep; const char* b2 = last ? nB : cB + (size_t)(t + 2) * kstep;
            const char* a3 = a2 + kstep; const char* b3 = b2 + kstep;
            if (last && has_next) S.a_ready(nxt);
            if constexpr (SP2) {
            PG8_LDB(B0, 0, 0); PG8_LDB(B1, 0, 1); PG8_SCHED; PG8_LDA(At, 0, 0); PG8_STAGE_A(PG8_SA(1, 1), a1, 1, false);
            PG8_WAIT_V(8); PG8_WAIT_L(0); PG8_BAR; PG8_MMA(0, 0, At, B0); PG8_MMA(0, 1, At, B1); PG8_BAR; PG8_SCHED;
            PG8_LDA(At, 0, 1); PG8_STAGE(PG8_SB(0, 0), b2, voffB); PG8_STAGE(PG8_SB(0, 1), b2 + hstep, voffB); PG8_STAGE_A(PG8_SA(0, 0), a2, 0, last);
            PG8_WAIT_V(8); PG8_WAIT_L(0); PG8_BAR; PG8_MMA(1, 0, At, B0); PG8_MMA(1, 1, At, B1); PG8_BAR; PG8_SCHED;
            PG8_LDB(B0, 1, 0); PG8_LDB(B1, 1, 1); PG8_SCHED; PG8_LDA(At, 1, 0); PG8_STAGE_A(PG8_SA(0, 1), a2, 1, last);
            PG8_WAIT_V(8); PG8_WAIT_L(0); PG8_BAR; PG8_MMA(0, 0, At, B0); PG8_MMA(0, 1, At, B1); PG8_BAR; PG8_SCHED;
            PG8_LDA(At, 1, 1); PG8_STAGE(PG8_SB(1, 0), b3, voffB); PG8_STAGE(PG8_SB(1, 1), b3 + hstep, voffB); PG8_STAGE_A(PG8_SA(1, 0), a3, 0, last);
            PG8_WAIT_V(8); PG8_WAIT_L(0); PG8_BAR; PG8_MMA(1, 0, At, B0); PG8_MMA(1, 1, At, B1); PG8_BAR; PG8_SCHED;
            } else {
            PG8_LDB(B0, 0, 0); PG8_SCHED; PG8_LDA(At, 0, 0); PG8_STAGE(PG8_SA(1, 1), a1 + hstep, voffA);
            PG8_WAIT_L(8); PG8_BAR; PG8_WAIT_L(0); PG8_MMA(0, 0, At, B0); PG8_BAR; PG8_SCHED;
            PG8_LDB(B1, 0, 1); PG8_STAGE(PG8_SB(0, 0), b2, voffB);
            PG8_BAR; PG8_WAIT_L(0); PG8_MMA(0, 1, At, B1); PG8_BAR;
            PG8_LDA(At, 0, 1); PG8_STAGE(PG8_SA(0, 0), a2, voffA);
            PG8_BAR; PG8_WAIT_L(0); PG8_MMA(1, 0, At, B0); PG8_BAR; PG8_SCHED;
            PG8_STAGE(PG8_SB(0, 1), b2 + hstep, voffB);
            PG8_WAIT_V(6); PG8_BAR; PG8_MMA(1, 1, At, B1); PG8_BAR;
            PG8_LDB(B0, 1, 0); PG8_SCHED; PG8_LDA(At, 1, 0); PG8_STAGE(PG8_SA(0, 1), a2 + hstep, voffA);
            PG8_WAIT_L(8); PG8_BAR; PG8_WAIT_L(0); PG8_MMA(0, 0, At, B0); PG8_BAR; PG8_SCHED;
            PG8_LDB(B1, 1, 1); PG8_STAGE(PG8_SB(1, 0), b3, voffB);
            PG8_BAR; PG8_WAIT_L(0); PG8_MMA(0, 1, At, B1); PG8_BAR;
            PG8_LDA(At, 1, 1); PG8_STAGE(PG8_SA(1, 0), a3, voffA);
            PG8_BAR; PG8_WAIT_L(0); PG8_MMA(1, 0, At, B0); PG8_BAR; PG8_SCHED;
            PG8_STAGE(PG8_SB(1, 1), b3 + hstep, voffB);
            PG8_WAIT_V(6); PG8_BAR; PG8_MMA(1, 1, At, B1); PG8_BAR;
            }
        }
        if constexpr (FP8) asm volatile("s_nop 15\n\ts_nop 15\n\ts_nop 15\n\ts_nop 15" ::: "memory");
        if constexpr (ALIGN_EPI) { if (wr == 0) PG8_BAR; }
        bool has2 = false;
        if constexpr (GATHER) { Unit n2; has2 = has_next && S.next(ui + 2, n2);
            if (has2) { ix2[0] = PG8_GIDX(n2, 0, 0); ix2[1] = PG8_GIDX(n2, 0, 1); ix2[2] = PG8_GIDX(n2, 1, 0); ix2[3] = PG8_GIDX(n2, 1, 1); } }
        if constexpr (!Epi::AFTER_DRAIN) { int fr_ = fr, fq_ = fq; asm volatile("" : "+v"(fr_), "+v"(fq_));
            E(acc, cur, wr, wc, fr_, fq_); S.done(cur); }
        if (!has_next) break;
#pragma unroll
        for (int a = 0; a < 2; ++a)
#pragma unroll
            for (int b = 0; b < 2; ++b)
#pragma unroll
                for (int m = 0; m < 4; ++m)
#pragma unroll
                    for (int n = 0; n < 2; ++n) acc[a][b][m][n] = (f32x4){0.f, 0.f, 0.f, 0.f};
        cur = nxt; cA = nA; cB = nB; ++ui;
        if constexpr (Epi::PREFETCH) E.prefetch(cur, lds + STAGE_BYTES, tid);
        if constexpr (GATHER) { gcu0[0] = gnx0[0]; gcu0[1] = gnx0[1]; gcu1[0] = gnx1[0]; gcu1[1] = gnx1[1];
            if (has2) { gnx0[0] = PG8_GOFF(ix2[0], 0); gnx0[1] = PG8_GOFF(ix2[1], 1); gnx1[0] = PG8_GOFF(ix2[2], 0); gnx1[1] = PG8_GOFF(ix2[3], 1); } }
        if constexpr (ALIGN_EPI) { if (wr == 1) PG8_BAR; }
    }
    PG8_WAIT_V(0);
    if constexpr (!ALIGN_EPI) { if (wr == 0) PG8_BAR; }
    PG8_BAR;
    if constexpr (Epi::AFTER_DRAIN) { E.fused(acc, cur, wr, wc, fr, fq, lds, wid, lane); S.done(cur); }
#undef PG8_SA
#undef PG8_SB
#undef PG8_STAGE
#undef PG8_STAGE_O
#undef PG8_STAGE_A
#undef PG8_GIDX
#undef PG8_GOFF
#undef PG8_LDA
#undef PG8_LDB
#undef PG8_MMA
#undef PG8_CAT8
#undef PG8_WAIT_V
#undef PG8_WAIT_L
#undef PG8_BAR
#undef PG8_SCHED
}
}
#define LAS __attribute__((address_space(3)))
#define XB_TMO      128
#define XB_XCNT(j)  (256  + 64 * (j))
#define XB_XSUB(j)  (1280 + 64 * (j))
#define XB_XGEN(j)  (2304 + 64 * (j))
#define XB_TOP      3328
#define XB_TOPGEN   3392
#define XCD_BAR_WORDS 3456
#define XB_SPIN_CAP (1u << 18)

__device__ __forceinline__ unsigned xb_ld(unsigned* p)              { return __hip_atomic_load(p, __ATOMIC_RELAXED, __HIP_MEMORY_SCOPE_AGENT); }
__device__ __forceinline__ unsigned xb_add(unsigned* p, unsigned v) { return __hip_atomic_fetch_add(p, v, __ATOMIC_RELAXED, __HIP_MEMORY_SCOPE_AGENT); }
__device__ __forceinline__ unsigned xb_xcc_id() { return (unsigned)__builtin_amdgcn_s_getreg((3 << 11) | 20) & 0xFu; }
#define XB_SPIN(cond, bar) do { unsigned _sp = 0; while (cond) { __builtin_amdgcn_s_sleep(1); \
    if ((++_sp & 255u) == 0u) { if (xb_ld(&(bar)[XB_TMO])) break; if (_sp > XB_SPIN_CAP) { atomicAdd(&(bar)[XB_TMO], 1u); break; } } } } while (0)

struct XcdBarrier {
    unsigned* bar; unsigned x;
    volatile LAS unsigned* st;
};

__device__ __forceinline__ XcdBarrier xcd_barrier_post(unsigned* bar, volatile LAS unsigned* st) {
    XcdBarrier b; b.bar = bar; b.x = xb_xcc_id(); b.st = st;
    if (threadIdx.x == 0) (void)xb_add(&bar[XB_XCNT(b.x)], 1u);
    return b;
}
__device__ __forceinline__ void xcd_barrier_complete(unsigned* bar, unsigned x, unsigned& nloc, unsigned& nx) {
    const unsigned G = gridDim.x * gridDim.y * gridDim.z;
    unsigned sum, cnt, mine, sp = 0u;
    for (;;) {
        sum = 0u; cnt = 0u; mine = 0u;
#pragma unroll
        for (unsigned j = 0; j < 16; ++j) { const unsigned c = xb_ld(&bar[XB_XCNT(j)]); sum += c; cnt += (c > 0u) ? 1u : 0u; mine = (j == x) ? c : mine; }
        if (sum == G) break;
        __builtin_amdgcn_s_sleep(1);
        if ((++sp & 255u) == 0u) { if (xb_ld(&bar[XB_TMO])) break; if (sp > XB_SPIN_CAP) { atomicAdd(&bar[XB_TMO], 1u); break; } }
    }
    nloc = mine > 0u ? mine : 1u; nx = cnt > 0u ? cnt : 1u;
}

__device__ __forceinline__ void xcd_barrier(const XcdBarrier& b) {
    asm volatile("s_waitcnt vmcnt(0)" ::: "memory");
    __syncthreads();
    if (threadIdx.x == 0) {
        unsigned* bar = b.bar;
        __builtin_amdgcn_s_waitcnt(0);
        unsigned nloc = b.st[0], nx = b.st[1];
        if (nloc == 0u) { xcd_barrier_complete(bar, b.x, nloc, nx); b.st[0] = nloc; b.st[1] = nx; }
        const unsigned old = xb_add(&bar[XB_XSUB(b.x)], 1u);
        const unsigned gen = old / nloc;
        if (old + 1u == (gen + 1u) * nloc) {
            __builtin_amdgcn_fence(__ATOMIC_RELEASE, "agent");
            asm volatile("s_waitcnt vmcnt(0)" ::: "memory");
            const unsigned og = xb_add(&bar[XB_TOP], 1u);
            const unsigned tg = og / nx;
            if (og + 1u == (tg + 1u) * nx) xb_add(&bar[XB_TOPGEN], 1u);
            else XB_SPIN(xb_ld(&bar[XB_TOPGEN]) == tg, bar);
            __builtin_amdgcn_fence(__ATOMIC_ACQUIRE, "agent");
            xb_add(&bar[XB_XGEN(b.x)], 1u);
            asm volatile("s_waitcnt vmcnt(0)" ::: "memory");
        } else {
            XB_SPIN(xb_ld(&bar[XB_XGEN(b.x)]) == gen, bar);
            __builtin_amdgcn_fence(__ATOMIC_ACQUIRE, "agent");
            asm volatile("s_waitcnt vmcnt(0)" ::: "memory");
        }
    }
    __syncthreads();
}

#define DI __device__ __forceinline__
typedef unsigned short bf16_t;
typedef short bf16x8 __attribute__((ext_vector_type(8)));
typedef short s16x4 __attribute__((ext_vector_type(4)));
typedef float f32x4 __attribute__((ext_vector_type(4)));
typedef float f32x16 __attribute__((ext_vector_type(16)));
typedef unsigned u32x4 __attribute__((ext_vector_type(4)));
typedef unsigned u32x2 __attribute__((ext_vector_type(2)));

#ifndef SKIP_ATTN
#define SKIP_ATTN 0
#endif
#ifndef SKIP_SGU
#define SKIP_SGU 0
#endif
#ifndef SKIP_MOE
#define SKIP_MOE 0
#endif
#ifndef PH_MASK
#define PH_MASK 0x3ff
#endif
#define PH(x) ((PH_MASK >> (x)) & 1)
#ifndef REP_PH
#define REP_PH -1
#endif
#define NREP(x) ((x) == REP_PH ? 2 : 1)
#ifndef NO_P6A
#define NO_P6A 0
#endif
#ifndef NO_P6B
#define NO_P6B 0
#endif
#ifndef STAG1
#define STAG1 0
#endif
#ifndef STAG8
#define STAG8 0
#endif
#ifndef STAG4
#define STAG4 0
#endif
#ifndef STAG5
#define STAG5 0
#endif
#ifndef ATT_TWICE
#define ATT_TWICE 1
#endif
#ifndef ATT_REP_W
#define ATT_REP_W 1
#endif
#ifndef ATT_REP_C
#define ATT_REP_C 1
#endif
#ifndef ATT_REP_S
#define ATT_REP_S 1
#endif
#ifndef PROBE_PH
#define PROBE_PH -1
#endif
#define DBL(x) ((x) == PROBE_PH ? 2 : 1)
#ifndef MOE_GATHER
#define MOE_GATHER 1
#endif
#ifndef Y_FP8
#define Y_FP8 1
#endif
#ifndef MOE_FP8
#define MOE_FP8 1
#endif
#ifndef ATTN_BRANCHES
#define ATTN_BRANCHES 7
#endif

constexpr int NB = 4, SEQ = 8192, MTOK = NB * SEQ, DM = 1024;
constexpr int DIN = 4376, NPROJ = 4608;
constexpr int NEXP = 32, DFF = 1024;
constexpr int MPAD = 131072 + 32 * 256;
constexpr float LOG2E = 1.4426950408889634f;
constexpr float QSCALE = 0.125f * LOG2E;
constexpr float NEGBIG = -1e30f;
constexpr float SC_W8 = 64.f, SC_A8 = 8.f, SC_ACT8 = 4.f, SC_Y8 = 32.f;

constexpr size_t MiB = 1u << 20;
constexpr size_t WS_CTL = 0;
constexpr size_t CTL_CNT = 0;
constexpr size_t CTL_TE = 64 * 1024;
constexpr size_t CTL_NT = 96 * 1024;
constexpr size_t CTL_C1 = 128 * 1024;
constexpr size_t CTL_BAR = 256 * 1024;
constexpr size_t WS_WIN = 1 * MiB, WS_WAB = 10 * MiB, WS_WOUT = 12 * MiB, WS_W1K = 14 * MiB, WS_W1V = 14 * MiB + 512 * 1024;
constexpr size_t WS_W2K = 15 * MiB, WS_W2V = 15 * MiB + 64 * 1024, WS_WTRIL = 15 * MiB + 512 * 1024;
constexpr size_t WS_WGU = 16 * MiB, WS_WD = 144 * MiB, WS_X2 = 208 * MiB;
constexpr size_t WS_H1 = 336 * MiB, WS_Q = 400 * MiB, WS_KV = 432 * MiB, WS_U = 480 * MiB, WS_V = 512 * MiB, WS_MG = 544 * MiB;
constexpr size_t WS_NG = 672 * MiB, WS_KCMP = 676 * MiB, WS_VCMP = 676 * MiB + 512 * 1024, WS_YAB = 678 * MiB, WS_MERGED = 742 * MiB;
constexpr size_t WS_VT = 806 * MiB;
constexpr size_t WS_AS = 336 * MiB, WS_Y = 336 * MiB, WS_ACT = 608 * MiB, WS_H2 = 608 * MiB;
constexpr size_t WS_TOKE = 880 * MiB, WS_TOKW = 881 * MiB, WS_SLOT = 882 * MiB, WS_WSLOT = 883 * MiB;
constexpr size_t WS_RINV = 884 * MiB;
constexpr size_t WS_WRT = 885 * MiB;
constexpr size_t WS_STOK = 886 * MiB;
constexpr size_t WS_RSLOT = 887 * MiB;
constexpr size_t WS_END = 888 * MiB;

constexpr int LDS_BYTES = 155648;
constexpr int NWAVES = 8, NTHREADS = 512;

struct Args { const float* in[26]; float* out; unsigned char* ws; };

DI float bf2f(unsigned b) { return __uint_as_float(b << 16); }
DI unsigned pk2(float lo, float hi) {
    typedef float f2_t __attribute__((ext_vector_type(2))); typedef __bf16 b2_t __attribute__((ext_vector_type(2)));
    f2_t v = {lo, hi}; b2_t b = __builtin_convertvector(v, b2_t); return __builtin_bit_cast(unsigned, b);
}
DI unsigned pk4_fp8(float a, float b, float c, float d) { int w = 0; w = __builtin_amdgcn_cvt_pk_fp8_f32(a, b, w, false); w = __builtin_amdgcn_cvt_pk_fp8_f32(c, d, w, true); return (unsigned)w; }
DI unsigned short f2bf(float x) { return (unsigned short)(pk2(x, 0.f) & 0xffffu); }
DI float ex2(float x) { return __builtin_amdgcn_exp2f(x); }
DI float rcpf_(float x) { return __builtin_amdgcn_rcpf(x); }
DI float sigm(float x) { return rcpf_(1.f + ex2(-LOG2E * x)); }
DI float gelu_t(float x) { const float u = 0.7978845608028654f * (x + 0.044715f * x * x * x); return x * rcpf_(1.f + ex2(-2.f * LOG2E * u)); }
typedef float f32x2 __attribute__((ext_vector_type(2)));
DI f32x2 ex2_2(f32x2 x) { f32x2 r; r.x = ex2(x.x); r.y = ex2(x.y); return r; }
DI f32x2 rcp_2(f32x2 x) { f32x2 r; r.x = rcpf_(x.x); r.y = rcpf_(x.y); return r; }
DI f32x2 sigm2(f32x2 x) { return rcp_2(ex2_2(x * (-LOG2E)) + 1.0f); }
DI f32x2 gelu_t2(f32x2 x) { const f32x2 x2 = x * x; const f32x2 u = x * (x2 * (0.7978845608028654f * 0.044715f * -2.f * LOG2E) + (0.7978845608028654f * -2.f * LOG2E)); return x * rcp_2(ex2_2(u) + 1.0f); }
DI float wave_sum(float v) {
#pragma unroll
    for (int o = 1; o < 64; o <<= 1) v += __shfl_xor(v, o);
    return v;
}
DI float wave_max(float v) {
#pragma unroll
    for (int o = 1; o < 64; o <<= 1) v = fmaxf(v, __shfl_xor(v, o));
    return v;
}
DI float xmax32(float v) {
    const unsigned u = __float_as_uint(v); auto rr = __builtin_amdgcn_permlane32_swap(u, u, false, false);
    return fmaxf(__uint_as_float(rr[0]), __uint_as_float(rr[1]));
}
DI float xsum32(float v) {
    const unsigned u = __float_as_uint(v); auto rr = __builtin_amdgcn_permlane32_swap(u, u, false, false);
    return __uint_as_float(rr[0]) + __uint_as_float(rr[1]);
}
DI int crow(int i, int h) { return (i & 3) + 8 * (i >> 2) + 4 * h; }
#define MFMA32(a, b, c) __builtin_amdgcn_mfma_f32_32x32x16_bf16((a), (b), (c), 0, 0, 0)
DI LAS unsigned char* lds_raw_las(unsigned char* p) { return (LAS unsigned char*)p; }
DI void stagger_us(int bx, int us) {
    if ((bx >> 3) & 1) {
        const unsigned long long t0 = __builtin_amdgcn_s_memrealtime();
        while (__builtin_amdgcn_s_memrealtime() - t0 < (unsigned long long)(us * 100)) __builtin_amdgcn_s_sleep(8);
    }
}
DI void lds_wait() { asm volatile("s_waitcnt lgkmcnt(0)" ::: "memory"); }

struct TItem { const float* W; bf16_t* WT; const float* ks; int K, N, k0, n0, map, f8, ldk, koff; };
DI int map_row(int map, int n) {
    if (map == 0) return n;
    if (map == 1) return n + 1024;
    if (map == 2) return n < 1280 ? n : (n < 1304 ? n + 3072 : n - 24);
    return n < 1024 ? ((n >> 7) * 256 + (n & 127)) : ((((n - 1024) >> 7) * 256) + 128 + (n & 127));
}
DI void titem_decode(const Args& a, int it, TItem& t) {
    unsigned char* ws = a.ws;
    constexpr int I_WIN = 16 * 137, I_WA = 8 * 32, I_WO = 16 * 32, I_W1 = 32 * 4, I_W2 = 2 * 2, I_GU1 = 16 * 64, I_GU = 32 * I_GU1, I_D1 = 16 * 32, I_D = 32 * I_D1;
    int r = it; t.ks = nullptr; t.map = 0; t.f8 = 0; t.ldk = 0; t.koff = 0;
    if (r < I_GU) { const int e = r / I_GU1; r -= e * I_GU1; t.W = a.in[21] + (size_t)e * 1024 * 2048; t.WT = (bf16_t*)(ws + WS_WGU + (size_t)e * 2048 * 1024 * (MOE_FP8 ? 1 : 2)); t.K = 1024; t.N = 2048; t.map = 3; t.f8 = MOE_FP8; }
    else if ((r -= I_GU) < I_D) { const int e = r / I_D1; r -= e * I_D1; t.W = a.in[23] + (size_t)e * 1024 * 1024; t.WT = (bf16_t*)(ws + WS_WD + (size_t)e * 1024 * 1024 * (MOE_FP8 ? 1 : 2)); t.K = 1024; t.N = 1024; t.f8 = MOE_FP8; }
    else if ((r -= I_D) < I_WIN) { t.W = a.in[2]; t.WT = (bf16_t*)(ws + WS_WIN); t.K = 1024; t.N = DIN; t.map = 2; t.ks = a.in[1]; }
    else if ((r -= I_WIN) < I_WA) { t.W = a.in[15]; t.WT = (bf16_t*)(ws + WS_WAB); t.K = 512; t.N = 1024; t.ldk = 1024; }
    else if ((r -= I_WA) < I_WA) { t.W = a.in[16]; t.WT = (bf16_t*)(ws + WS_WAB); t.K = 512; t.N = 1024; t.ldk = 1024; t.koff = 512; }
    else if ((r -= I_WA) < I_WO) { t.W = a.in[17]; t.WT = (bf16_t*)(ws + WS_WOUT); t.K = 1024; t.N = 1024; }
    else if ((r -= I_WO) < I_W1) { t.W = a.in[3]; t.WT = (bf16_t*)(ws + WS_W1K); t.K = 2048; t.N = 128; }
    else if ((r -= I_W1) < I_W1) { t.W = a.in[7]; t.WT = (bf16_t*)(ws + WS_W1V); t.K = 2048; t.N = 128; }
    else if ((r -= I_W1) < I_W2) { t.W = a.in[5]; t.WT = (bf16_t*)(ws + WS_W2K); t.K = 128; t.N = 64; }
    else { r -= I_W2; t.W = a.in[9]; t.WT = (bf16_t*)(ws + WS_W2V); t.K = 128; t.N = 64; }
    const int nblk = (t.N + 31) >> 5; int kb, nb;
    if (t.f8) { const int q = r >> 1; kb = 2 * (q / nblk) + (r & 1); nb = q % nblk; }
    else { kb = r / nblk; nb = r - kb * nblk; }
    t.k0 = 64 * kb; t.n0 = 32 * nb; if (t.ldk == 0) t.ldk = t.K;
}
DI void titem_load(const TItem& t, int lane, float (&v)[32]) {
    const int ncol = t.n0 + (lane & 31); const bool ok = ncol < t.N;
    const float* p = t.W + (size_t)(t.k0 + (lane >> 5)) * t.N + (ok ? ncol : 0);
#pragma unroll
    for (int i = 0; i < 32; ++i) v[i] = __builtin_nontemporal_load(p + (size_t)(2 * i) * t.N);
    if (!ok) {
#pragma unroll
        for (int i = 0; i < 32; ++i) v[i] = 0.f;
    }
}
DI void titem_process(const TItem& t, int lane, float (&v)[32], LAS float* scr) {
    if (t.ks) {
#pragma unroll
        for (int i = 0; i < 32; ++i) v[i] *= t.ks[t.k0 + 2 * i + (lane >> 5)];
    }
#pragma unroll
    for (int i = 0; i < 32; ++i) scr[(2 * i + (lane >> 5)) * 33 + (lane & 31)] = v[i];
    lds_wait();
    const int c = lane & 7;
#pragma unroll
    for (int j = 0; j < 4; ++j) {
        const int nl = (lane >> 3) + 8 * j, n = t.n0 + nl;
        const LAS float* s = scr + (8 * c) * 33 + nl;
        if (t.f8) {
            u32x2 o; o.x = pk4_fp8(s[0 * 33] * SC_W8, s[1 * 33] * SC_W8, s[2 * 33] * SC_W8, s[3 * 33] * SC_W8); o.y = pk4_fp8(s[4 * 33] * SC_W8, s[5 * 33] * SC_W8, s[6 * 33] * SC_W8, s[7 * 33] * SC_W8);
            if (n < t.N) *(u32x2*)((unsigned char*)t.WT + (size_t)map_row(t.map, n) * t.ldk + t.koff + t.k0 + 8 * c) = o;
        } else {
            u32x4 o; o.x = pk2(s[0 * 33], s[1 * 33]); o.y = pk2(s[2 * 33], s[3 * 33]); o.z = pk2(s[4 * 33], s[5 * 33]); o.w = pk2(s[6 * 33], s[7 * 33]);
            if (n < t.N) *(u32x4*)(t.WT + (size_t)map_row(t.map, n) * t.ldk + t.koff + t.k0 + 8 * c) = o;
        }
    }
    lds_wait();
}

DI void p0_prep(const Args& a, LAS unsigned char* lds, int gw, int NGW, int wave, int lane) {
    asm volatile("" : "+v"(lane));
    unsigned char* ws = a.ws;
    LAS float* scr = (LAS float*)(lds + wave * 8704);
    {
        constexpr int NIT = 16 * 137 + 2 * 8 * 32 + 16 * 32 + 2 * 32 * 4 + 2 * 2 * 2 + 32 * 16 * 64 + 32 * 16 * 32;
        TItem ta, tb; float va[32], vb[32];
        constexpr int NITX = NIT * DBL(0);
        int it = gw;
        if (it < NITX) { titem_decode(a, it % NIT, ta); titem_load(ta, lane, va); }
        while (it < NITX) {
            int nx = it + NGW;
            if (nx < NITX) { titem_decode(a, nx % NIT, tb); titem_load(tb, lane, vb); }
            titem_process(ta, lane, va, scr);
            it = nx; if (it >= NITX) break;
            nx = it + NGW;
            if (nx < NITX) { titem_decode(a, nx % NIT, ta); titem_load(ta, lane, va); }
            titem_process(tb, lane, vb, scr);
            it = nx;
        }
    }
    {
        const float* x = a.in[0]; bf16_t* H1 = (bf16_t*)(ws + WS_H1);
        for (int m0 = 2 * gw; m0 < MTOK * DBL(0); m0 += 2 * NGW) {
            const int m = m0 % MTOK;
            const f32x4* xr = (const f32x4*)(x + (size_t)m * DM) + lane;
            f32x4 v[8]; float s0 = 0.f, s1 = 0.f;
#pragma unroll
            for (int j = 0; j < 8; ++j) v[j] = __builtin_nontemporal_load(xr + 64 * j);
#pragma unroll
            for (int j = 0; j < 4; ++j) { s0 += (v[j].x * v[j].x + v[j].y * v[j].y) + (v[j].z * v[j].z + v[j].w * v[j].w); s1 += (v[4 + j].x * v[4 + j].x + v[4 + j].y * v[4 + j].y) + (v[4 + j].z * v[4 + j].z + v[4 + j].w * v[4 + j].w); }
            const float r0 = 1.0f / sqrtf(wave_sum(s0) * (1.f / DM) + 1e-5f), r1 = 1.0f / sqrtf(wave_sum(s1) * (1.f / DM) + 1e-5f);
            u32x2* o = (u32x2*)(H1 + (size_t)m * DM) + lane;
#pragma unroll
            for (int j = 0; j < 8; ++j) { const float rr = j < 4 ? r0 : r1; u32x2 w; w.x = pk2(v[j].x * rr, v[j].y * rr); w.y = pk2(v[j].z * rr, v[j].w * rr); o[64 * j] = w; }
        }
    }
    {
        float* C1P = (float*)(ws + WS_CTL + CTL_C1);
        for (int o8 = gw; o8 < 256 * 8; o8 += NGW) {
            const int o = o8 >> 3, part = o8 & 7, ty = o >> 7, f = o & 127; const float* pe = a.in[ty ? 10 : 6]; const float* w1 = a.in[ty ? 7 : 3]; const float* b1 = a.in[ty ? 8 : 4];
            float s = 0.f;
#pragma unroll
            for (int q = 0; q < 4; ++q) { const int k = part * 256 + q * 64 + lane; s += pe[k] * w1[(size_t)k * 128 + f]; }
            s = wave_sum(s);
            if (lane == 0) C1P[o8] = s + (part == 0 ? b1[f] : 0.f);
        }
    }
    {
        const float* wr = a.in[19]; const float* gm = a.in[18]; bf16_t* WRT = (bf16_t*)(ws + WS_WRT);
        for (int i = gw * 64 + lane; i < 32 * 1024; i += NGW * 64) { const int e = i >> 10, k = i & 1023; const float w = wr[k * 32 + e] * gm[k];
            const unsigned short hi = f2bf(w); WRT[i] = hi; WRT[32 * 1024 + i] = f2bf(w - bf2f(hi)); }
    }
    {
        const float* wsp = a.in[13]; bf16_t* WT = (bf16_t*)(ws + WS_WTRIL);
        for (int i = gw * 64 + lane; i < 8 * 128 * 128; i += NGW * 64) { const int t = (i >> 7) & 127, s = i & 127; WT[i] = f2bf(s <= t ? wsp[i] : 0.f); }
    }
}

typedef pg8::f32x4 pf4;
template <class S> struct Twice {
    S s; int n, rep;
    DI void init() { pg8::Unit u; n = 0; while (s.next(n, u)) ++n; }
    DI bool next(int i, pg8::Unit& u) const { return i < rep * n && s.next(i >= n ? i - n : i, u); }
    DI void a_ready(const pg8::Unit&) const {}
    DI void done(const pg8::Unit&) const {}
};
struct Epi1 {
    static constexpr bool PERM = true, AFTER_DRAIN = false, MIDK = false, PREFETCH = false;
    bf16_t *Q, *KV, *U, *V, *MG; float* NG;
    DI void operator()(const pf4 (&acc)[2][2][4][2], const pg8::Unit& u, int wr, int wc, int fr, int fq) const {
        const int row0 = u.pm * 256 + wr * 64 + fr, pn = u.pn, c0 = wc * 32 + 8 * fq;
        if (pn == 17) {
            if (wc == 0 && fq < 3) {
#pragma unroll
                for (int ai = 0; ai < 2; ++ai)
#pragma unroll
                    for (int m = 0; m < 4; ++m) { float* p = NG + (size_t)(row0 + ai * 128 + m * 16) * 24 + c0; const pf4 v0 = acc[ai][0][m][0], v1 = acc[ai][0][m][1];
                        *(f32x4*)p = (f32x4){sigm(v0[0]), sigm(v0[1]), sigm(v0[2]), sigm(v0[3])}; *(f32x4*)(p + 4) = (f32x4){sigm(v1[0]), sigm(v1[1]), sigm(v1[2]), sigm(v1[3])}; }
            }
            return;
        }
        bf16_t* base; int ldc, ct, mode;
        float sc = 1.f;
        if (pn < 2) { base = Q; ldc = 512; ct = pn; mode = 0; sc = QSCALE; }
        else if (pn < 5) { base = KV; ldc = 768; ct = pn - 2; mode = 0; }
        else if (pn < 7) { base = U; ldc = 512; ct = pn - 5; mode = 1; }
        else if (pn < 9) { base = V; ldc = 512; ct = pn - 7; mode = 1; }
        else { base = MG; ldc = 2048; ct = pn - 9; mode = 2; }
#pragma unroll
        for (int ai = 0; ai < 2; ++ai)
#pragma unroll
            for (int m = 0; m < 4; ++m) {
                bf16_t* rowp = base + (size_t)(row0 + ai * 128 + m * 16) * ldc + ct * 256 + c0;
#pragma unroll
                for (int bj = 0; bj < 2; ++bj) {
                    pf4 v0 = acc[ai][bj][m][0], v1 = acc[ai][bj][m][1];
                    if (mode == 0) { v0 = v0 * sc; v1 = v1 * sc; }
                    else if (mode == 1) { const f32x2 a = gelu_t2((f32x2){v0[0], v0[1]}), b = gelu_t2((f32x2){v0[2], v0[3]}), c = gelu_t2((f32x2){v1[0], v1[1]}), d = gelu_t2((f32x2){v1[2], v1[3]});
                        v0 = (pf4){a.x, a.y, b.x, b.y}; v1 = (pf4){c.x, c.y, d.x, d.y}; }
                    else { const f32x2 a = sigm2((f32x2){v0[0], v0[1]}), b = sigm2((f32x2){v0[2], v0[3]}), c = sigm2((f32x2){v1[0], v1[1]}), d = sigm2((f32x2){v1[2], v1[3]});
                        v0 = (pf4){a.x, a.y, b.x, b.y}; v1 = (pf4){c.x, c.y, d.x, d.y}; }
                    u32x4 w; w.x = pk2(v0[0], v0[1]); w.y = pk2(v0[2], v0[3]); w.z = pk2(v1[0], v1[1]); w.w = pk2(v1[2], v1[3]);
                    *(u32x4*)(rowp + bj * 128) = w;
                }
            }
    }
};
struct Epi4 {
    static constexpr bool PERM = true, AFTER_DRAIN = false, MIDK = true, PREFETCH = false;
    const bf16_t* MG; bf16_t* OUT;
    DI void prefetch(const pg8::Unit& u, LAS unsigned char* scratch, int tid) const {
#pragma unroll
        for (int q = 0; q < 4; ++q) { const int ln = tid + q * NTHREADS, row = ln >> 3, part = ln & 7;
            const bf16_t* p = MG + (size_t)(u.pm * 256 + row) * 2048 + (part >> 2) * 1024 + u.pn * 256 + (part & 3) * 64;
            __builtin_amdgcn_global_load_lds((const unsigned*)p, (LAS unsigned*)(scratch + (tid >> 6) * 256), 4, 0, 0); }
    }
    DI void midk(pf4 (&acc)[2][2][4][2], const pg8::Unit& u, int wr, int wc, int fr, int fq) const {
        const int row0 = u.pm * 256 + wr * 64 + fr, c0 = u.pn * 256 + wc * 32 + 8 * fq;
#pragma unroll
        for (int ai = 0; ai < 2; ++ai)
#pragma unroll
            for (int mh = 0; mh < 2; ++mh) {
                u32x4 ga[2][2], gb[2][2];
#pragma unroll
                for (int mm = 0; mm < 2; ++mm)
#pragma unroll
                    for (int bj = 0; bj < 2; ++bj) { const bf16_t* gp = MG + (size_t)(row0 + ai * 128 + (2 * mh + mm) * 16) * 2048 + c0 + bj * 128; ga[mm][bj] = __builtin_nontemporal_load((const u32x4*)gp); gb[mm][bj] = *(const u32x4*)(gp + 1024); }
#pragma unroll
                for (int mm = 0; mm < 2; ++mm)
#pragma unroll
                    for (int bj = 0; bj < 2; ++bj) {
                        const u32x4 a = ga[mm][bj], b = gb[mm][bj]; pf4& v0 = acc[ai][bj][2 * mh + mm][0]; pf4& v1 = acc[ai][bj][2 * mh + mm][1];
                        v0[0] *= bf2f(a.x & 0xffffu) * rcpf_(fmaxf(bf2f(b.x & 0xffffu), 1e-6f)); v0[1] *= bf2f(a.x >> 16) * rcpf_(fmaxf(bf2f(b.x >> 16), 1e-6f));
                        v0[2] *= bf2f(a.y & 0xffffu) * rcpf_(fmaxf(bf2f(b.y & 0xffffu), 1e-6f)); v0[3] *= bf2f(a.y >> 16) * rcpf_(fmaxf(bf2f(b.y >> 16), 1e-6f));
                        v1[0] *= bf2f(a.z & 0xffffu) * rcpf_(fmaxf(bf2f(b.z & 0xffffu), 1e-6f)); v1[1] *= bf2f(a.z >> 16) * rcpf_(fmaxf(bf2f(b.z >> 16), 1e-6f));
                        v1[2] *= bf2f(a.w & 0xffffu) * rcpf_(fmaxf(bf2f(b.w & 0xffffu), 1e-6f)); v1[3] *= bf2f(a.w >> 16) * rcpf_(fmaxf(bf2f(b.w >> 16), 1e-6f));
                    }
            }
    }
    DI void operator()(const pf4 (&acc)[2][2][4][2], const pg8::Unit& u, int wr, int wc, int fr, int fq) const {
        const int row0 = u.pm * 256 + wr * 64 + fr, c0 = u.pn * 256 + wc * 32 + 8 * fq;
#pragma unroll
        for (int ai = 0; ai < 2; ++ai) {
            u32x4 gb[4][2];
#pragma unroll
            for (int m = 0; m < 4; ++m)
#pragma unroll
                for (int bj = 0; bj < 2; ++bj) gb[m][bj] = __builtin_nontemporal_load((const u32x4*)(MG + (size_t)(row0 + ai * 128 + m * 16) * 2048 + 1024 + c0 + bj * 128));
#pragma unroll
            for (int m = 0; m < 4; ++m)
#pragma unroll
                for (int bj = 0; bj < 2; ++bj) {
                    const u32x4 b = gb[m][bj]; const pf4 v0 = acc[ai][bj][m][0], v1 = acc[ai][bj][m][1];
                    u32x4 w; w.x = pk2(v0[0] * fmaxf(bf2f(b.x & 0xffffu), 1e-6f), v0[1] * fmaxf(bf2f(b.x >> 16), 1e-6f)); w.y = pk2(v0[2] * fmaxf(bf2f(b.y & 0xffffu), 1e-6f), v0[3] * fmaxf(bf2f(b.y >> 16), 1e-6f));
                    w.z = pk2(v1[0] * fmaxf(bf2f(b.z & 0xffffu), 1e-6f), v1[1] * fmaxf(bf2f(b.z >> 16), 1e-6f)); w.w = pk2(v1[2] * fmaxf(bf2f(b.w & 0xffffu), 1e-6f), v1[3] * fmaxf(bf2f(b.w >> 16), 1e-6f));
                    *(u32x4*)(OUT + (size_t)(row0 + ai * 128 + m * 16) * 1024 + c0 + bj * 128) = w;
                }
        }
    }
};
struct Epi5 {
    static constexpr bool PERM = false, AFTER_DRAIN = false, MIDK = false, PREFETCH = false;
    const float* X; float* X2;
    DI void prefetch(const pg8::Unit& u, LAS unsigned char* scratch, int tid) const {
#pragma unroll
        for (int q = 0; q < 4; ++q) { const int ln = tid + q * NTHREADS, row = ln >> 3, part = ln & 7;
            const float* p = X + (size_t)(u.pm * 256 + row) * DM + u.pn * 256 + part * 32;
            __builtin_amdgcn_global_load_lds((const unsigned*)p, (LAS unsigned*)(scratch + (tid >> 6) * 256), 4, 0, 0); }
    }
    DI void operator()(const pf4 (&acc)[2][2][4][2], const pg8::Unit& u, int wr, int wc, int fr, int fq) const {
        const int row0 = u.pm * 256 + wr * 64 + fr, c0 = u.pn * 256 + wc * 32 + 4 * fq;
#pragma unroll
        for (int ai = 0; ai < 2; ++ai)
#pragma unroll
            for (int mh = 0; mh < 2; ++mh) {
                f32x4 xv[2][2][2];
#pragma unroll
                for (int mm = 0; mm < 2; ++mm)
#pragma unroll
                    for (int bj = 0; bj < 2; ++bj)
#pragma unroll
                        for (int n = 0; n < 2; ++n) xv[mm][bj][n] = __builtin_nontemporal_load((const f32x4*)(X + (size_t)(row0 + ai * 128 + (2 * mh + mm) * 16) * DM + c0 + bj * 128 + n * 16));
#pragma unroll
                for (int mm = 0; mm < 2; ++mm)
#pragma unroll
                    for (int bj = 0; bj < 2; ++bj)
#pragma unroll
                        for (int n = 0; n < 2; ++n) { const pf4 v = acc[ai][bj][2 * mh + mm][n]; const f32x4 x = xv[mm][bj][n];
                            *(f32x4*)(X2 + (size_t)(row0 + ai * 128 + (2 * mh + mm) * 16) * DM + c0 + bj * 128 + n * 16) = (f32x4){x[0] + v[0], x[1] + v[1], x[2] + v[2], x[3] + v[3]}; }
            }
    }
};
struct MoeOrder {
    const int* TE; int NT, npn, G, c;
    DI bool next(int i, pg8::Unit& u) const {
        int mt, pn;
        if ((G & 7) == 0) { const int x = c & 7, jj = i * (G >> 3) + (c >> 3); mt = x + 8 * (jj / npn); pn = jj % npn; }
        else { const int L = i * G + c; mt = L / npn; pn = L % npn; }
        if (mt >= NT) return false;
        const int e = __builtin_amdgcn_readfirstlane(TE[mt]);
        u.pm = mt; u.pn = e * npn + pn; return true;
    }
    DI void a_ready(const pg8::Unit&) const {}
    DI void done(const pg8::Unit&) const {}
};
constexpr int MOE_LIST_OFF = 131072 + 1024, MOE_LIST_MAX = 64;
struct MoeOrderLds {
    const LAS int* list;
    DI bool next(int i, pg8::Unit& u) const {
        if (i >= MOE_LIST_MAX) return false;
        const int v = __builtin_amdgcn_readfirstlane(list[i]);
        if (v < 0) return false;
        u.pm = v & 0xffff; u.pn = v >> 16; return true;
    }
    DI void a_ready(const pg8::Unit&) const {}
    DI void done(const pg8::Unit&) const {}
};
DI MoeOrderLds moe_list_build(const MoeOrder& S, LAS unsigned char* lds, int tid) {
    LAS int* list = (LAS int*)(lds + MOE_LIST_OFF);
    if (tid < MOE_LIST_MAX) {
        int mt, pn;
        if ((S.G & 7) == 0) { const int x = S.c & 7, jj = tid * (S.G >> 3) + (S.c >> 3); mt = x + 8 * (jj / S.npn); pn = jj % S.npn; }
        else { const int L = tid * S.G + S.c; mt = L / S.npn; pn = L % S.npn; }
        list[tid] = (mt < S.NT) ? (mt | ((S.TE[mt] * S.npn + pn) << 16)) : -1;
    }
    __syncthreads();
    return MoeOrderLds{list};
}
struct Epi7 {
    static constexpr bool PERM = true, AFTER_DRAIN = false, MIDK = false, PREFETCH = false;
    const float* BGU; bf16_t* ACT; const float* RS;
    DI void operator()(const pf4 (&acc)[2][2][4][2], const pg8::Unit& u, int wr, int wc, int fr, int fq) const {
        const int e = u.pn >> 3, pn = u.pn & 7, row0 = u.pm * 256 + wr * 64 + fr, c0 = pn * 128 + wc * 32 + 8 * fq;
        const float* bg = BGU + (size_t)e * 2048 + c0; const float* bu = bg + 1024;
        const f32x4 bg0 = *(const f32x4*)bg, bg1 = *(const f32x4*)(bg + 4), bu0 = *(const f32x4*)bu, bu1 = *(const f32x4*)(bu + 4);
        constexpr float ASC = MOE_FP8 ? 1.0f / (SC_A8 * SC_W8) : 1.0f, OSC = MOE_FP8 ? SC_ACT8 : 1.0f;
        float rsv[2][4];
#pragma unroll
        for (int ai = 0; ai < 2; ++ai)
#pragma unroll
            for (int m = 0; m < 4; ++m) rsv[ai][m] = RS ? RS[(size_t)(row0 + ai * 128 + m * 16)] : 1.0f;
#pragma unroll
        for (int ai = 0; ai < 2; ++ai)
#pragma unroll
            for (int m = 0; m < 4; ++m) {
                float r[8];
                const float asr = RS ? ASC * rsv[ai][m] : ASC;
#pragma unroll
                for (int n = 0; n < 2; ++n)
#pragma unroll
                    for (int k2 = 0; k2 < 2; ++k2) {
                        const int k = 2 * k2;
                        const f32x2 ag = {acc[ai][0][m][n][k], acc[ai][0][m][n][k + 1]}, au = {acc[ai][1][m][n][k], acc[ai][1][m][n][k + 1]};
                        const f32x2 bgv = {n ? bg1[k] : bg0[k], n ? bg1[k + 1] : bg0[k + 1]}, buv = {n ? bu1[k] : bu0[k], n ? bu1[k + 1] : bu0[k + 1]};
                        f32x2 g = ag * asr + bgv, u = au * asr + buv;
                        g.x = fminf(g.x, 7.0f); g.y = fminf(g.y, 7.0f);
                        u.x = __builtin_amdgcn_fmed3f(u.x, -7.0f, 7.0f); u.y = __builtin_amdgcn_fmed3f(u.y, -7.0f, 7.0f);
                        const f32x2 rc = rcp_2(ex2_2(g * (-1.702f * LOG2E)) + 1.0f);
                        const f32x2 o = (g * rc) * (u * OSC + OSC);
                        r[n * 4 + k] = o.x; r[n * 4 + k + 1] = o.y;
                    }
                if (MOE_FP8) { u32x2 w; w.x = pk4_fp8(r[0], r[1], r[2], r[3]); w.y = pk4_fp8(r[4], r[5], r[6], r[7]);
                    *(u32x2*)((unsigned char*)ACT + (size_t)(row0 + ai * 128 + m * 16) * DFF + c0) = w; }
                else { u32x4 w; w.x = pk2(r[0], r[1]); w.y = pk2(r[2], r[3]); w.z = pk2(r[4], r[5]); w.w = pk2(r[6], r[7]);
                    *(u32x4*)(ACT + (size_t)(row0 + ai * 128 + m * 16) * DFF + c0) = w; }
            }
    }
};
struct Epi8 {
    static constexpr bool PERM = true, AFTER_DRAIN = false, MIDK = false, PREFETCH = false;
    const float* BD; const float* WSLOT; bf16_t* Y;
    DI void operator()(const pf4 (&acc)[2][2][4][2], const pg8::Unit& u, int wr, int wc, int fr, int fq) const {
        const int e = u.pn >> 2, pn = u.pn & 3, row0 = u.pm * 256 + wr * 64 + fr, c0 = pn * 256 + wc * 32 + 8 * fq;
        f32x4 bv[2][2];
#pragma unroll
        for (int bj = 0; bj < 2; ++bj)
#pragma unroll
            for (int n = 0; n < 2; ++n) bv[bj][n] = *(const f32x4*)(BD + (size_t)e * DM + c0 + bj * 128 + 4 * n);
        float wts[2][4];
#pragma unroll
        for (int ai = 0; ai < 2; ++ai)
#pragma unroll
            for (int m = 0; m < 4; ++m) wts[ai][m] = WSLOT[(size_t)(row0 + ai * 128 + m * 16)];
#pragma unroll
        for (int ai = 0; ai < 2; ++ai)
#pragma unroll
            for (int m = 0; m < 4; ++m) {
                const size_t row = (size_t)(row0 + ai * 128 + m * 16); const float wt = wts[ai][m];
#pragma unroll
                for (int bj = 0; bj < 2; ++bj) {
                    const pf4 v0 = acc[ai][bj][m][0], v1 = acc[ai][bj][m][1]; const f32x4 b0 = bv[bj][0], b1 = bv[bj][1];
                    constexpr float ASC = MOE_FP8 ? 1.0f / (SC_ACT8 * SC_W8) : 1.0f;
                    if (Y_FP8) { const float w8 = wt * SC_Y8; u32x2 w;
                        w.x = pk4_fp8((v0[0] * ASC + b0[0]) * w8, (v0[1] * ASC + b0[1]) * w8, (v0[2] * ASC + b0[2]) * w8, (v0[3] * ASC + b0[3]) * w8);
                        w.y = pk4_fp8((v1[0] * ASC + b1[0]) * w8, (v1[1] * ASC + b1[1]) * w8, (v1[2] * ASC + b1[2]) * w8, (v1[3] * ASC + b1[3]) * w8);
                        *(u32x2*)((unsigned char*)Y + row * DM + c0 + bj * 128) = w; }
                    else {
                    u32x4 w; w.x = pk2((v0[0] * ASC + b0[0]) * wt, (v0[1] * ASC + b0[1]) * wt); w.y = pk2((v0[2] * ASC + b0[2]) * wt, (v0[3] * ASC + b0[3]) * wt);
                    w.z = pk2((v1[0] * ASC + b1[0]) * wt, (v1[1] * ASC + b1[1]) * wt); w.w = pk2((v1[2] * ASC + b1[2]) * wt, (v1[3] * ASC + b1[3]) * wt);
                    *(u32x4*)(Y + row * DM + c0 + bj * 128) = w; }
                }
            }
    }
};

DI void p2_compress_item(const Args& a, LAS unsigned char* lds, int item, int tid, int wave, int lane) {
    asm volatile("" : "+v"(tid), "+v"(lane));
    unsigned char* ws = a.ws;
    const int nt = item & 15, ty = (item >> 4) & 1, g = (item >> 5) & 1, b = item >> 6;
    const bf16_t* KV = (const bf16_t*)(ws + WS_KV);
    const bf16_t* W1 = (const bf16_t*)(ws + (ty ? WS_W1V : WS_W1K));
    const bf16_t* W2 = (const bf16_t*)(ws + (ty ? WS_W2V : WS_W2K));
    const float* C1P = (const float*)(ws + WS_CTL + CTL_C1) + ty * 128 * 8;
    bf16_t* OUT = (bf16_t*)(ws + (ty ? WS_VCMP : WS_KCMP)) + (size_t)((b * 2 + g) * 512 + nt * 32) * 64;
    LAS unsigned char* Xs = lds;
    LAS float* Hs = (LAS float*)(lds + 81920);
    LAS unsigned char* Hb = lds + 81920 + 32768;
    const int r = lane & 31, h = lane >> 5;
    const int p0 = 512 * nt, colsrc = ty * 128 + g * 64;
    {
        u32x4 xv[9];
#pragma unroll
        for (int q = 0; q < 9; ++q) { const int i = tid + q * NTHREADS; if (i < 528 * 8) { const int pr = i >> 3, ch = i & 7; int pos = p0 + pr; pos = pos > SEQ - 1 ? SEQ - 1 : pos;
            xv[q] = *(const u32x4*)(KV + (size_t)(b * SEQ + pos) * 768 + colsrc + ch * 8); } }
#pragma unroll
        for (int q = 0; q < 9; ++q) { const int i = tid + q * NTHREADS; if (i < 528 * 8) { const int pr = i >> 3, ch = i & 7; *(LAS u32x4*)(Xs + (pr + (pr >> 4)) * 144 + ch * 16) = xv[q]; } }
    }
    __syncthreads();
    {
        const int ft = wave & 3, kh = wave >> 2;
        f32x16 acc; for (int i = 0; i < 16; ++i) acc[i] = 0.f;
        const bf16_t* wrow = W1 + (size_t)(ft * 32 + r) * 2048 + 8 * h;
        for (int s0 = kh * 64; s0 < kh * 64 + 64; s0 += 16) {
            bf16x8 bw[16];
#pragma unroll
            for (int q = 0; q < 16; ++q) bw[q] = *(const bf16x8*)(wrow + 16 * (s0 + q));
#pragma unroll
            for (int q = 0; q < 16; ++q) {
                const int s = s0 + q, l = s >> 2, d0 = (s & 3) * 16;
                const bf16x8 af = *(const LAS bf16x8*)(Xs + (17 * r + l + (l >> 4)) * 144 + (d0 + 8 * h) * 2);
                acc = MFMA32(af, bw[q], acc);
            }
        }
#pragma unroll
        for (int i = 0; i < 16; ++i) Hs[(kh * 32 + crow(i, h)) * 128 + ft * 32 + r] = acc[i];
    }
    __syncthreads();
    for (int i = tid; i < 32 * 128; i += NTHREADS) {
        const int n = i >> 7, f = i & 127;
        const f32x4 c0 = *(const f32x4*)(C1P + f * 8), c1 = *(const f32x4*)(C1P + f * 8 + 4);
        const float v = Hs[n * 128 + f] + Hs[(32 + n) * 128 + f] + ((((c0[0] + c0[1]) + c0[2]) + c0[3]) + (((c1[0] + c1[1]) + c1[2]) + c1[3]));
        *(LAS unsigned short*)(Hb + n * 272 + f * 2) = f2bf(gelu_t(v));
    }
    __syncthreads();
    if (wave < 2) {
        f32x16 acc; for (int i = 0; i < 16; ++i) acc[i] = 0.f;
        const bf16_t* wrow = W2 + (size_t)(wave * 32 + r) * 128 + 8 * h;
#pragma unroll
        for (int s = 0; s < 8; ++s) {
            const bf16x8 af = *(const LAS bf16x8*)(Hb + r * 272 + (16 * s + 8 * h) * 2);
            const bf16x8 bfr = *(const bf16x8*)(wrow + 16 * s);
            acc = MFMA32(af, bfr, acc);
        }
        if (ty == 0) {
#pragma unroll
            for (int i = 0; i < 16; ++i) OUT[(size_t)crow(i, h) * 64 + wave * 32 + r] = f2bf(acc[i]);
        } else {
            bf16_t* OT = (bf16_t*)(ws + WS_VCMP) + (size_t)(b * 2 + g) * 64 * 512 + (size_t)(wave * 32 + r) * 512 + nt * 32;
#pragma unroll
            for (int i = 0; i < 16; ++i) OT[crow(i, h)] = f2bf(acc[i]);
        }
    }
    __syncthreads();
}

DI void p2_sgu_item(const Args& a, LAS unsigned char* lds, int item, int tid, int wave, int lane) {
    asm volatile("" : "+v"(tid), "+v"(lane));
    unsigned char* ws = a.ws;
    const bf16_t* U = (const bf16_t*)(ws + WS_U); const bf16_t* V = (const bf16_t*)(ws + WS_V);
    const bf16_t* WT = (const bf16_t*)(ws + WS_WTRIL);
    bf16_t* YB = (bf16_t*)(ws + WS_YAB) + 512;
    const float* lng = a.in[11]; const float* lnb = a.in[12]; const float* bs = a.in[14];
    const size_t row0 = (size_t)item * 128;
    LAS unsigned char* VnT = lds;
    const int r = lane & 31, h = lane >> 5;
    {
        const int p = lane & 15, cg = lane >> 4, pos = wave * 16 + p;
        const bf16_t* vrow = V + (row0 + pos) * 512 + cg * 128;
        u32x4 raw[16];
#pragma unroll
        for (int j = 0; j < 16; ++j) raw[j] = *(const u32x4*)(vrow + 8 * j);
        float sm = 0.f;
#pragma unroll
        for (int j = 0; j < 16; ++j) sm += (bf2f(raw[j].x & 0xffffu) + bf2f(raw[j].x >> 16)) + (bf2f(raw[j].y & 0xffffu) + bf2f(raw[j].y >> 16)) + (bf2f(raw[j].z & 0xffffu) + bf2f(raw[j].z >> 16)) + (bf2f(raw[j].w & 0xffffu) + bf2f(raw[j].w >> 16));
        sm += __shfl_xor(sm, 16); sm += __shfl_xor(sm, 32);
        const float mu = sm * (1.f / 512.f);
        float qq = 0.f;
#pragma unroll
        for (int j = 0; j < 16; ++j) {
            const float d0 = bf2f(raw[j].x & 0xffffu) - mu, d1 = bf2f(raw[j].x >> 16) - mu, d2 = bf2f(raw[j].y & 0xffffu) - mu, d3 = bf2f(raw[j].y >> 16) - mu;
            const float d4 = bf2f(raw[j].z & 0xffffu) - mu, d5 = bf2f(raw[j].z >> 16) - mu, d6 = bf2f(raw[j].w & 0xffffu) - mu, d7 = bf2f(raw[j].w >> 16) - mu;
            qq += (d0 * d0 + d1 * d1) + (d2 * d2 + d3 * d3) + (d4 * d4 + d5 * d5) + (d6 * d6 + d7 * d7);
        }
        qq += __shfl_xor(qq, 16); qq += __shfl_xor(qq, 32);
        const float rs = 1.0f / sqrtf(qq * (1.f / 512.f) + 1e-5f);
        const float* gp = lng + cg * 128; const float* bp = lnb + cg * 128;
        LAS unsigned char* wp = VnT + (cg * 128) * 272 + pos * 2;
#pragma unroll
        for (int j = 0; j < 16; ++j) {
            const f32x4 g0 = *(const f32x4*)(gp + 8 * j), g1 = *(const f32x4*)(gp + 8 * j + 4), b0 = *(const f32x4*)(bp + 8 * j), b1 = *(const f32x4*)(bp + 8 * j + 4);
            LAS unsigned char* w8 = wp + (8 * j) * 272;
            *(LAS unsigned short*)(w8 + 0 * 272) = f2bf((bf2f(raw[j].x & 0xffffu) - mu) * rs * g0[0] + b0[0]); *(LAS unsigned short*)(w8 + 1 * 272) = f2bf((bf2f(raw[j].x >> 16) - mu) * rs * g0[1] + b0[1]);
            *(LAS unsigned short*)(w8 + 2 * 272) = f2bf((bf2f(raw[j].y & 0xffffu) - mu) * rs * g0[2] + b0[2]); *(LAS unsigned short*)(w8 + 3 * 272) = f2bf((bf2f(raw[j].y >> 16) - mu) * rs * g0[3] + b0[3]);
            *(LAS unsigned short*)(w8 + 4 * 272) = f2bf((bf2f(raw[j].z & 0xffffu) - mu) * rs * g1[0] + b1[0]); *(LAS unsigned short*)(w8 + 5 * 272) = f2bf((bf2f(raw[j].z >> 16) - mu) * rs * g1[1] + b1[1]);
            *(LAS unsigned short*)(w8 + 6 * 272) = f2bf((bf2f(raw[j].w & 0xffffu) - mu) * rs * g1[2] + b1[2]); *(LAS unsigned short*)(w8 + 7 * 272) = f2bf((bf2f(raw[j].w >> 16) - mu) * rs * g1[3] + b1[3]);
        }
    }
    __syncthreads();
    {
        const int grp = wave;
        for (int tt = 0; tt < 4; ++tt) {
            f32x16 acc[2];
#pragma unroll
            for (int i = 0; i < 16; ++i) { acc[0][i] = 0.f; acc[1][i] = 0.f; }
            const bf16_t* wrow = WT + (size_t)(grp * 128 + tt * 32 + r) * 128 + 8 * h;
            const int nst = 2 * tt + 2;
            u32x2 uu8[2][4];
            { const size_t rowt_ = row0 + tt * 32 + r;
#pragma unroll
              for (int dt = 0; dt < 2; ++dt)
#pragma unroll
                  for (int q4 = 0; q4 < 4; ++q4) uu8[dt][q4] = *(const u32x2*)(U + rowt_ * 512 + grp * 64 + dt * 32 + 8 * q4 + 4 * h); }
            bf16x8 bw[8];
#pragma unroll
            for (int s = 0; s < 8; ++s) if (s < nst) bw[s] = *(const bf16x8*)(wrow + 16 * s);
#pragma unroll
            for (int s = 0; s < 8; ++s) if (s < nst) {
#pragma unroll
                for (int dt = 0; dt < 2; ++dt) {
                    const bf16x8 af = *(const LAS bf16x8*)(VnT + (grp * 64 + dt * 32 + r) * 272 + (16 * s + 8 * h) * 2);
                    acc[dt] = MFMA32(af, bw[s], acc[dt]);
                }
            }
            const int t = tt * 32 + r; const float bt = bs[grp * 128 + t];
            const size_t rowt = row0 + t;
#pragma unroll
            for (int dt = 0; dt < 2; ++dt)
#pragma unroll
                for (int q4 = 0; q4 < 4; ++q4) {
                    const int d = dt * 32 + 8 * q4 + 4 * h;
                    const u32x2 uu = uu8[dt][q4];
                    const float y0 = bf2f(uu.x & 0xffffu) * (acc[dt][4 * q4 + 0] + bt), y1 = bf2f(uu.x >> 16) * (acc[dt][4 * q4 + 1] + bt);
                    const float y2 = bf2f(uu.y & 0xffffu) * (acc[dt][4 * q4 + 2] + bt), y3 = bf2f(uu.y >> 16) * (acc[dt][4 * q4 + 3] + bt);
                    u32x2 w; w.x = pk2(y0, y1); w.y = pk2(y2, y3);
                    *(u32x2*)(YB + rowt * 1024 + grp * 64 + d) = w;
                }
        }
    }
    __syncthreads();
    {
        const bf16_t* KV = (const bf16_t*)(ws + WS_KV); bf16_t* VT = (bf16_t*)(ws + WS_VT);
        LAS unsigned char* T = lds;
        const int bb = item >> 6, posc = (item & 63) * 128;
        {
            u32x4 vv[8];
#pragma unroll
            for (int q = 0; q < 8; ++q) { const int i = tid + q * NTHREADS, pos = i & 127, ch = i >> 7, ty = ch >> 4, c8 = (ch & 15) * 8;
                vv[q] = *(const u32x4*)(KV + (row0 + pos) * 768 + (ty ? 5 : 3) * 128 + c8); }
#pragma unroll
            for (int q = 0; q < 8; ++q) { const int i = tid + q * NTHREADS, pos = i & 127, ch = i >> 7, ty = ch >> 4, c8 = (ch & 15) * 8; const u32x4 v = vv[q];
                LAS unsigned char* tp = T + (ty * 128 + c8) * 272 + pos * 2;
                *(LAS unsigned short*)(tp + 0 * 272) = (unsigned short)(v.x & 0xffffu); *(LAS unsigned short*)(tp + 1 * 272) = (unsigned short)(v.x >> 16);
                *(LAS unsigned short*)(tp + 2 * 272) = (unsigned short)(v.y & 0xffffu); *(LAS unsigned short*)(tp + 3 * 272) = (unsigned short)(v.y >> 16);
                *(LAS unsigned short*)(tp + 4 * 272) = (unsigned short)(v.z & 0xffffu); *(LAS unsigned short*)(tp + 5 * 272) = (unsigned short)(v.z >> 16);
                *(LAS unsigned short*)(tp + 6 * 272) = (unsigned short)(v.w & 0xffffu); *(LAS unsigned short*)(tp + 7 * 272) = (unsigned short)(v.w >> 16); }
        }
        __syncthreads();
        for (int i = tid; i < 256 * 16; i += NTHREADS) {
            const int rw = i >> 4, ch = i & 15, ty = rw >> 7, gd = rw & 127;
            const u32x4 v = *(const LAS u32x4*)(T + rw * 272 + ch * 16);
            *(u32x4*)(VT + ((size_t)(ty * 4 + bb) * 128 + gd) * SEQ + posc + ch * 8) = v;
        }
        __syncthreads();
    }
}

constexpr int AL_K0 = 0, AL_K1 = 9216, AL_V0 = 18432, AL_V1 = 27136, AL_PB = 35840, AL_IMP = 102400, AL_SELM = 135424, AL_UNI = 136448, AL_BL = 136512, AL_NBL = 137024, AL_THR = 137088;
static_assert(AL_THR + 256 <= LDS_BYTES, "attention LDS map");
struct KVSrc { const bf16_t* k; const bf16_t* v; int kp, vp; };
struct BlkPar { float base, ksl; int lo, hi; };

template <int MODE>
DI void attn_block(const LAS unsigned char* Ks, const LAS unsigned char* Vs, const bf16x8 (&qf)[4], f32x16 (&o)[2], float& m, float& l, float invl, LAS float* pbrow, const BlkPar bp, const bool MASK, const bool first, int r, int h) {
    f32x16 p0, p1;
    {
        const float bh = bp.base + bp.ksl * (float)(4 * h) - m, bh1 = bh + 32.f * bp.ksl;
        const f32x2 ks2 = {bp.ksl, bp.ksl}, b2 = {bh, bh}, b21 = {bh1, bh1};
#pragma unroll
        for (int i = 0; i < 16; i += 2) { const f32x2 kc = {(float)((i & 3) + 8 * (i >> 2)), (float)(((i + 1) & 3) + 8 * ((i + 1) >> 2))};
            const f32x2 a = ks2 * kc + b2, c = ks2 * kc + b21; p0[i] = a.x; p0[i + 1] = a.y; p1[i] = c.x; p1[i + 1] = c.y; }
    }
    {
        bf16x8 kf[8];
#pragma unroll
        for (int s = 0; s < 4; ++s) { kf[2 * s] = *(const LAS bf16x8*)(Ks + r * 144 + s * 32 + h * 16); kf[2 * s + 1] = *(const LAS bf16x8*)(Ks + (32 + r) * 144 + s * 32 + h * 16); }
        __builtin_amdgcn_sched_barrier(0);
#pragma unroll
        for (int s = 0; s < 4; ++s) { p0 = MFMA32(kf[2 * s], qf[s], p0); p1 = MFMA32(kf[2 * s + 1], qf[s], p1); }
    }
    s16x4 vlo[8], vhi[8];
    if (MODE != 1) {
#pragma unroll
        for (int dh = 0; dh < 2; ++dh)
#pragma unroll
            for (int ks = 0; ks < 4; ++ks) { const LAS unsigned char* vp = Vs + (dh * 32 + r) * 136 + ks * 32 + h * 8; vlo[dh * 4 + ks] = *(const LAS s16x4*)vp; vhi[dh * 4 + ks] = *(const LAS s16x4*)(vp + 16); }
        __builtin_amdgcn_sched_barrier(0);
    }
    if (MASK) {
        const int lo = bp.lo - 4 * h, hi = bp.hi - 4 * h;
#pragma unroll
        for (int i = 0; i < 16; ++i) { const int kc = (i & 3) + 8 * (i >> 2); p0[i] = (kc >= lo && kc <= hi) ? p0[i] : NEGBIG; p1[i] = (kc + 32 >= lo && kc + 32 <= hi) ? p1[i] : NEGBIG; }
    }
    if (MODE == 0 || MODE == 1) {
        float mx = fmaxf(p0[0], p1[0]);
#pragma unroll
        for (int i = 1; i < 16; ++i) mx = fmaxf(fmaxf(mx, p0[i]), p1[i]);
        mx = xmax32(mx);
        if (first) {
            m += mx;
#pragma unroll
            for (int i = 0; i < 16; ++i) { p0[i] -= mx; p1[i] -= mx; }
        } else if (__any(mx > 0.f)) {
            const float dl = fmaxf(mx, 0.f), alpha = ex2(-dl); m += dl; l *= alpha;
#pragma unroll
            for (int i = 0; i < 16; ++i) { p0[i] -= dl; p1[i] -= dl; }
            if (MODE == 0) {
#pragma unroll
                for (int i = 0; i < 16; ++i) { o[0][i] *= alpha; o[1][i] *= alpha; }
            }
        }
        if (!first && __all(mx < -40.f)) return;
        float s0 = 0.f, s1 = 0.f;
#pragma unroll
        for (int i = 0; i < 16; ++i) { p0[i] = ex2(p0[i]); p1[i] = ex2(p1[i]); s0 += p0[i]; s1 += p1[i]; }
        l += s0 + s1;
    } else {
#pragma unroll
        for (int i = 0; i < 16; ++i) {
            p0[i] = p0[i] > -1e29f ? ex2(p0[i]) * invl : 0.f; p1[i] = p1[i] > -1e29f ? ex2(p1[i]) * invl : 0.f;
            pbrow[crow(i, h)] = p0[i]; pbrow[32 + crow(i, h)] = p1[i];
        }
    }
    if (MODE != 1) {
        bf16x8 pf[4];
#pragma unroll
        for (int ks = 0; ks < 2; ++ks) {
            u32x4 w0, w1;
            w0.x = pk2(p0[8 * ks + 0], p0[8 * ks + 1]); w0.y = pk2(p0[8 * ks + 2], p0[8 * ks + 3]); w0.z = pk2(p0[8 * ks + 4], p0[8 * ks + 5]); w0.w = pk2(p0[8 * ks + 6], p0[8 * ks + 7]);
            w1.x = pk2(p1[8 * ks + 0], p1[8 * ks + 1]); w1.y = pk2(p1[8 * ks + 2], p1[8 * ks + 3]); w1.z = pk2(p1[8 * ks + 4], p1[8 * ks + 5]); w1.w = pk2(p1[8 * ks + 6], p1[8 * ks + 7]);
            pf[ks] = __builtin_bit_cast(bf16x8, w0); pf[2 + ks] = __builtin_bit_cast(bf16x8, w1);
        }
#pragma unroll
        for (int ks = 0; ks < 4; ++ks)
#pragma unroll
            for (int dh = 0; dh < 2; ++dh) {
                const bf16x8 af = __builtin_shufflevector(vlo[dh * 4 + ks], vhi[dh * 4 + ks], 0, 1, 2, 3, 4, 5, 6, 7);
                o[dh] = MFMA32(af, pf[ks], o[dh]);
            }
    }
}

DI void kv_load(const KVSrc& s, int tid, u32x4& kreg, u32x4& vreg) {
    const int ko = (tid >> 3) * s.kp + (tid & 7) * 8, vo = (tid >> 3) * s.vp + (tid & 7) * 8;
    kreg = *(const u32x4*)(s.k + ko);
    vreg = *(const u32x4*)(s.v + vo);
}
DI void kv_store(LAS unsigned char* Kb, LAS unsigned char* Vb, int tid, const u32x4& kreg, const u32x4& vreg) {
    *(LAS u32x4*)(Kb + (tid >> 3) * 144 + (tid & 7) * 16) = kreg;
    LAS unsigned char* vp = Vb + (tid >> 3) * 136 + (tid & 7) * 16;
    *(LAS u32x2*)vp = (u32x2){vreg.x, vreg.y}; *(LAS u32x2*)(vp + 8) = (u32x2){vreg.z, vreg.w};
}

template <int MODE, class SrcF, class ParF, class PostF>
DI void attn_run(int nb, SrcF src, ParF par, PostF post, LAS unsigned char* lds, const bf16x8 (&qf)[4], f32x16 (&o)[2], float& m, float& l, float invl, LAS float* pbrow,
                 int tid, int r, int h, const bool pre, u32x4& kp, u32x4& vp, const bool want_nxt, const KVSrc nxt) {
    u32x4& kreg = kp; u32x4& vreg = vp;
    if (!pre) kv_load(src(0), tid, kreg, vreg);
    kv_store(lds + AL_K0, lds + AL_V0, tid, kreg, vreg);
    __syncthreads();
    for (int i = 0; i < nb; ++i) {
        const int cur = i & 1;
        if (i + 1 < nb) kv_load(src(i + 1), tid, kreg, vreg);
        else if (want_nxt) kv_load(nxt, tid, kreg, vreg);
        bool msk; const BlkPar bp = par(i, msk);
        attn_block<MODE>(lds + (cur ? AL_K1 : AL_K0), lds + (cur ? AL_V1 : AL_V0), qf, o, m, l, invl, pbrow, bp, msk, i == 0, r, h);
        if (MODE == 2) { __syncthreads(); post(i); }
        if (i + 1 < nb) kv_store(lds + (cur ? AL_K0 : AL_K1), lds + (cur ? AL_V0 : AL_V1), tid, kreg, vreg);
        __syncthreads();
    }
}

#define CE_DESC(a, b) do { const unsigned _x = (a), _y = (b); (a) = _x > _y ? _x : _y; (b) = _x > _y ? _y : _x; } while (0)
DI void sort16_desc(unsigned (&k)[16]) {
#pragma unroll
    for (int kk = 2; kk <= 16; kk <<= 1)
#pragma unroll
        for (int j = kk >> 1; j > 0; j >>= 1)
#pragma unroll
            for (int i = 0; i < 16; ++i) { const int p = i ^ j; if (p > i) { if ((i & kk) == 0) CE_DESC(k[i], k[p]); else CE_DESC(k[p], k[i]); } }
}
DI void merge16_desc(unsigned (&k)[16]) {
#pragma unroll
    for (int j = 8; j > 0; j >>= 1)
#pragma unroll
        for (int i = 0; i < 16; ++i) { const int p = i ^ j; if (p > i) CE_DESC(k[i], k[p]); }
}

DI void attn_tile(const Args& a, LAS unsigned char* lds, int b, int g, int c, int tid, int wave, int lane) {
    asm volatile("" : "+v"(tid), "+v"(lane));
    unsigned char* ws = a.ws;
    const bf16_t* Q = (const bf16_t*)(ws + WS_Q); const bf16_t* KV = (const bf16_t*)(ws + WS_KV);
    const bf16_t* KC = (const bf16_t*)(ws + WS_KCMP) + (size_t)(b * 2 + g) * 512 * 64; const bf16_t* VC = (const bf16_t*)(ws + WS_VCMP) + (size_t)(b * 2 + g) * 64 * 512;
    const float* NG = (const float*)(ws + WS_NG); bf16_t* YA = (bf16_t*)(ws + WS_YAB); const bf16_t* VT = (const bf16_t*)(ws + WS_VT);
    const int r = lane & 31, h = lane >> 5, hd = wave >> 1, th = wave & 1, tl = th * 32 + r, t = 64 * c + tl;
    const size_t row = (size_t)b * SEQ + t;
    const float slope2 = ex2(-(float)(g * 4 + hd + 1)) * LOG2E;
    const float tf = (float)t;
    bf16x8 qf[4];
#pragma unroll
    for (int s = 0; s < 4; ++s) qf[s] = *(const bf16x8*)(Q + row * 512 + g * 256 + hd * 64 + 16 * s + 8 * h);
    const float gate_c = NG[row * 24 + g * 12 + hd * 3 + 0], gate_s = NG[row * 24 + g * 12 + hd * 3 + 1], gate_w = NG[row * 24 + g * 12 + hd * 3 + 2];
    f32x16 tot[2];
    LAS float* IMP = (LAS float*)(lds + AL_IMP);
    LAS float* PB = (LAS float*)(lds + AL_PB);
    LAS float* pbrow = PB + (hd * 64 + tl) * 65;
    const bf16_t* kvb = KV + (size_t)b * SEQ * 768 + g * 64;
    auto nopost = [](int) {};

    const bf16_t* vtw = VT + ((size_t)(4 + b) * 128 + g * 64) * SEQ;
    u32x4 kpre, vpre;
    KVSrc cmp0; cmp0.k = KC; cmp0.v = VC; cmp0.kp = 64; cmp0.vp = 512;
    KVSrc sel0; sel0.k = kvb + (size_t)(64 * c) * 768 + 2 * 128; sel0.v = VT + ((size_t)(0 + b) * 128 + g * 64) * SEQ + 64 * c; sel0.kp = 768; sel0.vp = SEQ;
    const bf16_t* vts = VT + ((size_t)(0 + b) * 128 + g * 64) * SEQ;
    for (int rep = 0; rep < ATT_REP_W; ++rep) {
        const int nb = (c > 8 ? 8 : c) + 1;
        f32x16 o[2];
#pragma unroll
        for (int i = 0; i < 16; ++i) { o[0][i] = 0.f; o[1][i] = 0.f; }
        float m = 0.f, l = 0.f;
        auto src = [=](int i) { const int j = c - i; KVSrc s; s.k = kvb + (size_t)(64 * j) * 768 + 4 * 128; s.v = vtw + 64 * j; s.kp = 768; s.vp = SEQ; return s; };
        auto par = [=](int i, bool& msk) { const int d0 = t - 64 * (c - i); msk = (i == 0) || (i == 8); BlkPar bp; bp.base = -slope2 * (float)d0; bp.ksl = slope2; bp.lo = d0 - 511; bp.hi = d0; return bp; };
        attn_run<0>(nb, src, par, nopost, lds, qf, o, m, l, 0.f, pbrow, tid, r, h, false, kpre, vpre, true, cmp0);
        const float sc = gate_w * rcpf_(xsum32(l));
#pragma unroll
        for (int i = 0; i < 16; ++i) { tot[0][i] = sc * o[0][i]; tot[1][i] = sc * o[1][i]; }
    }
    for (int i = tid; i < 64 * 129; i += NTHREADS) IMP[i] = 0.f;
    for (int rep = 0; rep < ATT_REP_C; ++rep) {
        if (rep > 0) { __syncthreads(); for (int i = tid; i < 64 * 129; i += NTHREADS) IMP[i] = 0.f; }
        const int nbc = (4 * c + 3 + 63) >> 6;
        auto src = [=](int i) { KVSrc s; s.k = KC + (size_t)(64 * i) * 64; s.v = VC + 64 * i; s.kp = 64; s.vp = 512; return s; };
        const int nvalid = ((t - 31) >> 4);
        auto par = [=](int i, bool& msk) { const int n0 = 64 * i; msk = (n0 + 63) > ((64 * c - 31) >> 4);
            BlkPar bp; bp.base = -slope2 * (tf - (float)(16 * n0) - 15.5f); bp.ksl = 16.f * slope2; bp.lo = -1000000; bp.hi = nvalid - n0; return bp; };
        f32x16 o[2];
#pragma unroll
        for (int i = 0; i < 16; ++i) { o[0][i] = 0.f; o[1][i] = 0.f; }
        float m = 0.f, l = 0.f;
        attn_run<1>(nbc, src, par, nopost, lds, qf, o, m, l, 0.f, pbrow, tid, r, h, true, kpre, vpre, true, cmp0);
        const float invl = rcpf_(xsum32(l));
        auto post = [=](int i) {
            for (int q = tid; q < 64 * 17; q += NTHREADS) {
                const int tok = q & 63, jj = q >> 6, j = 16 * i + jj;
                float acc = 0.f;
                if (jj < 16) {
#pragma unroll
                    for (int hh = 0; hh < 4; ++hh) { const LAS float* p = PB + (hh * 64 + tok) * 65 + 4 * jj; acc += (p[0] + p[1]) + (p[2] + 0.5f * p[3]); if (jj > 0) acc += 0.5f * p[-1]; }
                } else {
#pragma unroll
                    for (int hh = 0; hh < 4; ++hh) acc += 0.5f * PB[(hh * 64 + tok) * 65 + 63];
                }
                if (j < 128) IMP[tok * 129 + j] += acc;
            }
        };
        attn_run<2>(nbc, src, par, post, lds, qf, o, m, l, invl, pbrow, tid, r, h, true, kpre, vpre, rep == ATT_REP_C - 1, sel0);
        if (rep == ATT_REP_C - 1)
#pragma unroll
        for (int i = 0; i < 16; ++i) { tot[0][i] += gate_c * o[0][i]; tot[1][i] += gate_c * o[1][i]; }
    }
    __syncthreads();
    if (ATTN_BRANCHES & 4) {
        LAS unsigned* L0 = (LAS unsigned*)(lds + AL_PB);
        LAS unsigned* L1 = L0 + 8 * 16 * 64;
        LAS unsigned* L2 = L1 + 4 * 16 * 64;
        LAS unsigned* THR = (LAS unsigned*)(lds + AL_THR);
        LAS unsigned short* SELM = (LAS unsigned short*)(lds + AL_SELM);
        LAS unsigned* UNI = (LAS unsigned*)(lds + AL_UNI);
        LAS int* BL = (LAS int*)(lds + AL_BL);
        LAS int* NBL = (LAS int*)(lds + AL_NBL);
        const int tok = lane, seg = wave;
        unsigned key[16];
#pragma unroll
        for (int i = 0; i < 16; ++i) {
            const int j = 16 * seg + i;
            const bool forced = (j == 0) || (j == c) || (j == c - 1);
            const unsigned kvv = forced ? 0x1FFFFFFu : (j <= c ? (__float_as_uint(IMP[tok * 129 + j]) >> 7) + 1u : 0u);
            key[i] = (kvv << 7) | (unsigned)(127 - j);
        }
        sort16_desc(key);
#pragma unroll
        for (int i = 0; i < 16; ++i) L0[(seg * 16 + i) * 64 + tok] = key[i];
        __syncthreads();
        if (wave < 4) {
            unsigned kk[16];
#pragma unroll
            for (int i = 0; i < 16; ++i) { const unsigned x = L0[((2 * wave) * 16 + i) * 64 + tok], y = L0[((2 * wave + 1) * 16 + 15 - i) * 64 + tok]; kk[i] = x > y ? x : y; }
            merge16_desc(kk);
#pragma unroll
            for (int i = 0; i < 16; ++i) L1[(wave * 16 + i) * 64 + tok] = kk[i];
        }
        __syncthreads();
        if (wave < 2) {
            unsigned kk[16];
#pragma unroll
            for (int i = 0; i < 16; ++i) { const unsigned x = L1[((2 * wave) * 16 + i) * 64 + tok], y = L1[((2 * wave + 1) * 16 + 15 - i) * 64 + tok]; kk[i] = x > y ? x : y; }
            merge16_desc(kk);
#pragma unroll
            for (int i = 0; i < 16; ++i) L2[(wave * 16 + i) * 64 + tok] = kk[i];
        }
        __syncthreads();
        if (wave == 0) {
            unsigned mn = 0xffffffffu;
#pragma unroll
            for (int i = 0; i < 16; ++i) { const unsigned x = L2[i * 64 + tok], y = L2[(16 + 15 - i) * 64 + tok]; const unsigned z = x > y ? x : y; mn = z < mn ? z : mn; }
            THR[tok] = mn;
        }
        __syncthreads();
        {
            const unsigned T = THR[tok]; unsigned m16 = 0;
#pragma unroll
            for (int i = 0; i < 16; ++i) m16 |= (key[i] >= T) ? (1u << (15 - (key[i] & 15u))) : 0u;
            SELM[tok * 8 + seg] = (unsigned short)m16;
            unsigned uni = 0;
#pragma unroll
            for (int bb = 0; bb < 16; ++bb) uni |= (__ballot((m16 >> bb) & 1u) != 0ull) ? (1u << bb) : 0u;
            if (lane == 0) UNI[seg] = uni;
        }
        __syncthreads();
        if (wave == 0) {
            int base = 0;
#pragma unroll
            for (int half = 0; half < 2; ++half) {
                const int j = half * 64 + lane;
                const bool on = ((UNI[j >> 4] >> (j & 15)) & 1u) && (j <= c);
                const unsigned long long bal = __ballot(on);
                const int pos = base + __builtin_popcountll(bal & ((1ull << lane) - 1ull));
                if (on) BL[pos] = j;
                base += __builtin_popcountll(bal);
            }
            if (lane == 0) NBL[0] = base;
        }
        __syncthreads();
        const int nbs = __builtin_amdgcn_readfirstlane(NBL[0]);
        f32x16 o[2];
#pragma unroll
        for (int i = 0; i < 16; ++i) { o[0][i] = 0.f; o[1][i] = 0.f; }
        float m = 0.f, l = 0.f;
        auto src = [=](int i) { const int j = __builtin_amdgcn_readfirstlane(BL[nbs - 1 - i]); KVSrc s; s.k = kvb + (size_t)(64 * j) * 768 + 2 * 128; s.v = vts + 64 * j; s.kp = 768; s.vp = SEQ; return s; };
        auto par = [=](int i, bool& msk) { const int j = __builtin_amdgcn_readfirstlane(BL[nbs - 1 - i]); const bool sel = (SELM[tl * 8 + (j >> 4)] >> (j & 15)) & 1; const int d0 = t - 64 * j;
            msk = (j == c); BlkPar bp; bp.base = sel ? -slope2 * (float)d0 : NEGBIG; bp.ksl = slope2; bp.lo = -1000000; bp.hi = d0; return bp; };
        for (int rep = 0; rep < ATT_REP_S; ++rep) {
            if (rep > 0) { m = 0.f; l = 0.f;
#pragma unroll
                for (int i = 0; i < 16; ++i) { o[0][i] = 0.f; o[1][i] = 0.f; } }
            attn_run<0>(nbs, src, par, nopost, lds, qf, o, m, l, 0.f, pbrow, tid, r, h, rep == 0, kpre, vpre, false, sel0);
        }
        const float sc = gate_s * rcpf_(xsum32(l));
#pragma unroll
        for (int dh = 0; dh < 2; ++dh)
#pragma unroll
            for (int q4 = 0; q4 < 4; ++q4) {
                const int d = dh * 32 + 8 * q4 + 4 * h;
                u32x2 w; w.x = pk2(tot[dh][4 * q4 + 0] + sc * o[dh][4 * q4 + 0], tot[dh][4 * q4 + 1] + sc * o[dh][4 * q4 + 1]); w.y = pk2(tot[dh][4 * q4 + 2] + sc * o[dh][4 * q4 + 2], tot[dh][4 * q4 + 3] + sc * o[dh][4 * q4 + 3]);
                *(u32x2*)(YA + row * 1024 + g * 256 + hd * 64 + d) = w;
            }
    }
    __syncthreads();
}

DI void p6a_route(const Args& a, LAS unsigned char* lds, int tid, int wave, int lane) {
    asm volatile("" : "+v"(tid), "+v"(lane));
    unsigned char* ws = a.ws;
    const float* X2 = (const float*)(ws + WS_X2); const float* br = a.in[20];
    const bf16_t* WH = (const bf16_t*)(ws + WS_WRT); const bf16_t* WL = WH + 32 * 1024;
    int* TOKE = (int*)(ws + WS_TOKE); float* TOKW = (float*)(ws + WS_TOKW); int* CNT = (int*)(ws + WS_CTL + CTL_CNT); float* RINV = (float*)(ws + WS_RINV);
    LAS unsigned char* WHL = lds; LAS unsigned char* WLL = lds + 65536;
    LAS float* CS = (LAS float*)(lds + 131072 + wave * 2112);
    LAS int* CNTL = (LAS int*)(lds + 131072 + 8 * 2112);
    const int tk = lane & 15, kq = lane >> 4;
    LAS float* GSL = (LAS float*)(lds + 131072 + 8 * 2112 + 128);
    static_assert(131072 + 8 * 2112 + 128 + 4096 <= LDS_BYTES - 16, "router LDS map");
    for (int i = tid; i < DM; i += NTHREADS) GSL[i] = a.in[18][i] * SC_A8;
    for (int i = tid; i < 2 * 32 * 128; i += NTHREADS) {
        const int arr = i >> 12, e = (i >> 7) & 31, ch = i & 127;
        *(LAS u32x4*)(lds + arr * 65536 + e * 2048 + ((ch ^ (e & 15)) * 16)) = *(const u32x4*)(WH + (size_t)arr * 32 * 1024 + e * 1024 + ch * 8);
    }
    __syncthreads();
    const LAS float* GS = GSL;
    for (int blk0 = blockIdx.x; blk0 < 256 * DBL(6); blk0 += gridDim.x) {
        const int blk = blk0 & 255;
        if (tid < 32) CNTL[tid] = 0;
        __syncthreads();
        const int t0 = blk * 128 + wave * 16;
        const float* xp = X2 + (size_t)(t0 + tk) * DM + 8 * kq;
        const LAS unsigned char* wh0 = WHL + tk * 2048; const LAS unsigned char* wl0 = WLL + tk * 2048;
        f32x4 acc0 = {0.f, 0.f, 0.f, 0.f}, acc1 = {0.f, 0.f, 0.f, 0.f}; float ss = 0.f;
        unsigned char* H8 = (unsigned char*)(ws + WS_AS) + (size_t)(t0 + tk) * DM + 8 * kq; const LAS float* gmp = GS + 8 * kq;
#pragma unroll 8
        for (int s = 0; s < 32; ++s) {
            const f32x4 xa = __builtin_nontemporal_load((const f32x4*)(xp + 32 * s)), xb = __builtin_nontemporal_load((const f32x4*)(xp + 32 * s + 4));
            const int wo = ((4 * s + kq) ^ tk) * 16;
            const bf16x8 bh0 = *(const LAS bf16x8*)(wh0 + wo), bl0 = *(const LAS bf16x8*)(wl0 + wo), bh1 = *(const LAS bf16x8*)(wh0 + 16 * 2048 + wo), bl1 = *(const LAS bf16x8*)(wl0 + 16 * 2048 + wo);
            ss += (xa[0] * xa[0] + xa[1] * xa[1]) + (xa[2] * xa[2] + xa[3] * xa[3]) + (xb[0] * xb[0] + xb[1] * xb[1]) + (xb[2] * xb[2] + xb[3] * xb[3]);
            u32x4 hh; hh.x = pk2(xa[0], xa[1]); hh.y = pk2(xa[2], xa[3]); hh.z = pk2(xb[0], xb[1]); hh.w = pk2(xb[2], xb[3]);
            u32x4 lo; lo.x = pk2(xa[0] - bf2f(hh.x & 0xffffu), xa[1] - bf2f(hh.x >> 16)); lo.y = pk2(xa[2] - bf2f(hh.y & 0xffffu), xa[3] - bf2f(hh.y >> 16));
            lo.z = pk2(xb[0] - bf2f(hh.z & 0xffffu), xb[1] - bf2f(hh.z >> 16)); lo.w = pk2(xb[2] - bf2f(hh.w & 0xffffu), xb[3] - bf2f(hh.w >> 16));
            if (MOE_GATHER && MOE_FP8) {
                const f32x4 ga = *(const LAS f32x4*)(gmp + 32 * s), gb = *(const LAS f32x4*)(gmp + 32 * s + 4);
                u32x2 w; w.x = pk4_fp8(xa[0] * ga[0], xa[1] * ga[1], xa[2] * ga[2], xa[3] * ga[3]); w.y = pk4_fp8(xb[0] * gb[0], xb[1] * gb[1], xb[2] * gb[2], xb[3] * gb[3]);
                *(u32x2*)(H8 + 32 * s) = w;
            }
            const bf16x8 ah = __builtin_bit_cast(bf16x8, hh), al = __builtin_bit_cast(bf16x8, lo);
            acc0 = __builtin_amdgcn_mfma_f32_16x16x32_bf16(bh0, ah, acc0, 0, 0, 0); acc0 = __builtin_amdgcn_mfma_f32_16x16x32_bf16(bl0, ah, acc0, 0, 0, 0); acc0 = __builtin_amdgcn_mfma_f32_16x16x32_bf16(bh0, al, acc0, 0, 0, 0);
            acc1 = __builtin_amdgcn_mfma_f32_16x16x32_bf16(bh1, ah, acc1, 0, 0, 0); acc1 = __builtin_amdgcn_mfma_f32_16x16x32_bf16(bl1, ah, acc1, 0, 0, 0); acc1 = __builtin_amdgcn_mfma_f32_16x16x32_bf16(bh1, al, acc1, 0, 0, 0);
        }
#pragma unroll
        for (int i = 0; i < 4; ++i) { CS[tk * 33 + 4 * kq + i] = acc0[i]; CS[tk * 33 + 16 + 4 * kq + i] = acc1[i]; }
        ss += __shfl_xor(ss, 16); ss += __shfl_xor(ss, 32);
        const float rinv = 1.0f / sqrtf(ss * (1.f / DM) + 1e-5f);
        lds_wait();
        if (lane < 16) {
            float lg[32];
#pragma unroll
            for (int e = 0; e < 32; ++e) lg[e] = CS[lane * 33 + e] * rinv + br[e];
            int es0 = 0, es1 = 0, es2 = 0, es3 = 0; float vs0 = 0.f, vs1 = 0.f, vs2 = 0.f, vs3 = 0.f;
#define TOP1(ES, VS) { float mx = lg[0]; int ix = 0; _Pragma("unroll") for (int e = 1; e < 32; ++e) { const bool gt = lg[e] > mx; mx = gt ? lg[e] : mx; ix = gt ? e : ix; } ES = ix; VS = mx; \
                _Pragma("unroll") for (int e = 0; e < 32; ++e) lg[e] = (e == ix) ? -3e38f : lg[e]; }
            TOP1(es0, vs0) TOP1(es1, vs1) TOP1(es2, vs2) TOP1(es3, vs3)
#undef TOP1
            const float e1 = ex2((vs1 - vs0) * LOG2E), e2 = ex2((vs2 - vs0) * LOG2E), e3 = ex2((vs3 - vs0) * LOG2E);
            const float inv = 1.0f / (1.0f + e1 + e2 + e3);
            const int t = t0 + lane;
            *(u32x4*)(TOKE + (size_t)t * 4) = (u32x4){(unsigned)es0, (unsigned)es1, (unsigned)es2, (unsigned)es3};
            *(f32x4*)(TOKW + (size_t)t * 4) = (f32x4){inv, e1 * inv, e2 * inv, e3 * inv};
            RINV[t] = rinv;
            atomicAdd((int*)(CNTL + es0), 1); atomicAdd((int*)(CNTL + es1), 1); atomicAdd((int*)(CNTL + es2), 1); atomicAdd((int*)(CNTL + es3), 1);
        }
        __syncthreads();
        if (tid < 32) CNT[blk * 32 + tid] = CNTL[tid];
        __syncthreads();
    }
}
DI void p6b_place(const Args& a, LAS unsigned char* lds, int tid, int wave, int lane) {
    asm volatile("" : "+v"(tid), "+v"(lane));
    unsigned char* ws = a.ws;
    const float* X2 = (const float*)(ws + WS_X2); const float* RINV = (const float*)(ws + WS_RINV); bf16_t* AS = (bf16_t*)(ws + WS_AS);
    const float* gm = a.in[18];
    const f32x4 g00 = *(const f32x4*)(gm + lane * 8), g01 = *(const f32x4*)(gm + lane * 8 + 4), g10 = *(const f32x4*)(gm + 512 + lane * 8), g11 = *(const f32x4*)(gm + 512 + lane * 8 + 4);
    const int* TOKE = (const int*)(ws + WS_TOKE); const float* TOKW = (const float*)(ws + WS_TOKW); const int* CNT = (const int*)(ws + WS_CTL + CTL_CNT);
    int* SLOT = (int*)(ws + WS_SLOT); float* WSLOT = (float*)(ws + WS_WSLOT); int* TE = (int*)(ws + WS_CTL + CTL_TE); int* NT = (int*)(ws + WS_CTL + CTL_NT);
    LAS int* TOT = (LAS int*)lds; LAS int* OFFS = TOT + 32; LAS int* PADS = TOT + 64; LAS int* CUR = TOT + 96;
    for (int blk0 = blockIdx.x; blk0 < 256 * DBL(10); blk0 += gridDim.x) {
        const int blk = blk0 & 255;
        {
            LAS int* PT = TOT + 128; LAS int* PM = TOT + 128 + 512;
            const int e = tid & 31, part = tid >> 5; int tot = 0, mine = 0;
#pragma unroll
            for (int q = 0; q < 16; ++q) { const int bb = part * 16 + q; const int cc = CNT[bb * 32 + e]; tot += cc; mine += (bb < blk) ? cc : 0; }
            PT[part * 32 + e] = tot; PM[part * 32 + e] = mine;
            __syncthreads();
            if (tid < 32) { int t2 = 0, m2 = 0;
#pragma unroll
                for (int q = 0; q < 16; ++q) { t2 += PT[q * 32 + tid]; m2 += PM[q * 32 + tid]; }
                TOT[tid] = t2; OFFS[tid] = m2; CUR[tid] = 0; }
        }
        __syncthreads();
        if (tid == 0) {
            int ps = 0;
            for (int e = 0; e < 32; ++e) { PADS[e] = ps; ps += (TOT[e] + 255) & ~255; }
            if (blk == 0) NT[0] = ps >> 8;
        }
        __syncthreads();
        if (blk == 0 && tid < 32) { const int t0 = PADS[tid] >> 8, n = (TOT[tid] + 255) >> 8; for (int q = 0; q < n; ++q) TE[t0 + q] = tid; }
        if (MOE_GATHER && MOE_FP8) {
            int* STOK = (int*)(ws + WS_STOK); float* RSLOT = (float*)(ws + WS_RSLOT);
            if (blk == 0) { for (int e = wave; e < 32; e += NWAVES) { const int lo = PADS[e] + TOT[e], hi = PADS[e] + ((TOT[e] + 255) & ~255); for (int p = lo + lane; p < hi; p += 64) { STOK[p] = 0; WSLOT[p] = 0.f; RSLOT[p] = 0.f; } } }
            const int t = blk * 128 + (tid >> 2), k = tid & 3;
            const int e = TOKE[(size_t)t * 4 + k];
            const int pos = PADS[e] + OFFS[e] + atomicAdd((int*)(CUR + e), 1);
            STOK[pos] = t; SLOT[(size_t)t * 4 + k] = pos; WSLOT[pos] = TOKW[(size_t)t * 4 + k]; RSLOT[pos] = RINV[t];
        } else
        {
            const int tb = blk * 128 + wave * 16;
            f32x4 a0, a1, b0, b1, na0, na1, nb0, nb1; float rv, nrv; int e0, e1, e2, e3, ne0, ne1, ne2, ne3; float w0, w1, w2, w3, nw0, nw1, nw2, nw3;
#define P6B_LOAD(T, A0, A1, B0, B1, RV, E0, E1, E2, E3, W0, W1, W2, W3) { const float* xp = X2 + (size_t)(T) * DM + lane * 8; A0 = *(const f32x4*)xp; A1 = *(const f32x4*)(xp + 4); B0 = *(const f32x4*)(xp + 512); B1 = *(const f32x4*)(xp + 516); RV = RINV[T]; \
                const int* ep = TOKE + (size_t)(T) * 4; E0 = ep[0]; E1 = ep[1]; E2 = ep[2]; E3 = ep[3]; const float* wp = TOKW + (size_t)(T) * 4; W0 = wp[0]; W1 = wp[1]; W2 = wp[2]; W3 = wp[3]; }
            P6B_LOAD(tb, a0, a1, b0, b1, rv, e0, e1, e2, e3, w0, w1, w2, w3)
            for (int it = 0; it < 16; ++it) {
                const int t = tb + it;
                if (it + 1 < 16) P6B_LOAD(t + 1, na0, na1, nb0, nb1, nrv, ne0, ne1, ne2, ne3, nw0, nw1, nw2, nw3)
                u32x4 r0, r1; u32x2 q0, q1;
                if (MOE_FP8) { const float r8 = rv * SC_A8;
                    q0.x = pk4_fp8(a0[0] * r8 * g00[0], a0[1] * r8 * g00[1], a0[2] * r8 * g00[2], a0[3] * r8 * g00[3]); q0.y = pk4_fp8(a1[0] * r8 * g01[0], a1[1] * r8 * g01[1], a1[2] * r8 * g01[2], a1[3] * r8 * g01[3]);
                    q1.x = pk4_fp8(b0[0] * r8 * g10[0], b0[1] * r8 * g10[1], b0[2] * r8 * g10[2], b0[3] * r8 * g10[3]); q1.y = pk4_fp8(b1[0] * r8 * g11[0], b1[1] * r8 * g11[1], b1[2] * r8 * g11[2], b1[3] * r8 * g11[3]);
                } else {
                    r0.x = pk2(a0[0] * rv * g00[0], a0[1] * rv * g00[1]); r0.y = pk2(a0[2] * rv * g00[2], a0[3] * rv * g00[3]); r0.z = pk2(a1[0] * rv * g01[0], a1[1] * rv * g01[1]); r0.w = pk2(a1[2] * rv * g01[2], a1[3] * rv * g01[3]);
                    r1.x = pk2(b0[0] * rv * g10[0], b0[1] * rv * g10[1]); r1.y = pk2(b0[2] * rv * g10[2], b0[3] * rv * g10[3]); r1.z = pk2(b1[0] * rv * g11[0], b1[1] * rv * g11[1]); r1.w = pk2(b1[2] * rv * g11[2], b1[3] * rv * g11[3]);
                }
#pragma unroll
                for (int k = 0; k < 4; ++k) {
                    const int e = k == 0 ? e0 : k == 1 ? e1 : k == 2 ? e2 : e3; const float wk = k == 0 ? w0 : k == 1 ? w1 : k == 2 ? w2 : w3;
                    int p = 0; if (lane == 0) p = atomicAdd((int*)(CUR + e), 1);
                    p = __builtin_amdgcn_readfirstlane(p);
                    const int pos = PADS[e] + OFFS[e] + p;
                    if (MOE_FP8) { *(u32x2*)((unsigned char*)AS + (size_t)pos * DM + lane * 8) = q0; *(u32x2*)((unsigned char*)AS + (size_t)pos * DM + 512 + lane * 8) = q1; }
                    else { *(u32x4*)(AS + (size_t)pos * DM + lane * 8) = r0; *(u32x4*)(AS + (size_t)pos * DM + 512 + lane * 8) = r1; }
                    if (lane == 0) { SLOT[(size_t)t * 4 + k] = pos; WSLOT[pos] = wk; }
                }
                a0 = na0; a1 = na1; b0 = nb0; b1 = nb1; rv = nrv; e0 = ne0; e1 = ne1; e2 = ne2; e3 = ne3; w0 = nw0; w1 = nw1; w2 = nw2; w3 = nw3;
            }
#undef P6B_LOAD
        }
        __syncthreads();
    }
}
#if Y_FP8
DI void p9_final(const Args& a, int gw, int NGW, int lane) {
    asm volatile("" : "+v"(lane));
    unsigned char* ws = a.ws;
    const float* X2 = (const float*)(ws + WS_X2); const unsigned char* Y = (const unsigned char*)(ws + WS_Y); const int* SLOT = (const int*)(ws + WS_SLOT);
    const float* gf = a.in[25]; float* out = a.out;
    f32x4 gv[4];
#pragma unroll
    for (int j = 0; j < 4; ++j) gv[j] = *((const f32x4*)gf + lane * 4 + j);
    int t0 = gw;
    int p0 = 0, p1 = 0, p2 = 0, p3 = 0;
    constexpr int TX = MTOK * DBL(9);
    if (t0 < TX) { const int t = t0 % MTOK; p0 = SLOT[(size_t)t * 4]; p1 = SLOT[(size_t)t * 4 + 1]; p2 = SLOT[(size_t)t * 4 + 2]; p3 = SLOT[(size_t)t * 4 + 3]; }
    for (; t0 < TX; t0 += NGW) {
        const int t = t0 % MTOK; const int tn0 = t0 + NGW, tn = tn0 % MTOK;
        int q0 = 0, q1 = 0, q2 = 0, q3 = 0;
        if (tn0 < TX) { q0 = SLOT[(size_t)tn * 4]; q1 = SLOT[(size_t)tn * 4 + 1]; q2 = SLOT[(size_t)tn * 4 + 2]; q3 = SLOT[(size_t)tn * 4 + 3]; }
        f32x4 v[4]; u32x4 y[4];
#pragma unroll
        for (int j = 0; j < 4; ++j) v[j] = __builtin_nontemporal_load((const f32x4*)(X2 + (size_t)t * DM) + lane * 4 + j);
        y[0] = __builtin_nontemporal_load((const u32x4*)(Y + (size_t)p0 * DM) + lane); y[1] = __builtin_nontemporal_load((const u32x4*)(Y + (size_t)p1 * DM) + lane);
        y[2] = __builtin_nontemporal_load((const u32x4*)(Y + (size_t)p2 * DM) + lane); y[3] = __builtin_nontemporal_load((const u32x4*)(Y + (size_t)p3 * DM) + lane);
        float s = 0.f;
#pragma unroll
        for (int j = 0; j < 4; ++j) {
            f32x2 lo = {0.f, 0.f}, hi = {0.f, 0.f};
#pragma unroll
            for (int k = 0; k < 4; ++k) { const int w = (int)y[k][j]; lo += __builtin_amdgcn_cvt_pk_f32_fp8(w, false); hi += __builtin_amdgcn_cvt_pk_f32_fp8(w, true); }
            v[j].x += lo.x * (1.0f / SC_Y8); v[j].y += lo.y * (1.0f / SC_Y8); v[j].z += hi.x * (1.0f / SC_Y8); v[j].w += hi.y * (1.0f / SC_Y8);
            s += (v[j].x * v[j].x + v[j].y * v[j].y) + (v[j].z * v[j].z + v[j].w * v[j].w);
        }
        const float rinv = 1.0f / sqrtf(wave_sum(s) * (1.f / DM) + 1e-5f);
#pragma unroll
        for (int j = 0; j < 4; ++j) *((f32x4*)(out + (size_t)t * DM) + lane * 4 + j) = (f32x4){v[j].x * rinv * gv[j].x, v[j].y * rinv * gv[j].y, v[j].z * rinv * gv[j].z, v[j].w * rinv * gv[j].w};
        p0 = q0; p1 = q1; p2 = q2; p3 = q3;
    }
}
#else
DI void p9_final(const Args& a, int gw, int NGW, int lane) {
    asm volatile("" : "+v"(lane));
    unsigned char* ws = a.ws;
    const float* X2 = (const float*)(ws + WS_X2); const bf16_t* Y = (const bf16_t*)(ws + WS_Y); const int* SLOT = (const int*)(ws + WS_SLOT);
    const float* gf = a.in[25]; float* out = a.out;
    f32x4 gv[4];
#pragma unroll
    for (int j = 0; j < 4; ++j) gv[j] = *((const f32x4*)gf + lane + 64 * j);
    int t0 = gw;
    int p0 = 0, p1 = 0, p2 = 0, p3 = 0;
    constexpr int TX = MTOK * DBL(9);
    if (t0 < TX) { const int t = t0 % MTOK; p0 = SLOT[(size_t)t * 4]; p1 = SLOT[(size_t)t * 4 + 1]; p2 = SLOT[(size_t)t * 4 + 2]; p3 = SLOT[(size_t)t * 4 + 3]; }
    for (; t0 < TX; t0 += NGW) {
        const int t = t0 % MTOK; const int tn0 = t0 + NGW, tn = tn0 % MTOK;
        int q0 = 0, q1 = 0, q2 = 0, q3 = 0;
        if (tn0 < TX) { q0 = SLOT[(size_t)tn * 4]; q1 = SLOT[(size_t)tn * 4 + 1]; q2 = SLOT[(size_t)tn * 4 + 2]; q3 = SLOT[(size_t)tn * 4 + 3]; }
        f32x4 v[4]; u32x2 y0[4], y1[4], y2[4], y3[4];
#pragma unroll
        for (int j = 0; j < 4; ++j) v[j] = *((const f32x4*)(X2 + (size_t)t * DM) + lane + 64 * j);
#pragma unroll
        for (int j = 0; j < 4; ++j) { y0[j] = *((const u32x2*)(Y + (size_t)p0 * DM) + lane + 64 * j); y1[j] = *((const u32x2*)(Y + (size_t)p1 * DM) + lane + 64 * j);
            y2[j] = *((const u32x2*)(Y + (size_t)p2 * DM) + lane + 64 * j); y3[j] = *((const u32x2*)(Y + (size_t)p3 * DM) + lane + 64 * j); }
        float s = 0.f;
#pragma unroll
        for (int j = 0; j < 4; ++j) {
            v[j].x += ((bf2f(y0[j].x & 0xffffu) + bf2f(y1[j].x & 0xffffu)) + bf2f(y2[j].x & 0xffffu)) + bf2f(y3[j].x & 0xffffu);
            v[j].y += ((bf2f(y0[j].x >> 16) + bf2f(y1[j].x >> 16)) + bf2f(y2[j].x >> 16)) + bf2f(y3[j].x >> 16);
            v[j].z += ((bf2f(y0[j].y & 0xffffu) + bf2f(y1[j].y & 0xffffu)) + bf2f(y2[j].y & 0xffffu)) + bf2f(y3[j].y & 0xffffu);
            v[j].w += ((bf2f(y0[j].y >> 16) + bf2f(y1[j].y >> 16)) + bf2f(y2[j].y >> 16)) + bf2f(y3[j].y >> 16);
            s += (v[j].x * v[j].x + v[j].y * v[j].y) + (v[j].z * v[j].z + v[j].w * v[j].w);
        }
        const float rinv = 1.0f / sqrtf(wave_sum(s) * (1.f / DM) + 1e-5f);
#pragma unroll
        for (int j = 0; j < 4; ++j) *((f32x4*)(out + (size_t)t * DM) + lane + 64 * j) = (f32x4){v[j].x * rinv * gv[j].x, v[j].y * rinv * gv[j].y, v[j].z * rinv * gv[j].z, v[j].w * rinv * gv[j].w};
        p0 = q0; p1 = q1; p2 = q2; p3 = q3;
    }
}

#endif
__global__ void __launch_bounds__(NTHREADS, 2) hybrid_fwd(Args args) {
    extern __shared__ __attribute__((aligned(16))) unsigned char lds_raw[];
    LAS unsigned char* lds = (LAS unsigned char*)lds_raw;
    cg::grid_group grid = cg::this_grid();
    const int tid = threadIdx.x, lane = tid & 63, wave = __builtin_amdgcn_readfirstlane(tid >> 6);
    volatile LAS unsigned* bst = (volatile LAS unsigned*)(lds_raw_las(lds_raw) + LDS_BYTES - 16);
    if (tid < 4) bst[tid] = 0u;
    __syncthreads();
    const XcdBarrier xbar = xcd_barrier_post((unsigned*)(args.ws + WS_CTL + CTL_BAR), bst);
#define SYNC() xcd_barrier(xbar)
    const int G = gridDim.x, bx = blockIdx.x;
    const int gw = bx * NWAVES + wave, NGW = G * NWAVES;
    unsigned char* ws = args.ws;

#if PROBE_PH == 30
    for (int pass = 0; pass < 2; ++pass) {
#endif
    if (args.ws == nullptr) grid.sync();
    for (int rep = 0; rep < NREP(0); ++rep) p0_prep(args, lds, gw, NGW, wave, lane);
    SYNC();
    for (int rep = 0; rep < NREP(1); ++rep) {
        if (STAG1) stagger_us(bx, STAG1);
        pg8::Gemm g{(const pg8::bf16_t*)(ws + WS_H1), (const pg8::bf16_t*)(ws + WS_WIN), MTOK, NPROJ, DM};
        pg8::StaticOrder S; S.init(MTOK, NPROJ, G, bx);
#if PROBE_PH == 1
        Twice<pg8::StaticOrder> S2{S, 0, 2}; S2.init();
#endif
        Epi1 E{(bf16_t*)(ws + WS_Q), (bf16_t*)(ws + WS_KV), (bf16_t*)(ws + WS_U), (bf16_t*)(ws + WS_V), (bf16_t*)(ws + WS_MG), (float*)(ws + WS_NG)};

#if PROBE_PH == 1
        pg8::gemm_phase<Epi1, Twice<pg8::StaticOrder>, true, true>(lds, g, S2, E);
#else
        pg8::gemm_phase<Epi1, pg8::StaticOrder, true, true>(lds, g, S, E);
#endif
    }
    SYNC();
    for (int rep = 0; rep < NREP(2); ++rep)
    for (int it0 = bx; it0 < 512 * DBL(2); it0 += G) {
        const int it = it0 & 511;
        if (it < 256) { p2_compress_item(args, lds, it, tid, wave, lane);
#if PROBE_PH == 50
            p2_compress_item(args, lds, it, tid, wave, lane);
#endif
        } else { p2_sgu_item(args, lds, it - 256, tid, wave, lane);
#if PROBE_PH == 51
            p2_sgu_item(args, lds, it - 256, tid, wave, lane);
#endif
        }
    }
    SYNC();
    for (int rep = 0; rep < NREP(3); ++rep) {
        for (int it0 = bx; it0 < 1024 * ATT_TWICE; it0 += G) {
            const int it = it0 & 1023;
            const int w = it & 255, i = it >> 8, s = w & 63, b = w >> 6;
            const int g = i & 1, c = (i >> 1) ? 127 - s : s;
            attn_tile(args, lds, b, g, c, tid, wave, lane);
        }
    }
    SYNC();
    for (int rep = 0; rep < NREP(4); ++rep) {
        if (STAG4) stagger_us(bx, STAG4);
        pg8::Gemm g{(const pg8::bf16_t*)(ws + WS_YAB), (const pg8::bf16_t*)(ws + WS_WAB), MTOK, DM, DM};
        pg8::StaticOrder S; S.init(MTOK, DM, G, bx);
        Epi4 E{(const bf16_t*)(ws + WS_MG), (bf16_t*)(ws + WS_MERGED)};
        pg8::gemm_phase<Epi4, pg8::StaticOrder, true, true>(lds, g, S, E);
    }
    SYNC();
    for (int rep = 0; rep < NREP(5); ++rep) {
        if (STAG5) stagger_us(bx, STAG5);
        pg8::Gemm g{(const pg8::bf16_t*)(ws + WS_MERGED), (const pg8::bf16_t*)(ws + WS_WOUT), MTOK, DM, DM};
        pg8::StaticOrder S; S.init(MTOK, DM, G, bx);
#if PROBE_PH == 5
        Twice<pg8::StaticOrder> S2{S, 0, 2}; S2.init();
#endif
        Epi5 E{args.in[0], (float*)(ws + WS_X2)};

#if PROBE_PH == 5
        pg8::gemm_phase<Epi5, Twice<pg8::StaticOrder>, true, true>(lds, g, S2, E);
#else
        pg8::gemm_phase<Epi5, pg8::StaticOrder, true, true>(lds, g, S, E);
#endif
    }
    SYNC();
    for (int rep = 0; rep < NREP(6); ++rep) { p6a_route(args, lds, tid, wave, lane); }
    SYNC();
    for (int rep = 0; rep < NREP(10); ++rep) { p6b_place(args, lds, tid, wave, lane); }
    SYNC();
    const int* TE = (const int*)(ws + WS_CTL + CTL_TE);
    const int NT = __builtin_amdgcn_readfirstlane(*(const int*)(ws + WS_CTL + CTL_NT));
    for (int rep = 0; rep < NREP(7); ++rep) {
        int kq = MOE_FP8 ? DM / 2 : DM; asm volatile("" : "+s"(kq));
        pg8::Gemm g{(const pg8::bf16_t*)(ws + WS_AS), (const pg8::bf16_t*)(ws + WS_WGU), MPAD, NEXP * 2048, kq, (MOE_GATHER && MOE_FP8) ? (const int*)(ws + WS_STOK) : nullptr};
        MoeOrder S{TE, NT, 8, G, bx};
#if PROBE_PH == 7
        Twice<MoeOrder> S2{S, 0, 2}; S2.init();
#endif
        Epi7 E{args.in[22], (bf16_t*)(ws + WS_ACT), (MOE_GATHER && MOE_FP8) ? (const float*)(ws + WS_RSLOT) : nullptr};

#if PROBE_PH == 7
        pg8::gemm_phase<Epi7, Twice<MoeOrder>, true, true, MOE_FP8 != 0, (MOE_GATHER && MOE_FP8)>(lds, g, S2, E);
#else
        { const MoeOrderLds SL = moe_list_build(S, lds, tid); pg8::gemm_phase<Epi7, MoeOrderLds, true, true, MOE_FP8 != 0, (MOE_GATHER && MOE_FP8)>(lds, g, SL, E); }
#endif
    }
    SYNC();
    for (int rep = 0; rep < NREP(8); ++rep) {
        if (STAG8) stagger_us(bx, STAG8);
        int kq = MOE_FP8 ? DFF / 2 : DFF; asm volatile("" : "+s"(kq));
        pg8::Gemm g{(const pg8::bf16_t*)(ws + WS_ACT), (const pg8::bf16_t*)(ws + WS_WD), MPAD, NEXP * 1024, kq};
        MoeOrder S{TE, NT, 4, G, bx};
#if PROBE_PH == 8
        Twice<MoeOrder> S2{S, 0, 2}; S2.init();
#endif
        Epi8 E{args.in[24], (const float*)(ws + WS_WSLOT), (bf16_t*)(ws + WS_Y)};

#if PROBE_PH == 8
        pg8::gemm_phase<Epi8, Twice<MoeOrder>, true, true, MOE_FP8 != 0>(lds, g, S2, E);
#else
        { const MoeOrderLds SL = moe_list_build(S, lds, tid); pg8::gemm_phase<Epi8, MoeOrderLds, true, true, MOE_FP8 != 0>(lds, g, SL, E); }
#endif
    }
    SYNC();
#if PROBE_PH == 20
    for (int i = 0; i < 10; ++i) SYNC();
#endif
#if PROBE_PH == 40
    asm volatile(".rept 8192\n\ts_nop 0\n\t.endr" ::: "memory");
#endif
#if PROBE_PH == 41
    for (int i = 0; i < 1024; ++i) asm volatile("s_nop 0\n\ts_nop 0\n\ts_nop 0\n\ts_nop 0\n\ts_nop 0\n\ts_nop 0\n\ts_nop 0\n\ts_nop 0" ::: "memory");
#endif
#if PROBE_PH == 21 || PROBE_PH == 22 || PROBE_PH == 23
    {
        float a0 = 0.5f, a1 = 0.25f, a2 = 0.125f, a3 = 0.0625f; typedef float f2_t __attribute__((ext_vector_type(2))); f2_t b0 = {0.5f, 0.5f}, b1 = {0.25f, 0.25f}, b2 = {0.1f, 0.1f}, b3 = {0.2f, 0.2f};
        for (int i = 0; i < 4096; ++i) {
#if PROBE_PH == 21
            asm volatile("v_exp_f32 %0, %0\n\tv_exp_f32 %1, %1\n\tv_exp_f32 %2, %2\n\tv_exp_f32 %3, %3" : "+v"(a0), "+v"(a1), "+v"(a2), "+v"(a3));
#elif PROBE_PH == 22
            asm volatile("v_mul_f32 %0, %0, %0\n\tv_mul_f32 %1, %1, %1\n\tv_mul_f32 %2, %2, %2\n\tv_mul_f32 %3, %3, %3" : "+v"(a0), "+v"(a1), "+v"(a2), "+v"(a3));
#else
            asm volatile("v_pk_mul_f32 %0, %0, %0\n\tv_pk_mul_f32 %1, %1, %1\n\tv_pk_mul_f32 %2, %2, %2\n\tv_pk_mul_f32 %3, %3, %3" : "+v"(b0), "+v"(b1), "+v"(b2), "+v"(b3));
#endif
        }
        if (a0 + a1 + a2 + a3 + b0.x + b1.x + b2.x + b3.x == 123.456f) args.out[0] = 0.f;
    }
#endif
    for (int rep = 0; rep < NREP(9); ++rep) p9_final(args, gw, NGW, lane);
#if PROBE_PH == 30
    SYNC();
    }
#endif
}

extern "C" void kernel_launch(void* const* d_in, const int* in_sizes, int n_in, void* d_out, int out_size, void* d_ws, size_t ws_size, hipStream_t stream) {
    static int grid = 0;
    if (grid == 0) {
        if (n_in != 26 || in_sizes[0] != MTOK * DM || out_size != MTOK * DM || ws_size < WS_END) {
            fprintf(stderr, "kernel_launch: unexpected shapes (n_in %d, in0 %d, out %d, ws %zu < %zu)\n", n_in, n_in > 0 ? in_sizes[0] : -1, out_size, ws_size, (size_t)WS_END); grid = -1; return; }
        int dev = 0, cus = 0, per_cu = 0;
        hipGetDevice(&dev);
        hipDeviceGetAttribute(&cus, hipDeviceAttributeMultiprocessorCount, dev);
        if (hipFuncSetAttribute((const void*)hybrid_fwd, hipFuncAttributeMaxDynamicSharedMemorySize, LDS_BYTES) != hipSuccess) { fprintf(stderr, "kernel_launch: hipFuncSetAttribute failed\n"); grid = -1; return; }
        if (hipOccupancyMaxActiveBlocksPerMultiprocessor(&per_cu, (const void*)hybrid_fwd, NTHREADS, LDS_BYTES) != hipSuccess || per_cu < 1) { fprintf(stderr, "kernel_launch: occupancy query says %d\n", per_cu); per_cu = 1; }
        (void)hipGetLastError();
        grid = cus * 1;
        if (grid > cus * per_cu) grid = cus * per_cu;
    }
    if (grid < 0) return;
    if (hipMemsetAsync((unsigned char*)d_ws + WS_CTL + CTL_BAR, 0, XCD_BAR_WORDS * 4, stream) != hipSuccess) { fprintf(stderr, "kernel_launch: memset failed\n"); return; }
    Args a{};
    for (int i = 0; i < 26; ++i) a.in[i] = (const float*)d_in[i];
    a.out = (float*)d_out; a.ws = (unsigned char*)d_ws;
    void* kargs[] = {&a};
    hipError_t e = hipLaunchCooperativeKernel((const void*)hybrid_fwd, dim3(grid), dim3(NTHREADS), kargs, LDS_BYTES, stream);
    if (e != hipSuccess) fprintf(stderr, "kernel_launch: cooperative launch failed: %s (grid %d)\n", hipGetErrorString(e), grid);
}
```

```cpp
#include <hip/hip_runtime.h>
#include <hip/hip_cooperative_groups.h>
#include <cstdio>
#include <cstdint>
namespace cg = cooperative_groups;
namespace pg8 {
#define PG8_LAS __attribute__((address_space(3)))
typedef unsigned short bf16_t;
typedef short bf16x8 __attribute__((ext_vector_type(8)));
typedef float f32x4 __attribute__((ext_vector_type(4)));
typedef unsigned u32x4 __attribute__((ext_vector_type(4)));
typedef int v4i32_t __attribute__((ext_vector_type(4)));
typedef int v8i32_t __attribute__((ext_vector_type(8)));
constexpr int BM = 256, BK = 64, HALF = 128, HTB = HALF * BK * 2  , STAGE_BYTES = 8 * HTB, NXCD = 8, WGM = 8;

__host__ __device__ __forceinline__ int lds_byte(int r, int c) { const int st = (r >> 4) * 2 + (c >> 5), rr = r & 15, cc = c & 31, ob = rr * 64 + cc * 2; return st * 1024 + (ob ^ (((ob >> 9) & 1) << 5)); }
__host__ __device__ __forceinline__ void stage_rc(int b, int& R, int& C) { const int st = b / 1024, sb = b % 1024, swz = sb ^ (((sb >> 9) & 1) << 5); R = (st >> 1) * 16 + swz / 64; C = (st & 1) * 32 + (swz % 64) / 2; }
__host__ __device__ __forceinline__ int perm32(int rho) { const int n = rho >> 4, i = rho & 15; return 8 * (i >> 2) + 4 * n + (i & 3); }

struct Unit { int pm, pn; };
struct Gemm { const bf16_t* A; const bf16_t* Bt; int M, N, K; const int* rowmap = nullptr; };

struct StaticOrder {
    int nM, nN, nwg, G, c;
    __host__ __device__ void init(int M, int N, int G_, int c_) { nM = M / BM; nN = N / BM; nwg = nM * nN; G = G_; c = c_; }
    __host__ __device__ bool next(int i, Unit& u) const {
        const long L = (long)i * G + c; if (L >= nwg) return false;
        int wgid = (int)L; { const int q = nwg / NXCD, r = nwg % NXCD, xcd = wgid % NXCD, off = wgid / NXCD; wgid = (xcd < r ? xcd * (q + 1) : r * (q + 1) + (xcd - r) * q) + off; }
        const int nig = WGM * nN, gid = wgid / nig, fm = gid * WGM, gsz = (nM - fm) < WGM ? (nM - fm) : WGM;
        u.pm = fm + ((wgid % nig) % gsz); u.pn = (wgid % nig) / gsz; return true;
    }
    __device__ __forceinline__ void a_ready(const Unit&) const {}
    __device__ __forceinline__ void done(const Unit&) const {}
};

__device__ __forceinline__ unsigned cvt_pk_bf16(float lo, float hi) { unsigned r; asm volatile("v_cvt_pk_bf16_f32 %0, %1, %2" : "=v"(r) : "v"(lo), "v"(hi)); return r; }
typedef float f32x2 __attribute__((ext_vector_type(2)));
template <class Epi, class Sched, bool ALIGN_EPI = false, bool SP2 = false, bool FP8 = false, bool GATHER = false>
__device__ __forceinline__ void gemm_phase(PG8_LAS unsigned char* lds, const Gemm g, const Sched& S, const Epi& E) {
    int tid_ = threadIdx.x; asm volatile("" : "+v"(tid_));
    const int tid = tid_, wid = __builtin_amdgcn_readfirstlane(tid >> 6), lane = tid & 63, wr = wid >> 2, wc = wid & 3, fr = lane & 15, fq = lane >> 4;
    const int K = g.K, nt = K / BK;
    unsigned voffA[2], voffB[2];
    int rA[2]; unsigned cA2[2];
#pragma unroll
    for (int i = 0; i < 2; ++i) { int R, C; stage_rc(tid * 16 + i * 8192, R, C); const int Rb = Epi::PERM ? ((R & ~31) + perm32(R & 31)) : R;
        voffA[i] = (unsigned)(R * K + C) * 2u; voffB[i] = (unsigned)(Rb * K + C) * 2u; rA[i] = R; cA2[i] = (unsigned)C * 2u; }
    static_assert(!GATHER || SP2, "GATHER is wired into the SP2 loop only");
    unsigned gcu0[2], gcu1[2], gnx0[2], gnx1[2]; int ix2[4] = {0, 0, 0, 0};
#define PG8_GIDX(u, h, i) (g.rowmap[(u).pm * BM + (h) * HALF + rA[i]])
#define PG8_GOFF(ix, i) ((unsigned)(ix) * (unsigned)(K * 2) + cA2[i])
    const size_t kstep = (size_t)(BK * 2);
    const size_t hstep = (size_t)HALF * K * 2;
    const size_t tstep = 2 * hstep;
    const unsigned ldsw = (unsigned)wid * 1024u;
    const int aoff = lds_byte(wr * 64 + fr, fq * 8), boff = lds_byte(wc * 32 + fr, fq * 8);
#define PG8_SA(b, h) (((b) * 2 + (h)) * HTB)
#define PG8_SB(b, h) ((4 + (b) * 2 + (h)) * HTB)
#define PG8_STAGE(bufoff, gbase, voff) do { _Pragma("unroll") for (int _i = 0; _i < 2; ++_i) \
        __builtin_amdgcn_global_load_lds((const unsigned*)((const char*)(gbase) + (voff)[_i]), (PG8_LAS unsigned*)(lds + (bufoff) + ldsw + _i * 8192), 16, 0, 0); } while (0)
#define PG8_STAGE_O(bufoff, gbase, o0, o1) do { \
        __builtin_amdgcn_global_load_lds((const unsigned*)((const char*)(gbase) + (o0)), (PG8_LAS unsigned*)(lds + (bufoff) + ldsw), 16, 0, 0); \
        __builtin_amdgcn_global_load_lds((const unsigned*)((const char*)(gbase) + (o1)), (PG8_LAS unsigned*)(lds + (bufoff) + ldsw + 8192), 16, 0, 0); } while (0)
#define PG8_STAGE_A(bufoff, gbase, h, nx) do { if constexpr (GATHER) { if (h) PG8_STAGE_O(bufoff, gbase, (nx) ? gnx1[0] : gcu1[0], (nx) ? gnx1[1] : gcu1[1]); else PG8_STAGE_O(bufoff, gbase, (nx) ? gnx0[0] : gcu0[0], (nx) ? gnx0[1] : gcu0[1]); } \
        else { PG8_STAGE(bufoff, (gbase) + ((h) ? hstep : 0), voffA); } } while (0)
#define PG8_LDA(dst, b, h) do { _Pragma("unroll") for (int m = 0; m < 4; ++m) _Pragma("unroll") for (int k = 0; k < 2; ++k) dst[m][k] = *(const PG8_LAS bf16x8*)(lds + PG8_SA(b, h) + aoff + m * 2048 + k * 1024); } while (0)
#define PG8_LDB(dst, b, h) do { _Pragma("unroll") for (int n = 0; n < 2; ++n) _Pragma("unroll") for (int k = 0; k < 2; ++k) dst[n][k] = *(const PG8_LAS bf16x8*)(lds + PG8_SB(b, h) + boff + n * 2048 + k * 1024); } while (0)
#define PG8_CAT8(x) __builtin_shufflevector(__builtin_bit_cast(v4i32_t, (x)[0]), __builtin_bit_cast(v4i32_t, (x)[1]), 0, 1, 2, 3, 4, 5, 6, 7)
#define PG8_MMA(ai, bj, At, Bt) do { __builtin_amdgcn_s_setprio(1); \
        if constexpr (FP8) { _Pragma("unroll") for (int m = 0; m < 4; ++m) _Pragma("unroll") for (int n = 0; n < 2; ++n) \
            { const v8i32_t a8_ = PG8_CAT8(Bt[n]), b8_ = PG8_CAT8(At[m]); asm volatile("v_mfma_scale_f32_16x16x128_f8f6f4 %0, %1, %2, %0, %3, %3 op_sel_hi:[0,0,0]" : "+v"(acc[ai][bj][m][n]) : "v"(a8_), "v"(b8_), "v"(0x7f7f7f7f)); } } \
        else { _Pragma("unroll") for (int m = 0; m < 4; ++m) _Pragma("unroll") for (int n = 0; n < 2; ++n) _Pragma("unroll") for (int k = 0; k < 2; ++k) \
            acc[ai][bj][m][n] = __builtin_amdgcn_mfma_f32_16x16x32_bf16(Bt[n][k], At[m][k], acc[ai][bj][m][n], 0, 0, 0); } \
        __builtin_amdgcn_s_setprio(0); } while (0)
#define PG8_WAIT_V(n) asm volatile("s_waitcnt vmcnt(" #n ")" ::: "memory")
#define PG8_WAIT_L(n) asm volatile("s_waitcnt lgkmcnt(" #n ")" ::: "memory")
#define PG8_BAR __builtin_amdgcn_s_barrier()
#define PG8_SCHED __builtin_amdgcn_sched_barrier(0)
    Unit cur, nxt; int ui = 0;
    if (!S.next(0, cur)) return;
    f32x4 acc[2][2][4][2];
#pragma unroll
    for (int a = 0; a < 2; ++a)
#pragma unroll
        for (int b = 0; b < 2; ++b)
#pragma unroll
            for (int m = 0; m < 4; ++m)
#pragma unroll
                for (int n = 0; n < 2; ++n) acc[a][b][m][n] = (f32x4){0.f, 0.f, 0.f, 0.f};
    bf16x8 At[4][2], B0[2][2], B1[2][2];
    const char* cA = (const char*)g.A + (GATHER ? (size_t)0 : (size_t)cur.pm * tstep); const char* cB = (const char*)g.Bt + (size_t)cur.pn * tstep;
    if constexpr (GATHER) { gcu0[0] = PG8_GOFF(PG8_GIDX(cur, 0, 0), 0); gcu0[1] = PG8_GOFF(PG8_GIDX(cur, 0, 1), 1); gcu1[0] = PG8_GOFF(PG8_GIDX(cur, 1, 0), 0); gcu1[1] = PG8_GOFF(PG8_GIDX(cur, 1, 1), 1);
        gnx0[0] = gcu0[0]; gnx0[1] = gcu0[1]; gnx1[0] = gcu1[0]; gnx1[1] = gcu1[1]; }
    S.a_ready(cur);
    if constexpr (Epi::PREFETCH) E.prefetch(cur, lds + STAGE_BYTES, tid);
    if constexpr (SP2) {
        PG8_STAGE(PG8_SB(0, 0), cB, voffB); PG8_STAGE(PG8_SB(0, 1), cB + hstep, voffB); PG8_STAGE_A(PG8_SA(0, 0), cA, 0, false); PG8_STAGE_A(PG8_SA(0, 1), cA, 1, false);
        if (wr == 1) PG8_BAR;
        PG8_WAIT_V(2); PG8_BAR;
        PG8_STAGE(PG8_SB(1, 0), cB + kstep, voffB); PG8_STAGE_A(PG8_SA(1, 0), cA + kstep, 0, false); PG8_STAGE(PG8_SB(1, 1), cB + hstep + kstep, voffB);
        PG8_WAIT_V(6); PG8_BAR;
    } else {
        PG8_STAGE(PG8_SB(0, 0), cB, voffB); PG8_STAGE(PG8_SA(0, 0), cA, voffA); PG8_STAGE(PG8_SB(0, 1), cB + hstep, voffB); PG8_STAGE(PG8_SA(0, 1), cA + hstep, voffA);
        if (wr == 1) PG8_BAR;
        PG8_WAIT_V(4); PG8_BAR;
        PG8_STAGE(PG8_SB(1, 0), cB + kstep, voffB); PG8_STAGE(PG8_SA(1, 0), cA + kstep, voffA); PG8_STAGE(PG8_SB(1, 1), cB + hstep + kstep, voffB);
        PG8_WAIT_V(6); PG8_BAR;
    }
    for (;;) {
        const bool has_next = S.next(ui + 1, nxt);
        const char* nA = GATHER ? cA : (has_next ? (const char*)g.A + (size_t)nxt.pm * tstep : cA); const char* nB = has_next ? (const char*)g.Bt + (size_t)nxt.pn * tstep : cB;
        if constexpr (GATHER) { if (ui == 0 && has_next) { gnx0[0] = PG8_GOFF(PG8_GIDX(nxt, 0, 0), 0); gnx0[1] = PG8_GOFF(PG8_GIDX(nxt, 0, 1), 1); gnx1[0] = PG8_GOFF(PG8_GIDX(nxt, 1, 0), 0); gnx1[1] = PG8_GOFF(PG8_GIDX(nxt, 1, 1), 1); } }
        for (int t = 0; t < nt; t += 2) {
            if constexpr (Epi::MIDK) { if (t == nt / 2) { int fr_ = fr, fq_ = fq; asm volatile("" : "+v"(fr_), "+v"(fq_)); E.midk(acc, cur, wr, wc, fr_, fq_); } }
            const bool last = (t == nt - 2);
            const char* a1 = cA + (size_t)(t + 1) * kstep;
            const char* a2 = last ? nA : cA + (size_t)(t + 2) * kstep; const char* b2 = last ? nB : cB + (size_t)(t + 2) * kstep;
            const char* a3 = a2 + kstep; const char* b3 = b2 + kstep;
            if (last && has_next) S.a_ready(nxt);
            if constexpr (SP2) {
            PG8_LDB(B0, 0, 0); PG8_LDB(B1, 0, 1); PG8_SCHED; PG8_LDA(At, 0, 0); PG8_STAGE_A(PG8_SA(1, 1), a1, 1, false);
            PG8_WAIT_V(8); PG8_WAIT_L(0); PG8_BAR; PG8_MMA(0, 0, At, B0); PG8_MMA(0, 1, At, B1); PG8_BAR; PG8_SCHED;
            PG8_LDA(At, 0, 1); PG8_STAGE(PG8_SB(0, 0), b2, voffB); PG8_STAGE(PG8_SB(0, 1), b2 + hstep, voffB); PG8_STAGE_A(PG8_SA(0, 0), a2, 0, last);
            PG8_WAIT_V(8); PG8_WAIT_L(0); PG8_BAR; PG8_MMA(1, 0, At, B0); PG8_MMA(1, 1, At, B1); PG8_BAR; PG8_SCHED;
            PG8_LDB(B0, 1, 0); PG8_LDB(B1, 1, 1); PG8_SCHED; PG8_LDA(At, 1, 0); PG8_STAGE_A(PG8_SA(0, 1), a2, 1, last);
            PG8_WAIT_V(8); PG8_WAIT_L(0); PG8_BAR; PG8_MMA(0, 0, At, B0); PG8_MMA(0, 1, At, B1); PG8_BAR; PG8_SCHED;
            PG8_LDA(At, 1, 1); PG8_STAGE(PG8_SB(1, 0), b3, voffB); PG8_STAGE(PG8_SB(1, 1), b3 + hstep, voffB); PG8_STAGE_A(PG8_SA(1, 0), a3, 0, last);
            PG8_WAIT_V(8); PG8_WAIT_L(0); PG8_BAR; PG8_MMA(1, 0, At, B0); PG8_MMA(1, 1, At, B1); PG8_BAR; PG8_SCHED;
            } else {
            PG8_LDB(B0, 0, 0); PG8_SCHED; PG8_LDA(At, 0, 0); PG8_STAGE(PG8_SA(1, 1), a1 + hstep, voffA);
            PG8_WAIT_L(8); PG8_BAR; PG8_WAIT_L(0); PG8_MMA(0, 0, At, B0); PG8_BAR; PG8_SCHED;
            PG8_LDB(B1, 0, 1); PG8_STAGE(PG8_SB(0, 0), b2, voffB);
            PG8_BAR; PG8_WAIT_L(0); PG8_MMA(0, 1, At, B1); PG8_BAR;
            PG8_LDA(At, 0, 1); PG8_STAGE(PG8_SA(0, 0), a2, voffA);
            PG8_BAR; PG8_WAIT_L(0); PG8_MMA(1, 0, At, B0); PG8_BAR; PG8_SCHED;
            PG8_STAGE(PG8_SB(0, 1), b2 + hstep, voffB);
            PG8_WAIT_V(6); PG8_BAR; PG8_MMA(1, 1, At, B1); PG8_BAR;
            PG8_LDB(B0, 1, 0); PG8_SCHED; PG8_LDA(At, 1, 0); PG8_STAGE(PG8_SA(0, 1), a2 + hstep, voffA);
            PG8_WAIT_L(8); PG8_BAR; PG8_WAIT_L(0); PG8_MMA(0, 0, At, B0); PG8_BAR; PG8_SCHED;
            PG8_LDB(B1, 1, 1); PG8_STAGE(PG8_SB(1, 0), b3, voffB);
            PG8_BAR; PG8_WAIT_L(0); PG8_MMA(0, 1, At, B1); PG8_BAR;
            PG8_LDA(At, 1, 1); PG8_STAGE(PG8_SA(1, 0), a3, voffA);
            PG8_BAR; PG8_WAIT_L(0); PG8_MMA(1, 0, At, B0); PG8_BAR; PG8_SCHED;
            PG8_STAGE(PG8_SB(1, 1), b3 + hstep, voffB);
            PG8_WAIT_V(6); PG8_BAR; PG8_MMA(1, 1, At, B1); PG8_BAR;
            }
        }
        if constexpr (FP8) asm volatile("s_nop 15\n\ts_nop 15\n\ts_nop 15\n\ts_nop 15" ::: "memory");
        if constexpr (ALIGN_EPI) { if (wr == 0) PG8_BAR; }
        bool has2 = false;
        if constexpr (GATHER) { Unit n2; has2 = has_next && S.next(ui + 2, n2);
            if (has2) { ix2[0] = PG8_GIDX(n2, 0, 0); ix2[1] = PG8_GIDX(n2, 0, 1); ix2[2] = PG8_GIDX(n2, 1, 0); ix2[3] = PG8_GIDX(n2, 1, 1); } }
        if constexpr (!Epi::AFTER_DRAIN) { int fr_ = fr, fq_ = fq; asm volatile("" : "+v"(fr_), "+v"(fq_));
            E(acc, cur, wr, wc, fr_, fq_); S.done(cur); }
        if (!has_next) break;
#pragma unroll
        for (int a = 0; a < 2; ++a)
#pragma unroll
            for (int b = 0; b < 2; ++b)
#pragma unroll
                for (int m = 0; m < 4; ++m)
#pragma unroll
                    for (int n = 0; n < 2; ++n) acc[a][b][m][n] = (f32x4){0.f, 0.f, 0.f, 0.f};
        cur = nxt; cA = nA; cB = nB; ++ui;
        if constexpr (Epi::PREFETCH) E.prefetch(cur, lds + STAGE_BYTES, tid);
        if constexpr (GATHER) { gcu0[0] = gnx0[0]; gcu0[1] = gnx0[1]; gcu1[0] = gnx1[0]; gcu1[1] = gnx1[1];
            if (has2) { gnx0[0] = PG8_GOFF(ix2[0], 0); gnx0[1] = PG8_GOFF(ix2[1], 1); gnx1[0] = PG8_GOFF(ix2[2], 0); gnx1[1] = PG8_GOFF(ix2[3], 1); } }
        if constexpr (ALIGN_EPI) { if (wr == 1) PG8_BAR; }
    }
    PG8_WAIT_V(0);
    if constexpr (!ALIGN_EPI) { if (wr == 0) PG8_BAR; }
    PG8_BAR;
    if constexpr (Epi::AFTER_DRAIN) { E.fused(acc, cur, wr, wc, fr, fq, lds, wid, lane); S.done(cur); }
#undef PG8_SA
#undef PG8_SB
#undef PG8_STAGE
#undef PG8_STAGE_O
#undef PG8_STAGE_A
#undef PG8_GIDX
#undef PG8_GOFF
#undef PG8_LDA
#undef PG8_LDB
#undef PG8_MMA
#undef PG8_CAT8
#undef PG8_WAIT_V
#undef PG8_WAIT_L
#undef PG8_BAR
#undef PG8_SCHED
}
}
#define LAS __attribute__((address_space(3)))
#define XB_TMO      128
#define XB_XCNT(j)  (256  + 64 * (j))
#define XB_XSUB(j)  (1280 + 64 * (j))
#define XB_XGEN(j)  (2304 + 64 * (j))
#define XB_TOP      3328
#define XB_TOPGEN   3392
#define XCD_BAR_WORDS 3456
#define XB_SPIN_CAP (1u << 18)

__device__ __forceinline__ unsigned xb_ld(unsigned* p)              { return __hip_atomic_load(p, __ATOMIC_RELAXED, __HIP_MEMORY_SCOPE_AGENT); }
__device__ __forceinline__ unsigned xb_add(unsigned* p, unsigned v) { return __hip_atomic_fetch_add(p, v, __ATOMIC_RELAXED, __HIP_MEMORY_SCOPE_AGENT); }
__device__ __forceinline__ unsigned xb_xcc_id() { return (unsigned)__builtin_amdgcn_s_getreg((3 << 11) | 20) & 0xFu; }
#define XB_SPIN(cond, bar) do { unsigned _sp = 0; while (cond) { __builtin_amdgcn_s_sleep(1); \
    if ((++_sp & 255u) == 0u) { if (xb_ld(&(bar)[XB_TMO])) break; if (_sp > XB_SPIN_CAP) { atomicAdd(&(bar)[XB_TMO], 1u); break; } } } } while (0)

struct XcdBarrier {
    unsigned* bar; unsigned x;
    volatile LAS unsigned* st;
};

__device__ __forceinline__ XcdBarrier xcd_barrier_post(unsigned* bar, volatile LAS unsigned* st) {
    XcdBarrier b; b.bar = bar; b.x = xb_xcc_id(); b.st = st;
    if (threadIdx.x == 0) (void)xb_add(&bar[XB_XCNT(b.x)], 1u);
    return b;
}
__device__ __forceinline__ void xcd_barrier_complete(unsigned* bar, unsigned x, unsigned& nloc, unsigned& nx) {
    const unsigned G = gridDim.x * gridDim.y * gridDim.z;
    unsigned sum, cnt, mine, sp = 0u;
    for (;;) {
        sum = 0u; cnt = 0u; mine = 0u;
#pragma unroll
        for (unsigned j = 0; j < 16; ++j) { const unsigned c = xb_ld(&bar[XB_XCNT(j)]); sum += c; cnt += (c > 0u) ? 1u : 0u; mine = (j == x) ? c : mine; }
        if (sum == G) break;
        __builtin_amdgcn_s_sleep(1);
        if ((++sp & 255u) == 0u) { if (xb_ld(&bar[XB_TMO])) break; if (sp > XB_SPIN_CAP) { atomicAdd(&bar[XB_TMO], 1u); break; } }
    }
    nloc = mine > 0u ? mine : 1u; nx = cnt > 0u ? cnt : 1u;
}

__device__ __forceinline__ void xcd_barrier(const XcdBarrier& b) {
    asm volatile("s_waitcnt vmcnt(0)" ::: "memory");
    __syncthreads();
    if (threadIdx.x == 0) {
        unsigned* bar = b.bar;
        __builtin_amdgcn_s_waitcnt(0);
        unsigned nloc = b.st[0], nx = b.st[1];
        if (nloc == 0u) { xcd_barrier_complete(bar, b.x, nloc, nx); b.st[0] = nloc; b.st[1] = nx; }
        const unsigned old = xb_add(&bar[XB_XSUB(b.x)], 1u);
        const unsigned gen = old / nloc;
        if (old + 1u == (gen + 1u) * nloc) {
            __builtin_amdgcn_fence(__ATOMIC_RELEASE, "agent");
            asm volatile("s_waitcnt vmcnt(0)" ::: "memory");
            const unsigned og = xb_add(&bar[XB_TOP], 1u);
            const unsigned tg = og / nx;
            if (og + 1u == (tg + 1u) * nx) xb_add(&bar[XB_TOPGEN], 1u);
            else XB_SPIN(xb_ld(&bar[XB_TOPGEN]) == tg, bar);
            __builtin_amdgcn_fence(__ATOMIC_ACQUIRE, "agent");
            xb_add(&bar[XB_XGEN(b.x)], 1u);
            asm volatile("s_waitcnt vmcnt(0)" ::: "memory");
        } else {
            XB_SPIN(xb_ld(&bar[XB_XGEN(b.x)]) == gen, bar);
            __builtin_amdgcn_fence(__ATOMIC_ACQUIRE, "agent");
            asm volatile("s_waitcnt vmcnt(0)" ::: "memory");
        }
    }
    __syncthreads();
}

#define DI __device__ __forceinline__
typedef unsigned short bf16_t;
typedef short bf16x8 __attribute__((ext_vector_type(8)));
typedef short s16x4 __attribute__((ext_vector_type(4)));
typedef float f32x4 __attribute__((ext_vector_type(4)));
typedef float f32x16 __attribute__((ext_vector_type(16)));
typedef unsigned u32x4 __attribute__((ext_vector_type(4)));
typedef unsigned u32x2 __attribute__((ext_vector_type(2)));

#ifndef SKIP_ATTN
#define SKIP_ATTN 0
#endif
#ifndef SKIP_SGU
#define SKIP_SGU 0
#endif
#ifndef SKIP_MOE
#define SKIP_MOE 0
#endif
#ifndef PH_MASK
#define PH_MASK 0x3ff
#endif
#define PH(x) ((PH_MASK >> (x)) & 1)
#ifndef REP_PH
#define REP_PH -1
#endif
#define NREP(x) ((x) == REP_PH ? 2 : 1)
#ifndef NO_P6A
#define NO_P6A 0
#endif
#ifndef NO_P6B
#define NO_P6B 0
#endif
#ifndef STAG1
#define STAG1 0
#endif
#ifndef STAG8
#define STAG8 0
#endif
#ifndef STAG4
#define STAG4 0
#endif
#ifndef STAG5
#define STAG5 0
#endif
#ifndef ATT_TWICE
#define ATT_TWICE 1
#endif
#ifndef ATT_REP_W
#define ATT_REP_W 1
#endif
#ifndef ATT_REP_C
#define ATT_REP_C 1
#endif
#ifndef ATT_REP_S
#define ATT_REP_S 1
#endif
#ifndef PROBE_PH
#define PROBE_PH -1
#endif
#define DBL(x) ((x) == PROBE_PH ? 2 : 1)
#ifndef MOE_GATHER
#define MOE_GATHER 1
#endif
#ifndef Y_FP8
#define Y_FP8 1
#endif
#ifndef MOE_FP8
#define MOE_FP8 1
#endif
#ifndef ATTN_BRANCHES
#define ATTN_BRANCHES 7
#endif

constexpr int NB = 4, SEQ = 8192, MTOK = NB * SEQ, DM = 1024;
constexpr int DIN = 4376, NPROJ = 4608;
constexpr int NEXP = 32, DFF = 1024;
constexpr int MPAD = 131072 + 32 * 256;
constexpr float LOG2E = 1.4426950408889634f;
constexpr float QSCALE = 0.125f * LOG2E;
constexpr float NEGBIG = -1e30f;
constexpr float SC_W8 = 64.f, SC_A8 = 8.f, SC_ACT8 = 4.f, SC_Y8 = 32.f;

constexpr size_t MiB = 1u << 20;
constexpr size_t WS_CTL = 0;
constexpr size_t CTL_CNT = 0;
constexpr size_t CTL_TE = 64 * 1024;
constexpr size_t CTL_NT = 96 * 1024;
constexpr size_t CTL_C1 = 128 * 1024;
constexpr size_t CTL_BAR = 256 * 1024;
constexpr size_t WS_WIN = 1 * MiB, WS_WAB = 10 * MiB, WS_WOUT = 12 * MiB, WS_W1K = 14 * MiB, WS_W1V = 14 * MiB + 512 * 1024;
constexpr size_t WS_W2K = 15 * MiB, WS_W2V = 15 * MiB + 64 * 1024, WS_WTRIL = 15 * MiB + 512 * 1024;
constexpr size_t WS_WGU = 16 * MiB, WS_WD = 144 * MiB, WS_X2 = 208 * MiB;
constexpr size_t WS_H1 = 336 * MiB, WS_Q = 400 * MiB, WS_KV = 432 * MiB, WS_U = 480 * MiB, WS_V = 512 * MiB, WS_MG = 544 * MiB;
constexpr size_t WS_NG = 672 * MiB, WS_KCMP = 676 * MiB, WS_VCMP = 676 * MiB + 512 * 1024, WS_YAB = 678 * MiB, WS_MERGED = 742 * MiB;
constexpr size_t WS_VT = 806 * MiB;
constexpr size_t WS_AS = 336 * MiB, WS_Y = 336 * MiB, WS_ACT = 608 * MiB, WS_H2 = 608 * MiB;
constexpr size_t WS_TOKE = 880 * MiB, WS_TOKW = 881 * MiB, WS_SLOT = 882 * MiB, WS_WSLOT = 883 * MiB;
constexpr size_t WS_RINV = 884 * MiB;
constexpr size_t WS_WRT = 885 * MiB;
constexpr size_t WS_STOK = 886 * MiB;
constexpr size_t WS_RSLOT = 887 * MiB;
constexpr size_t WS_END = 888 * MiB;

constexpr int LDS_BYTES = 155648;
constexpr int NWAVES = 8, NTHREADS = 512;

struct Args { const float* in[26]; float* out; unsigned char* ws; };

DI float bf2f(unsigned b) { return __uint_as_float(b << 16); }
DI unsigned pk2(float lo, float hi) {
    typedef float f2_t __attribute__((ext_vector_type(2))); typedef __bf16 b2_t __attribute__((ext_vector_type(2)));
    f2_t v = {lo, hi}; b2_t b = __builtin_convertvector(v, b2_t); return __builtin_bit_cast(unsigned, b);
}
DI unsigned pk4_fp8(float a, float b, float c, float d) { int w = 0; w = __builtin_amdgcn_cvt_pk_fp8_f32(a, b, w, false); w = __builtin_amdgcn_cvt_pk_fp8_f32(c, d, w, true); return (unsigned)w; }
DI unsigned short f2bf(float x) { return (unsigned short)(pk2(x, 0.f) & 0xffffu); }
DI float ex2(float x) { return __builtin_amdgcn_exp2f(x); }
DI float rcpf_(float x) { return __builtin_amdgcn_rcpf(x); }
DI float sigm(float x) { return rcpf_(1.f + ex2(-LOG2E * x)); }
DI float gelu_t(float x) { const float u = 0.7978845608028654f * (x + 0.044715f * x * x * x); return x * rcpf_(1.f + ex2(-2.f * LOG2E * u)); }
typedef float f32x2 __attribute__((ext_vector_type(2)));
DI f32x2 ex2_2(f32x2 x) { f32x2 r; r.x = ex2(x.x); r.y = ex2(x.y); return r; }
DI f32x2 rcp_2(f32x2 x) { f32x2 r; r.x = rcpf_(x.x); r.y = rcpf_(x.y); return r; }
DI f32x2 sigm2(f32x2 x) { return rcp_2(ex2_2(x * (-LOG2E)) + 1.0f); }
DI f32x2 gelu_t2(f32x2 x) { const f32x2 x2 = x * x; const f32x2 u = x * (x2 * (0.7978845608028654f * 0.044715f * -2.f * LOG2E) + (0.7978845608028654f * -2.f * LOG2E)); return x * rcp_2(ex2_2(u) + 1.0f); }
DI float wave_sum(float v) {
#pragma unroll
    for (int o = 1; o < 64; o <<= 1) v += __shfl_xor(v, o);
    return v;
}
DI float wave_max(float v) {
#pragma unroll
    for (int o = 1; o < 64; o <<= 1) v = fmaxf(v, __shfl_xor(v, o));
    return v;
}
DI float xmax32(float v) {
    const unsigned u = __float_as_uint(v); auto rr = __builtin_amdgcn_permlane32_swap(u, u, false, false);
    return fmaxf(__uint_as_float(rr[0]), __uint_as_float(rr[1]));
}
DI float xsum32(float v) {
    const unsigned u = __float_as_uint(v); auto rr = __builtin_amdgcn_permlane32_swap(u, u, false, false);
    return __uint_as_float(rr[0]) + __uint_as_float(rr[1]);
}
DI int crow(int i, int h) { return (i & 3) + 8 * (i >> 2) + 4 * h; }
#define MFMA32(a, b, c) __builtin_amdgcn_mfma_f32_32x32x16_bf16((a), (b), (c), 0, 0, 0)
DI LAS unsigned char* lds_raw_las(unsigned char* p) { return (LAS unsigned char*)p; }
DI void stagger_us(int bx, int us) {
    if ((bx >> 3) & 1) {
        const unsigned long long t0 = __builtin_amdgcn_s_memrealtime();
        while (__builtin_amdgcn_s_memrealtime() - t0 < (unsigned long long)(us * 100)) __builtin_amdgcn_s_sleep(8);
    }
}
DI void lds_wait() { asm volatile("s_waitcnt lgkmcnt(0)" ::: "memory"); }

struct TItem { const float* W; bf16_t* WT; const float* ks; int K, N, k0, n0, map, f8, ldk, koff; };
DI int map_row(int map, int n) {
    if (map == 0) return n;
    if (map == 1) return n + 1024;
    if (map == 2) return n < 1280 ? n : (n < 1304 ? n + 3072 : n - 24);
    return n < 1024 ? ((n >> 7) * 256 + (n & 127)) : ((((n - 1024) >> 7) * 256) + 128 + (n & 127));
}
DI void titem_decode(const Args& a, int it, TItem& t) {
    unsigned char* ws = a.ws;
    constexpr int I_WIN = 16 * 137, I_WA = 8 * 32, I_WO = 16 * 32, I_W1 = 32 * 4, I_W2 = 2 * 2, I_GU1 = 16 * 64, I_GU = 32 * I_GU1, I_D1 = 16 * 32, I_D = 32 * I_D1;
    int r = it; t.ks = nullptr; t.map = 0; t.f8 = 0; t.ldk = 0; t.koff = 0;
    if (r < I_GU) { const int e = r / I_GU1; r -= e * I_GU1; t.W = a.in[21] + (size_t)e * 1024 * 2048; t.WT = (bf16_t*)(ws + WS_WGU + (size_t)e * 2048 * 1024 * (MOE_FP8 ? 1 : 2)); t.K = 1024; t.N = 2048; t.map = 3; t.f8 = MOE_FP8; }
    else if ((r -= I_GU) < I_D) { const int e = r / I_D1; r -= e * I_D1; t.W = a.in[23] + (size_t)e * 1024 * 1024; t.WT = (bf16_t*)(ws + WS_WD + (size_t)e * 1024 * 1024 * (MOE_FP8 ? 1 : 2)); t.K = 1024; t.N = 1024; t.f8 = MOE_FP8; }
    else if ((r -= I_D) < I_WIN) { t.W = a.in[2]; t.WT = (bf16_t*)(ws + WS_WIN); t.K = 1024; t.N = DIN; t.map = 2; t.ks = a.in[1]; }
    else if ((r -= I_WIN) < I_WA) { t.W = a.in[15]; t.WT = (bf16_t*)(ws + WS_WAB); t.K = 512; t.N = 1024; t.ldk = 1024; }
    else if ((r -= I_WA) < I_WA) { t.W = a.in[16]; t.WT = (bf16_t*)(ws + WS_WAB); t.K = 512; t.N = 1024; t.ldk = 1024; t.koff = 512; }
    else if ((r -= I_WA) < I_WO) { t.W = a.in[17]; t.WT = (bf16_t*)(ws + WS_WOUT); t.K = 1024; t.N = 1024; }
    else if ((r -= I_WO) < I_W1) { t.W = a.in[3]; t.WT = (bf16_t*)(ws + WS_W1K); t.K = 2048; t.N = 128; }
    else if ((r -= I_W1) < I_W1) { t.W = a.in[7]; t.WT = (bf16_t*)(ws + WS_W1V); t.K = 2048; t.N = 128; }
    else if ((r -= I_W1) < I_W2) { t.W = a.in[5]; t.WT = (bf16_t*)(ws + WS_W2K); t.K = 128; t.N = 64; }
    else { r -= I_W2; t.W = a.in[9]; t.WT = (bf16_t*)(ws + WS_W2V); t.K = 128; t.N = 64; }
    const int nblk = (t.N + 31) >> 5; int kb, nb;
    if (t.f8) { const int q = r >> 1; kb = 2 * (q / nblk) + (r & 1); nb = q % nblk; }
    else { kb = r / nblk; nb = r - kb * nblk; }
    t.k0 = 64 * kb; t.n0 = 32 * nb; if (t.ldk == 0) t.ldk = t.K;
}
DI void titem_load(const TItem& t, int lane, float (&v)[32]) {
    const int ncol = t.n0 + (lane & 31); const bool ok = ncol < t.N;
    const float* p = t.W + (size_t)(t.k0 + (lane >> 5)) * t.N + (ok ? ncol : 0);
#pragma unroll
    for (int i = 0; i < 32; ++i) v[i] = __builtin_nontemporal_load(p + (size_t)(2 * i) * t.N);
    if (!ok) {
#pragma unroll
        for (int i = 0; i < 32; ++i) v[i] = 0.f;
    }
}
DI void titem_process(const TItem& t, int lane, float (&v)[32], LAS float* scr) {
    if (t.ks) {
#pragma unroll
        for (int i = 0; i < 32; ++i) v[i] *= t.ks[t.k0 + 2 * i + (lane >> 5)];
    }
#pragma unroll
    for (int i = 0; i < 32; ++i) scr[(2 * i + (lane >> 5)) * 33 + (lane & 31)] = v[i];
    lds_wait();
    const int c = lane & 7;
#pragma unroll
    for (int j = 0; j < 4; ++j) {
        const int nl = (lane >> 3) + 8 * j, n = t.n0 + nl;
        const LAS float* s = scr + (8 * c) * 33 + nl;
        if (t.f8) {
            u32x2 o; o.x = pk4_fp8(s[0 * 33] * SC_W8, s[1 * 33] * SC_W8, s[2 * 33] * SC_W8, s[3 * 33] * SC_W8); o.y = pk4_fp8(s[4 * 33] * SC_W8, s[5 * 33] * SC_W8, s[6 * 33] * SC_W8, s[7 * 33] * SC_W8);
            if (n < t.N) *(u32x2*)((unsigned char*)t.WT + (size_t)map_row(t.map, n) * t.ldk + t.koff + t.k0 + 8 * c) = o;
        } else {
            u32x4 o; o.x = pk2(s[0 * 33], s[1 * 33]); o.y = pk2(s[2 * 33], s[3 * 33]); o.z = pk2(s[4 * 33], s[5 * 33]); o.w = pk2(s[6 * 33], s[7 * 33]);
            if (n < t.N) *(u32x4*)(t.WT + (size_t)map_row(t.map, n) * t.ldk + t.koff + t.k0 + 8 * c) = o;
        }
    }
    lds_wait();
}

DI void p0_prep(const Args& a, LAS unsigned char* lds, int gw, int NGW, int wave, int lane) {
    asm volatile("" : "+v"(lane));
    unsigned char* ws = a.ws;
    LAS float* scr = (LAS float*)(lds + wave * 8704);
    {
        constexpr int NIT = 16 * 137 + 2 * 8 * 32 + 16 * 32 + 2 * 32 * 4 + 2 * 2 * 2 + 32 * 16 * 64 + 32 * 16 * 32;
        TItem ta, tb; float va[32], vb[32];
        constexpr int NITX = NIT * DBL(0);
        int it = gw;
        if (it < NITX) { titem_decode(a, it % NIT, ta); titem_load(ta, lane, va); }
        while (it < NITX) {
            int nx = it + NGW;
            if (nx < NITX) { titem_decode(a, nx % NIT, tb); titem_load(tb, lane, vb); }
            titem_process(ta, lane, va, scr);
            it = nx; if (it >= NITX) break;
            nx = it + NGW;
            if (nx < NITX) { titem_decode(a, nx % NIT, ta); titem_load(ta, lane, va); }
            titem_process(tb, lane, vb, scr);
            it = nx;
        }
    }
    {
        const float* x = a.in[0]; bf16_t* H1 = (bf16_t*)(ws + WS_H1);
        for (int m0 = 2 * gw; m0 < MTOK * DBL(0); m0 += 2 * NGW) {
            const int m = m0 % MTOK;
            const f32x4* xr = (const f32x4*)(x + (size_t)m * DM) + lane;
            f32x4 v[8]; float s0 = 0.f, s1 = 0.f;
#pragma unroll
            for (int j = 0; j < 8; ++j) v[j] = __builtin_nontemporal_load(xr + 64 * j);
#pragma unroll
            for (int j = 0; j < 4; ++j) { s0 += (v[j].x * v[j].x + v[j].y * v[j].y) + (v[j].z * v[j].z + v[j].w * v[j].w); s1 += (v[4 + j].x * v[4 + j].x + v[4 + j].y * v[4 + j].y) + (v[4 + j].z * v[4 + j].z + v[4 + j].w * v[4 + j].w); }
            const float r0 = 1.0f / sqrtf(wave_sum(s0) * (1.f / DM) + 1e-5f), r1 = 1.0f / sqrtf(wave_sum(s1) * (1.f / DM) + 1e-5f);
            u32x2* o = (u32x2*)(H1 + (size_t)m * DM) + lane;
#pragma unroll
            for (int j = 0; j < 8; ++j) { const float rr = j < 4 ? r0 : r1; u32x2 w; w.x = pk2(v[j].x * rr, v[j].y * rr); w.y = pk2(v[j].z * rr, v[j].w * rr); o[64 * j] = w; }
        }
    }
    {
        float* C1P = (float*)(ws + WS_CTL + CTL_C1);
        for (int o8 = gw; o8 < 256 * 8; o8 += NGW) {
            const int o = o8 >> 3, part = o8 & 7, ty = o >> 7, f = o & 127; const float* pe = a.in[ty ? 10 : 6]; const float* w1 = a.in[ty ? 7 : 3]; const float* b1 = a.in[ty ? 8 : 4];
            float s = 0.f;
#pragma unroll
            for (int q = 0; q < 4; ++q) { const int k = part * 256 + q * 64 + lane; s += pe[k] * w1[(size_t)k * 128 + f]; }
            s = wave_sum(s);
            if (lane == 0) C1P[o8] = s + (part == 0 ? b1[f] : 0.f);
        }
    }
    {
        const float* wr = a.in[19]; const float* gm = a.in[18]; bf16_t* WRT = (bf16_t*)(ws + WS_WRT);
        for (int i = gw * 64 + lane; i < 32 * 1024; i += NGW * 64) { const int e = i >> 10, k = i & 1023; const float w = wr[k * 32 + e] * gm[k];
            const unsigned short hi = f2bf(w); WRT[i] = hi; WRT[32 * 1024 + i] = f2bf(w - bf2f(hi)); }
    }
    {
        const float* wsp = a.in[13]; bf16_t* WT = (bf16_t*)(ws + WS_WTRIL);
        for (int i = gw * 64 + lane; i < 8 * 128 * 128; i += NGW * 64) { const int t = (i >> 7) & 127, s = i & 127; WT[i] = f2bf(s <= t ? wsp[i] : 0.f); }
    }
}

typedef pg8::f32x4 pf4;
template <class S> struct Twice {
    S s; int n, rep;
    DI void init() { pg8::Unit u; n = 0; while (s.next(n, u)) ++n; }
    DI bool next(int i, pg8::Unit& u) const { return i < rep * n && s.next(i >= n ? i - n : i, u); }
    DI void a_ready(const pg8::Unit&) const {}
    DI void done(const pg8::Unit&) const {}
};
struct Epi1 {
    static constexpr bool PERM = true, AFTER_DRAIN = false, MIDK = false, PREFETCH = false;
    bf16_t *Q, *KV, *U, *V, *MG; float* NG;
    DI void operator()(const pf4 (&acc)[2][2][4][2], const pg8::Unit& u, int wr, int wc, int fr, int fq) const {
        const int row0 = u.pm * 256 + wr * 64 + fr, pn = u.pn, c0 = wc * 32 + 8 * fq;
        if (pn == 17) {
            if (wc == 0 && fq < 3) {
#pragma unroll
                for (int ai = 0; ai < 2; ++ai)
#pragma unroll
                    for (int m = 0; m < 4; ++m) { float* p = NG + (size_t)(row0 + ai * 128 + m * 16) * 24 + c0; const pf4 v0 = acc[ai][0][m][0], v1 = acc[ai][0][m][1];
                        *(f32x4*)p = (f32x4){sigm(v0[0]), sigm(v0[1]), sigm(v0[2]), sigm(v0[3])}; *(f32x4*)(p + 4) = (f32x4){sigm(v1[0]), sigm(v1[1]), sigm(v1[2]), sigm(v1[3])}; }
            }
            return;
        }
        bf16_t* base; int ldc, ct, mode;
        float sc = 1.f;
        if (pn < 2) { base = Q; ldc = 512; ct = pn; mode = 0; sc = QSCALE; }
        else if (pn < 5) { base = KV; ldc = 768; ct = pn - 2; mode = 0; }
        else if (pn < 7) { base = U; ldc = 512; ct = pn - 5; mode = 1; }
        else if (pn < 9) { base = V; ldc = 512; ct = pn - 7; mode = 1; }
        else { base = MG; ldc = 2048; ct = pn - 9; mode = 2; }
#pragma unroll
        for (int ai = 0; ai < 2; ++ai)
#pragma unroll
            for (int m = 0; m < 4; ++m) {
                bf16_t* rowp = base + (size_t)(row0 + ai * 128 + m * 16) * ldc + ct * 256 + c0;
#pragma unroll
                for (int bj = 0; bj < 2; ++bj) {
                    pf4 v0 = acc[ai][bj][m][0], v1 = acc[ai][bj][m][1];
                    if (mode == 0) { v0 = v0 * sc; v1 = v1 * sc; }
                    else if (mode == 1) { const f32x2 a = gelu_t2((f32x2){v0[0], v0[1]}), b = gelu_t2((f32x2){v0[2], v0[3]}), c = gelu_t2((f32x2){v1[0], v1[1]}), d = gelu_t2((f32x2){v1[2], v1[3]});
                        v0 = (pf4){a.x, a.y, b.x, b.y}; v1 = (pf4){c.x, c.y, d.x, d.y}; }
                    else { const f32x2 a = sigm2((f32x2){v0[0], v0[1]}), b = sigm2((f32x2){v0[2], v0[3]}), c = sigm2((f32x2){v1[0], v1[1]}), d = sigm2((f32x2){v1[2], v1[3]});
                        v0 = (pf4){a.x, a.y, b.x, b.y}; v1 = (pf4){c.x, c.y, d.x, d.y}; }
                    u32x4 w; w.x = pk2(v0[0], v0[1]); w.y = pk2(v0[2], v0[3]); w.z = pk2(v1[0], v1[1]); w.w = pk2(v1[2], v1[3]);
                    *(u32x4*)(rowp + bj * 128) = w;
                }
            }
    }
};
struct Epi4 {
    static constexpr bool PERM = true, AFTER_DRAIN = false, MIDK = true, PREFETCH = false;
    const bf16_t* MG; bf16_t* OUT;
    DI void prefetch(const pg8::Unit& u, LAS unsigned char* scratch, int tid) const {
#pragma unroll
        for (int q = 0; q < 4; ++q) { const int ln = tid + q * NTHREADS, row = ln >> 3, part = ln & 7;
            const bf16_t* p = MG + (size_t)(u.pm * 256 + row) * 2048 + (part >> 2) * 1024 + u.pn * 256 + (part & 3) * 64;
            __builtin_amdgcn_global_load_lds((const unsigned*)p, (LAS unsigned*)(scratch + (tid >> 6) * 256), 4, 0, 0); }
    }
    DI void midk(pf4 (&acc)[2][2][4][2], const pg8::Unit& u, int wr, int wc, int fr, int fq) const {
        const int row0 = u.pm * 256 + wr * 64 + fr, c0 = u.pn * 256 + wc * 32 + 8 * fq;
#pragma unroll
        for (int ai = 0; ai < 2; ++ai)
#pragma unroll
            for (int mh = 0; mh < 2; ++mh) {
                u32x4 ga[2][2], gb[2][2];
#pragma unroll
                for (int mm = 0; mm < 2; ++mm)
#pragma unroll
                    for (int bj = 0; bj < 2; ++bj) { const bf16_t* gp = MG + (size_t)(row0 + ai * 128 + (2 * mh + mm) * 16) * 2048 + c0 + bj * 128; ga[mm][bj] = __builtin_nontemporal_load((const u32x4*)gp); gb[mm][bj] = *(const u32x4*)(gp + 1024); }
#pragma unroll
                for (int mm = 0; mm < 2; ++mm)
#pragma unroll
                    for (int bj = 0; bj < 2; ++bj) {
                        const u32x4 a = ga[mm][bj], b = gb[mm][bj]; pf4& v0 = acc[ai][bj][2 * mh + mm][0]; pf4& v1 = acc[ai][bj][2 * mh + mm][1];
                        v0[0] *= bf2f(a.x & 0xffffu) * rcpf_(fmaxf(bf2f(b.x & 0xffffu), 1e-6f)); v0[1] *= bf2f(a.x >> 16) * rcpf_(fmaxf(bf2f(b.x >> 16), 1e-6f));
                        v0[2] *= bf2f(a.y & 0xffffu) * rcpf_(fmaxf(bf2f(b.y & 0xffffu), 1e-6f)); v0[3] *= bf2f(a.y >> 16) * rcpf_(fmaxf(bf2f(b.y >> 16), 1e-6f));
                        v1[0] *= bf2f(a.z & 0xffffu) * rcpf_(fmaxf(bf2f(b.z & 0xffffu), 1e-6f)); v1[1] *= bf2f(a.z >> 16) * rcpf_(fmaxf(bf2f(b.z >> 16), 1e-6f));
                        v1[2] *= bf2f(a.w & 0xffffu) * rcpf_(fmaxf(bf2f(b.w & 0xffffu), 1e-6f)); v1[3] *= bf2f(a.w >> 16) * rcpf_(fmaxf(bf2f(b.w >> 16), 1e-6f));
                    }
            }
    }
    DI void operator()(const pf4 (&acc)[2][2][4][2], const pg8::Unit& u, int wr, int wc, int fr, int fq) const {
        const int row0 = u.pm * 256 + wr * 64 + fr, c0 = u.pn * 256 + wc * 32 + 8 * fq;
#pragma unroll
        for (int ai = 0; ai < 2; ++ai) {
            u32x4 gb[4][2];
#pragma unroll
            for (int m = 0; m < 4; ++m)
#pragma unroll
                for (int bj = 0; bj < 2; ++bj) gb[m][bj] = __builtin_nontemporal_load((const u32x4*)(MG + (size_t)(row0 + ai * 128 + m * 16) * 2048 + 1024 + c0 + bj * 128));
#pragma unroll
            for (int m = 0; m < 4; ++m)
#pragma unroll
                for (int bj = 0; bj < 2; ++bj) {
                    const u32x4 b = gb[m][bj]; const pf4 v0 = acc[ai][bj][m][0], v1 = acc[ai][bj][m][1];
                    u32x4 w; w.x = pk2(v0[0] * fmaxf(bf2f(b.x & 0xffffu), 1e-6f), v0[1] * fmaxf(bf2f(b.x >> 16), 1e-6f)); w.y = pk2(v0[2] * fmaxf(bf2f(b.y & 0xffffu), 1e-6f), v0[3] * fmaxf(bf2f(b.y >> 16), 1e-6f));
                    w.z = pk2(v1[0] * fmaxf(bf2f(b.z & 0xffffu), 1e-6f), v1[1] * fmaxf(bf2f(b.z >> 16), 1e-6f)); w.w = pk2(v1[2] * fmaxf(bf2f(b.w & 0xffffu), 1e-6f), v1[3] * fmaxf(bf2f(b.w >> 16), 1e-6f));
                    *(u32x4*)(OUT + (size_t)(row0 + ai * 128 + m * 16) * 1024 + c0 + bj * 128) = w;
                }
        }
    }
};
struct Epi5 {
    static constexpr bool PERM = false, AFTER_DRAIN = false, MIDK = false, PREFETCH = false;
    const float* X; float* X2;
    DI void prefetch(const pg8::Unit& u, LAS unsigned char* scratch, int tid) const {
#pragma unroll
        for (int q = 0; q < 4; ++q) { const int ln = tid + q * NTHREADS, row = ln >> 3, part = ln & 7;
            const float* p = X + (size_t)(u.pm * 256 + row) * DM + u.pn * 256 + part * 32;
            __builtin_amdgcn_global_load_lds((const unsigned*)p, (LAS unsigned*)(scratch + (tid >> 6) * 256), 4, 0, 0); }
    }
    DI void operator()(const pf4 (&acc)[2][2][4][2], const pg8::Unit& u, int wr, int wc, int fr, int fq) const {
        const int row0 = u.pm * 256 + wr * 64 + fr, c0 = u.pn * 256 + wc * 32 + 4 * fq;
#pragma unroll
        for (int ai = 0; ai < 2; ++ai)
#pragma unroll
            for (int mh = 0; mh < 2; ++mh) {
                f32x4 xv[2][2][2];
#pragma unroll
                for (int mm = 0; mm < 2; ++mm)
#pragma unroll
                    for (int bj = 0; bj < 2; ++bj)
#pragma unroll
                        for (int n = 0; n < 2; ++n) xv[mm][bj][n] = __builtin_nontemporal_load((const f32x4*)(X + (size_t)(row0 + ai * 128 + (2 * mh + mm) * 16) * DM + c0 + bj * 128 + n * 16));
#pragma unroll
                for (int mm = 0; mm < 2; ++mm)
#pragma unroll
                    for (int bj = 0; bj < 2; ++bj)
#pragma unroll
                        for (int n = 0; n < 2; ++n) { const pf4 v = acc[ai][bj][2 * mh + mm][n]; const f32x4 x = xv[mm][bj][n];
                            *(f32x4*)(X2 + (size_t)(row0 + ai * 128 + (2 * mh + mm) * 16) * DM + c0 + bj * 128 + n * 16) = (f32x4){x[0] + v[0], x[1] + v[1], x[2] + v[2], x[3] + v[3]}; }
            }
    }
};
struct MoeOrder {
    const int* TE; int NT, npn, G, c;
    DI bool next(int i, pg8::Unit& u) const {
        int mt, pn;
        if ((G & 7) == 0) { const int x = c & 7, jj = i * (G >> 3) + (c >> 3); mt = x + 8 * (jj / npn); pn = jj % npn; }
        else { const int L = i * G + c; mt = L / npn; pn = L % npn; }
        if (mt >= NT) return false;
        const int e = __builtin_amdgcn_readfirstlane(TE[mt]);
        u.pm = mt; u.pn = e * npn + pn; return true;
    }
    DI void a_ready(const pg8::Unit&) const {}
    DI void done(const pg8::Unit&) const {}
};
constexpr int MOE_LIST_OFF = 131072 + 1024, MOE_LIST_MAX = 64;
struct MoeOrderLds {
    const LAS int* list;
    DI bool next(int i, pg8::Unit& u) const {
        if (i >= MOE_LIST_MAX) return false;
        const int v = __builtin_amdgcn_readfirstlane(list[i]);
        if (v < 0) return false;
        u.pm = v & 0xffff; u.pn = v >> 16; return true;
    }
    DI void a_ready(const pg8::Unit&) const {}
    DI void done(const pg8::Unit&) const {}
};
DI MoeOrderLds moe_list_build(const MoeOrder& S, LAS unsigned char* lds, int tid) {
    LAS int* list = (LAS int*)(lds + MOE_LIST_OFF);
    if (tid < MOE_LIST_MAX) {
        int mt, pn;
        if ((S.G & 7) == 0) { const int x = S.c & 7, jj = tid * (S.G >> 3) + (S.c >> 3); mt = x + 8 * (jj / S.npn); pn = jj % S.npn; }
        else { const int L = tid * S.G + S.c; mt = L / S.npn; pn = L % S.npn; }
        list[tid] = (mt < S.NT) ? (mt | ((S.TE[mt] * S.npn + pn) << 16)) : -1;
    }
    __syncthreads();
    return MoeOrderLds{list};
}
struct Epi7 {
    static constexpr bool PERM = true, AFTER_DRAIN = false, MIDK = false, PREFETCH = false;
    const float* BGU; bf16_t* ACT; const float* RS;
    DI void operator()(const pf4 (&acc)[2][2][4][2], const pg8::Unit& u, int wr, int wc, int fr, int fq) const {
        const int e = u.pn >> 3, pn = u.pn & 7, row0 = u.pm * 256 + wr * 64 + fr, c0 = pn * 128 + wc * 32 + 8 * fq;
        const float* bg = BGU + (size_t)e * 2048 + c0; const float* bu = bg + 1024;
        const f32x4 bg0 = *(const f32x4*)bg, bg1 = *(const f32x4*)(bg + 4), bu0 = *(const f32x4*)bu, bu1 = *(const f32x4*)(bu + 4);
        constexpr float ASC = MOE_FP8 ? 1.0f / (SC_A8 * SC_W8) : 1.0f, OSC = MOE_FP8 ? SC_ACT8 : 1.0f;
        float rsv[2][4];
#pragma unroll
        for (int ai = 0; ai < 2; ++ai)
#pragma unroll
            for (int m = 0; m < 4; ++m) rsv[ai][m] = RS ? RS[(size_t)(row0 + ai * 128 + m * 16)] : 1.0f;
#pragma unroll
        for (int ai = 0; ai < 2; ++ai)
#pragma unroll
            for (int m = 0; m < 4; ++m) {
                float r[8];
                const float asr = RS ? ASC * rsv[ai][m] : ASC;
#pragma unroll
                for (int n = 0; n < 2; ++n)
#pragma unroll
                    for (int k2 = 0; k2 < 2; ++k2) {
                        const int k = 2 * k2;
                        const f32x2 ag = {acc[ai][0][m][n][k], acc[ai][0][m][n][k + 1]}, au = {acc[ai][1][m][n][k], acc[ai][1][m][n][k + 1]};
                        const f32x2 bgv = {n ? bg1[k] : bg0[k], n ? bg1[k + 1] : bg0[k + 1]}, buv = {n ? bu1[k] : bu0[k], n ? bu1[k + 1] : bu0[k + 1]};
                        f32x2 g = ag * asr + bgv, u = au * asr + buv;
                        g.x = fminf(g.x, 7.0f); g.y = fminf(g.y, 7.0f);
                        u.x = __builtin_amdgcn_fmed3f(u.x, -7.0f, 7.0f); u.y = __builtin_amdgcn_fmed3f(u.y, -7.0f, 7.0f);
                        const f32x2 rc = rcp_2(ex2_2(g * (-1.702f * LOG2E)) + 1.0f);
                        const f32x2 o = (g * rc) * (u * OSC + OSC);
                        r[n * 4 + k] = o.x; r[n * 4 + k + 1] = o.y;
                    }
                if (MOE_FP8) { u32x2 w; w.x = pk4_fp8(r[0], r[1], r[2], r[3]); w.y = pk4_fp8(r[4], r[5], r[6], r[7]);
                    *(u32x2*)((unsigned char*)ACT + (size_t)(row0 + ai * 128 + m * 16) * DFF + c0) = w; }
                else { u32x4 w; w.x = pk2(r[0], r[1]); w.y = pk2(r[2], r[3]); w.z = pk2(r[4], r[5]); w.w = pk2(r[6], r[7]);
                    *(u32x4*)(ACT + (size_t)(row0 + ai * 128 + m * 16) * DFF + c0) = w; }
            }
    }
};
struct Epi8 {
    static constexpr bool PERM = true, AFTER_DRAIN = false, MIDK = false, PREFETCH = false;
    const float* BD; const float* WSLOT; bf16_t* Y;
    DI void operator()(const pf4 (&acc)[2][2][4][2], const pg8::Unit& u, int wr, int wc, int fr, int fq) const {
        const int e = u.pn >> 2, pn = u.pn & 3, row0 = u.pm * 256 + wr * 64 + fr, c0 = pn * 256 + wc * 32 + 8 * fq;
        f32x4 bv[2][2];
#pragma unroll
        for (int bj = 0; bj < 2; ++bj)
#pragma unroll
            for (int n = 0; n < 2; ++n) bv[bj][n] = *(const f32x4*)(BD + (size_t)e * DM + c0 + bj * 128 + 4 * n);
        float wts[2][4];
#pragma unroll
        for (int ai = 0; ai < 2; ++ai)
#pragma unroll
            for (int m = 0; m < 4; ++m) wts[ai][m] = WSLOT[(size_t)(row0 + ai * 128 + m * 16)];
#pragma unroll
        for (int ai = 0; ai < 2; ++ai)
#pragma unroll
            for (int m = 0; m < 4; ++m) {
                const size_t row = (size_t)(row0 + ai * 128 + m * 16); const float wt = wts[ai][m];
#pragma unroll
                for (int bj = 0; bj < 2; ++bj) {
                    const pf4 v0 = acc[ai][bj][m][0], v1 = acc[ai][bj][m][1]; const f32x4 b0 = bv[bj][0], b1 = bv[bj][1];
                    constexpr float ASC = MOE_FP8 ? 1.0f / (SC_ACT8 * SC_W8) : 1.0f;
                    if (Y_FP8) { const float w8 = wt * SC_Y8; u32x2 w;
                        w.x = pk4_fp8((v0[0] * ASC + b0[0]) * w8, (v0[1] * ASC + b0[1]) * w8, (v0[2] * ASC + b0[2]) * w8, (v0[3] * ASC + b0[3]) * w8);
                        w.y = pk4_fp8((v1[0] * ASC + b1[0]) * w8, (v1[1] * ASC + b1[1]) * w8, (v1[2] * ASC + b1[2]) * w8, (v1[3] * ASC + b1[3]) * w8);
                        *(u32x2*)((unsigned char*)Y + row * DM + c0 + bj * 128) = w; }
                    else {
                    u32x4 w; w.x = pk2((v0[0] * ASC + b0[0]) * wt, (v0[1] * ASC + b0[1]) * wt); w.y = pk2((v0[2] * ASC + b0[2]) * wt, (v0[3] * ASC + b0[3]) * wt);
                    w.z = pk2((v1[0] * ASC + b1[0]) * wt, (v1[1] * ASC + b1[1]) * wt); w.w = pk2((v1[2] * ASC + b1[2]) * wt, (v1[3] * ASC + b1[3]) * wt);
                    *(u32x4*)(Y + row * DM + c0 + bj * 128) = w; }
                }
            }
    }
};

DI void p2_compress_item(const Args& a, LAS unsigned char* lds, int item, int tid, int wave, int lane) {
    asm volatile("" : "+v"(tid), "+v"(lane));
    unsigned char* ws = a.ws;
    const int nt = item & 15, ty = (item >> 4) & 1, g = (item >> 5) & 1, b = item >> 6;
    const bf16_t* KV = (const bf16_t*)(ws + WS_KV);
    const bf16_t* W1 = (const bf16_t*)(ws + (ty ? WS_W1V : WS_W1K));
    const bf16_t* W2 = (const bf16_t*)(ws + (ty ? WS_W2V : WS_W2K));
    const float* C1P = (const float*)(ws + WS_CTL + CTL_C1) + ty * 128 * 8;
    bf16_t* OUT = (bf16_t*)(ws + (ty ? WS_VCMP : WS_KCMP)) + (size_t)((b * 2 + g) * 512 + nt * 32) * 64;
    LAS unsigned char* Xs = lds;
    LAS float* Hs = (LAS float*)(lds + 81920);
    LAS unsigned char* Hb = lds + 81920 + 32768;
    const int r = lane & 31, h = lane >> 5;
    const int p0 = 512 * nt, colsrc = ty * 128 + g * 64;
    {
        u32x4 xv[9];
#pragma unroll
        for (int q = 0; q < 9; ++q) { const int i = tid + q * NTHREADS; if (i < 528 * 8) { const int pr = i >> 3, ch = i & 7; int pos = p0 + pr; pos = pos > SEQ - 1 ? SEQ - 1 : pos;
            xv[q] = *(const u32x4*)(KV + (size_t)(b * SEQ + pos) * 768 + colsrc + ch * 8); } }
#pragma unroll
        for (int q = 0; q < 9; ++q) { const int i = tid + q * NTHREADS; if (i < 528 * 8) { const int pr = i >> 3, ch = i & 7; *(LAS u32x4*)(Xs + (pr + (pr >> 4)) * 144 + ch * 16) = xv[q]; } }
    }
    __syncthreads();
    {
        const int ft = wave & 3, kh = wave >> 2;
        f32x16 acc; for (int i = 0; i < 16; ++i) acc[i] = 0.f;
        const bf16_t* wrow = W1 + (size_t)(ft * 32 + r) * 2048 + 8 * h;
        for (int s0 = kh * 64; s0 < kh * 64 + 64; s0 += 16) {
            bf16x8 bw[16];
#pragma unroll
            for (int q = 0; q < 16; ++q) bw[q] = *(const bf16x8*)(wrow + 16 * (s0 + q));
#pragma unroll
            for (int q = 0; q < 16; ++q) {
                const int s = s0 + q, l = s >> 2, d0 = (s & 3) * 16;
                const bf16x8 af = *(const LAS bf16x8*)(Xs + (17 * r + l + (l >> 4)) * 144 + (d0 + 8 * h) * 2);
                acc = MFMA32(af, bw[q], acc);
            }
        }
#pragma unroll
        for (int i = 0; i < 16; ++i) Hs[(kh * 32 + crow(i, h)) * 128 + ft * 32 + r] = acc[i];
    }
    __syncthreads();
    for (int i = tid; i < 32 * 128; i += NTHREADS) {
        const int n = i >> 7, f = i & 127;
        const f32x4 c0 = *(const f32x4*)(C1P + f * 8), c1 = *(const f32x4*)(C1P + f * 8 + 4);
        const float v = Hs[n * 128 + f] + Hs[(32 + n) * 128 + f] + ((((c0[0] + c0[1]) + c0[2]) + c0[3]) + (((c1[0] + c1[1]) + c1[2]) + c1[3]));
        *(LAS unsigned short*)(Hb + n * 272 + f * 2) = f2bf(gelu_t(v));
    }
    __syncthreads();
    if (wave < 2) {
        f32x16 acc; for (int i = 0; i < 16; ++i) acc[i] = 0.f;
        const bf16_t* wrow = W2 + (size_t)(wave * 32 + r) * 128 + 8 * h;
#pragma unroll
        for (int s = 0; s < 8; ++s) {
            const bf16x8 af = *(const LAS bf16x8*)(Hb + r * 272 + (16 * s + 8 * h) * 2);
            const bf16x8 bfr = *(const bf16x8*)(wrow + 16 * s);
            acc = MFMA32(af, bfr, acc);
        }
        if (ty == 0) {
#pragma unroll
            for (int i = 0; i < 16; ++i) OUT[(size_t)crow(i, h) * 64 + wave * 32 + r] = f2bf(acc[i]);
        } else {
            bf16_t* OT = (bf16_t*)(ws + WS_VCMP) + (size_t)(b * 2 + g) * 64 * 512 + (size_t)(wave * 32 + r) * 512 + nt * 32;
#pragma unroll
            for (int i = 0; i < 16; ++i) OT[crow(i, h)] = f2bf(acc[i]);
        }
    }
    __syncthreads();
}

DI void p2_sgu_item(const Args& a, LAS unsigned char* lds, int item, int tid, int wave, int lane) {
    asm volatile("" : "+v"(tid), "+v"(lane));
    unsigned char* ws = a.ws;
    const bf16_t* U = (const bf16_t*)(ws + WS_U); const bf16_t* V = (const bf16_t*)(ws + WS_V);
    const bf16_t* WT = (const bf16_t*)(ws + WS_WTRIL);
    bf16_t* YB = (bf16_t*)(ws + WS_YAB) + 512;
    const float* lng = a.in[11]; const float* lnb = a.in[12]; const float* bs = a.in[14];
    const size_t row0 = (size_t)item * 128;
    LAS unsigned char* VnT = lds;
    const int r = lane & 31, h = lane >> 5;
    {
        const int p = lane & 15, cg = lane >> 4, pos = wave * 16 + p;
        const bf16_t* vrow = V + (row0 + pos) * 512 + cg * 128;
        u32x4 raw[16];
#pragma unroll
        for (int j = 0; j < 16; ++j) raw[j] = *(const u32x4*)(vrow + 8 * j);
        float sm = 0.f;
#pragma unroll
        for (int j = 0; j < 16; ++j) sm += (bf2f(raw[j].x & 0xffffu) + bf2f(raw[j].x >> 16)) + (bf2f(raw[j].y & 0xffffu) + bf2f(raw[j].y >> 16)) + (bf2f(raw[j].z & 0xffffu) + bf2f(raw[j].z >> 16)) + (bf2f(raw[j].w & 0xffffu) + bf2f(raw[j].w >> 16));
        sm += __shfl_xor(sm, 16); sm += __shfl_xor(sm, 32);
        const float mu = sm * (1.f / 512.f);
        float qq = 0.f;
#pragma unroll
        for (int j = 0; j < 16; ++j) {
            const float d0 = bf2f(raw[j].x & 0xffffu) - mu, d1 = bf2f(raw[j].x >> 16) - mu, d2 = bf2f(raw[j].y & 0xffffu) - mu, d3 = bf2f(raw[j].y >> 16) - mu;
            const float d4 = bf2f(raw[j].z & 0xffffu) - mu, d5 = bf2f(raw[j].z >> 16) - mu, d6 = bf2f(raw[j].w & 0xffffu) - mu, d7 = bf2f(raw[j].w >> 16) - mu;
            qq += (d0 * d0 + d1 * d1) + (d2 * d2 + d3 * d3) + (d4 * d4 + d5 * d5) + (d6 * d6 + d7 * d7);
        }
        qq += __shfl_xor(qq, 16); qq += __shfl_xor(qq, 32);
        const float rs = 1.0f / sqrtf(qq * (1.f / 512.f) + 1e-5f);
        const float* gp = lng + cg * 128; const float* bp = lnb + cg * 128;
        LAS unsigned char* wp = VnT + (cg * 128) * 272 + pos * 2;
#pragma unroll
        for (int j = 0; j < 16; ++j) {
            const f32x4 g0 = *(const f32x4*)(gp + 8 * j), g1 = *(const f32x4*)(gp + 8 * j + 4), b0 = *(const f32x4*)(bp + 8 * j), b1 = *(const f32x4*)(bp + 8 * j + 4);
            LAS unsigned char* w8 = wp + (8 * j) * 272;
            *(LAS unsigned short*)(w8 + 0 * 272) = f2bf((bf2f(raw[j].x & 0xffffu) - mu) * rs * g0[0] + b0[0]); *(LAS unsigned short*)(w8 + 1 * 272) = f2bf((bf2f(raw[j].x >> 16) - mu) * rs * g0[1] + b0[1]);
            *(LAS unsigned short*)(w8 + 2 * 272) = f2bf((bf2f(raw[j].y & 0xffffu) - mu) * rs * g0[2] + b0[2]); *(LAS unsigned short*)(w8 + 3 * 272) = f2bf((bf2f(raw[j].y >> 16) - mu) * rs * g0[3] + b0[3]);
            *(LAS unsigned short*)(w8 + 4 * 272) = f2bf((bf2f(raw[j].z & 0xffffu) - mu) * rs * g1[0] + b1[0]); *(LAS unsigned short*)(w8 + 5 * 272) = f2bf((bf2f(raw[j].z >> 16) - mu) * rs * g1[1] + b1[1]);
            *(LAS unsigned short*)(w8 + 6 * 272) = f2bf((bf2f(raw[j].w & 0xffffu) - mu) * rs * g1[2] + b1[2]); *(LAS unsigned short*)(w8 + 7 * 272) = f2bf((bf2f(raw[j].w >> 16) - mu) * rs * g1[3] + b1[3]);
        }
    }
    __syncthreads();
    {
        const int grp = wave;
        for (int tt = 0; tt < 4; ++tt) {
            f32x16 acc[2];
#pragma unroll
            for (int i = 0; i < 16; ++i) { acc[0][i] = 0.f; acc[1][i] = 0.f; }
            const bf16_t* wrow = WT + (size_t)(grp * 128 + tt * 32 + r) * 128 + 8 * h;
            const int nst = 2 * tt + 2;
            u32x2 uu8[2][4];
            { const size_t rowt_ = row0 + tt * 32 + r;
#pragma unroll
              for (int dt = 0; dt < 2; ++dt)
#pragma unroll
                  for (int q4 = 0; q4 < 4; ++q4) uu8[dt][q4] = *(const u32x2*)(U + rowt_ * 512 + grp * 64 + dt * 32 + 8 * q4 + 4 * h); }
            bf16x8 bw[8];
#pragma unroll
            for (int s = 0; s < 8; ++s) if (s < nst) bw[s] = *(const bf16x8*)(wrow + 16 * s);
#pragma unroll
            for (int s = 0; s < 8; ++s) if (s < nst) {
#pragma unroll
                for (int dt = 0; dt < 2; ++dt) {
                    const bf16x8 af = *(const LAS bf16x8*)(VnT + (grp * 64 + dt * 32 + r) * 272 + (16 * s + 8 * h) * 2);
                    acc[dt] = MFMA32(af, bw[s], acc[dt]);
                }
            }
            const int t = tt * 32 + r; const float bt = bs[grp * 128 + t];
            const size_t rowt = row0 + t;
#pragma unroll
            for (int dt = 0; dt < 2; ++dt)
#pragma unroll
                for (int q4 = 0; q4 < 4; ++q4) {
                    const int d = dt * 32 + 8 * q4 + 4 * h;
                    const u32x2 uu = uu8[dt][q4];
                    const float y0 = bf2f(uu.x & 0xffffu) * (acc[dt][4 * q4 + 0] + bt), y1 = bf2f(uu.x >> 16) * (acc[dt][4 * q4 + 1] + bt);
                    const float y2 = bf2f(uu.y & 0xffffu) * (acc[dt][4 * q4 + 2] + bt), y3 = bf2f(uu.y >> 16) * (acc[dt][4 * q4 + 3] + bt);
                    u32x2 w; w.x = pk2(y0, y1); w.y = pk2(y2, y3);
                    *(u32x2*)(YB + rowt * 1024 + grp * 64 + d) = w;
                }
        }
    }
    __syncthreads();
    {
        const bf16_t* KV = (const bf16_t*)(ws + WS_KV); bf16_t* VT = (bf16_t*)(ws + WS_VT);
        LAS unsigned char* T = lds;
        const int bb = item >> 6, posc = (item & 63) * 128;
        {
            u32x4 vv[8];
#pragma unroll
            for (int q = 0; q < 8; ++q) { const int i = tid + q * NTHREADS, pos = i & 127, ch = i >> 7, ty = ch >> 4, c8 = (ch & 15) * 8;
                vv[q] = *(const u32x4*)(KV + (row0 + pos) * 768 + (ty ? 5 : 3) * 128 + c8); }
#pragma unroll
            for (int q = 0; q < 8; ++q) { const int i = tid + q * NTHREADS, pos = i & 127, ch = i >> 7, ty = ch >> 4, c8 = (ch & 15) * 8; const u32x4 v = vv[q];
                LAS unsigned char* tp = T + (ty * 128 + c8) * 272 + pos * 2;
                *(LAS unsigned short*)(tp + 0 * 272) = (unsigned short)(v.x & 0xffffu); *(LAS unsigned short*)(tp + 1 * 272) = (unsigned short)(v.x >> 16);
                *(LAS unsigned short*)(tp + 2 * 272) = (unsigned short)(v.y & 0xffffu); *(LAS unsigned short*)(tp + 3 * 272) = (unsigned short)(v.y >> 16);
                *(LAS unsigned short*)(tp + 4 * 272) = (unsigned short)(v.z & 0xffffu); *(LAS unsigned short*)(tp + 5 * 272) = (unsigned short)(v.z >> 16);
                *(LAS unsigned short*)(tp + 6 * 272) = (unsigned short)(v.w & 0xffffu); *(LAS unsigned short*)(tp + 7 * 272) = (unsigned short)(v.w >> 16); }
        }
        __syncthreads();
        for (int i = tid; i < 256 * 16; i += NTHREADS) {
            const int rw = i >> 4, ch = i & 15, ty = rw >> 7, gd = rw & 127;
            const u32x4 v = *(const LAS u32x4*)(T + rw * 272 + ch * 16);
            *(u32x4*)(VT + ((size_t)(ty * 4 + bb) * 128 + gd) * SEQ + posc + ch * 8) = v;
        }
        __syncthreads();
    }
}

constexpr int AL_K0 = 0, AL_K1 = 9216, AL_V0 = 18432, AL_V1 = 27136, AL_PB = 35840, AL_IMP = 102400, AL_SELM = 135424, AL_UNI = 136448, AL_BL = 136512, AL_NBL = 137024, AL_THR = 137088;
static_assert(AL_THR + 256 <= LDS_BYTES, "attention LDS map");
struct KVSrc { const bf16_t* k; const bf16_t* v; int kp, vp; };
struct BlkPar { float base, ksl; int lo, hi; };

template <int MODE>
DI void attn_block(const LAS unsigned char* Ks, const LAS unsigned char* Vs, const bf16x8 (&qf)[4], f32x16 (&o)[2], float& m, float& l, float invl, LAS float* pbrow, const BlkPar bp, const bool MASK, const bool first, int r, int h) {
    f32x16 p0, p1;
    {
        const float bh = bp.base + bp.ksl * (float)(4 * h) - m, bh1 = bh + 32.f * bp.ksl;
        const f32x2 ks2 = {bp.ksl, bp.ksl}, b2 = {bh, bh}, b21 = {bh1, bh1};
#pragma unroll
        for (int i = 0; i < 16; i += 2) { const f32x2 kc = {(float)((i & 3) + 8 * (i >> 2)), (float)(((i + 1) & 3) + 8 * ((i + 1) >> 2))};
            const f32x2 a = ks2 * kc + b2, c = ks2 * kc + b21; p0[i] = a.x; p0[i + 1] = a.y; p1[i] = c.x; p1[i + 1] = c.y; }
    }
    {
        bf16x8 kf[8];
#pragma unroll
        for (int s = 0; s < 4; ++s) { kf[2 * s] = *(const LAS bf16x8*)(Ks + r * 144 + s * 32 + h * 16); kf[2 * s + 1] = *(const LAS bf16x8*)(Ks + (32 + r) * 144 + s * 32 + h * 16); }
        __builtin_amdgcn_sched_barrier(0);
#pragma unroll
        for (int s = 0; s < 4; ++s) { p0 = MFMA32(kf[2 * s], qf[s], p0); p1 = MFMA32(kf[2 * s + 1], qf[s], p1); }
    }
    s16x4 vlo[8], vhi[8];
    if (MODE != 1) {
#pragma unroll
        for (int dh = 0; dh < 2; ++dh)
#pragma unroll
            for (int ks = 0; ks < 4; ++ks) { const LAS unsigned char* vp = Vs + (dh * 32 + r) * 136 + ks * 32 + h * 8; vlo[dh * 4 + ks] = *(const LAS s16x4*)vp; vhi[dh * 4 + ks] = *(const LAS s16x4*)(vp + 16); }
        __builtin_amdgcn_sched_barrier(0);
    }
    if (MASK) {
        const int lo = bp.lo - 4 * h, hi = bp.hi - 4 * h;
#pragma unroll
        for (int i = 0; i < 16; ++i) { const int kc = (i & 3) + 8 * (i >> 2); p0[i] = (kc >= lo && kc <= hi) ? p0[i] : NEGBIG; p1[i] = (kc + 32 >= lo && kc + 32 <= hi) ? p1[i] : NEGBIG; }
    }
    if (MODE == 0 || MODE == 1) {
        float mx = fmaxf(p0[0], p1[0]);
#pragma unroll
        for (int i = 1; i < 16; ++i) mx = fmaxf(fmaxf(mx, p0[i]), p1[i]);
        mx = xmax32(mx);
        if (first) {
            m += mx;
#pragma unroll
            for (int i = 0; i < 16; ++i) { p0[i] -= mx; p1[i] -= mx; }
        } else if (__any(mx > 0.f)) {
            const float dl = fmaxf(mx, 0.f), alpha = ex2(-dl); m += dl; l *= alpha;
#pragma unroll
            for (int i = 0; i < 16; ++i) { p0[i] -= dl; p1[i] -= dl; }
            if (MODE == 0) {
#pragma unroll
                for (int i = 0; i < 16; ++i) { o[0][i] *= alpha; o[1][i] *= alpha; }
            }
        }
        if (!first && __all(mx < -40.f)) return;
        float s0 = 0.f, s1 = 0.f;
#pragma unroll
        for (int i = 0; i < 16; ++i) { p0[i] = ex2(p0[i]); p1[i] = ex2(p1[i]); s0 += p0[i]; s1 += p1[i]; }
        l += s0 + s1;
    } else {
#pragma unroll
        for (int i = 0; i < 16; ++i) {
            p0[i] = p0[i] > -1e29f ? ex2(p0[i]) * invl : 0.f; p1[i] = p1[i] > -1e29f ? ex2(p1[i]) * invl : 0.f;
            pbrow[crow(i, h)] = p0[i]; pbrow[32 + crow(i, h)] = p1[i];
        }
    }
    if (MODE != 1) {
        bf16x8 pf[4];
#pragma unroll
        for (int ks = 0; ks < 2; ++ks) {
            u32x4 w0, w1;
            w0.x = pk2(p0[8 * ks + 0], p0[8 * ks + 1]); w0.y = pk2(p0[8 * ks + 2], p0[8 * ks + 3]); w0.z = pk2(p0[8 * ks + 4], p0[8 * ks + 5]); w0.w = pk2(p0[8 * ks + 6], p0[8 * ks + 7]);
            w1.x = pk2(p1[8 * ks + 0], p1[8 * ks + 1]); w1.y = pk2(p1[8 * ks + 2], p1[8 * ks + 3]); w1.z = pk2(p1[8 * ks + 4], p1[8 * ks + 5]); w1.w = pk2(p1[8 * ks + 6], p1[8 * ks + 7]);
            pf[ks] = __builtin_bit_cast(bf16x8, w0); pf[2 + ks] = __builtin_bit_cast(bf16x8, w1);
        }
#pragma unroll
        for (int ks = 0; ks < 4; ++ks)
#pragma unroll
            for (int dh = 0; dh < 2; ++dh) {
                const bf16x8 af = __builtin_shufflevector(vlo[dh * 4 + ks], vhi[dh * 4 + ks], 0, 1, 2, 3, 4, 5, 6, 7);
                o[dh] = MFMA32(af, pf[ks], o[dh]);
            }
    }
}

DI void kv_load(const KVSrc& s, int tid, u32x4& kreg, u32x4& vreg) {
    const int ko = (tid >> 3) * s.kp + (tid & 7) * 8, vo = (tid >> 3) * s.vp + (tid & 7) * 8;
    kreg = *(const u32x4*)(s.k + ko);
    vreg = *(const u32x4*)(s.v + vo);
}
DI void kv_store(LAS unsigned char* Kb, LAS unsigned char* Vb, int tid, const u32x4& kreg, const u32x4& vreg) {
    *(LAS u32x4*)(Kb + (tid >> 3) * 144 + (tid & 7) * 16) = kreg;
    LAS unsigned char* vp = Vb + (tid >> 3) * 136 + (tid & 7) * 16;
    *(LAS u32x2*)vp = (u32x2){vreg.x, vreg.y}; *(LAS u32x2*)(vp + 8) = (u32x2){vreg.z, vreg.w};
}

template <int MODE, class SrcF, class ParF, class PostF>
DI void attn_run(int nb, SrcF src, ParF par, PostF post, LAS unsigned char* lds, const bf16x8 (&qf)[4], f32x16 (&o)[2], float& m, float& l, float invl, LAS float* pbrow,
                 int tid, int r, int h, const bool pre, u32x4& kp, u32x4& vp, const bool want_nxt, const KVSrc nxt) {
    u32x4& kreg = kp; u32x4& vreg = vp;
    if (!pre) kv_load(src(0), tid, kreg, vreg);
    kv_store(lds + AL_K0, lds + AL_V0, tid, kreg, vreg);
    __syncthreads();
    for (int i = 0; i < nb; ++i) {
        const int cur = i & 1;
        if (i + 1 < nb) kv_load(src(i + 1), tid, kreg, vreg);
        else if (want_nxt) kv_load(nxt, tid, kreg, vreg);
        bool msk; const BlkPar bp = par(i, msk);
        attn_block<MODE>(lds + (cur ? AL_K1 : AL_K0), lds + (cur ? AL_V1 : AL_V0), qf, o, m, l, invl, pbrow, bp, msk, i == 0, r, h);
        if (MODE == 2) { __syncthreads(); post(i); }
        if (i + 1 < nb) kv_store(lds + (cur ? AL_K0 : AL_K1), lds + (cur ? AL_V0 : AL_V1), tid, kreg, vreg);
        __syncthreads();
    }
}

#define CE_DESC(a, b) do { const unsigned _x = (a), _y = (b); (a) = _x > _y ? _x : _y; (b) = _x > _y ? _y : _x; } while (0)
DI void sort16_desc(unsigned (&k)[16]) {
#pragma unroll
    for (int kk = 2; kk <= 16; kk <<= 1)
#pragma unroll
        for (int j = kk >> 1; j > 0; j >>= 1)
#pragma unroll
            for (int i = 0; i < 16; ++i) { const int p = i ^ j; if (p > i) { if ((i & kk) == 0) CE_DESC(k[i], k[p]); else CE_DESC(k[p], k[i]); } }
}
DI void merge16_desc(unsigned (&k)[16]) {
#pragma unroll
    for (int j = 8; j > 0; j >>= 1)
#pragma unroll
        for (int i = 0; i < 16; ++i) { const int p = i ^ j; if (p > i) CE_DESC(k[i], k[p]); }
}

DI void attn_tile(const Args& a, LAS unsigned char* lds, int b, int g, int c, int tid, int wave, int lane) {
    asm volatile("" : "+v"(tid), "+v"(lane));
    unsigned char* ws = a.ws;
    const bf16_t* Q = (const bf16_t*)(ws + WS_Q); const bf16_t* KV = (const bf16_t*)(ws + WS_KV);
    const bf16_t* KC = (const bf16_t*)(ws + WS_KCMP) + (size_t)(b * 2 + g) * 512 * 64; const bf16_t* VC = (const bf16_t*)(ws + WS_VCMP) + (size_t)(b * 2 + g) * 64 * 512;
    const float* NG = (const float*)(ws + WS_NG); bf16_t* YA = (bf16_t*)(ws + WS_YAB); const bf16_t* VT = (const bf16_t*)(ws + WS_VT);
    const int r = lane & 31, h = lane >> 5, hd = wave >> 1, th = wave & 1, tl = th * 32 + r, t = 64 * c + tl;
    const size_t row = (size_t)b * SEQ + t;
    const float slope2 = ex2(-(float)(g * 4 + hd + 1)) * LOG2E;
    const float tf = (float)t;
    bf16x8 qf[4];
#pragma unroll
    for (int s = 0; s < 4; ++s) qf[s] = *(const bf16x8*)(Q + row * 512 + g * 256 + hd * 64 + 16 * s + 8 * h);
    const float gate_c = NG[row * 24 + g * 12 + hd * 3 + 0], gate_s = NG[row * 24 + g * 12 + hd * 3 + 1], gate_w = NG[row * 24 + g * 12 + hd * 3 + 2];
    f32x16 tot[2];
    LAS float* IMP = (LAS float*)(lds + AL_IMP);
    LAS float* PB = (LAS float*)(lds + AL_PB);
    LAS float* pbrow = PB + (hd * 64 + tl) * 65;
    const bf16_t* kvb = KV + (size_t)b * SEQ * 768 + g * 64;
    auto nopost = [](int) {};

    const bf16_t* vtw = VT + ((size_t)(4 + b) * 128 + g * 64) * SEQ;
    u32x4 kpre, vpre;
    KVSrc cmp0; cmp0.k = KC; cmp0.v = VC; cmp0.kp = 64; cmp0.vp = 512;
    KVSrc sel0; sel0.k = kvb + (size_t)(64 * c) * 768 + 2 * 128; sel0.v = VT + ((size_t)(0 + b) * 128 + g * 64) * SEQ + 64 * c; sel0.kp = 768; sel0.vp = SEQ;
    const bf16_t* vts = VT + ((size_t)(0 + b) * 128 + g * 64) * SEQ;
    for (int rep = 0; rep < ATT_REP_W; ++rep) {
        const int nb = (c > 8 ? 8 : c) + 1;
        f32x16 o[2];
#pragma unroll
        for (int i = 0; i < 16; ++i) { o[0][i] = 0.f; o[1][i] = 0.f; }
        float m = 0.f, l = 0.f;
        auto src = [=](int i) { const int j = c - i; KVSrc s; s.k = kvb + (size_t)(64 * j) * 768 + 4 * 128; s.v = vtw + 64 * j; s.kp = 768; s.vp = SEQ; return s; };
        auto par = [=](int i, bool& msk) { const int d0 = t - 64 * (c - i); msk = (i == 0) || (i == 8); BlkPar bp; bp.base = -slope2 * (float)d0; bp.ksl = slope2; bp.lo = d0 - 511; bp.hi = d0; return bp; };
        attn_run<0>(nb, src, par, nopost, lds, qf, o, m, l, 0.f, pbrow, tid, r, h, false, kpre, vpre, true, cmp0);
        const float sc = gate_w * rcpf_(xsum32(l));
#pragma unroll
        for (int i = 0; i < 16; ++i) { tot[0][i] = sc * o[0][i]; tot[1][i] = sc * o[1][i]; }
    }
    for (int i = tid; i < 64 * 129; i += NTHREADS) IMP[i] = 0.f;
    for (int rep = 0; rep < ATT_REP_C; ++rep) {
        if (rep > 0) { __syncthreads(); for (int i = tid; i < 64 * 129; i += NTHREADS) IMP[i] = 0.f; }
        const int nbc = (4 * c + 3 + 63) >> 6;
        auto src = [=](int i) { KVSrc s; s.k = KC + (size_t)(64 * i) * 64; s.v = VC + 64 * i; s.kp = 64; s.vp = 512; return s; };
        const int nvalid = ((t - 31) >> 4);
        auto par = [=](int i, bool& msk) { const int n0 = 64 * i; msk = (n0 + 63) > ((64 * c - 31) >> 4);
            BlkPar bp; bp.base = -slope2 * (tf - (float)(16 * n0) - 15.5f); bp.ksl = 16.f * slope2; bp.lo = -1000000; bp.hi = nvalid - n0; return bp; };
        f32x16 o[2];
#pragma unroll
        for (int i = 0; i < 16; ++i) { o[0][i] = 0.f; o[1][i] = 0.f; }
        float m = 0.f, l = 0.f;
        attn_run<1>(nbc, src, par, nopost, lds, qf, o, m, l, 0.f, pbrow, tid, r, h, true, kpre, vpre, true, cmp0);
        const float invl = rcpf_(xsum32(l));
        auto post = [=](int i) {
            for (int q = tid; q < 64 * 17; q += NTHREADS) {
                const int tok = q & 63, jj = q >> 6, j = 16 * i + jj;
                float acc = 0.f;
                if (jj < 16) {
#pragma unroll
                    for (int hh = 0; hh < 4; ++hh) { const LAS float* p = PB + (hh * 64 + tok) * 65 + 4 * jj; acc += (p[0] + p[1]) + (p[2] + 0.5f * p[3]); if (jj > 0) acc += 0.5f * p[-1]; }
                } else {
#pragma unroll
                    for (int hh = 0; hh < 4; ++hh) acc += 0.5f * PB[(hh * 64 + tok) * 65 + 63];
                }
                if (j < 128) IMP[tok * 129 + j] += acc;
            }
        };
        attn_run<2>(nbc, src, par, post, lds, qf, o, m, l, invl, pbrow, tid, r, h, true, kpre, vpre, rep == ATT_REP_C - 1, sel0);
        if (rep == ATT_REP_C - 1)
#pragma unroll
        for (int i = 0; i < 16; ++i) { tot[0][i] += gate_c * o[0][i]; tot[1][i] += gate_c * o[1][i]; }
    }
    __syncthreads();
    if (ATTN_BRANCHES & 4) {
        LAS unsigned* L0 = (LAS unsigned*)(lds + AL_PB);
        LAS unsigned* L1 = L0 + 8 * 16 * 64;
        LAS unsigned* L2 = L1 + 4 * 16 * 64;
        LAS unsigned* THR = (LAS unsigned*)(lds + AL_THR);
        LAS unsigned short* SELM = (LAS unsigned short*)(lds + AL_SELM);
        LAS unsigned* UNI = (LAS unsigned*)(lds + AL_UNI);
        LAS int* BL = (LAS int*)(lds + AL_BL);
        LAS int* NBL = (LAS int*)(lds + AL_NBL);
        const int tok = lane, seg = wave;
        unsigned key[16];
#pragma unroll
        for (int i = 0; i < 16; ++i) {
            const int j = 16 * seg + i;
            const bool forced = (j == 0) || (j == c) || (j == c - 1);
            const unsigned kvv = forced ? 0x1FFFFFFu : (j <= c ? (__float_as_uint(IMP[tok * 129 + j]) >> 7) + 1u : 0u);
            key[i] = (kvv << 7) | (unsigned)(127 - j);
        }
        sort16_desc(key);
#pragma unroll
        for (int i = 0; i < 16; ++i) L0[(seg * 16 + i) * 64 + tok] = key[i];
        __syncthreads();
        if (wave < 4) {
            unsigned kk[16];
#pragma unroll
            for (int i = 0; i < 16; ++i) { const unsigned x = L0[((2 * wave) * 16 + i) * 64 + tok], y = L0[((2 * wave + 1) * 16 + 15 - i) * 64 + tok]; kk[i] = x > y ? x : y; }
            merge16_desc(kk);
#pragma unroll
            for (int i = 0; i < 16; ++i) L1[(wave * 16 + i) * 64 + tok] = kk[i];
        }
        __syncthreads();
        if (wave < 2) {
            unsigned kk[16];
#pragma unroll
            for (int i = 0; i < 16; ++i) { const unsigned x = L1[((2 * wave) * 16 + i) * 64 + tok], y = L1[((2 * wave + 1) * 16 + 15 - i) * 64 + tok]; kk[i] = x > y ? x : y; }
            merge16_desc(kk);
#pragma unroll
            for (int i = 0; i < 16; ++i) L2[(wave * 16 + i) * 64 + tok] = kk[i];
        }
        __syncthreads();
        if (wave == 0) {
            unsigned mn = 0xffffffffu;
#pragma unroll
            for (int i = 0; i < 16; ++i) { const unsigned x = L2[i * 64 + tok], y = L2[(16 + 15 - i) * 64 + tok]; const unsigned z = x > y ? x : y; mn = z < mn ? z : mn; }
            THR[tok] = mn;
        }
        __syncthreads();
        {
            const unsigned T = THR[tok]; unsigned m16 = 0;
#pragma unroll
            for (int i = 0; i < 16; ++i) m16 |= (key[i] >= T) ? (1u << (15 - (key[i] & 15u))) : 0u;
            SELM[tok * 8 + seg] = (unsigned short)m16;
            unsigned uni = 0;
#pragma unroll
            for (int bb = 0; bb < 16; ++bb) uni |= (__ballot((m16 >> bb) & 1u) != 0ull) ? (1u << bb) : 0u;
            if (lane == 0) UNI[seg] = uni;
        }
        __syncthreads();
        if (wave == 0) {
            int base = 0;
#pragma unroll
            for (int half = 0; half < 2; ++half) {
                const int j = half * 64 + lane;
                const bool on = ((UNI[j >> 4] >> (j & 15)) & 1u) && (j <= c);
                const unsigned long long bal = __ballot(on);
                const int pos = base + __builtin_popcountll(bal & ((1ull << lane) - 1ull));
                if (on) BL[pos] = j;
                base += __builtin_popcountll(bal);
            }
            if (lane == 0) NBL[0] = base;
        }
        __syncthreads();
        const int nbs = __builtin_amdgcn_readfirstlane(NBL[0]);
        f32x16 o[2];
#pragma unroll
        for (int i = 0; i < 16; ++i) { o[0][i] = 0.f; o[1][i] = 0.f; }
        float m = 0.f, l = 0.f;
        auto src = [=](int i) { const int j = __builtin_amdgcn_readfirstlane(BL[nbs - 1 - i]); KVSrc s; s.k = kvb + (size_t)(64 * j) * 768 + 2 * 128; s.v = vts + 64 * j; s.kp = 768; s.vp = SEQ; return s; };
        auto par = [=](int i, bool& msk) { const int j = __builtin_amdgcn_readfirstlane(BL[nbs - 1 - i]); const bool sel = (SELM[tl * 8 + (j >> 4)] >> (j & 15)) & 1; const int d0 = t - 64 * j;
            msk = (j == c); BlkPar bp; bp.base = sel ? -slope2 * (float)d0 : NEGBIG; bp.ksl = slope2; bp.lo = -1000000; bp.hi = d0; return bp; };
        for (int rep = 0; rep < ATT_REP_S; ++rep) {
            if (rep > 0) { m = 0.f; l = 0.f;
#pragma unroll
                for (int i = 0; i < 16; ++i) { o[0][i] = 0.f; o[1][i] = 0.f; } }
            attn_run<0>(nbs, src, par, nopost, lds, qf, o, m, l, 0.f, pbrow, tid, r, h, rep == 0, kpre, vpre, false, sel0);
        }
        const float sc = gate_s * rcpf_(xsum32(l));
#pragma unroll
        for (int dh = 0; dh < 2; ++dh)
#pragma unroll
            for (int q4 = 0; q4 < 4; ++q4) {
                const int d = dh * 32 + 8 * q4 + 4 * h;
                u32x2 w; w.x = pk2(tot[dh][4 * q4 + 0] + sc * o[dh][4 * q4 + 0], tot[dh][4 * q4 + 1] + sc * o[dh][4 * q4 + 1]); w.y = pk2(tot[dh][4 * q4 + 2] + sc * o[dh][4 * q4 + 2], tot[dh][4 * q4 + 3] + sc * o[dh][4 * q4 + 3]);
                *(u32x2*)(YA + row * 1024 + g * 256 + hd * 64 + d) = w;
            }
    }
    __syncthreads();
}

DI void p6a_route(const Args& a, LAS unsigned char* lds, int tid, int wave, int lane) {
    asm volatile("" : "+v"(tid), "+v"(lane));
    unsigned char* ws = a.ws;
    const float* X2 = (const float*)(ws + WS_X2); const float* br = a.in[20];
    const bf16_t* WH = (const bf16_t*)(ws + WS_WRT); const bf16_t* WL = WH + 32 * 1024;
    int* TOKE = (int*)(ws + WS_TOKE); float* TOKW = (float*)(ws + WS_TOKW); int* CNT = (int*)(ws + WS_CTL + CTL_CNT); float* RINV = (float*)(ws + WS_RINV);
    LAS unsigned char* WHL = lds; LAS unsigned char* WLL = lds + 65536;
    LAS float* CS = (LAS float*)(lds + 131072 + wave * 2112);
    LAS int* CNTL = (LAS int*)(lds + 131072 + 8 * 2112);
    const int tk = lane & 15, kq = lane >> 4;
    LAS float* GSL = (LAS float*)(lds + 131072 + 8 * 2112 + 128);
    static_assert(131072 + 8 * 2112 + 128 + 4096 <= LDS_BYTES - 16, "router LDS map");
    for (int i = tid; i < DM; i += NTHREADS) GSL[i] = a.in[18][i] * SC_A8;
    {
        u32x4 wv[16];
#pragma unroll
        for (int q = 0; q < 16; ++q) { const int i = tid + q * NTHREADS, arr = i >> 12, e = (i >> 7) & 31, ch = i & 127; wv[q] = *(const u32x4*)(WH + (size_t)arr * 32 * 1024 + e * 1024 + ch * 8); }
#pragma unroll
        for (int q = 0; q < 16; ++q) { const int i = tid + q * NTHREADS, arr = i >> 12, e = (i >> 7) & 31, ch = i & 127; *(LAS u32x4*)(lds + arr * 65536 + e * 2048 + ((ch ^ (e & 15)) * 16)) = wv[q]; }
    }
    __syncthreads();
    const LAS float* GS = GSL;
    for (int blk0 = blockIdx.x; blk0 < 256 * DBL(6); blk0 += gridDim.x) {
        const int blk = blk0 & 255;
        if (tid < 32) CNTL[tid] = 0;
        __syncthreads();
        const int t0 = blk * 128 + wave * 16;
        const float* xp = X2 + (size_t)(t0 + tk) * DM + 8 * kq;
        const LAS unsigned char* wh0 = WHL + tk * 2048; const LAS unsigned char* wl0 = WLL + tk * 2048;
        f32x4 acc0 = {0.f, 0.f, 0.f, 0.f}, acc1 = {0.f, 0.f, 0.f, 0.f}; float ss = 0.f;
        unsigned char* H8 = (unsigned char*)(ws + WS_AS) + (size_t)(t0 + tk) * DM + 8 * kq; const LAS float* gmp = GS + 8 * kq;
#pragma unroll 8
        for (int s = 0; s < 32; ++s) {
            const f32x4 xa = __builtin_nontemporal_load((const f32x4*)(xp + 32 * s)), xb = __builtin_nontemporal_load((const f32x4*)(xp + 32 * s + 4));
            const int wo = ((4 * s + kq) ^ tk) * 16;
            const bf16x8 bh0 = *(const LAS bf16x8*)(wh0 + wo), bl0 = *(const LAS bf16x8*)(wl0 + wo), bh1 = *(const LAS bf16x8*)(wh0 + 16 * 2048 + wo), bl1 = *(const LAS bf16x8*)(wl0 + 16 * 2048 + wo);
            ss += (xa[0] * xa[0] + xa[1] * xa[1]) + (xa[2] * xa[2] + xa[3] * xa[3]) + (xb[0] * xb[0] + xb[1] * xb[1]) + (xb[2] * xb[2] + xb[3] * xb[3]);
            u32x4 hh; hh.x = pk2(xa[0], xa[1]); hh.y = pk2(xa[2], xa[3]); hh.z = pk2(xb[0], xb[1]); hh.w = pk2(xb[2], xb[3]);
            u32x4 lo; lo.x = pk2(xa[0] - bf2f(hh.x & 0xffffu), xa[1] - bf2f(hh.x >> 16)); lo.y = pk2(xa[2] - bf2f(hh.y & 0xffffu), xa[3] - bf2f(hh.y >> 16));
            lo.z = pk2(xb[0] - bf2f(hh.z & 0xffffu), xb[1] - bf2f(hh.z >> 16)); lo.w = pk2(xb[2] - bf2f(hh.w & 0xffffu), xb[3] - bf2f(hh.w >> 16));
            if (MOE_GATHER && MOE_FP8) {
                const f32x4 ga = *(const LAS f32x4*)(gmp + 32 * s), gb = *(const LAS f32x4*)(gmp + 32 * s + 4);
                u32x2 w; w.x = pk4_fp8(xa[0] * ga[0], xa[1] * ga[1], xa[2] * ga[2], xa[3] * ga[3]); w.y = pk4_fp8(xb[0] * gb[0], xb[1] * gb[1], xb[2] * gb[2], xb[3] * gb[3]);
                *(u32x2*)(H8 + 32 * s) = w;
            }
            const bf16x8 ah = __builtin_bit_cast(bf16x8, hh), al = __builtin_bit_cast(bf16x8, lo);
            acc0 = __builtin_amdgcn_mfma_f32_16x16x32_bf16(bh0, ah, acc0, 0, 0, 0); acc0 = __builtin_amdgcn_mfma_f32_16x16x32_bf16(bl0, ah, acc0, 0, 0, 0); acc0 = __builtin_amdgcn_mfma_f32_16x16x32_bf16(bh0, al, acc0, 0, 0, 0);
            acc1 = __builtin_amdgcn_mfma_f32_16x16x32_bf16(bh1, ah, acc1, 0, 0, 0); acc1 = __builtin_amdgcn_mfma_f32_16x16x32_bf16(bl1, ah, acc1, 0, 0, 0); acc1 = __builtin_amdgcn_mfma_f32_16x16x32_bf16(bh1, al, acc1, 0, 0, 0);
        }
#pragma unroll
        for (int i = 0; i < 4; ++i) { CS[tk * 33 + 4 * kq + i] = acc0[i]; CS[tk * 33 + 16 + 4 * kq + i] = acc1[i]; }
        ss += __shfl_xor(ss, 16); ss += __shfl_xor(ss, 32);
        const float rinv = 1.0f / sqrtf(ss * (1.f / DM) + 1e-5f);
        lds_wait();
        if (lane < 16) {
            float lg[32];
#pragma unroll
            for (int e = 0; e < 32; ++e) lg[e] = CS[lane * 33 + e] * rinv + br[e];
            int es0 = 0, es1 = 0, es2 = 0, es3 = 0; float vs0 = 0.f, vs1 = 0.f, vs2 = 0.f, vs3 = 0.f;
#define TOP1(ES, VS) { float mx = lg[0]; int ix = 0; _Pragma("unroll") for (int e = 1; e < 32; ++e) { const bool gt = lg[e] > mx; mx = gt ? lg[e] : mx; ix = gt ? e : ix; } ES = ix; VS = mx; \
                _Pragma("unroll") for (int e = 0; e < 32; ++e) lg[e] = (e == ix) ? -3e38f : lg[e]; }
            TOP1(es0, vs0) TOP1(es1, vs1) TOP1(es2, vs2) TOP1(es3, vs3)
#undef TOP1
            const float e1 = ex2((vs1 - vs0) * LOG2E), e2 = ex2((vs2 - vs0) * LOG2E), e3 = ex2((vs3 - vs0) * LOG2E);
            const float inv = 1.0f / (1.0f + e1 + e2 + e3);
            const int t = t0 + lane;
            *(u32x4*)(TOKE + (size_t)t * 4) = (u32x4){(unsigned)es0, (unsigned)es1, (unsigned)es2, (unsigned)es3};
            *(f32x4*)(TOKW + (size_t)t * 4) = (f32x4){inv, e1 * inv, e2 * inv, e3 * inv};
            RINV[t] = rinv;
            atomicAdd((int*)(CNTL + es0), 1); atomicAdd((int*)(CNTL + es1), 1); atomicAdd((int*)(CNTL + es2), 1); atomicAdd((int*)(CNTL + es3), 1);
        }
        __syncthreads();
        if (tid < 32) CNT[blk * 32 + tid] = CNTL[tid];
        __syncthreads();
    }
}
DI void p6b_place(const Args& a, LAS unsigned char* lds, int tid, int wave, int lane) {
    asm volatile("" : "+v"(tid), "+v"(lane));
    unsigned char* ws = a.ws;
    const float* X2 = (const float*)(ws + WS_X2); const float* RINV = (const float*)(ws + WS_RINV); bf16_t* AS = (bf16_t*)(ws + WS_AS);
    const float* gm = a.in[18];
    const f32x4 g00 = *(const f32x4*)(gm + lane * 8), g01 = *(const f32x4*)(gm + lane * 8 + 4), g10 = *(const f32x4*)(gm + 512 + lane * 8), g11 = *(const f32x4*)(gm + 512 + lane * 8 + 4);
    const int* TOKE = (const int*)(ws + WS_TOKE); const float* TOKW = (const float*)(ws + WS_TOKW); const int* CNT = (const int*)(ws + WS_CTL + CTL_CNT);
    int* SLOT = (int*)(ws + WS_SLOT); float* WSLOT = (float*)(ws + WS_WSLOT); int* TE = (int*)(ws + WS_CTL + CTL_TE); int* NT = (int*)(ws + WS_CTL + CTL_NT);
    LAS int* TOT = (LAS int*)lds; LAS int* OFFS = TOT + 32; LAS int* PADS = TOT + 64; LAS int* CUR = TOT + 96;
    for (int blk0 = blockIdx.x; blk0 < 256 * DBL(10); blk0 += gridDim.x) {
        const int blk = blk0 & 255;
        {
            LAS int* PT = TOT + 128; LAS int* PM = TOT + 128 + 512;
            const int e = tid & 31, part = tid >> 5; int tot = 0, mine = 0;
#pragma unroll
            for (int q = 0; q < 16; ++q) { const int bb = part * 16 + q; const int cc = CNT[bb * 32 + e]; tot += cc; mine += (bb < blk) ? cc : 0; }
            PT[part * 32 + e] = tot; PM[part * 32 + e] = mine;
            __syncthreads();
            if (tid < 32) { int t2 = 0, m2 = 0;
#pragma unroll
                for (int q = 0; q < 16; ++q) { t2 += PT[q * 32 + tid]; m2 += PM[q * 32 + tid]; }
                TOT[tid] = t2; OFFS[tid] = m2; CUR[tid] = 0; }
        }
        __syncthreads();
        if (tid == 0) {
            int ps = 0;
            for (int e = 0; e < 32; ++e) { PADS[e] = ps; ps += (TOT[e] + 255) & ~255; }
            if (blk == 0) NT[0] = ps >> 8;
        }
        __syncthreads();
        if (blk == 0 && tid < 32) { const int t0 = PADS[tid] >> 8, n = (TOT[tid] + 255) >> 8; for (int q = 0; q < n; ++q) TE[t0 + q] = tid; }
        if (MOE_GATHER && MOE_FP8) {
            int* STOK = (int*)(ws + WS_STOK); float* RSLOT = (float*)(ws + WS_RSLOT);
            if (blk == 0) { for (int e = wave; e < 32; e += NWAVES) { const int lo = PADS[e] + TOT[e], hi = PADS[e] + ((TOT[e] + 255) & ~255); for (int p = lo + lane; p < hi; p += 64) { STOK[p] = 0; WSLOT[p] = 0.f; RSLOT[p] = 0.f; } } }
            const int t = blk * 128 + (tid >> 2), k = tid & 3;
            const int e = TOKE[(size_t)t * 4 + k];
            const int pos = PADS[e] + OFFS[e] + atomicAdd((int*)(CUR + e), 1);
            STOK[pos] = t; SLOT[(size_t)t * 4 + k] = pos; WSLOT[pos] = TOKW[(size_t)t * 4 + k]; RSLOT[pos] = RINV[t];
        } else
        {
            const int tb = blk * 128 + wave * 16;
            f32x4 a0, a1, b0, b1, na0, na1, nb0, nb1; float rv, nrv; int e0, e1, e2, e3, ne0, ne1, ne2, ne3; float w0, w1, w2, w3, nw0, nw1, nw2, nw3;
#define P6B_LOAD(T, A0, A1, B0, B1, RV, E0, E1, E2, E3, W0, W1, W2, W3) { const float* xp = X2 + (size_t)(T) * DM + lane * 8; A0 = *(const f32x4*)xp; A1 = *(const f32x4*)(xp + 4); B0 = *(const f32x4*)(xp + 512); B1 = *(const f32x4*)(xp + 516); RV = RINV[T]; \
                const int* ep = TOKE + (size_t)(T) * 4; E0 = ep[0]; E1 = ep[1]; E2 = ep[2]; E3 = ep[3]; const float* wp = TOKW + (size_t)(T) * 4; W0 = wp[0]; W1 = wp[1]; W2 = wp[2]; W3 = wp[3]; }
            P6B_LOAD(tb, a0, a1, b0, b1, rv, e0, e1, e2, e3, w0, w1, w2, w3)
            for (int it = 0; it < 16; ++it) {
                const int t = tb + it;
                if (it + 1 < 16) P6B_LOAD(t + 1, na0, na1, nb0, nb1, nrv, ne0, ne1, ne2, ne3, nw0, nw1, nw2, nw3)
                u32x4 r0, r1; u32x2 q0, q1;
                if (MOE_FP8) { const float r8 = rv * SC_A8;
                    q0.x = pk4_fp8(a0[0] * r8 * g00[0], a0[1] * r8 * g00[1], a0[2] * r8 * g00[2], a0[3] * r8 * g00[3]); q0.y = pk4_fp8(a1[0] * r8 * g01[0], a1[1] * r8 * g01[1], a1[2] * r8 * g01[2], a1[3] * r8 * g01[3]);
                    q1.x = pk4_fp8(b0[0] * r8 * g10[0], b0[1] * r8 * g10[1], b0[2] * r8 * g10[2], b0[3] * r8 * g10[3]); q1.y = pk4_fp8(b1[0] * r8 * g11[0], b1[1] * r8 * g11[1], b1[2] * r8 * g11[2], b1[3] * r8 * g11[3]);
                } else {
                    r0.x = pk2(a0[0] * rv * g00[0], a0[1] * rv * g00[1]); r0.y = pk2(a0[2] * rv * g00[2], a0[3] * rv * g00[3]); r0.z = pk2(a1[0] * rv * g01[0], a1[1] * rv * g01[1]); r0.w = pk2(a1[2] * rv * g01[2], a1[3] * rv * g01[3]);
                    r1.x = pk2(b0[0] * rv * g10[0], b0[1] * rv * g10[1]); r1.y = pk2(b0[2] * rv * g10[2], b0[3] * rv * g10[3]); r1.z = pk2(b1[0] * rv * g11[0], b1[1] * rv * g11[1]); r1.w = pk2(b1[2] * rv * g11[2], b1[3] * rv * g11[3]);
                }
#pragma unroll
                for (int k = 0; k < 4; ++k) {
                    const int e = k == 0 ? e0 : k == 1 ? e1 : k == 2 ? e2 : e3; const float wk = k == 0 ? w0 : k == 1 ? w1 : k == 2 ? w2 : w3;
                    int p = 0; if (lane == 0) p = atomicAdd((int*)(CUR + e), 1);
                    p = __builtin_amdgcn_readfirstlane(p);
                    const int pos = PADS[e] + OFFS[e] + p;
                    if (MOE_FP8) { *(u32x2*)((unsigned char*)AS + (size_t)pos * DM + lane * 8) = q0; *(u32x2*)((unsigned char*)AS + (size_t)pos * DM + 512 + lane * 8) = q1; }
                    else { *(u32x4*)(AS + (size_t)pos * DM + lane * 8) = r0; *(u32x4*)(AS + (size_t)pos * DM + 512 + lane * 8) = r1; }
                    if (lane == 0) { SLOT[(size_t)t * 4 + k] = pos; WSLOT[pos] = wk; }
                }
                a0 = na0; a1 = na1; b0 = nb0; b1 = nb1; rv = nrv; e0 = ne0; e1 = ne1; e2 = ne2; e3 = ne3; w0 = nw0; w1 = nw1; w2 = nw2; w3 = nw3;
            }
#undef P6B_LOAD
        }
        __syncthreads();
    }
}
#if Y_FP8
DI void p9_final(const Args& a, int gw, int NGW, int lane) {
    asm volatile("" : "+v"(lane));
    unsigned char* ws = a.ws;
    const float* X2 = (const float*)(ws + WS_X2); const unsigned char* Y = (const unsigned char*)(ws + WS_Y); const int* SLOT = (const int*)(ws + WS_SLOT);
    const float* gf = a.in[25]; float* out = a.out;
    f32x4 gv[4];
#pragma unroll
    for (int j = 0; j < 4; ++j) gv[j] = *((const f32x4*)gf + lane * 4 + j);
    int t0 = gw;
    int p0 = 0, p1 = 0, p2 = 0, p3 = 0;
    constexpr int TX = MTOK * DBL(9);
    if (t0 < TX) { const int t = t0 % MTOK; p0 = SLOT[(size_t)t * 4]; p1 = SLOT[(size_t)t * 4 + 1]; p2 = SLOT[(size_t)t * 4 + 2]; p3 = SLOT[(size_t)t * 4 + 3]; }
    for (; t0 < TX; t0 += NGW) {
        const int t = t0 % MTOK; const int tn0 = t0 + NGW, tn = tn0 % MTOK;
        int q0 = 0, q1 = 0, q2 = 0, q3 = 0;
        if (tn0 < TX) { q0 = SLOT[(size_t)tn * 4]; q1 = SLOT[(size_t)tn * 4 + 1]; q2 = SLOT[(size_t)tn * 4 + 2]; q3 = SLOT[(size_t)tn * 4 + 3]; }
        f32x4 v[4]; u32x4 y[4];
#pragma unroll
        for (int j = 0; j < 4; ++j) v[j] = __builtin_nontemporal_load((const f32x4*)(X2 + (size_t)t * DM) + lane * 4 + j);
        y[0] = __builtin_nontemporal_load((const u32x4*)(Y + (size_t)p0 * DM) + lane); y[1] = __builtin_nontemporal_load((const u32x4*)(Y + (size_t)p1 * DM) + lane);
        y[2] = __builtin_nontemporal_load((const u32x4*)(Y + (size_t)p2 * DM) + lane); y[3] = __builtin_nontemporal_load((const u32x4*)(Y + (size_t)p3 * DM) + lane);
        float s = 0.f;
#pragma unroll
        for (int j = 0; j < 4; ++j) {
            f32x2 lo = {0.f, 0.f}, hi = {0.f, 0.f};
#pragma unroll
            for (int k = 0; k < 4; ++k) { const int w = (int)y[k][j]; lo += __builtin_amdgcn_cvt_pk_f32_fp8(w, false); hi += __builtin_amdgcn_cvt_pk_f32_fp8(w, true); }
            v[j].x += lo.x * (1.0f / SC_Y8); v[j].y += lo.y * (1.0f / SC_Y8); v[j].z += hi.x * (1.0f / SC_Y8); v[j].w += hi.y * (1.0f / SC_Y8);
            s += (v[j].x * v[j].x + v[j].y * v[j].y) + (v[j].z * v[j].z + v[j].w * v[j].w);
        }
        const float rinv = 1.0f / sqrtf(wave_sum(s) * (1.f / DM) + 1e-5f);
#pragma unroll
        for (int j = 0; j < 4; ++j) *((f32x4*)(out + (size_t)t * DM) + lane * 4 + j) = (f32x4){v[j].x * rinv * gv[j].x, v[j].y * rinv * gv[j].y, v[j].z * rinv * gv[j].z, v[j].w * rinv * gv[j].w};
        p0 = q0; p1 = q1; p2 = q2; p3 = q3;
    }
}
#else
DI void p9_final(const Args& a, int gw, int NGW, int lane) {
    asm volatile("" : "+v"(lane));
    unsigned char* ws = a.ws;
    const float* X2 = (const float*)(ws + WS_X2); const bf16_t* Y = (const bf16_t*)(ws + WS_Y); const int* SLOT = (const int*)(ws + WS_SLOT);
    const float* gf = a.in[25]; float* out = a.out;
    f32x4 gv[4];
#pragma unroll
    for (int j = 0; j < 4; ++j) gv[j] = *((const f32x4*)gf + lane + 64 * j);
    int t0 = gw;
    int p0 = 0, p1 = 0, p2 = 0, p3 = 0;
    constexpr int TX = MTOK * DBL(9);
    if (t0 < TX) { const int t = t0 % MTOK; p0 = SLOT[(size_t)t * 4]; p1 = SLOT[(size_t)t * 4 + 1]; p2 = SLOT[(size_t)t * 4 + 2]; p3 = SLOT[(size_t)t * 4 + 3]; }
    for (; t0 < TX; t0 += NGW) {
        const int t = t0 % MTOK; const int tn0 = t0 + NGW, tn = tn0 % MTOK;
        int q0 = 0, q1 = 0, q2 = 0, q3 = 0;
        if (tn0 < TX) { q0 = SLOT[(size_t)tn * 4]; q1 = SLOT[(size_t)tn * 4 + 1]; q2 = SLOT[(size_t)tn * 4 + 2]; q3 = SLOT[(size_t)tn * 4 + 3]; }
        f32x4 v[4]; u32x2 y0[4], y1[4], y2[4], y3[4];
#pragma unroll
        for (int j = 0; j < 4; ++j) v[j] = *((const f32x4*)(X2 + (size_t)t * DM) + lane + 64 * j);
#pragma unroll
        for (int j = 0; j < 4; ++j) { y0[j] = *((const u32x2*)(Y + (size_t)p0 * DM) + lane + 64 * j); y1[j] = *((const u32x2*)(Y + (size_t)p1 * DM) + lane + 64 * j);
            y2[j] = *((const u32x2*)(Y + (size_t)p2 * DM) + lane + 64 * j); y3[j] = *((const u32x2*)(Y + (size_t)p3 * DM) + lane + 64 * j); }
        float s = 0.f;
#pragma unroll
        for (int j = 0; j < 4; ++j) {
            v[j].x += ((bf2f(y0[j].x & 0xffffu) + bf2f(y1[j].x & 0xffffu)) + bf2f(y2[j].x & 0xffffu)) + bf2f(y3[j].x & 0xffffu);
            v[j].y += ((bf2f(y0[j].x >> 16) + bf2f(y1[j].x >> 16)) + bf2f(y2[j].x >> 16)) + bf2f(y3[j].x >> 16);
            v[j].z += ((bf2f(y0[j].y & 0xffffu) + bf2f(y1[j].y & 0xffffu)) + bf2f(y2[j].y & 0xffffu)) + bf2f(y3[j].y & 0xffffu);
            v[j].w += ((bf2f(y0[j].y >> 16) + bf2f(y1[j].y >> 16)) + bf2f(y2[j].y >> 16)) + bf2f(y3[j].y >> 16);
            s += (v[j].x * v[j].x + v[j].y * v[j].y) + (v[j].z * v[j].z + v[j].w * v[j].w);
        }
        const float rinv = 1.0f / sqrtf(wave_sum(s) * (1.f / DM) + 1e-5f);
#pragma unroll
        for (int j = 0; j < 4; ++j) *((f32x4*)(out + (size_t)t * DM) + lane + 64 * j) = (f32x4){v[j].x * rinv * gv[j].x, v[j].y * rinv * gv[j].y, v[j].z * rinv * gv[j].z, v[j].w * rinv * gv[j].w};
        p0 = q0; p1 = q1; p2 = q2; p3 = q3;
    }
}

#endif
__global__ void __launch_bounds__(NTHREADS, 2) hybrid_fwd(Args args) {
    extern __shared__ __attribute__((aligned(16))) unsigned char lds_raw[];
    LAS unsigned char* lds = (LAS unsigned char*)lds_raw;
    cg::grid_group grid = cg::this_grid();
    const int tid = threadIdx.x, lane = tid & 63, wave = __builtin_amdgcn_readfirstlane(tid >> 6);
    volatile LAS unsigned* bst = (volatile LAS unsigned*)(lds_raw_las(lds_raw) + LDS_BYTES - 16);
    if (tid < 4) bst[tid] = 0u;
    __syncthreads();
    const XcdBarrier xbar = xcd_barrier_post((unsigned*)(args.ws + WS_CTL + CTL_BAR), bst);
#define SYNC() xcd_barrier(xbar)
    const int G = gridDim.x, bx = blockIdx.x;
    const int gw = bx * NWAVES + wave, NGW = G * NWAVES;
    unsigned char* ws = args.ws;

#if PROBE_PH == 30
    for (int pass = 0; pass < 2; ++pass) {
#endif
    if (args.ws == nullptr) grid.sync();
    for (int rep = 0; rep < NREP(0); ++rep) p0_prep(args, lds, gw, NGW, wave, lane);
    SYNC();
    for (int rep = 0; rep < NREP(1); ++rep) {
        if (STAG1) stagger_us(bx, STAG1);
        pg8::Gemm g{(const pg8::bf16_t*)(ws + WS_H1), (const pg8::bf16_t*)(ws + WS_WIN), MTOK, NPROJ, DM};
        pg8::StaticOrder S; S.init(MTOK, NPROJ, G, bx);
#if PROBE_PH == 1
        Twice<pg8::StaticOrder> S2{S, 0, 2}; S2.init();
#endif
        Epi1 E{(bf16_t*)(ws + WS_Q), (bf16_t*)(ws + WS_KV), (bf16_t*)(ws + WS_U), (bf16_t*)(ws + WS_V), (bf16_t*)(ws + WS_MG), (float*)(ws + WS_NG)};

#if PROBE_PH == 1
        pg8::gemm_phase<Epi1, Twice<pg8::StaticOrder>, true, true>(lds, g, S2, E);
#else
        pg8::gemm_phase<Epi1, pg8::StaticOrder, true, true>(lds, g, S, E);
#endif
    }
    SYNC();
    for (int rep = 0; rep < NREP(2); ++rep)
    for (int it0 = bx; it0 < 512 * DBL(2); it0 += G) {
        const int it = it0 & 511;
        if (it < 256) { p2_compress_item(args, lds, it, tid, wave, lane);
#if PROBE_PH == 50
            p2_compress_item(args, lds, it, tid, wave, lane);
#endif
        } else { p2_sgu_item(args, lds, it - 256, tid, wave, lane);
#if PROBE_PH == 51
            p2_sgu_item(args, lds, it - 256, tid, wave, lane);
#endif
        }
    }
    SYNC();
    for (int rep = 0; rep < NREP(3); ++rep) {
        for (int it0 = bx; it0 < 1024 * ATT_TWICE; it0 += G) {
            const int it = it0 & 1023;
            const int w = it & 255, i = it >> 8, s = w & 63, b = w >> 6;
            const int g = i & 1, c = (i >> 1) ? 127 - s : s;
            attn_tile(args, lds, b, g, c, tid, wave, lane);
        }
    }
    SYNC();
    for (int rep = 0; rep < NREP(4); ++rep) {
        if (STAG4) stagger_us(bx, STAG4);
        pg8::Gemm g{(const pg8::bf16_t*)(ws + WS_YAB), (const pg8::bf16_t*)(ws + WS_WAB), MTOK, DM, DM};
        pg8::StaticOrder S; S.init(MTOK, DM, G, bx);
        Epi4 E{(const bf16_t*)(ws + WS_MG), (bf16_t*)(ws + WS_MERGED)};
        pg8::gemm_phase<Epi4, pg8::StaticOrder, true, true>(lds, g, S, E);
    }
    SYNC();
    for (int rep = 0; rep < NREP(5); ++rep) {
        if (STAG5) stagger_us(bx, STAG5);
        pg8::Gemm g{(const pg8::bf16_t*)(ws + WS_MERGED), (const pg8::bf16_t*)(ws + WS_WOUT), MTOK, DM, DM};
        pg8::StaticOrder S; S.init(MTOK, DM, G, bx);
#if PROBE_PH == 5
        Twice<pg8::StaticOrder> S2{S, 0, 2}; S2.init();
#endif
        Epi5 E{args.in[0], (float*)(ws + WS_X2)};

#if PROBE_PH == 5
        pg8::gemm_phase<Epi5, Twice<pg8::StaticOrder>, true, true>(lds, g, S2, E);
#else
        pg8::gemm_phase<Epi5, pg8::StaticOrder, true, true>(lds, g, S, E);
#endif
    }
    SYNC();
    for (int rep = 0; rep < NREP(6); ++rep) { p6a_route(args, lds, tid, wave, lane); }
    SYNC();
    for (int rep = 0; rep < NREP(10); ++rep) { p6b_place(args, lds, tid, wave, lane); }
    SYNC();
    const int* TE = (const int*)(ws + WS_CTL + CTL_TE);
    const int NT = __builtin_amdgcn_readfirstlane(*(const int*)(ws + WS_CTL + CTL_NT));
    for (int rep = 0; rep < NREP(7); ++rep) {
        int kq = MOE_FP8 ? DM / 2 : DM; asm volatile("" : "+s"(kq));
        pg8::Gemm g{(const pg8::bf16_t*)(ws + WS_AS), (const pg8::bf16_t*)(ws + WS_WGU), MPAD, NEXP * 2048, kq, (MOE_GATHER && MOE_FP8) ? (const int*)(ws + WS_STOK) : nullptr};
        MoeOrder S{TE, NT, 8, G, bx};
#if PROBE_PH == 7
        Twice<MoeOrder> S2{S, 0, 2}; S2.init();
#endif
        Epi7 E{args.in[22], (bf16_t*)(ws + WS_ACT), (MOE_GATHER && MOE_FP8) ? (const float*)(ws + WS_RSLOT) : nullptr};

#if PROBE_PH == 7
        pg8::gemm_phase<Epi7, Twice<MoeOrder>, true, true, MOE_FP8 != 0, (MOE_GATHER && MOE_FP8)>(lds, g, S2, E);
#else
        { const MoeOrderLds SL = moe_list_build(S, lds, tid); pg8::gemm_phase<Epi7, MoeOrderLds, true, true, MOE_FP8 != 0, (MOE_GATHER && MOE_FP8)>(lds, g, SL, E); }
#endif
    }
    SYNC();
    for (int rep = 0; rep < NREP(8); ++rep) {
        if (STAG8) stagger_us(bx, STAG8);
        int kq = MOE_FP8 ? DFF / 2 : DFF; asm volatile("" : "+s"(kq));
        pg8::Gemm g{(const pg8::bf16_t*)(ws + WS_ACT), (const pg8::bf16_t*)(ws + WS_WD), MPAD, NEXP * 1024, kq};
        MoeOrder S{TE, NT, 4, G, bx};
#if PROBE_PH == 8
        Twice<MoeOrder> S2{S, 0, 2}; S2.init();
#endif
        Epi8 E{args.in[24], (const float*)(ws + WS_WSLOT), (bf16_t*)(ws + WS_Y)};

#if PROBE_PH == 8
        pg8::gemm_phase<Epi8, Twice<MoeOrder>, true, true, MOE_FP8 != 0>(lds, g, S2, E);
#else
        { const MoeOrderLds SL = moe_list_build(S, lds, tid); pg8::gemm_phase<Epi8, MoeOrderLds, true, true, MOE_FP8 != 0>(lds, g, SL, E); }
#endif
    }
    SYNC();
#if PROBE_PH == 20
    for (int i = 0; i < 10; ++i) SYNC();
#endif
#if PROBE_PH == 40
    asm volatile(".rept 8192\n\ts_nop 0\n\t.endr" ::: "memory");
#endif
#if PROBE_PH == 41
    for (int i = 0; i < 1024; ++i) asm volatile("s_nop 0\n\ts_nop 0\n\ts_nop 0\n\ts_nop 0\n\ts_nop 0\n\ts_nop 0\n\ts_nop 0\n\ts_nop 0" ::: "memory");
#endif
#if PROBE_PH == 21 || PROBE_PH == 22 || PROBE_PH == 23
    {
        float a0 = 0.5f, a1 = 0.25f, a2 = 0.125f, a3 = 0.0625f; typedef float f2_t __attribute__((ext_vector_type(2))); f2_t b0 = {0.5f, 0.5f}, b1 = {0.25f, 0.25f}, b2 = {0.1f, 0.1f}, b3 = {0.2f, 0.2f};
        for (int i = 0; i < 4096; ++i) {
#if PROBE_PH == 21
            asm volatile("v_exp_f32 %0, %0\n\tv_exp_f32 %1, %1\n\tv_exp_f32 %2, %2\n\tv_exp_f32 %3, %3" : "+v"(a0), "+v"(a1), "+v"(a2), "+v"(a3));
#elif PROBE_PH == 22
            asm volatile("v_mul_f32 %0, %0, %0\n\tv_mul_f32 %1, %1, %1\n\tv_mul_f32 %2, %2, %2\n\tv_mul_f32 %3, %3, %3" : "+v"(a0), "+v"(a1), "+v"(a2), "+v"(a3));
#else
            asm volatile("v_pk_mul_f32 %0, %0, %0\n\tv_pk_mul_f32 %1, %1, %1\n\tv_pk_mul_f32 %2, %2, %2\n\tv_pk_mul_f32 %3, %3, %3" : "+v"(b0), "+v"(b1), "+v"(b2), "+v"(b3));
#endif
        }
        if (a0 + a1 + a2 + a3 + b0.x + b1.x + b2.x + b3.x == 123.456f) args.out[0] = 0.f;
    }
#endif
    for (int rep = 0; rep < NREP(9); ++rep) p9_final(args, gw, NGW, lane);
#if PROBE_PH == 30
    SYNC();
    }
#endif
}

extern "C" void kernel_launch(void* const* d_in, const int* in_sizes, int n_in, void* d_out, int out_size, void* d_ws, size_t ws_size, hipStream_t stream) {
    static int grid = 0;
    if (grid == 0) {
        if (n_in != 26 || in_sizes[0] != MTOK * DM || out_size != MTOK * DM || ws_size < WS_END) {
            fprintf(stderr, "kernel_launch: unexpected shapes (n_in %d, in0 %d, out %d, ws %zu < %zu)\n", n_in, n_in > 0 ? in_sizes[0] : -1, out_size, ws_size, (size_t)WS_END); grid = -1; return; }
        int dev = 0, cus = 0, per_cu = 0;
        hipGetDevice(&dev);
        hipDeviceGetAttribute(&cus, hipDeviceAttributeMultiprocessorCount, dev);
        if (hipFuncSetAttribute((const void*)hybrid_fwd, hipFuncAttributeMaxDynamicSharedMemorySize, LDS_BYTES) != hipSuccess) { fprintf(stderr, "kernel_launch: hipFuncSetAttribute failed\n"); grid = -1; return; }
        if (hipOccupancyMaxActiveBlocksPerMultiprocessor(&per_cu, (const void*)hybrid_fwd, NTHREADS, LDS_BYTES) != hipSuccess || per_cu < 1) { fprintf(stderr, "kernel_launch: occupancy query says %d\n", per_cu); per_cu = 1; }
        (void)hipGetLastError();
        grid = cus * 1;
        if (grid > cus * per_cu) grid = cus * per_cu;
    }
    if (grid < 0) return;
    if (hipMemsetAsync((unsigned char*)d_ws + WS_CTL + CTL_BAR, 0, XCD_BAR_WORDS * 4, stream) != hipSuccess) { fprintf(stderr, "kernel_launch: memset failed\n"); return; }
    Args a{};
    for (int i = 0; i < 26; ++i) a.in[i] = (const float*)d_in[i];
    a.out = (float*)d_out; a.ws = (unsigned char*)d_ws;
    void* kargs[] = {&a};
    hipError_t e = hipLaunchCooperativeKernel((const void*)hybrid_fwd, dim3(grid), dim3(NTHREADS), kargs, LDS_BYTES, stream);
    if (e != hipSuccess) fprintf(stderr, "kernel_launch: cooperative launch failed: %s (grid %d)\n", hipGetErrorString(e), grid);
}
```
